# Optimizing an MI355X kernel written in HIP

```python
import jax, jax.numpy as jnp
from jax import lax
import numpy as np

D_MODEL = 1024
BATCH = 2
SEQ = 8192
DEPTH = 1
DEC_BATCH = 128
DEC_SEQ = 4
PAST_LEN = 16384
PAGE_SIZE = 128

D_LRU = D_MODEL // 2
LRU_BLOCKS = 8
LRU_BLOCK = D_LRU // LRU_BLOCKS
LRU_CONV_W = 4
LRU_C = 8.0
N_Q_HEADS = 8
N_KV_HEADS = 2
GROUP = N_Q_HEADS // N_KV_HEADS
HEAD_DIM = 64
D_ATTN = N_Q_HEADS * HEAD_DIM
D_KV = N_KV_HEADS * HEAD_DIM
WINDOW = 128
BLOCK_Q = WINDOW
W_BUF = min(WINDOW, PAST_LEN)
D_MIX = D_LRU + D_ATTN
D_IN = 2 * D_LRU + D_ATTN + 2 * D_KV
SPLITS = (D_LRU, 2 * D_LRU, 2 * D_LRU + D_ATTN, 2 * D_LRU + D_ATTN + D_KV)
MEM_LEN = 256
N_MEM_HEADS = 4
MEM_HEAD_DIM = 128
D_MEM = N_MEM_HEADS * MEM_HEAD_DIM
D_FF = 3 * D_MODEL
FFN_CONV_W = 3
EPS = 1e-6
NEG_INF = -1e30

kernel_name = 'hymba_rglru_swa_sink_convffn_step'


def rmsnorm(x, g):
    xf = x.astype(jnp.float32)
    r = xf * lax.rsqrt(jnp.mean(xf * xf, axis=-1, keepdims=True) + EPS)
    return (r * g.astype(jnp.float32)).astype(x.dtype)


def alibi_slopes():
    m = 2.0 ** (-8.0 * np.arange(1, N_Q_HEADS + 1) / N_Q_HEADS)
    return jnp.asarray(m, jnp.float32).reshape(N_KV_HEADS, GROUP)


def causal_dwconv(x, prev, w, b):
    K = w.shape[0]
    T = x.shape[1]
    xp = jnp.concatenate([prev.astype(x.dtype), x], axis=1)
    y = b + sum(w[k] * xp[:, k:k + T] for k in range(K))
    return y, xp[:, T:]


def _lru_combine(e1, e2):
    a1, b1 = e1
    a2, b2 = e2
    return a1 * a2, a2 * b1 + b2


def rg_lru(x, h0, w_a, b_a, w_x, b_x, lam):
    B, T, _ = x.shape
    xf = x.astype(jnp.float32)
    xb = xf.reshape(B, T, LRU_BLOCKS, LRU_BLOCK)
    r = jax.nn.sigmoid(jnp.einsum('btnc,ncd->btnd', xb, w_a.astype(jnp.float32)).reshape(B, T, D_LRU) + b_a)
    i = jax.nn.sigmoid(jnp.einsum('btnc,ncd->btnd', xb, w_x.astype(jnp.float32)).reshape(B, T, D_LRU) + b_x)
    log_a = -LRU_C * r * jax.nn.softplus(-lam.astype(jnp.float32))
    a = jnp.exp(log_a)
    b = jnp.sqrt(-jnp.expm1(2.0 * log_a)) * (i * xf)
    b = b.at[:, 0].add(a[:, 0] * h0.astype(jnp.float32))
    _, h = lax.associative_scan(_lru_combine, (a, b), axis=1)
    return h.astype(x.dtype), h[:, -1].astype(x.dtype)


def sink_attention(q, k, v, dist, valid, slopes, sinks):
    s = jnp.einsum('...qhgd,...khd->...hgqk', q, k).astype(jnp.float32) * (HEAD_DIM ** -0.5)
    s = s - slopes[:, :, None, None] * dist.astype(jnp.float32)
    s = jnp.where(valid, s, NEG_INF)
    sink = jnp.broadcast_to(sinks.astype(jnp.float32).reshape(N_KV_HEADS, GROUP)[:, :, None, None], s.shape[:-1] + (1,))
    p = jax.nn.softmax(jnp.concatenate([s, sink], axis=-1), axis=-1)[..., :-1]
    return jnp.einsum('...hgqk,...khd->...qhgd', p.astype(v.dtype), v)


def swa_prompt(q, k, v, slopes, sinks):
    B, T = q.shape[:2]
    nb = T // BLOCK_Q
    qb = q.reshape(B, nb, BLOCK_Q, N_KV_HEADS, GROUP, HEAD_DIM)
    kb = k.reshape(B, nb, BLOCK_Q, N_KV_HEADS, HEAD_DIM)
    vb = v.reshape(B, nb, BLOCK_Q, N_KV_HEADS, HEAD_DIM)
    kk = jnp.concatenate([jnp.concatenate([jnp.zeros_like(kb[:, :1]), kb[:, :-1]], axis=1), kb], axis=2)
    vv = jnp.concatenate([jnp.concatenate([jnp.zeros_like(vb[:, :1]), vb[:, :-1]], axis=1), vb], axis=2)
    qi = jnp.arange(BLOCK_Q)[:, None]
    kj = jnp.arange(2 * BLOCK_Q)[None, :]
    dist = qi + BLOCK_Q - kj
    kpos = jnp.arange(nb)[:, None] * BLOCK_Q - BLOCK_Q + kj
    valid = (dist >= 0) & (dist < WINDOW) & (kpos[:, None, :] >= 0)
    o = sink_attention(qb, kk, vv, dist, valid[:, None, None], slopes, sinks)
    return o.reshape(B, T, D_ATTN), k[:, -W_BUF:], v[:, -W_BUF:]


def swa_sample(q, k, v, cache_k, cache_v, slopes, sinks):
    B, T = q.shape[:2]
    kk = jnp.concatenate([cache_k.astype(k.dtype), k], axis=1)
    vv = jnp.concatenate([cache_v.astype(v.dtype), v], axis=1)
    qi = jnp.arange(T)[:, None]
    kj = jnp.arange(W_BUF + T)[None, :]
    dist = qi + W_BUF - kj
    valid = (dist >= 0) & (dist < WINDOW)
    o = sink_attention(q.reshape(B, T, N_KV_HEADS, GROUP, HEAD_DIM), kk, vv, dist, valid, slopes, sinks)
    return o.reshape(B, T, D_ATTN), kk[:, -W_BUF:], vv[:, -W_BUF:]


def layer(x, mem_k, mem_v, conv_prev, h0, ffn_prev, swa_buf, p, slopes):
    B, T, _ = x.shape
    n1 = rmsnorm(x, p['g_mix'])
    xr, gate, q, k, v = jnp.split(n1 @ p['w_in'], SPLITS, axis=-1)
    xc, conv_state = causal_dwconv(xr, conv_prev, p['w_lru_conv'], p['b_lru_conv'])
    h, h_last = rg_lru(xc, h0, p['w_lru_a'], p['b_lru_a'], p['w_lru_x'], p['b_lru_x'], p['lru_lambda'])
    y_lru = h * jax.nn.gelu(gate)
    k = k.reshape(B, T, N_KV_HEADS, HEAD_DIM)
    v = v.reshape(B, T, N_KV_HEADS, HEAD_DIM)
    if swa_buf is None:
        y_att, buf_k, buf_v = swa_prompt(q, k, v, slopes, p['attn_sinks'])
    else:
        y_att, buf_k, buf_v = swa_sample(q, k, v, swa_buf[0], swa_buf[1], slopes, p['attn_sinks'])
    x = x + jnp.concatenate([y_lru, y_att], axis=-1) @ p['w_out']
    qc = (rmsnorm(x, p['g_cross']) @ p['w_mem_q']).reshape(B, T, N_MEM_HEADS, MEM_HEAD_DIM)
    s = jnp.einsum('bthd,bshd->bhts', qc, mem_k.astype(qc.dtype)).astype(jnp.float32) * (MEM_HEAD_DIM ** -0.5)
    pr = jax.nn.softmax(s, axis=-1)
    oc = jnp.einsum('bhts,bshd->bthd', pr.astype(x.dtype), mem_v.astype(x.dtype)).reshape(B, T, D_MEM)
    x = x + oc @ p['w_mem_o']
    n3 = rmsnorm(x, p['g_ffn'])
    g, ffn_state = causal_dwconv(n3 @ p['w_ffn_gate'], ffn_prev, p['w_ffn_conv'], p['b_ffn_conv'])
    x = x + (jax.nn.gelu(g) * (n3 @ p['w_ffn_up'])) @ p['w_ffn_down']
    return x, (buf_k, buf_v, conv_state, h_last, ffn_state)


def setup_inputs(seed: int = 0) -> dict:
    key = jax.random.key(seed)
    ks = iter(jax.random.split(key, 40))

    def nrm(shape, scale=1.0):
        return scale * jax.random.normal(next(ks), shape, jnp.float32)

    def gain(shape):
        return 1.0 + nrm(shape, 0.02)

    u = jax.random.uniform(next(ks), (DEPTH, D_LRU), jnp.float32, minval=0.9, maxval=0.999)
    sa = u ** (1.0 / LRU_C)
    lam = jnp.log(sa) - jnp.log1p(-sa)
    return {
        'x_prompt': nrm((BATCH, SEQ, D_MODEL)),
        'x_sample': nrm((DEC_BATCH, DEC_SEQ, D_MODEL)),
        'cache_swa_k': nrm((DEPTH, DEC_BATCH, W_BUF, N_KV_HEADS, HEAD_DIM)),
        'cache_swa_v': nrm((DEPTH, DEC_BATCH, W_BUF, N_KV_HEADS, HEAD_DIM)),
        'cache_mem_k': nrm((DEPTH, DEC_BATCH, MEM_LEN, N_MEM_HEADS, MEM_HEAD_DIM)),
        'cache_mem_v': nrm((DEPTH, DEC_BATCH, MEM_LEN, N_MEM_HEADS, MEM_HEAD_DIM)),
        'state_lru_conv': nrm((DEPTH, DEC_BATCH, LRU_CONV_W - 1, D_LRU)),
        'state_lru_h': nrm((DEPTH, DEC_BATCH, D_LRU)),
        'state_ffn_conv': nrm((DEPTH, DEC_BATCH, FFN_CONV_W - 1, D_FF)),
        'mem_prompt': nrm((BATCH, MEM_LEN, D_MODEL)),
        'g_mix': gain((DEPTH, D_MODEL)),
        'w_in': nrm((DEPTH, D_MODEL, D_IN), D_MODEL ** -0.5),
        'w_lru_conv': nrm((DEPTH, LRU_CONV_W, D_LRU), LRU_CONV_W ** -0.5),
        'b_lru_conv': nrm((DEPTH, D_LRU), 0.02),
        'w_lru_a': nrm((DEPTH, LRU_BLOCKS, LRU_BLOCK, LRU_BLOCK), LRU_BLOCK ** -0.5),
        'b_lru_a': nrm((DEPTH, D_LRU), 0.02),
        'w_lru_x': nrm((DEPTH, LRU_BLOCKS, LRU_BLOCK, LRU_BLOCK), LRU_BLOCK ** -0.5),
        'b_lru_x': nrm((DEPTH, D_LRU), 0.02),
        'lru_lambda': lam,
        'attn_sinks': nrm((DEPTH, N_Q_HEADS)),
        'w_out': nrm((DEPTH, D_MIX, D_MODEL), D_MIX ** -0.5),
        'g_cross': gain((DEPTH, D_MODEL)),
        'g_mem': gain((DEPTH, D_MODEL)),
        'w_mem_q': nrm((DEPTH, D_MODEL, D_MEM), D_MODEL ** -0.5),
        'w_mem_k': nrm((DEPTH, D_MODEL, D_MEM), D_MODEL ** -0.5),
        'w_mem_v': nrm((DEPTH, D_MODEL, D_MEM), D_MODEL ** -0.5),
        'w_mem_o': nrm((DEPTH, D_MEM, D_MODEL), D_MEM ** -0.5),
        'g_ffn': gain((DEPTH, D_MODEL)),
        'w_ffn_gate': nrm((DEPTH, D_MODEL, D_FF), D_MODEL ** -0.5),
        'w_ffn_up': nrm((DEPTH, D_MODEL, D_FF), D_MODEL ** -0.5),
        'w_ffn_conv': nrm((DEPTH, FFN_CONV_W, D_FF), FFN_CONV_W ** -0.5),
        'b_ffn_conv': nrm((DEPTH, D_FF), 0.02),
        'w_ffn_down': nrm((DEPTH, D_FF, D_MODEL), D_FF ** -0.5),
        'g_final': gain((D_MODEL,)),
    }


def reference(x_prompt, x_sample, cache_swa_k, cache_swa_v, cache_mem_k, cache_mem_v, state_lru_conv, state_lru_h, state_ffn_conv, mem_prompt, g_mix, w_in, w_lru_conv, b_lru_conv, w_lru_a, b_lru_a, w_lru_x, b_lru_x, lru_lambda, attn_sinks, w_out, g_cross, g_mem, w_mem_q, w_mem_k, w_mem_v, w_mem_o, g_ffn, w_ffn_gate, w_ffn_up, w_ffn_conv, b_ffn_conv, w_ffn_down, g_final):
    slopes = alibi_slopes()
    xp, xs = x_prompt, x_sample
    B = x_prompt.shape[0]
    p_states, s_states = [], []
    for l in range(DEPTH):
        p = dict(g_mix=g_mix[l], w_in=w_in[l], w_lru_conv=w_lru_conv[l], b_lru_conv=b_lru_conv[l],
                 w_lru_a=w_lru_a[l], b_lru_a=b_lru_a[l], w_lru_x=w_lru_x[l], b_lru_x=b_lru_x[l],
                 lru_lambda=lru_lambda[l], attn_sinks=attn_sinks[l], w_out=w_out[l], g_cross=g_cross[l],
                 w_mem_q=w_mem_q[l], w_mem_o=w_mem_o[l], g_ffn=g_ffn[l], w_ffn_gate=w_ffn_gate[l],
                 w_ffn_up=w_ffn_up[l], w_ffn_conv=w_ffn_conv[l], b_ffn_conv=b_ffn_conv[l], w_ffn_down=w_ffn_down[l])
        mem_n = rmsnorm(mem_prompt, g_mem[l])
        mk = (mem_n @ w_mem_k[l]).reshape(B, MEM_LEN, N_MEM_HEADS, MEM_HEAD_DIM)
        mv = (mem_n @ w_mem_v[l]).reshape(B, MEM_LEN, N_MEM_HEADS, MEM_HEAD_DIM)
        xp, (pk, pv, pconv, ph, pffn) = layer(
            xp, mk, mv,
            jnp.zeros((B, LRU_CONV_W - 1, D_LRU), xp.dtype),
            jnp.zeros((B, D_LRU), xp.dtype),
            jnp.zeros((B, FFN_CONV_W - 1, D_FF), xp.dtype),
            None, p, slopes)
        p_states.append((pk, pv, mk, mv, pconv, ph, pffn))
        xs, (sk, sv, sconv, sh, sffn) = layer(
            xs, cache_mem_k[l], cache_mem_v[l], state_lru_conv[l], state_lru_h[l], state_ffn_conv[l],
            (cache_swa_k[l], cache_swa_v[l]), p, slopes)
        s_states.append((sk, sv, sconv, sh, sffn))
    p_swa_k, p_swa_v, p_mem_k, p_mem_v, p_lru_conv, p_lru_h, p_ffn_conv = [jnp.stack(a, axis=0) for a in zip(*p_states)]
    s_swa_k, s_swa_v, s_lru_conv, s_lru_h, s_ffn_conv = [jnp.stack(a, axis=0) for a in zip(*s_states)]
    y_prompt = rmsnorm(xp, g_final)
    y_sample = rmsnorm(xs, g_final)
    return (y_prompt, y_sample, p_swa_k, p_swa_v, p_mem_k, p_mem_v, p_lru_conv, p_lru_h, p_ffn_conv, s_swa_k, s_swa_v, s_lru_conv, s_lru_h, s_ffn_conv)
```

```cpp
#include <hip/hip_runtime.h>
#include <hip/hip_cooperative_groups.h>
#include <cstdio>
#include <cstdint>
namespace cg = cooperative_groups;

#ifndef MK_N_LAUNCHES
#define MK_N_LAUNCHES 1
#endif

constexpr int MP = 16384, MS = 512, MT = MP + MS;
constexpr int DM = 1024, SEQ = 8192, DIN = 1792, DFF = 3072, DLRU = 512;
constexpr float EPS = 1e-6f;
constexpr float LOG2E = 1.4426950408889634f;
constexpr size_t O_YP = 0, O_YS = 16777216, O_PSK = 17301504, O_PSV = 17334272, O_PMK = 17367040, O_PMV = 17629184, O_PLC = 17891328,
                 O_PLH = 17894400, O_PFC = 17895424, O_SSK = 17907712, O_SSV = 20004864, O_SLC = 22102016, O_SLH = 22298624, O_SFC = 22364160;
constexpr size_t MiB = 1u << 20;
constexpr size_t WS_SSQ0 = 0, WS_SSQ1 = 128 * 1024, WS_SSQ2 = 256 * 1024, WS_SSQ3 = 384 * 1024, WS_SSQM = 512 * 1024, WS_SUMM = 640 * 1024;
constexpr size_t WS_WIN = 1 * MiB, WS_WOUT = 5 * MiB, WS_WQ = 7 * MiB, WS_WKV = 8 * MiB, WS_WMO = 10 * MiB, WS_WGU = 11 * MiB, WS_WD = 23 * MiB;
constexpr size_t WS_MEMA = 29 * MiB, WS_MEMKV = 30 * MiB, WS_EDGE = 31 * MiB, WS_XB = 50 * MiB, WS_PROJ = 83 * MiB, WS_MIX = 141 * MiB, WS_QC = 174 * MiB, WS_OC = 191 * MiB;
constexpr size_t WS_H = 83 * MiB;
constexpr size_t WS_END = 208 * MiB;
static_assert(WS_EDGE + (size_t)264 * 6 * 3072 * 4 <= WS_XB && WS_XB + (size_t)MT * 1024 * 2 <= WS_PROJ && WS_PROJ + (size_t)MT * DIN * 2 <= WS_MIX &&
              WS_MIX + (size_t)MT * 1024 * 2 <= WS_QC && WS_QC + (size_t)MT * 512 * 2 <= WS_OC && WS_OC + (size_t)MT * 512 * 2 <= WS_END && WS_H + (size_t)MT * DFF * 2 <= WS_OC, "ws map");

__device__ __forceinline__ unsigned pkbf(float lo, float hi) {
    typedef float f2_t __attribute__((ext_vector_type(2))); typedef __bf16 b2_t __attribute__((ext_vector_type(2)));
    f2_t v = {lo, hi}; b2_t b = __builtin_convertvector(v, b2_t); return __builtin_bit_cast(unsigned, b);
}
__device__ __forceinline__ float bf2f(unsigned short x) { return __uint_as_float((unsigned)x << 16); }
__device__ __forceinline__ float bflo(unsigned x) { return __uint_as_float(x << 16); }
__device__ __forceinline__ float bfhi(unsigned x) { return __uint_as_float(x & 0xffff0000u); }
__device__ __forceinline__ float fexp2(float x) { return __builtin_amdgcn_exp2f(x); }
__device__ __forceinline__ float frcp(float x) { return __builtin_amdgcn_rcpf(x); }
__device__ __forceinline__ float sigmoidf_(float x) { return frcp(1.0f + fexp2(-LOG2E * x)); }
__device__ __forceinline__ float gelu_tanh(float x) {
    const float t = x * (1.0f + 0.044715f * x * x);
    return x * frcp(1.0f + fexp2(-2.302208198f * t));
}
namespace pg8 {
#define PG8_LAS __attribute__((address_space(3)))
typedef unsigned short bf16_t;
typedef short bf16x8 __attribute__((ext_vector_type(8)));
typedef float f32x4 __attribute__((ext_vector_type(4)));
typedef unsigned u32x4 __attribute__((ext_vector_type(4)));
constexpr int BM = 256, BK = 64, HALF = 128, HTB = HALF * BK * 2  , STAGE_BYTES = 8 * HTB, NXCD = 8, WGM = 8;

__host__ __device__ __forceinline__ int lds_byte(int r, int c) { const int st = (r >> 4) * 2 + (c >> 5), rr = r & 15, cc = c & 31, ob = rr * 64 + cc * 2; return st * 1024 + (ob ^ (((ob >> 9) & 1) << 5)); }
__host__ __device__ __forceinline__ void stage_rc(int b, int& R, int& C) { const int st = b / 1024, sb = b % 1024, swz = sb ^ (((sb >> 9) & 1) << 5); R = (st >> 1) * 16 + swz / 64; C = (st & 1) * 32 + (swz % 64) / 2; }
__host__ __device__ __forceinline__ int perm32(int rho) { const int n = rho >> 4, i = rho & 15; return 8 * (i >> 2) + 4 * n + (i & 3); }

struct Unit { int pm, pn; };
struct Gemm { const bf16_t* A; const bf16_t* Bt; int M, N, K; };

struct StaticOrder {
    int nM, nN, nwg, G, c;
    __host__ __device__ void init(int M, int N, int G_, int c_) { nM = M / BM; nN = N / BM; nwg = nM * nN; G = G_; c = c_; }
    __host__ __device__ bool next(int i, Unit& u) const {
        const long L = (long)i * G + c; if (L >= nwg) return false;
        int wgid = (int)L; { const int q = nwg / NXCD, r = nwg % NXCD, xcd = wgid % NXCD, off = wgid / NXCD; wgid = (xcd < r ? xcd * (q + 1) : r * (q + 1) + (xcd - r) * q) + off; }
        const int nig = WGM * nN, gid = wgid / nig, fm = gid * WGM, gsz = (nM - fm) < WGM ? (nM - fm) : WGM;
        u.pm = fm + ((wgid % nig) % gsz); u.pn = (wgid % nig) / gsz; return true;
    }
    __device__ __forceinline__ void a_ready(const Unit&) const {}
    __device__ __forceinline__ void done(const Unit&) const {}
};

#define EPI_ROW(u, ai, m) ((u).pm * BM + (ai) * HALF + wr * 64 + (m) * 16 + fr)
__device__ __forceinline__ void st_bf16x8(bf16_t* p, f32x4 v0, f32x4 v1) { u32x4 w; w.x = pkbf(v0[0], v0[1]); w.y = pkbf(v0[2], v0[3]); w.z = pkbf(v1[0], v1[1]); w.w = pkbf(v1[2], v1[3]); *(u32x4*)p = w; }

struct EpiProj {
    static constexpr bool PERM = true, AFTER_DRAIN = false;
    bf16_t* proj; const float* ssq; float* out;
    __device__ __forceinline__ void operator()(const f32x4 (&acc)[2][2][4][2], const Unit& u, int wr, int wc, int fr, int fq) const {
        const int colb = u.pn * BM + wc * 32 + 8 * fq;
        const float qs = (u.pn == 4 || u.pn == 5) ? 0.125f : 1.0f;
#pragma unroll
        for (int ai = 0; ai < 2; ++ai)
#pragma unroll
            for (int m = 0; m < 4; ++m) {
                const int row = EPI_ROW(u, ai, m);
                const float rs = __builtin_amdgcn_rsqf(ssq[row] * (1.0f / 1024.0f) + EPS) * qs;
#pragma unroll
                for (int bj = 0; bj < 2; ++bj) {
                    const int col = colb + bj * HALF;
                    const f32x4 v0 = acc[ai][bj][m][0] * rs, v1 = acc[ai][bj][m][1] * rs;
                    st_bf16x8(proj + (size_t)row * DIN + col, v0, v1);
                    float* dst = nullptr;
                    if (u.pn == 6) {
                        const int kc = wc * 32 + 8 * fq;
                        if (row < MP) { const int t = row & 8191, b = row >> 13; if (t >= 8064) dst = out + (bj ? O_PSV : O_PSK) + (size_t)(b * 128 + t - 8064) * 128 + kc; }
                        else { const int r2 = row - MP, b = r2 >> 2, t = r2 & 3; dst = out + (bj ? O_SSV : O_SSK) + (size_t)(b * 128 + 124 + t) * 128 + kc; }
                    } else if (u.pn < 2) {
                        if (row < MP) { const int t = row & 8191, b = row >> 13; if (t >= 8189) dst = out + O_PLC + (size_t)(b * 3 + t - 8189) * 512 + col; }
                        else { const int r2 = row - MP, b = r2 >> 2, t = r2 & 3; if (t >= 1) dst = out + O_SLC + (size_t)(b * 3 + t - 1) * 512 + col; }
                    }
                    if (dst) { *(f32x4*)dst = v0; *(f32x4*)(dst + 4) = v1; }
                }
            }
    }
};
struct EpiMemKV {
    static constexpr bool PERM = true, AFTER_DRAIN = false;
    bf16_t* memkv; const float* ssq; float* out;
    __device__ __forceinline__ void operator()(const f32x4 (&acc)[2][2][4][2], const Unit& u, int wr, int wc, int fr, int fq) const {
        const int colb = u.pn * BM + wc * 32 + 8 * fq;
#pragma unroll
        for (int ai = 0; ai < 2; ++ai)
#pragma unroll
            for (int m = 0; m < 4; ++m) {
                const int row = EPI_ROW(u, ai, m);
                const float rs = __builtin_amdgcn_rsqf(ssq[row] * (1.0f / 1024.0f) + EPS);
#pragma unroll
                for (int bj = 0; bj < 2; ++bj) {
                    const int col = colb + bj * HALF;
                    const f32x4 v0 = acc[ai][bj][m][0] * rs, v1 = acc[ai][bj][m][1] * rs;
                    st_bf16x8(memkv + (size_t)row * 1024 + col, v0, v1);
                    float* dst = out + (col < 512 ? O_PMK + (size_t)row * 512 + col : O_PMV + (size_t)row * 512 + (col - 512));
                    *(f32x4*)dst = v0; *(f32x4*)(dst + 4) = v1;
                }
            }
    }
};
template <bool XBW> struct EpiRes {
    static constexpr bool PERM = true, AFTER_DRAIN = false;
    const float* resp; const float* ress; float* xout; bf16_t* xb; float* ssq;
    __device__ __forceinline__ void operator()(const f32x4 (&acc)[2][2][4][2], const Unit& u, int wr, int wc, int fr, int fq) const {
        const int colb = u.pn * BM + wc * 32 + 8 * fq;
#pragma unroll
        for (int ai = 0; ai < 2; ++ai)
#pragma unroll
            for (int m = 0; m < 4; ++m) {
                const int row = EPI_ROW(u, ai, m);
                const float* rp = row < MP ? resp + (size_t)row * 1024 : ress + (size_t)(row - MP) * 1024;
                float sq = 0.f;
#pragma unroll
                for (int bj = 0; bj < 2; ++bj) {
                    const int col = colb + bj * HALF;
                    const f32x4 v0 = acc[ai][bj][m][0] + *(const f32x4*)(rp + col), v1 = acc[ai][bj][m][1] + *(const f32x4*)(rp + col + 4);
                    float* op = xout + (size_t)row * 1024 + col;
                    *(f32x4*)op = v0; *(f32x4*)(op + 4) = v1;
                    if (XBW) st_bf16x8(xb + (size_t)row * 1024 + col, v0, v1);
                    sq += (v0[0] * v0[0] + v0[1] * v0[1]) + (v0[2] * v0[2] + v0[3] * v0[3]) + (v1[0] * v1[0] + v1[1] * v1[1]) + (v1[2] * v1[2] + v1[3] * v1[3]);
                }
                sq += __shfl_xor(sq, 16); sq += __shfl_xor(sq, 32);
                if (fq == 0) __hip_atomic_fetch_add(ssq + row, sq, __ATOMIC_RELAXED, __HIP_MEMORY_SCOPE_AGENT);
            }
    }
};
struct EpiQ {
    static constexpr bool PERM = true, AFTER_DRAIN = false;
    bf16_t* qc; const float* ssq;
    __device__ __forceinline__ void operator()(const f32x4 (&acc)[2][2][4][2], const Unit& u, int wr, int wc, int fr, int fq) const {
        const int colb = u.pn * BM + wc * 32 + 8 * fq;
#pragma unroll
        for (int ai = 0; ai < 2; ++ai)
#pragma unroll
            for (int m = 0; m < 4; ++m) {
                const int row = EPI_ROW(u, ai, m);
                const float rs = __builtin_amdgcn_rsqf(ssq[row] * (1.0f / 1024.0f) + EPS) * 0.08838834764831845f;
#pragma unroll
                for (int bj = 0; bj < 2; ++bj) st_bf16x8(qc + (size_t)row * 512 + colb + bj * HALF, acc[ai][bj][m][0] * rs, acc[ai][bj][m][1] * rs);
            }
    }
};
__device__ __forceinline__ float dpp_ror1(float v) { return __builtin_bit_cast(float, __builtin_amdgcn_update_dpp(0, __builtin_bit_cast(int, v), 0x121, 0xf, 0xf, false)); }
__device__ __forceinline__ float dpp_ror2(float v) { return __builtin_bit_cast(float, __builtin_amdgcn_update_dpp(0, __builtin_bit_cast(int, v), 0x122, 0xf, 0xf, false)); }
struct EpiGU {
    static constexpr bool PERM = true, AFTER_DRAIN = false;
    bf16_t* h; const float* ssq; float* edge; const float* wconv; const float* bconv; const float* state; float* out;
    __device__ __forceinline__ void operator()(const f32x4 (&acc)[2][2][4][2], const Unit& u, int wr, int wc, int fr, int fq) const {
        const int chb = u.pn * HALF + wc * 32 + 8 * fq;
        const bool sample = u.pm >= MP / BM;
#pragma unroll
        for (int n = 0; n < 2; ++n) {
            const int ch = chb + 4 * n;
            const f32x4 w0 = *(const f32x4*)(wconv + ch), w1 = *(const f32x4*)(wconv + DFF + ch), w2 = *(const f32x4*)(wconv + 2 * DFF + ch), bc = *(const f32x4*)(bconv + ch);
#pragma unroll
            for (int ai = 0; ai < 2; ++ai) {
                f32x4 p1p = {0.f, 0.f, 0.f, 0.f}, p2p = {0.f, 0.f, 0.f, 0.f};
#pragma unroll
                for (int m = 0; m < 4; ++m) {
                    const int row = EPI_ROW(u, ai, m);
                    const float rs = __builtin_amdgcn_rsqf(ssq[row] * (1.0f / 1024.0f) + EPS);
                    const f32x4 g = acc[ai][0][m][n] * rs, up = acc[ai][1][m][n] * rs;
                    f32x4 p1, p2, g1, g2;
#pragma unroll
                    for (int j = 0; j < 4; ++j) { p1[j] = dpp_ror1(g[j]); p2[j] = dpp_ror2(g[j]); }
                    if (!sample) {
                        g1 = fr >= 1 ? p1 : p1p; g2 = fr >= 2 ? p2 : p2p; p1p = p1; p2p = p2;
                        const int blk = row >> 6;
                        if (m == 0 && fr < 2) { *(f32x4*)(edge + ((size_t)blk * 6 + fr) * DFF + ch) = g; *(f32x4*)(edge + ((size_t)blk * 6 + 4 + fr) * DFF + ch) = up; }
                        if (m == 3 && fr >= 14) {
                            *(f32x4*)(edge + ((size_t)blk * 6 + 2 + (fr - 14)) * DFF + ch) = g;
                            if ((blk & 127) == 127) *(f32x4*)(out + O_PFC + (size_t)((blk >> 7) * 2 + (fr - 14)) * DFF + ch) = g;
                        }
                    } else {
                        const int r2 = row - MP, bs = r2 >> 2, t = r2 & 3;
                        f32x4 s1 = {0.f, 0.f, 0.f, 0.f}, s0 = {0.f, 0.f, 0.f, 0.f};
                        if (t < 2) s1 = *(const f32x4*)(state + ((size_t)bs * 2 + 1) * DFF + ch);
                        if (t == 0) s0 = *(const f32x4*)(state + ((size_t)bs * 2 + 0) * DFF + ch);
                        g1 = t >= 1 ? p1 : s1; g2 = t >= 2 ? p2 : (t == 1 ? s1 : s0);
                        if (t >= 2) *(f32x4*)(out + O_SFC + ((size_t)bs * 2 + (t - 2)) * DFF + ch) = g;
                    }
                    const f32x4 gc = bc + w0 * g2 + w1 * g1 + w2 * g;
                    f32x4 hv;
#pragma unroll
                    for (int j = 0; j < 4; ++j) hv[j] = gelu_tanh(gc[j]) * up[j];
                    typedef unsigned u32x2_t __attribute__((ext_vector_type(2)));
                    u32x2_t w; w.x = pkbf(hv[0], hv[1]); w.y = pkbf(hv[2], hv[3]);
                    *(u32x2_t*)(h + (size_t)row * DFF + ch) = w;
                }
            }
        }
    }
};
template <class Epi, class Sched, bool ALIGN_EPI = false, bool SP2 = false>
__device__ __forceinline__ void gemm_phase(PG8_LAS unsigned char* lds, const Gemm g, const Sched& S, const Epi& E) {
    const int tid = threadIdx.x, wid = __builtin_amdgcn_readfirstlane(tid >> 6), lane = tid & 63, wr = wid >> 2, wc = wid & 3, fr = lane & 15, fq = lane >> 4;
    const int K = g.K, nt = K / BK;
    unsigned voffA[2], voffB[2];
#pragma unroll
    for (int i = 0; i < 2; ++i) { int R, C; stage_rc(tid * 16 + i * 8192, R, C); const int Rb = Epi::PERM ? ((R & ~31) + perm32(R & 31)) : R;
        voffA[i] = (unsigned)(R * K + C) * 2u; voffB[i] = (unsigned)(Rb * K + C) * 2u; }
    const size_t kstep = (size_t)(BK * 2);
    const size_t hstep = (size_t)HALF * K * 2;
    const size_t tstep = 2 * hstep;
    const unsigned ldsw = (unsigned)wid * 1024u;
    const int aoff = lds_byte(wr * 64 + fr, fq * 8), boff = lds_byte(wc * 32 + fr, fq * 8);
#define PG8_SA(b, h) (((b) * 2 + (h)) * HTB)
#define PG8_SB(b, h) ((4 + (b) * 2 + (h)) * HTB)
#define PG8_STAGE(bufoff, gbase, voff) do { _Pragma("unroll") for (int _i = 0; _i < 2; ++_i) \
        __builtin_amdgcn_global_load_lds((const unsigned*)((const char*)(gbase) + (voff)[_i]), (PG8_LAS unsigned*)(lds + (bufoff) + ldsw + _i * 8192), 16, 0, 0); } while (0)
#define PG8_LDA(dst, b, h) do { _Pragma("unroll") for (int m = 0; m < 4; ++m) _Pragma("unroll") for (int k = 0; k < 2; ++k) dst[m][k] = *(const PG8_LAS bf16x8*)(lds + PG8_SA(b, h) + aoff + m * 2048 + k * 1024); } while (0)
#define PG8_LDB(dst, b, h) do { _Pragma("unroll") for (int n = 0; n < 2; ++n) _Pragma("unroll") for (int k = 0; k < 2; ++k) dst[n][k] = *(const PG8_LAS bf16x8*)(lds + PG8_SB(b, h) + boff + n * 2048 + k * 1024); } while (0)
#define PG8_MMA(ai, bj, At, Bt) do { __builtin_amdgcn_s_setprio(1); _Pragma("unroll") for (int m = 0; m < 4; ++m) _Pragma("unroll") for (int n = 0; n < 2; ++n) _Pragma("unroll") for (int k = 0; k < 2; ++k) \
        acc[ai][bj][m][n] = __builtin_amdgcn_mfma_f32_16x16x32_bf16(Bt[n][k], At[m][k], acc[ai][bj][m][n], 0, 0, 0); __builtin_amdgcn_s_setprio(0); } while (0)
#define PG8_WAIT_V(n) asm volatile("s_waitcnt vmcnt(" #n ")" ::: "memory")
#define PG8_WAIT_L(n) asm volatile("s_waitcnt lgkmcnt(" #n ")" ::: "memory")
#define PG8_BAR __builtin_amdgcn_s_barrier()
#define PG8_SCHED __builtin_amdgcn_sched_barrier(0)
    Unit cur, nxt; int ui = 0;
    if (!S.next(0, cur)) return;
    f32x4 acc[2][2][4][2];
#pragma unroll
    for (int a = 0; a < 2; ++a)
#pragma unroll
        for (int b = 0; b < 2; ++b)
#pragma unroll
            for (int m = 0; m < 4; ++m)
#pragma unroll
                for (int n = 0; n < 2; ++n) acc[a][b][m][n] = (f32x4){0.f, 0.f, 0.f, 0.f};
    bf16x8 At[4][2], B0[2][2], B1[2][2];
    const char* cA = (const char*)g.A + (size_t)cur.pm * tstep; const char* cB = (const char*)g.Bt + (size_t)cur.pn * tstep;
    S.a_ready(cur);
    if constexpr (SP2) {
        PG8_STAGE(PG8_SB(0, 0), cB, voffB); PG8_STAGE(PG8_SB(0, 1), cB + hstep, voffB); PG8_STAGE(PG8_SA(0, 0), cA, voffA); PG8_STAGE(PG8_SA(0, 1), cA + hstep, voffA);
        if (wr == 1) PG8_BAR;
        PG8_WAIT_V(2); PG8_BAR;
        PG8_STAGE(PG8_SB(1, 0), cB + kstep, voffB); PG8_STAGE(PG8_SA(1, 0), cA + kstep, voffA); PG8_STAGE(PG8_SB(1, 1), cB + hstep + kstep, voffB);
        PG8_WAIT_V(6); PG8_BAR;
    } else {
        PG8_STAGE(PG8_SB(0, 0), cB, voffB); PG8_STAGE(PG8_SA(0, 0), cA, voffA); PG8_STAGE(PG8_SB(0, 1), cB + hstep, voffB); PG8_STAGE(PG8_SA(0, 1), cA + hstep, voffA);
        if (wr == 1) PG8_BAR;
        PG8_WAIT_V(4); PG8_BAR;
        PG8_STAGE(PG8_SB(1, 0), cB + kstep, voffB); PG8_STAGE(PG8_SA(1, 0), cA + kstep, voffA); PG8_STAGE(PG8_SB(1, 1), cB + hstep + kstep, voffB);
        PG8_WAIT_V(6); PG8_BAR;
    }
    for (;;) {
        const bool has_next = S.next(ui + 1, nxt);
        const char* nA = has_next ? (const char*)g.A + (size_t)nxt.pm * tstep : cA; const char* nB = has_next ? (const char*)g.Bt + (size_t)nxt.pn * tstep : cB;
        for (int t = 0; t < nt; t += 2) {
            const bool last = (t == nt - 2);
            const char* a1 = cA + (size_t)(t + 1) * kstep;
            const char* a2 = last ? nA : cA + (size_t)(t + 2) * kstep; const char* b2 = last ? nB : cB + (size_t)(t + 2) * kstep;
            const char* a3 = a2 + kstep; const char* b3 = b2 + kstep;
            if (last && has_next) S.a_ready(nxt);
            if constexpr (SP2) {
            PG8_LDB(B0, 0, 0); PG8_LDB(B1, 0, 1); PG8_SCHED; PG8_LDA(At, 0, 0); PG8_STAGE(PG8_SA(1, 1), a1 + hstep, voffA);
            PG8_WAIT_V(8); PG8_WAIT_L(0); PG8_BAR; PG8_MMA(0, 0, At, B0); PG8_MMA(0, 1, At, B1); PG8_BAR; PG8_SCHED;
            PG8_LDA(At, 0, 1); PG8_STAGE(PG8_SB(0, 0), b2, voffB); PG8_STAGE(PG8_SB(0, 1), b2 + hstep, voffB); PG8_STAGE(PG8_SA(0, 0), a2, voffA);
            PG8_WAIT_V(8); PG8_WAIT_L(0); PG8_BAR; PG8_MMA(1, 0, At, B0); PG8_MMA(1, 1, At, B1); PG8_BAR; PG8_SCHED;
            PG8_LDB(B0, 1, 0); PG8_LDB(B1, 1, 1); PG8_SCHED; PG8_LDA(At, 1, 0); PG8_STAGE(PG8_SA(0, 1), a2 + hstep, voffA);
            PG8_WAIT_V(8); PG8_WAIT_L(0); PG8_BAR; PG8_MMA(0, 0, At, B0); PG8_MMA(0, 1, At, B1); PG8_BAR; PG8_SCHED;
            PG8_LDA(At, 1, 1); PG8_STAGE(PG8_SB(1, 0), b3, voffB); PG8_STAGE(PG8_SB(1, 1), b3 + hstep, voffB); PG8_STAGE(PG8_SA(1, 0), a3, voffA);
            PG8_WAIT_V(8); PG8_WAIT_L(0); PG8_BAR; PG8_MMA(1, 0, At, B0); PG8_MMA(1, 1, At, B1); PG8_BAR; PG8_SCHED;
            } else {
            PG8_LDB(B0, 0, 0); PG8_SCHED; PG8_LDA(At, 0, 0); PG8_STAGE(PG8_SA(1, 1), a1 + hstep, voffA);
            PG8_WAIT_L(8); PG8_BAR; PG8_WAIT_L(0); PG8_MMA(0, 0, At, B0); PG8_BAR; PG8_SCHED;
            PG8_LDB(B1, 0, 1); PG8_STAGE(PG8_SB(0, 0), b2, voffB);
            PG8_BAR; PG8_WAIT_L(0); PG8_MMA(0, 1, At, B1); PG8_BAR;
            PG8_LDA(At, 0, 1); PG8_STAGE(PG8_SA(0, 0), a2, voffA);
            PG8_BAR; PG8_WAIT_L(0); PG8_MMA(1, 0, At, B0); PG8_BAR; PG8_SCHED;
            PG8_STAGE(PG8_SB(0, 1), b2 + hstep, voffB);
            PG8_WAIT_V(6); PG8_BAR; PG8_MMA(1, 1, At, B1); PG8_BAR;
            PG8_LDB(B0, 1, 0); PG8_SCHED; PG8_LDA(At, 1, 0); PG8_STAGE(PG8_SA(0, 1), a2 + hstep, voffA);
            PG8_WAIT_L(8); PG8_BAR; PG8_WAIT_L(0); PG8_MMA(0, 0, At, B0); PG8_BAR; PG8_SCHED;
            PG8_LDB(B1, 1, 1); PG8_STAGE(PG8_SB(1, 0), b3, voffB);
            PG8_BAR; PG8_WAIT_L(0); PG8_MMA(0, 1, At, B1); PG8_BAR;
            PG8_LDA(At, 1, 1); PG8_STAGE(PG8_SA(1, 0), a3, voffA);
            PG8_BAR; PG8_WAIT_L(0); PG8_MMA(1, 0, At, B0); PG8_BAR; PG8_SCHED;
            PG8_STAGE(PG8_SB(1, 1), b3 + hstep, voffB);
            PG8_WAIT_V(6); PG8_BAR; PG8_MMA(1, 1, At, B1); PG8_BAR;
            }
        }
        if constexpr (ALIGN_EPI) { if (wr == 0) PG8_BAR; }
        if constexpr (!Epi::AFTER_DRAIN) { E(acc, cur, wr, wc, fr, fq); S.done(cur); }
        if (!has_next) break;
#pragma unroll
        for (int a = 0; a < 2; ++a)
#pragma unroll
            for (int b = 0; b < 2; ++b)
#pragma unroll
                for (int m = 0; m < 4; ++m)
#pragma unroll
                    for (int n = 0; n < 2; ++n) acc[a][b][m][n] = (f32x4){0.f, 0.f, 0.f, 0.f};
        cur = nxt; cA = nA; cB = nB; ++ui;
        if constexpr (ALIGN_EPI) { if (wr == 1) PG8_BAR; }
    }
    PG8_WAIT_V(0);
    if constexpr (!ALIGN_EPI) { if (wr == 0) PG8_BAR; }
    PG8_BAR;
    if constexpr (Epi::AFTER_DRAIN) { E.fused(acc, cur, wr, wc, fr, fq, lds, wid, lane); S.done(cur); }
#undef PG8_SA
#undef PG8_SB
#undef PG8_STAGE
#undef PG8_LDA
#undef PG8_LDB
#undef PG8_MMA
#undef PG8_WAIT_V
#undef PG8_WAIT_L
#undef PG8_BAR
#undef PG8_SCHED
}
}

#define LAS __attribute__((address_space(3)))
typedef unsigned short bf16_t;
typedef short bf16x8 __attribute__((ext_vector_type(8)));
typedef short s16x4 __attribute__((ext_vector_type(4)));
typedef float f32x4 __attribute__((ext_vector_type(4)));
typedef float f32x16 __attribute__((ext_vector_type(16)));
typedef unsigned u32x4 __attribute__((ext_vector_type(4)));
typedef unsigned u32x2 __attribute__((ext_vector_type(2)));
typedef LAS unsigned char* ldsp;
constexpr int NWAVES = 8, NTHREADS = 512, LDS_BYTES = 147456;
#define MFMA32(a, b, c) __builtin_amdgcn_mfma_f32_32x32x16_bf16((a), (b), (c), 0, 0, 0)
#define MFMA16(a, b, c) __builtin_amdgcn_mfma_f32_16x16x32_bf16((a), (b), (c), 0, 0, 0)
__device__ __forceinline__ int crow(int r, int hi) { return (r & 3) + 8 * (r >> 2) + 4 * hi; }
__device__ __forceinline__ unsigned f2bf(float f) { return pkbf(f, 0.f) & 0xffffu; }
__device__ __forceinline__ float wave_sum(float v) {
#pragma unroll
    for (int o = 1; o < 64; o <<= 1) v += __shfl_xor(v, o);
    return v;
}
__device__ __forceinline__ bf16x8 pack8(const f32x16& x, int s) {
    u32x4 p; p.x = pkbf(x[8 * s], x[8 * s + 1]); p.y = pkbf(x[8 * s + 2], x[8 * s + 3]); p.z = pkbf(x[8 * s + 4], x[8 * s + 5]); p.w = pkbf(x[8 * s + 6], x[8 * s + 7]);
    return __builtin_bit_cast(bf16x8, p);
}

struct Args {
    const float* in[34]; float* out; unsigned char* ws; int ph_lo, ph_hi;
};
enum { I_XP = 0, I_XS, I_CSK, I_CSV, I_CMK, I_CMV, I_SLC, I_SLH, I_SFC, I_MEMP, I_GMIX, I_WIN, I_WLC, I_BLC, I_WLA, I_BLA, I_WLX, I_BLX, I_LAM, I_SINK, I_WOUT, I_GCROSS, I_GMEM,
       I_WMQ, I_WMK, I_WMV, I_WMO, I_GFFN, I_WFG, I_WFU, I_WFC, I_BFC, I_WFD, I_GFIN };

__device__ __forceinline__ void p0_transpose_item(const float* W, const float* g, int K, int N, bf16_t* WT, int row_off, int ilv, LAS float* scr, int item, int lane) {
    const int nblk = N / 32, kb = item / nblk, nb = item % nblk, k0 = 64 * kb, n0 = 32 * nb;
#pragma unroll 8
    for (int i = 0; i < 32; ++i) { const int kk = 2 * i + (lane >> 5); const float s = g ? g[k0 + kk] : 1.0f; scr[kk * 33 + (lane & 31)] = W[(size_t)(k0 + kk) * N + n0 + (lane & 31)] * s; }
    asm volatile("s_waitcnt lgkmcnt(0)" ::: "memory");
    const int c = lane & 7;
    const int rbase = ilv ? (((n0 >> 7) << 8) + (n0 & 127) + (ilv == 2 ? 128 : 0)) : (row_off + n0);
#pragma unroll
    for (int j = 0; j < 4; ++j) { const int n = (lane >> 3) + 8 * j; const LAS float* s = scr + (8 * c) * 33 + n;
        u32x4 o; o.x = pkbf(s[0 * 33], s[1 * 33]); o.y = pkbf(s[2 * 33], s[3 * 33]); o.z = pkbf(s[4 * 33], s[5 * 33]); o.w = pkbf(s[6 * 33], s[7 * 33]);
        *(u32x4*)(WT + (size_t)(rbase + n) * K + k0 + 8 * c) = o; }
    asm volatile("s_waitcnt lgkmcnt(0)" ::: "memory");
}
__device__ __forceinline__ void row_to_bf16(const float* xrow, bf16_t* orow, float* ssq, int lane) {
    const f32x4* xr = (const f32x4*)xrow + lane;
    f32x4 v[4]; float s = 0.f;
#pragma unroll
    for (int j = 0; j < 4; ++j) { v[j] = xr[64 * j]; s += (v[j].x * v[j].x + v[j].y * v[j].y) + (v[j].z * v[j].z + v[j].w * v[j].w); }
    s = wave_sum(s);
    u32x2* o8 = (u32x2*)orow + lane;
#pragma unroll
    for (int j = 0; j < 4; ++j) { u32x2 w; w.x = pkbf(v[j].x, v[j].y); w.y = pkbf(v[j].z, v[j].w); o8[64 * j] = w; }
    if (lane == 0) *ssq = s;
}
__device__ __forceinline__ void p0_prologue(const Args& a, ldsp lds, int tid, int lane, int wave) {
    unsigned char* ws = a.ws;
    LAS float* scr = (LAS float*)(lds + wave * 16384);
    const int gw = blockIdx.x * NWAVES + wave, NGW = gridDim.x * NWAVES;
    constexpr int I_IN = 16 * 56, I_OUT = 16 * 32, I_Q = 16 * 16, I_MO = 8 * 32, I_G = 16 * 96, I_D = 48 * 32;
    constexpr int NITEMS = I_IN + I_OUT + 3 * I_Q + I_MO + 2 * I_G + I_D;
    for (int it = gw; it < NITEMS; it += NGW) {
        int r = it;
        if (r < I_IN) { p0_transpose_item(a.in[I_WIN], a.in[I_GMIX], 1024, DIN, (bf16_t*)(ws + WS_WIN), 0, 0, scr, r, lane); continue; } r -= I_IN;
        if (r < I_OUT) { p0_transpose_item(a.in[I_WOUT], nullptr, 1024, 1024, (bf16_t*)(ws + WS_WOUT), 0, 0, scr, r, lane); continue; } r -= I_OUT;
        if (r < I_Q) { p0_transpose_item(a.in[I_WMQ], a.in[I_GCROSS], 1024, 512, (bf16_t*)(ws + WS_WQ), 0, 0, scr, r, lane); continue; } r -= I_Q;
        if (r < I_Q) { p0_transpose_item(a.in[I_WMK], a.in[I_GMEM], 1024, 512, (bf16_t*)(ws + WS_WKV), 0, 0, scr, r, lane); continue; } r -= I_Q;
        if (r < I_Q) { p0_transpose_item(a.in[I_WMV], a.in[I_GMEM], 1024, 512, (bf16_t*)(ws + WS_WKV), 512, 0, scr, r, lane); continue; } r -= I_Q;
        if (r < I_MO) { p0_transpose_item(a.in[I_WMO], nullptr, 512, 1024, (bf16_t*)(ws + WS_WMO), 0, 0, scr, r, lane); continue; } r -= I_MO;
        if (r < I_G) { p0_transpose_item(a.in[I_WFG], a.in[I_GFFN], 1024, DFF, (bf16_t*)(ws + WS_WGU), 0, 1, scr, r, lane); continue; } r -= I_G;
        if (r < I_G) { p0_transpose_item(a.in[I_WFU], a.in[I_GFFN], 1024, DFF, (bf16_t*)(ws + WS_WGU), 0, 2, scr, r, lane); continue; } r -= I_G;
        p0_transpose_item(a.in[I_WFD], nullptr, DFF, 1024, (bf16_t*)(ws + WS_WD), 0, 0, scr, r, lane);
    }
    bf16_t* xb = (bf16_t*)(ws + WS_XB); float* ssq0 = (float*)(ws + WS_SSQ0);
    for (int m = gw; m < MT + 512; m += NGW) {
        if (m < MP) row_to_bf16(a.in[I_XP] + (size_t)m * 1024, xb + (size_t)m * 1024, ssq0 + m, lane);
        else if (m < MT) row_to_bf16(a.in[I_XS] + (size_t)(m - MP) * 1024, xb + (size_t)m * 1024, ssq0 + m, lane);
        else { const int r = m - MT; row_to_bf16(a.in[I_MEMP] + (size_t)r * 1024, (bf16_t*)(ws + WS_MEMA) + (size_t)r * 1024, (float*)(ws + WS_SSQM) + r, lane); }
    }
    for (int i = blockIdx.x * NTHREADS + tid; i < MT; i += gridDim.x * NTHREADS) { ((float*)(ws + WS_SSQ1))[i] = 0.f; ((float*)(ws + WS_SSQ2))[i] = 0.f; ((float*)(ws + WS_SSQ3))[i] = 0.f; }
}

template <bool SAMPLE, int PASS>
__device__ __forceinline__ void lru_unit(const Args& a, ldsp lds, int unit, int tid, int lane, int w) {
    constexpr int NTOK = SAMPLE ? 64 : 256, NROW = SAMPLE ? (NTOK / 4) * 7 : NTOK + 3, RS = 272;
    const ldsp XR = lds, XC = lds + 259 * RS;
    unsigned char* ws = a.ws;
    const bf16_t* proj = (const bf16_t*)(ws + WS_PROJ);
    int b = 0, chunk, bp;
    if (!SAMPLE) { b = unit >> 7; chunk = (unit >> 2) & 31; bp = unit & 3; } else { chunk = unit >> 2; bp = unit & 3; }
    const int c0 = bp * 128;
    const int row0 = SAMPLE ? MP + chunk * 64 : b * SEQ + chunk * 256;
    __syncthreads();
    for (int it = tid; it < NROW * 16; it += NTHREADS) {
        const int r = it >> 4, cq = it & 15;
        u32x4 v = {0u, 0u, 0u, 0u};
        if (!SAMPLE) { const int t = chunk * 256 - 3 + r; if (t >= 0) v = *(const u32x4*)(proj + (size_t)(b * SEQ + t) * DIN + c0 + cq * 8); }
        else { const int bl = r / 7, rr = r % 7, bs = chunk * 16 + bl;
            if (rr >= 3) v = *(const u32x4*)(proj + (size_t)(MP + bs * 4 + rr - 3) * DIN + c0 + cq * 8);
            else { const float* s = a.in[I_SLC] + (size_t)(bs * 3 + rr) * 512 + c0 + cq * 8; const f32x4 s0 = *(const f32x4*)s, s1 = *(const f32x4*)(s + 4);
                v.x = pkbf(s0[0], s0[1]); v.y = pkbf(s0[2], s0[3]); v.z = pkbf(s1[0], s1[1]); v.w = pkbf(s1[2], s1[3]); } }
        *(LAS u32x4*)(XR + r * RS + cq * 16) = v;
    }
    __syncthreads();
    {
        const int cq = tid & 15, tg = tid >> 4;
        float wk[4][8], bb[8];
#pragma unroll
        for (int j = 0; j < 8; ++j) { bb[j] = a.in[I_BLC][c0 + cq * 8 + j];
#pragma unroll
            for (int k = 0; k < 4; ++k) wk[k][j] = a.in[I_WLC][k * 512 + c0 + cq * 8 + j]; }
#pragma unroll
        for (int q = 0; q < NTOK / 32; ++q) {
            const int tok = tg * (NTOK / 32) + q; const int base = SAMPLE ? (tok >> 2) * 7 + (tok & 3) : tok;
            float x[8];
#pragma unroll
            for (int j = 0; j < 8; ++j) x[j] = bb[j];
#pragma unroll
            for (int k = 0; k < 4; ++k) { const u32x4 v = *(const LAS u32x4*)(XR + (base + k) * RS + cq * 16);
                x[0] += wk[k][0] * bflo(v.x); x[1] += wk[k][1] * bfhi(v.x); x[2] += wk[k][2] * bflo(v.y); x[3] += wk[k][3] * bfhi(v.y);
                x[4] += wk[k][4] * bflo(v.z); x[5] += wk[k][5] * bfhi(v.z); x[6] += wk[k][6] * bflo(v.w); x[7] += wk[k][7] * bfhi(v.w); }
            u32x4 o; o.x = pkbf(x[0], x[1]); o.y = pkbf(x[2], x[3]); o.z = pkbf(x[4], x[5]); o.w = pkbf(x[6], x[7]);
            *(LAS u32x4*)(XC + tok * RS + cq * 16) = o;
        }
    }
    __syncthreads();
    const int nb = w >> 2, jt = w & 3, n = bp * 2 + nb, fr = lane & 15, fq = lane >> 4;
    const int ch = n * 64 + jt * 16 + fr, chl = nb * 64 + jt * 16 + fr;
    bf16x8 bA[2], bX[2];
#pragma unroll
    for (int kh = 0; kh < 2; ++kh)
#pragma unroll
        for (int j = 0; j < 8; ++j) { const int c = kh * 32 + 8 * fq + j; const size_t o = (size_t)(n * 64 + c) * 64 + jt * 16 + fr;
            bA[kh][j] = (short)f2bf(a.in[I_WLA][o]); bX[kh][j] = (short)f2bf(a.in[I_WLX][o]); }
    const float ba_ = a.in[I_BLA][ch], bx_ = a.in[I_BLX][ch];
    const float lam = a.in[I_LAM][ch];
    const float sp = (lam > 15.f) ? __expf(-lam) : log1pf(__expf(-lam));
    const float k8 = -8.0f * sp * LOG2E;
    const float wc0 = a.in[I_WLC][ch], wc1 = a.in[I_WLC][512 + ch], wc2 = a.in[I_WLC][1024 + ch], wc3 = a.in[I_WLC][1536 + ch], bcv = a.in[I_BLC][ch];
    float hc = 0.f, Atot = 1.f, Htot = 0.f;
    float* summ = (float*)(ws + WS_SUMM);
    if (!SAMPLE && PASS == 2) { for (int j = 0; j < chunk; ++j) { const float A = summ[((size_t)(b * 32 + j) * 512 + ch) * 2], H = summ[((size_t)(b * 32 + j) * 512 + ch) * 2 + 1]; hc = A * hc + H; } }
    bf16_t* mix = (bf16_t*)(ws + WS_MIX);
    for (int s = 0; s < NTOK / 16; ++s) {
        bf16x8 aF[2];
#pragma unroll
        for (int kh = 0; kh < 2; ++kh) aF[kh] = *(const LAS bf16x8*)(XC + (16 * s + fr) * RS + (nb * 64 + kh * 32 + 8 * fq) * 2);
        f32x4 accA = {0.f, 0.f, 0.f, 0.f}, accX = {0.f, 0.f, 0.f, 0.f};
        accA = MFMA16(aF[0], bA[0], accA); accA = MFMA16(aF[1], bA[1], accA);
        accX = MFMA16(aF[0], bX[0], accX); accX = MFMA16(aF[1], bX[1], accX);
        const int base = SAMPLE ? (4 * s + fq) * 7 : 16 * s + 4 * fq;
        float x7[7];
#pragma unroll
        for (int q = 0; q < 7; ++q) x7[q] = bf2f(*(const LAS unsigned short*)(XR + (base + q) * RS + chl * 2));
        float av[4], bv[4];
#pragma unroll
        for (int r = 0; r < 4; ++r) {
            const float xc = bcv + wc0 * x7[r] + wc1 * x7[r + 1] + wc2 * x7[r + 2] + wc3 * x7[r + 3];
            const float rg = sigmoidf_(accA[r] + ba_), ig = sigmoidf_(accX[r] + bx_);
            const float a_ = fexp2(k8 * rg);
            av[r] = a_; bv[r] = __builtin_sqrtf(fmaxf(1.0f - a_ * a_, 0.f)) * (ig * xc);
        }
        float hv[4];
        if (SAMPLE) {
            const int bs = chunk * 16 + 4 * s + fq;
            float h = a.in[I_SLH][(size_t)bs * 512 + ch];
#pragma unroll
            for (int r = 0; r < 4; ++r) { h = av[r] * h + bv[r]; hv[r] = h; }
            a.out[O_SLH + (size_t)bs * 512 + ch] = h;
        } else {
            float Ai = av[0] * av[1] * av[2] * av[3], Hi = 0.f;
#pragma unroll
            for (int r = 0; r < 4; ++r) Hi = av[r] * Hi + bv[r];
            float tA = __shfl_up(Ai, 16), tH = __shfl_up(Hi, 16);
            if (fq >= 1) { Hi = Ai * tH + Hi; Ai = Ai * tA; }
            tA = __shfl_up(Ai, 32); tH = __shfl_up(Hi, 32);
            if (fq >= 2) { Hi = Ai * tH + Hi; Ai = Ai * tA; }
            float Ae = __shfl_up(Ai, 16), He = __shfl_up(Hi, 16);
            if (fq == 0) { Ae = 1.f; He = 0.f; }
            const float At = __shfl(Ai, 48 + fr), Ht = __shfl(Hi, 48 + fr);
            if (PASS == 1) { Htot = At * Htot + Ht; Atot *= At; }
            else {
                float h = Ae * hc + He;
#pragma unroll
                for (int r = 0; r < 4; ++r) { h = av[r] * h + bv[r]; hv[r] = h; }
                hc = At * hc + Ht;
            }
        }
        if (SAMPLE || PASS == 2) {
#pragma unroll
            for (int r = 0; r < 4; ++r) {
                const size_t row = (size_t)row0 + 16 * s + 4 * fq + r;
                const float gt = bf2f(proj[row * DIN + 512 + ch]);
                mix[row * 1024 + ch] = (bf16_t)f2bf(hv[r] * gelu_tanh(gt));
            }
        }
    }
    if (!SAMPLE && PASS == 1 && fq == 0) { summ[((size_t)(b * 32 + chunk) * 512 + ch) * 2] = Atot; summ[((size_t)(b * 32 + chunk) * 512 + ch) * 2 + 1] = Htot; }
    if (!SAMPLE && PASS == 2 && chunk == 31 && fq == 0) a.out[O_PLH + (size_t)b * 512 + ch] = hc;
}

__device__ __forceinline__ void swa_prompt_unit(const Args& a, ldsp lds, int unit, int tid, int lane, int w) {
    constexpr int KRS = 144, VRS = 400;
    const ldsp Ks = lds, VT = lds + 192 * KRS;
    const bf16_t* proj = (const bf16_t*)(a.ws + WS_PROJ);
    const int b = unit >> 8, hk = (unit >> 7) & 1, qb = unit & 127, t0 = qb * 64;
    __syncthreads();
    for (int it = tid; it < 192 * 8; it += NTHREADS) {
        const int kl = it >> 3, cq = it & 7, t = t0 - 128 + kl;
        u32x4 kv = {0u, 0u, 0u, 0u}, vv = {0u, 0u, 0u, 0u};
        if (t >= 0) { const bf16_t* p = proj + (size_t)(b * SEQ + t) * DIN; kv = *(const u32x4*)(p + 1536 + hk * 64 + cq * 8); vv = *(const u32x4*)(p + 1664 + hk * 64 + cq * 8); }
        *(LAS u32x4*)(Ks + kl * KRS + cq * 16) = kv;
#pragma unroll
        for (int e = 0; e < 8; ++e) *(LAS unsigned short*)(VT + (cq * 8 + e) * VRS + kl * 2) = (unsigned short)(vv[e >> 1] >> (16 * (e & 1)));
    }
    __syncthreads();
    const int g = w >> 1, hf = w & 1, hq = hk * 4 + g, j = lane & 31, hi = lane >> 5;
    const size_t qrow = (size_t)b * SEQ + t0 + 32 * hf + j;
    bf16x8 qf[4];
#pragma unroll
    for (int ks = 0; ks < 4; ++ks) qf[ks] = *(const bf16x8*)(proj + qrow * DIN + 1024 + hq * 64 + 16 * ks + 8 * hi);
    const float slope2 = fexp2(-(float)(hq + 1)) * LOG2E, sink2 = a.in[I_SINK][hq] * LOG2E;
    float mx = sink2;
    f32x16 st[5];
#pragma unroll
    for (int kt = 0; kt < 5; ++kt) {
        f32x16 acc = {};
#pragma unroll
        for (int ks = 0; ks < 4; ++ks) { const bf16x8 kf = *(const LAS bf16x8*)(Ks + (32 * hf + 32 * kt + j) * KRS + (16 * ks + 8 * hi) * 2); acc = MFMA32(kf, qf[ks], acc); }
        int dbase = 128 + j - 32 * kt - 4 * hi;
        int kpb = t0 - 128 + 32 * hf + 32 * kt + 4 * hi;
        asm volatile("" : "+v"(dbase), "+v"(kpb));
#pragma unroll
        for (int r = 0; r < 16; ++r) {
            const int cr = (r & 3) + 8 * (r >> 2), dist = dbase - cr;
            const bool valid = (unsigned)dist < 128u && (kpb + cr) >= 0;
            float s = acc[r] * LOG2E - slope2 * (float)dist; s = valid ? s : -1e30f; acc[r] = s; mx = fmaxf(mx, s);
        }
        st[kt] = acc;
        __builtin_amdgcn_sched_barrier(0);
    }
    mx = fmaxf(mx, __shfl_xor(mx, 32));
    float l = 0.f;
#pragma unroll
    for (int kt = 0; kt < 5; ++kt)
#pragma unroll
        for (int r = 0; r < 16; ++r) { const float p = fexp2(st[kt][r] - mx); st[kt][r] = p; l += p; }
    l += __shfl_xor(l, 32); l += fexp2(sink2 - mx);
    const float inv = frcp(l);
    f32x16 o[2] = {};
#pragma unroll
    for (int kt = 0; kt < 5; ++kt)
#pragma unroll
        for (int s = 0; s < 2; ++s) {
            const bf16x8 pf = pack8(st[kt], s);
#pragma unroll
            for (int dt = 0; dt < 2; ++dt) {
                const int d = 32 * dt + j, kb = 32 * hf + 32 * kt + 16 * s + 4 * hi;
                const s16x4 lo = *(const LAS s16x4*)(VT + d * VRS + kb * 2), hi4 = *(const LAS s16x4*)(VT + d * VRS + (kb + 8) * 2);
                const bf16x8 vf = __builtin_shufflevector(lo, hi4, 0, 1, 2, 3, 4, 5, 6, 7);
                o[dt] = MFMA32(vf, pf, o[dt]);
            }
            __builtin_amdgcn_sched_barrier(0);
        }
    bf16_t* mix = (bf16_t*)(a.ws + WS_MIX);
#pragma unroll
    for (int dt = 0; dt < 2; ++dt)
#pragma unroll
        for (int rg = 0; rg < 4; ++rg) {
            u32x2 wv; wv.x = pkbf(o[dt][4 * rg] * inv, o[dt][4 * rg + 1] * inv); wv.y = pkbf(o[dt][4 * rg + 2] * inv, o[dt][4 * rg + 3] * inv);
            *(u32x2*)(mix + qrow * 1024 + 512 + hq * 64 + 32 * dt + 8 * rg + 4 * hi) = wv;
        }
}

__device__ __forceinline__ void swa_sample_unit(const Args& a, ldsp lds, int bs, int tid) {
    LAS float* Kc = (LAS float*)lds;
    LAS float* Vc = (LAS float*)(lds + 69696);
    LAS float* Qs = (LAS float*)(lds + 137280);
    LAS float* P = Kc;
    const bf16_t* proj = (const bf16_t*)(a.ws + WS_PROJ);
    __syncthreads();
    for (int it = tid; it < 128 * 32; it += NTHREADS) {
        const int r = it >> 5, c4 = (it & 31) * 4;
        const f32x4 kv = *(const f32x4*)(a.in[I_CSK] + (size_t)(bs * 128 + r) * 128 + c4), vv = *(const f32x4*)(a.in[I_CSV] + (size_t)(bs * 128 + r) * 128 + c4);
        *(LAS f32x4*)(Kc + r * 132 + c4) = kv; *(LAS f32x4*)(Vc + r * 128 + c4) = vv;
        if (r >= 4) { *(f32x4*)(a.out + O_SSK + (size_t)(bs * 128 + r - 4) * 128 + c4) = kv; *(f32x4*)(a.out + O_SSV + (size_t)(bs * 128 + r - 4) * 128 + c4) = vv; }
    }
    { const int i = tid >> 7, c = tid & 127; const bf16_t* p = proj + (size_t)(MP + bs * 4 + i) * DIN; Kc[(128 + i) * 132 + c] = bf2f(p[1536 + c]); Vc[(128 + i) * 128 + c] = bf2f(p[1664 + c]); }
    for (int e = tid; e < 2048; e += NTHREADS) { const int rq = e >> 6, d = e & 63, hq = rq >> 2, i = rq & 3; Qs[rq * 64 + d] = bf2f(proj[(size_t)(MP + bs * 4 + i) * DIN + 1024 + hq * 64 + d]); }
    __syncthreads();
    float sc[16];
    const int key = tid % 132, hk = tid / 132;
#pragma unroll
    for (int q = 0; q < 16; ++q) sc[q] = 0.f;
    if (tid < 264) {
#pragma unroll 1
        for (int c = 0; c < 16; ++c) {
            const f32x4 k4 = *(const LAS f32x4*)(Kc + key * 132 + hk * 64 + 4 * c);
#pragma unroll
            for (int q = 0; q < 16; ++q) { const f32x4 q4 = *(const LAS f32x4*)(Qs + (hk * 16 + q) * 64 + 4 * c); sc[q] += (k4[0] * q4[0] + k4[1] * q4[1]) + (k4[2] * q4[2] + k4[3] * q4[3]); }
        }
    }
    __syncthreads();
    if (tid < 264) {
#pragma unroll
        for (int q = 0; q < 16; ++q) { const int hq = hk * 4 + (q >> 2), i = q & 3, dist = i + 128 - key; const bool valid = dist >= 0 && dist < 128;
            const float s = sc[q] * LOG2E - fexp2(-(float)(hq + 1)) * LOG2E * (float)dist; P[(hk * 16 + q) * 132 + key] = valid ? s : -1e30f; }
    }
    __syncthreads();
    {
        const int row = tid >> 4, sub = tid & 15, hq = row >> 2; const float sink2 = a.in[I_SINK][hq] * LOG2E;
        float v[9], m = sink2;
#pragma unroll
        for (int jj = 0; jj < 9; ++jj) { const int k2 = sub + 16 * jj; v[jj] = k2 < 132 ? P[row * 132 + k2] : -1e30f; m = fmaxf(m, v[jj]); }
#pragma unroll
        for (int o = 8; o >= 1; o >>= 1) m = fmaxf(m, __shfl_xor(m, o));
        float l = 0.f;
#pragma unroll
        for (int jj = 0; jj < 9; ++jj) { v[jj] = fexp2(v[jj] - m); l += v[jj]; }
#pragma unroll
        for (int o = 8; o >= 1; o >>= 1) l += __shfl_xor(l, o);
        l += fexp2(sink2 - m);
        const float inv = 1.0f / l;
#pragma unroll
        for (int jj = 0; jj < 9; ++jj) { const int k2 = sub + 16 * jj; if (k2 < 132) P[row * 132 + k2] = v[jj] * inv; }
    }
    __syncthreads();
    {
        const int row = tid >> 4, d4 = (tid & 15) * 4, hq = row >> 2, hk2 = hq >> 2, i = row & 3;
        f32x4 acc = {0.f, 0.f, 0.f, 0.f};
#pragma unroll 4
        for (int k2 = 0; k2 < 132; ++k2) acc += P[row * 132 + k2] * *(const LAS f32x4*)(Vc + k2 * 128 + hk2 * 64 + d4);
        u32x2 wv; wv.x = pkbf(acc[0], acc[1]); wv.y = pkbf(acc[2], acc[3]);
        *(u32x2*)((bf16_t*)(a.ws + WS_MIX) + (size_t)(MP + bs * 4 + i) * 1024 + 512 + hq * 64 + d4) = wv;
    }
}

__device__ __forceinline__ void xattn_prompt_unit(const Args& a, ldsp lds, int unit, int tid, int lane, int w) {
    constexpr int KRS = 272, VRS = 528;
    const ldsp Km = lds, VmT = lds + 256 * KRS;
    const bf16_t* memkv = (const bf16_t*)(a.ws + WS_MEMKV);
    const bf16_t* qcb = (const bf16_t*)(a.ws + WS_QC);
    const int b = unit >> 7, h = (unit >> 5) & 3, qc = unit & 31;
    __syncthreads();
    for (int it = tid; it < 256 * 16; it += NTHREADS) {
        const int key = it >> 4, cq = it & 15; const bf16_t* p = memkv + (size_t)(b * 256 + key) * 1024 + h * 128 + cq * 8;
        const u32x4 kv = *(const u32x4*)p, vv = *(const u32x4*)(p + 512);
        *(LAS u32x4*)(Km + key * KRS + cq * 16) = kv;
#pragma unroll
        for (int e = 0; e < 8; ++e) *(LAS unsigned short*)(VmT + (cq * 8 + e) * VRS + key * 2) = (unsigned short)(vv[e >> 1] >> (16 * (e & 1)));
    }
    __syncthreads();
    const int j = lane & 31, hi = lane >> 5;
    const size_t qrow = (size_t)b * SEQ + qc * 256 + 32 * w + j;
    bf16x8 qf[8];
#pragma unroll
    for (int ks = 0; ks < 8; ++ks) qf[ks] = *(const bf16x8*)(qcb + qrow * 512 + h * 128 + 16 * ks + 8 * hi);
    float m = -1e30f, l = 0.f;
    f32x16 o[4] = {};
#pragma unroll
    for (int kh = 0; kh < 2; ++kh) {
        f32x16 st[4];
        float mx = -1e30f;
#pragma unroll
        for (int kt = 0; kt < 4; ++kt) {
            f32x16 acc = {};
#pragma unroll
            for (int ks = 0; ks < 8; ++ks) { const bf16x8 kf = *(const LAS bf16x8*)(Km + (128 * kh + 32 * kt + j) * KRS + (16 * ks + 8 * hi) * 2); acc = MFMA32(kf, qf[ks], acc); }
#pragma unroll
            for (int r = 0; r < 16; ++r) { acc[r] *= LOG2E; mx = fmaxf(mx, acc[r]); }
            st[kt] = acc;
        }
        mx = fmaxf(mx, __shfl_xor(mx, 32));
        const float mn = fmaxf(m, mx), scl = fexp2(m - mn);
        m = mn; l *= scl;
#pragma unroll
        for (int dt = 0; dt < 4; ++dt) o[dt] *= scl;
#pragma unroll
        for (int kt = 0; kt < 4; ++kt)
#pragma unroll
            for (int r = 0; r < 16; ++r) { const float p = fexp2(st[kt][r] - m); st[kt][r] = p; l += p; }
#pragma unroll
        for (int kt = 0; kt < 4; ++kt)
#pragma unroll
            for (int s = 0; s < 2; ++s) {
                const bf16x8 pf = pack8(st[kt], s);
#pragma unroll
                for (int dt = 0; dt < 4; ++dt) {
                    const int d = 32 * dt + j, kb = 128 * kh + 32 * kt + 16 * s + 4 * hi;
                    const s16x4 lo = *(const LAS s16x4*)(VmT + d * VRS + kb * 2), hi4 = *(const LAS s16x4*)(VmT + d * VRS + (kb + 8) * 2);
                    const bf16x8 vf = __builtin_shufflevector(lo, hi4, 0, 1, 2, 3, 4, 5, 6, 7);
                    o[dt] = MFMA32(vf, pf, o[dt]);
                }
            }
    }
    l += __shfl_xor(l, 32);
    const float inv = frcp(l);
    bf16_t* oc = (bf16_t*)(a.ws + WS_OC);
#pragma unroll
    for (int dt = 0; dt < 4; ++dt)
#pragma unroll
        for (int rg = 0; rg < 4; ++rg) {
            u32x2 wv; wv.x = pkbf(o[dt][4 * rg] * inv, o[dt][4 * rg + 1] * inv); wv.y = pkbf(o[dt][4 * rg + 2] * inv, o[dt][4 * rg + 3] * inv);
            *(u32x2*)(oc + qrow * 512 + h * 128 + 32 * dt + 8 * rg + 4 * hi) = wv;
        }
}
__device__ __forceinline__ void xattn_sample_unit(const Args& a, ldsp lds, int unit, int tid, int lane, int w) {
    LAS float* Qs = (LAS float*)lds;
    LAS float* S = (LAS float*)(lds + 2048);
    LAS float* RED = (LAS float*)(lds + 8192);
    const bf16_t* qcb = (const bf16_t*)(a.ws + WS_QC);
    const int bs = unit >> 2, h = unit & 3;
    __syncthreads();
    { const int i = tid >> 7, d = tid & 127; Qs[i * 128 + d] = bf2f(qcb[(size_t)(MP + bs * 4 + i) * 512 + h * 128 + d]); }
    __syncthreads();
    {
        const int key = tid >> 1, hf = tid & 1; const float* kp = a.in[I_CMK] + ((size_t)(bs * 256 + key) * 4 + h) * 128 + hf * 64;
        float s0 = 0.f, s1 = 0.f, s2 = 0.f, s3 = 0.f;
#pragma unroll
        for (int c = 0; c < 16; ++c) {
            const f32x4 k4 = *(const f32x4*)(kp + 4 * c);
            const f32x4 q0 = *(const LAS f32x4*)(Qs + hf * 64 + 4 * c), q1 = *(const LAS f32x4*)(Qs + 128 + hf * 64 + 4 * c), q2 = *(const LAS f32x4*)(Qs + 256 + hf * 64 + 4 * c), q3 = *(const LAS f32x4*)(Qs + 384 + hf * 64 + 4 * c);
            s0 += (k4[0] * q0[0] + k4[1] * q0[1]) + (k4[2] * q0[2] + k4[3] * q0[3]); s1 += (k4[0] * q1[0] + k4[1] * q1[1]) + (k4[2] * q1[2] + k4[3] * q1[3]);
            s2 += (k4[0] * q2[0] + k4[1] * q2[1]) + (k4[2] * q2[2] + k4[3] * q2[3]); s3 += (k4[0] * q3[0] + k4[1] * q3[1]) + (k4[2] * q3[2] + k4[3] * q3[3]);
        }
        s0 += __shfl_xor(s0, 1); s1 += __shfl_xor(s1, 1); s2 += __shfl_xor(s2, 1); s3 += __shfl_xor(s3, 1);
        if (hf == 0) { S[key] = s0 * LOG2E; S[256 + key] = s1 * LOG2E; S[512 + key] = s2 * LOG2E; S[768 + key] = s3 * LOG2E; }
    }
    __syncthreads();
    if (w < 4) {
        f32x4 v = *(const LAS f32x4*)(S + w * 256 + lane * 4);
        float m = fmaxf(fmaxf(v[0], v[1]), fmaxf(v[2], v[3]));
#pragma unroll
        for (int o = 32; o >= 1; o >>= 1) m = fmaxf(m, __shfl_xor(m, o));
        v[0] = fexp2(v[0] - m); v[1] = fexp2(v[1] - m); v[2] = fexp2(v[2] - m); v[3] = fexp2(v[3] - m);
        const float l = wave_sum((v[0] + v[1]) + (v[2] + v[3]));
        v *= (1.0f / l);
        *(LAS f32x4*)(S + w * 256 + lane * 4) = v;
    }
    __syncthreads();
    {
        const int dq = tid & 31, kg = tid >> 5; const float* vp = a.in[I_CMV] + ((size_t)(bs * 256 + kg * 16) * 4 + h) * 128 + dq * 4;
        f32x4 a0 = {0.f, 0.f, 0.f, 0.f}, a1 = a0, a2 = a0, a3 = a0;
#pragma unroll
        for (int kk = 0; kk < 16; ++kk) { const f32x4 v4 = *(const f32x4*)(vp + (size_t)kk * 512); const int k2 = kg * 16 + kk;
            a0 += S[k2] * v4; a1 += S[256 + k2] * v4; a2 += S[512 + k2] * v4; a3 += S[768 + k2] * v4; }
        *(LAS f32x4*)(RED + (kg * 4 + 0) * 128 + dq * 4) = a0; *(LAS f32x4*)(RED + (kg * 4 + 1) * 128 + dq * 4) = a1;
        *(LAS f32x4*)(RED + (kg * 4 + 2) * 128 + dq * 4) = a2; *(LAS f32x4*)(RED + (kg * 4 + 3) * 128 + dq * 4) = a3;
    }
    __syncthreads();
    { const int i = tid >> 7, d = tid & 127; float s = 0.f;
#pragma unroll
        for (int kg = 0; kg < 16; ++kg) s += RED[(kg * 4 + i) * 128 + d];
        ((bf16_t*)(a.ws + WS_OC))[(size_t)(MP + bs * 4 + i) * 512 + h * 128 + d] = (bf16_t)f2bf(s); }
}

__device__ __forceinline__ void ffn_fixup_tile(const Args& a, int pm, int tid) {
    const float* edge = (const float*)(a.ws + WS_EDGE); bf16_t* hb = (bf16_t*)(a.ws + WS_H);
    const float* wconv = a.in[I_WFC]; const float* bconv = a.in[I_BFC];
    for (int it = tid; it < 4 * 2 * 768; it += NTHREADS) {
        const int q = it / 1536, rem = it % 1536, rr = rem / 768, c4 = (rem % 768) * 4;
        const int blk = pm * 4 + q; const bool hasprev = (blk & 127) != 0;
        const f32x4 z = {0.f, 0.f, 0.f, 0.f};
        const f32x4 G0 = *(const f32x4*)(edge + ((size_t)blk * 6 + 0) * DFF + c4), G1 = *(const f32x4*)(edge + ((size_t)blk * 6 + 1) * DFF + c4);
        const f32x4 Gm2 = hasprev ? *(const f32x4*)(edge + ((size_t)(blk - 1) * 6 + 2) * DFF + c4) : z, Gm1 = hasprev ? *(const f32x4*)(edge + ((size_t)(blk - 1) * 6 + 3) * DFF + c4) : z;
        const f32x4 U = *(const f32x4*)(edge + ((size_t)blk * 6 + 4 + rr) * DFF + c4);
        const f32x4 w0 = *(const f32x4*)(wconv + c4), w1 = *(const f32x4*)(wconv + DFF + c4), w2 = *(const f32x4*)(wconv + 2 * DFF + c4), bc = *(const f32x4*)(bconv + c4);
        const f32x4 gc = rr == 0 ? (bc + w0 * Gm2 + w1 * Gm1 + w2 * G0) : (bc + w0 * Gm1 + w1 * G0 + w2 * G1);
        u32x2 wv; wv.x = pkbf(gelu_tanh(gc[0]) * U[0], gelu_tanh(gc[1]) * U[1]); wv.y = pkbf(gelu_tanh(gc[2]) * U[2], gelu_tanh(gc[3]) * U[3]);
        *(u32x2*)(hb + ((size_t)blk * 64 + rr) * DFF + c4) = wv;
    }
}

__global__ void __launch_bounds__(NTHREADS, 2) hymba_fwd(Args a) {
    extern __shared__ __attribute__((aligned(16))) unsigned char smem[];
    const ldsp lds = (ldsp)smem;
    const int tid = threadIdx.x, lane = tid & 63, w = __builtin_amdgcn_readfirstlane(tid >> 6);
    const int G = gridDim.x, bx = blockIdx.x;
    unsigned char* ws = a.ws;
    const int lo = a.ph_lo, hi = a.ph_hi;
#ifndef PHASE_MASK
#define PHASE_MASK 0xfff
#endif
#define IN(k) (((PHASE_MASK >> (k)) & 1) && lo <= (k) && (k) < hi)
#define SEAM(k) do { if (IN(k) && IN((k) + 1)) { cg::this_grid().sync(); } } while (0)
    bf16_t* XB = (bf16_t*)(ws + WS_XB);
    if (IN(0)) { p0_prologue(a, lds, tid, lane, w); }
    SEAM(0);
    if (IN(1)) {
        { pg8::Gemm g{XB, (const bf16_t*)(ws + WS_WIN), MT, DIN, 1024}; pg8::StaticOrder S; S.init(MT, DIN, G, bx);
          pg8::EpiProj E{(bf16_t*)(ws + WS_PROJ), (const float*)(ws + WS_SSQ0), a.out};
          pg8::gemm_phase<pg8::EpiProj, pg8::StaticOrder, true, true>(lds, g, S, E); }
        { pg8::Gemm g{(const bf16_t*)(ws + WS_MEMA), (const bf16_t*)(ws + WS_WKV), 512, 1024, 1024}; pg8::StaticOrder S; S.init(512, 1024, G, G - 1 - bx);
          pg8::EpiMemKV E{(bf16_t*)(ws + WS_MEMKV), (const float*)(ws + WS_SSQM), a.out};
          pg8::gemm_phase<pg8::EpiMemKV, pg8::StaticOrder, true, true>(lds, g, S, E); }
    }
    SEAM(1);
    if (IN(2)) {
        for (int u = bx; u < 416; u += G) {
            if (u < 256) lru_unit<false, 1>(a, lds, u, tid, lane, w);
            else if (u < 288) lru_unit<true, 2>(a, lds, u - 256, tid, lane, w);
            else swa_sample_unit(a, lds, u - 288, tid);
        }
    }
    SEAM(2);
    if (IN(3)) {
        for (int u = bx; u < 768; u += G) {
            if (u < 256) lru_unit<false, 2>(a, lds, u, tid, lane, w);
            else swa_prompt_unit(a, lds, u - 256, tid, lane, w);
        }
    }
    SEAM(3);
    if (IN(4)) {
        pg8::Gemm g{(const bf16_t*)(ws + WS_MIX), (const bf16_t*)(ws + WS_WOUT), MT, 1024, 1024}; pg8::StaticOrder S; S.init(MT, 1024, G, bx);
        pg8::EpiRes<true> E{a.in[I_XP], a.in[I_XS], a.out, XB, (float*)(ws + WS_SSQ1)};
        pg8::gemm_phase<pg8::EpiRes<true>, pg8::StaticOrder, true, true>(lds, g, S, E);
    }
    SEAM(4);
    if (IN(5)) {
        pg8::Gemm g{XB, (const bf16_t*)(ws + WS_WQ), MT, 512, 1024}; pg8::StaticOrder S; S.init(MT, 512, G, bx);
        pg8::EpiQ E{(bf16_t*)(ws + WS_QC), (const float*)(ws + WS_SSQ1)};
        pg8::gemm_phase<pg8::EpiQ, pg8::StaticOrder, true, true>(lds, g, S, E);
    }
    SEAM(5);
    if (IN(6)) {
        for (int u = bx; u < 768; u += G) {
            if (u < 256) xattn_prompt_unit(a, lds, u, tid, lane, w);
            else xattn_sample_unit(a, lds, u - 256, tid, lane, w);
        }
    }
    SEAM(6);
    if (IN(7)) {
        pg8::Gemm g{(const bf16_t*)(ws + WS_OC), (const bf16_t*)(ws + WS_WMO), MT, 1024, 512}; pg8::StaticOrder S; S.init(MT, 1024, G, bx);
        pg8::EpiRes<true> E{a.out, a.out + O_YS, a.out, XB, (float*)(ws + WS_SSQ2)};
        pg8::gemm_phase<pg8::EpiRes<true>, pg8::StaticOrder, true, true>(lds, g, S, E);
    }
    SEAM(7);
    if (IN(8)) {
        pg8::Gemm g{XB, (const bf16_t*)(ws + WS_WGU), MT, 2 * DFF, 1024}; pg8::StaticOrder S; S.init(MT, 2 * DFF, G, bx);
        pg8::EpiGU E{(bf16_t*)(ws + WS_H), (const float*)(ws + WS_SSQ2), (float*)(ws + WS_EDGE), a.in[I_WFC], a.in[I_BFC], a.in[I_SFC], a.out};
        pg8::gemm_phase<pg8::EpiGU, pg8::StaticOrder, true, true>(lds, g, S, E);
    }
    SEAM(8);
    if (IN(9)) {
        pg8::Gemm g{(const bf16_t*)(ws + WS_H), (const bf16_t*)(ws + WS_WD), MT, 1024, DFF}; pg8::StaticOrder S; S.init(MT, 1024, G, bx);
        pg8::Unit u;
        for (int i = 0; S.next(i, u); ++i) if (u.pm < MP / 256) ffn_fixup_tile(a, u.pm, tid);
        __builtin_amdgcn_fence(__ATOMIC_RELEASE, "agent");
        asm volatile("s_waitcnt vmcnt(0)" ::: "memory");
        __syncthreads();
        __builtin_amdgcn_fence(__ATOMIC_ACQUIRE, "agent");
        pg8::EpiRes<false> E{a.out, a.out + O_YS, a.out, nullptr, (float*)(ws + WS_SSQ3)};
        pg8::gemm_phase<pg8::EpiRes<false>, pg8::StaticOrder, true, true>(lds, g, S, E);
    }
    SEAM(9);
    if (IN(10)) {
        const float* ssq3 = (const float*)(ws + WS_SSQ3); const float* gf = a.in[I_GFIN];
        f32x4 gv[4];
#pragma unroll
        for (int j = 0; j < 4; ++j) gv[j] = *((const f32x4*)gf + lane + 64 * j);
        for (int m = bx * NWAVES + w; m < MT; m += G * NWAVES) {
            const float rs = __builtin_amdgcn_rsqf(ssq3[m] * (1.0f / 1024.0f) + EPS);
            f32x4* xr = (f32x4*)(a.out + (size_t)m * 1024) + lane;
#pragma unroll
            for (int j = 0; j < 4; ++j) xr[64 * j] = xr[64 * j] * rs * gv[j];
        }
    }
#undef IN
#undef SEAM
}
constexpr int N_PHASES = 11;

extern "C" void kernel_launch(void* const* d_in, const int* in_sizes, int n_in, void* d_out, int out_size, void* d_ws, size_t ws_size, hipStream_t stream) {
    static int grid = 0;
    if (grid == 0) {
        if (n_in != 34 || ws_size < WS_END) { fprintf(stderr, "kernel_launch: unexpected n_in %d / ws %zu\n", n_in, ws_size); grid = -1; return; }
        int dev = 0, cus = 0, per_cu = 0;
        if (hipGetDevice(&dev) != hipSuccess || hipDeviceGetAttribute(&cus, hipDeviceAttributeMultiprocessorCount, dev) != hipSuccess) { grid = -1; return; }
        if (hipFuncSetAttribute((const void*)hymba_fwd, hipFuncAttributeMaxDynamicSharedMemorySize, LDS_BYTES) != hipSuccess) { fprintf(stderr, "kernel_launch: hipFuncSetAttribute failed\n"); grid = -1; return; }
        if (hipOccupancyMaxActiveBlocksPerMultiprocessor(&per_cu, (const void*)hymba_fwd, NTHREADS, LDS_BYTES) != hipSuccess || per_cu < 1) { fprintf(stderr, "kernel_launch: occupancy query says %d\n", per_cu); per_cu = 1; }
        (void)hipGetLastError();
        grid = cus;
    }
    if (grid < 0) return;
    Args a{};
    for (int i = 0; i < 34; ++i) a.in[i] = (const float*)d_in[i];
    a.out = (float*)d_out; a.ws = (unsigned char*)d_ws;
#if MK_N_LAUNCHES == 1
    a.ph_lo = 0; a.ph_hi = N_PHASES;
    void* args[] = {&a};
    hipError_t e = hipLaunchCooperativeKernel((const void*)hymba_fwd, dim3(grid), dim3(NTHREADS), args, LDS_BYTES, stream);
    if (e != hipSuccess) fprintf(stderr, "kernel_launch: cooperative launch failed: %s (grid %d)\n", hipGetErrorString(e), grid);
#else
    for (int p = 0; p < N_PHASES; ++p) { a.ph_lo = p; a.ph_hi = p + 1; hipLaunchKernelGGL(hymba_fwd, dim3(grid), dim3(NTHREADS), LDS_BYTES, stream, a); }
#endif
}
```

```cpp
#include <hip/hip_runtime.h>
#include <hip/hip_cooperative_groups.h>
#include <cstdio>
#include <cstdint>
namespace cg = cooperative_groups;

#ifndef MK_N_LAUNCHES
#define MK_N_LAUNCHES 1
#endif

constexpr int MP = 16384, MS = 512, MT = MP + MS;
constexpr int DM = 1024, SEQ = 8192, DIN = 1792, DFF = 3072, DLRU = 512;
constexpr float EPS = 1e-6f;
constexpr float LOG2E = 1.4426950408889634f;
constexpr size_t O_YP = 0, O_YS = 16777216, O_PSK = 17301504, O_PSV = 17334272, O_PMK = 17367040, O_PMV = 17629184, O_PLC = 17891328,
                 O_PLH = 17894400, O_PFC = 17895424, O_SSK = 17907712, O_SSV = 20004864, O_SLC = 22102016, O_SLH = 22298624, O_SFC = 22364160;
constexpr size_t MiB = 1u << 20;
constexpr size_t WS_SSQ0 = 0, WS_SSQ1 = 128 * 1024, WS_SSQ2 = 256 * 1024, WS_SSQ3 = 384 * 1024, WS_SSQM = 512 * 1024, WS_SUMM = 640 * 1024;
constexpr size_t WS_WIN = 1 * MiB, WS_WOUT = 5 * MiB, WS_WQ = 7 * MiB, WS_WKV = 8 * MiB, WS_WMO = 10 * MiB, WS_WGU = 11 * MiB, WS_WD = 23 * MiB;
constexpr size_t WS_MEMA = 29 * MiB, WS_MEMKV = 30 * MiB, WS_EDGE = 31 * MiB, WS_XB = 50 * MiB, WS_PROJ = 83 * MiB, WS_MIX = 141 * MiB, WS_QC = 174 * MiB, WS_OC = 191 * MiB;
constexpr size_t WS_H = 83 * MiB;
constexpr size_t WS_END = 208 * MiB;
static_assert(WS_EDGE + (size_t)264 * 6 * 3072 * 4 <= WS_XB && WS_XB + (size_t)MT * 1024 * 2 <= WS_PROJ && WS_PROJ + (size_t)MT * DIN * 2 <= WS_MIX &&
              WS_MIX + (size_t)MT * 1024 * 2 <= WS_QC && WS_QC + (size_t)MT * 512 * 2 <= WS_OC && WS_OC + (size_t)MT * 512 * 2 <= WS_END && WS_H + (size_t)MT * DFF * 2 <= WS_OC, "ws map");

__device__ __forceinline__ unsigned pkbf(float lo, float hi) {
    typedef float f2_t __attribute__((ext_vector_type(2))); typedef __bf16 b2_t __attribute__((ext_vector_type(2)));
    f2_t v = {lo, hi}; b2_t b = __builtin_convertvector(v, b2_t); return __builtin_bit_cast(unsigned, b);
}
__device__ __forceinline__ float bf2f(unsigned short x) { return __uint_as_float((unsigned)x << 16); }
__device__ __forceinline__ float bflo(unsigned x) { return __uint_as_float(x << 16); }
__device__ __forceinline__ float bfhi(unsigned x) { return __uint_as_float(x & 0xffff0000u); }
__device__ __forceinline__ float fexp2(float x) { return __builtin_amdgcn_exp2f(x); }
__device__ __forceinline__ float frcp(float x) { return __builtin_amdgcn_rcpf(x); }
__device__ __forceinline__ float sigmoidf_(float x) { return frcp(1.0f + fexp2(-LOG2E * x)); }
__device__ __forceinline__ float gelu_tanh(float x) {
    const float t = x * (1.0f + 0.044715f * x * x);
    return x * frcp(1.0f + fexp2(-2.302208198f * t));
}
namespace pg8 {
#define PG8_LAS __attribute__((address_space(3)))
typedef unsigned short bf16_t;
typedef short bf16x8 __attribute__((ext_vector_type(8)));
typedef float f32x4 __attribute__((ext_vector_type(4)));
typedef unsigned u32x4 __attribute__((ext_vector_type(4)));
constexpr int BM = 256, BK = 64, HALF = 128, HTB = HALF * BK * 2  , STAGE_BYTES = 8 * HTB, NXCD = 8, WGM = 8;

__host__ __device__ __forceinline__ int lds_byte(int r, int c) { const int st = (r >> 4) * 2 + (c >> 5), rr = r & 15, cc = c & 31, ob = rr * 64 + cc * 2; return st * 1024 + (ob ^ (((ob >> 9) & 1) << 5)); }
__host__ __device__ __forceinline__ void stage_rc(int b, int& R, int& C) { const int st = b / 1024, sb = b % 1024, swz = sb ^ (((sb >> 9) & 1) << 5); R = (st >> 1) * 16 + swz / 64; C = (st & 1) * 32 + (swz % 64) / 2; }
__host__ __device__ __forceinline__ int perm32(int rho) { const int n = rho >> 4, i = rho & 15; return 8 * (i >> 2) + 4 * n + (i & 3); }

struct Unit { int pm, pn; };
struct Gemm { const bf16_t* A; const bf16_t* Bt; int M, N, K; };

struct StaticOrder {
    int nM, nN, nwg, G, c;
    __host__ __device__ __forceinline__ void init(int M, int N, int G_, int c_) { nM = M / BM; nN = N / BM; nwg = nM * nN; G = G_; c = c_; }
    __host__ __device__ __forceinline__ bool next(int i, Unit& u) const {
        const long L = (long)i * G + c; if (L >= nwg) return false;
        int wgid = (int)L; { const int q = nwg / NXCD, r = nwg % NXCD, xcd = wgid % NXCD, off = wgid / NXCD; wgid = (xcd < r ? xcd * (q + 1) : r * (q + 1) + (xcd - r) * q) + off; }
        const int nig = WGM * nN, gid = wgid / nig, fm = gid * WGM, gsz = (nM - fm) < WGM ? (nM - fm) : WGM;
        u.pm = fm + ((wgid % nig) % gsz); u.pn = (wgid % nig) / gsz; return true;
    }
    __device__ __forceinline__ void a_ready(const Unit&) const {}
    __device__ __forceinline__ void done(const Unit&) const {}
};

#define EPI_ROW(u, ai, m) ((u).pm * BM + (ai) * HALF + wr * 64 + (m) * 16 + fr)
__device__ __forceinline__ void st_bf16x8(bf16_t* p, f32x4 v0, f32x4 v1) { u32x4 w; w.x = pkbf(v0[0], v0[1]); w.y = pkbf(v0[2], v0[3]); w.z = pkbf(v1[0], v1[1]); w.w = pkbf(v1[2], v1[3]); *(u32x4*)p = w; }

struct EpiProj {
    static constexpr bool PERM = true, AFTER_DRAIN = false;
    bf16_t* proj; const float* ssq; float* out;
    __device__ __forceinline__ void operator()(const f32x4 (&acc)[2][2][4][2], const Unit& u, int wr, int wc, int fr, int fq) const {
        const int colb = u.pn * BM + wc * 32 + 8 * fq;
        const float qs = (u.pn == 4 || u.pn == 5) ? 0.125f : 1.0f;
#pragma unroll
        for (int ai = 0; ai < 2; ++ai)
#pragma unroll
            for (int m = 0; m < 4; ++m) {
                const int row = EPI_ROW(u, ai, m);
                const float rs = __builtin_amdgcn_rsqf(ssq[row] * (1.0f / 1024.0f) + EPS) * qs;
#pragma unroll
                for (int bj = 0; bj < 2; ++bj) {
                    const int col = colb + bj * HALF;
                    const f32x4 v0 = acc[ai][bj][m][0] * rs, v1 = acc[ai][bj][m][1] * rs;
                    st_bf16x8(proj + (size_t)row * DIN + col, v0, v1);
                    float* dst = nullptr;
                    if (u.pn == 6) {
                        const int kc = wc * 32 + 8 * fq;
                        if (row < MP) { const int t = row & 8191, b = row >> 13; if (t >= 8064) dst = out + (bj ? O_PSV : O_PSK) + (size_t)(b * 128 + t - 8064) * 128 + kc; }
                        else { const int r2 = row - MP, b = r2 >> 2, t = r2 & 3; dst = out + (bj ? O_SSV : O_SSK) + (size_t)(b * 128 + 124 + t) * 128 + kc; }
                    } else if (u.pn < 2) {
                        if (row < MP) { const int t = row & 8191, b = row >> 13; if (t >= 8189) dst = out + O_PLC + (size_t)(b * 3 + t - 8189) * 512 + col; }
                        else { const int r2 = row - MP, b = r2 >> 2, t = r2 & 3; if (t >= 1) dst = out + O_SLC + (size_t)(b * 3 + t - 1) * 512 + col; }
                    }
                    if (dst) { *(f32x4*)dst = v0; *(f32x4*)(dst + 4) = v1; }
                }
            }
    }
};
struct EpiMemKV {
    static constexpr bool PERM = true, AFTER_DRAIN = false;
    bf16_t* memkv; const float* ssq; float* out;
    __device__ __forceinline__ void operator()(const f32x4 (&acc)[2][2][4][2], const Unit& u, int wr, int wc, int fr, int fq) const {
        const int colb = u.pn * BM + wc * 32 + 8 * fq;
#pragma unroll
        for (int ai = 0; ai < 2; ++ai)
#pragma unroll
            for (int m = 0; m < 4; ++m) {
                const int row = EPI_ROW(u, ai, m);
                const float rs = __builtin_amdgcn_rsqf(ssq[row] * (1.0f / 1024.0f) + EPS);
#pragma unroll
                for (int bj = 0; bj < 2; ++bj) {
                    const int col = colb + bj * HALF;
                    const f32x4 v0 = acc[ai][bj][m][0] * rs, v1 = acc[ai][bj][m][1] * rs;
                    st_bf16x8(memkv + (size_t)row * 1024 + col, v0, v1);
                    float* dst = out + (col < 512 ? O_PMK + (size_t)row * 512 + col : O_PMV + (size_t)row * 512 + (col - 512));
                    *(f32x4*)dst = v0; *(f32x4*)(dst + 4) = v1;
                }
            }
    }
};
template <bool XBW> struct EpiRes {
    static constexpr bool PERM = true, AFTER_DRAIN = false;
    const float* resp; const float* ress; float* xout; bf16_t* xb; float* ssq;
    __device__ __forceinline__ void operator()(const f32x4 (&acc)[2][2][4][2], const Unit& u, int wr, int wc, int fr, int fq) const {
        const int colb = u.pn * BM + wc * 32 + 8 * fq;
#pragma unroll
        for (int ai = 0; ai < 2; ++ai)
#pragma unroll
            for (int m = 0; m < 4; ++m) {
                const int row = EPI_ROW(u, ai, m);
                const float* rp = row < MP ? resp + (size_t)row * 1024 : ress + (size_t)(row - MP) * 1024;
                float sq = 0.f;
#pragma unroll
                for (int bj = 0; bj < 2; ++bj) {
                    const int col = colb + bj * HALF;
                    const f32x4 v0 = acc[ai][bj][m][0] + *(const f32x4*)(rp + col), v1 = acc[ai][bj][m][1] + *(const f32x4*)(rp + col + 4);
                    float* op = xout + (size_t)row * 1024 + col;
                    *(f32x4*)op = v0; *(f32x4*)(op + 4) = v1;
                    if (XBW) st_bf16x8(xb + (size_t)row * 1024 + col, v0, v1);
                    sq += (v0[0] * v0[0] + v0[1] * v0[1]) + (v0[2] * v0[2] + v0[3] * v0[3]) + (v1[0] * v1[0] + v1[1] * v1[1]) + (v1[2] * v1[2] + v1[3] * v1[3]);
                }
                sq += __shfl_xor(sq, 16); sq += __shfl_xor(sq, 32);
                if (fq == 0) __hip_atomic_fetch_add(ssq + row, sq, __ATOMIC_RELAXED, __HIP_MEMORY_SCOPE_AGENT);
            }
    }
};
struct EpiQ {
    static constexpr bool PERM = true, AFTER_DRAIN = false;
    bf16_t* qc; const float* ssq;
    __device__ __forceinline__ void operator()(const f32x4 (&acc)[2][2][4][2], const Unit& u, int wr, int wc, int fr, int fq) const {
        const int colb = u.pn * BM + wc * 32 + 8 * fq;
#pragma unroll
        for (int ai = 0; ai < 2; ++ai)
#pragma unroll
            for (int m = 0; m < 4; ++m) {
                const int row = EPI_ROW(u, ai, m);
                const float rs = __builtin_amdgcn_rsqf(ssq[row] * (1.0f / 1024.0f) + EPS) * 0.08838834764831845f;
#pragma unroll
                for (int bj = 0; bj < 2; ++bj) st_bf16x8(qc + (size_t)row * 512 + colb + bj * HALF, acc[ai][bj][m][0] * rs, acc[ai][bj][m][1] * rs);
            }
    }
};
__device__ __forceinline__ float dpp_ror1(float v) { return __builtin_bit_cast(float, __builtin_amdgcn_update_dpp(0, __builtin_bit_cast(int, v), 0x121, 0xf, 0xf, false)); }
__device__ __forceinline__ float dpp_ror2(float v) { return __builtin_bit_cast(float, __builtin_amdgcn_update_dpp(0, __builtin_bit_cast(int, v), 0x122, 0xf, 0xf, false)); }
struct EpiGU {
    static constexpr bool PERM = true, AFTER_DRAIN = false;
    bf16_t* h; const float* ssq; float* edge; const float* wconv; const float* bconv; const float* state; float* out;
    __device__ __forceinline__ void operator()(const f32x4 (&acc)[2][2][4][2], const Unit& u, int wr, int wc, int fr, int fq) const {
        const int chb = u.pn * HALF + wc * 32 + 8 * fq;
        const bool sample = u.pm >= MP / BM;
#pragma unroll
        for (int n = 0; n < 2; ++n) {
            const int ch = chb + 4 * n;
            const f32x4 w0 = *(const f32x4*)(wconv + ch), w1 = *(const f32x4*)(wconv + DFF + ch), w2 = *(const f32x4*)(wconv + 2 * DFF + ch), bc = *(const f32x4*)(bconv + ch);
#pragma unroll
            for (int ai = 0; ai < 2; ++ai) {
                f32x4 p1p = {0.f, 0.f, 0.f, 0.f}, p2p = {0.f, 0.f, 0.f, 0.f};
#pragma unroll
                for (int m = 0; m < 4; ++m) {
                    const int row = EPI_ROW(u, ai, m);
                    const float rs = __builtin_amdgcn_rsqf(ssq[row] * (1.0f / 1024.0f) + EPS);
                    const f32x4 g = acc[ai][0][m][n] * rs, up = acc[ai][1][m][n] * rs;
                    f32x4 p1, p2, g1, g2;
#pragma unroll
                    for (int j = 0; j < 4; ++j) { p1[j] = dpp_ror1(g[j]); p2[j] = dpp_ror2(g[j]); }
                    if (!sample) {
                        g1 = fr >= 1 ? p1 : p1p; g2 = fr >= 2 ? p2 : p2p; p1p = p1; p2p = p2;
                        const int blk = row >> 6;
                        if (m == 0 && fr < 2) { *(f32x4*)(edge + ((size_t)blk * 6 + fr) * DFF + ch) = g; *(f32x4*)(edge + ((size_t)blk * 6 + 4 + fr) * DFF + ch) = up; }
                        if (m == 3 && fr >= 14) {
                            *(f32x4*)(edge + ((size_t)blk * 6 + 2 + (fr - 14)) * DFF + ch) = g;
                            if ((blk & 127) == 127) *(f32x4*)(out + O_PFC + (size_t)((blk >> 7) * 2 + (fr - 14)) * DFF + ch) = g;
                        }
                    } else {
                        const int r2 = row - MP, bs = r2 >> 2, t = r2 & 3;
                        f32x4 s1 = {0.f, 0.f, 0.f, 0.f}, s0 = {0.f, 0.f, 0.f, 0.f};
                        if (t < 2) s1 = *(const f32x4*)(state + ((size_t)bs * 2 + 1) * DFF + ch);
                        if (t == 0) s0 = *(const f32x4*)(state + ((size_t)bs * 2 + 0) * DFF + ch);
                        g1 = t >= 1 ? p1 : s1; g2 = t >= 2 ? p2 : (t == 1 ? s1 : s0);
                        if (t >= 2) *(f32x4*)(out + O_SFC + ((size_t)bs * 2 + (t - 2)) * DFF + ch) = g;
                    }
                    const f32x4 gc = bc + w0 * g2 + w1 * g1 + w2 * g;
                    f32x4 hv;
#pragma unroll
                    for (int j = 0; j < 4; ++j) hv[j] = gelu_tanh(gc[j]) * up[j];
                    typedef unsigned u32x2_t __attribute__((ext_vector_type(2)));
                    u32x2_t w; w.x = pkbf(hv[0], hv[1]); w.y = pkbf(hv[2], hv[3]);
                    *(u32x2_t*)(h + (size_t)row * DFF + ch) = w;
                }
            }
        }
    }
};
template <class Epi, class Sched, bool ALIGN_EPI = false, bool SP2 = false>
__device__ __forceinline__ void gemm_phase(PG8_LAS unsigned char* lds, const Gemm g, const Sched& S, const Epi& E) {
    const int tid = threadIdx.x, wid = __builtin_amdgcn_readfirstlane(tid >> 6), lane = tid & 63, wr = wid >> 2, wc = wid & 3, fr = lane & 15, fq = lane >> 4;
    const int K = g.K, nt = K / BK;
    unsigned voffA[2], voffB[2];
#pragma unroll
    for (int i = 0; i < 2; ++i) { int R, C; stage_rc(tid * 16 + i * 8192, R, C); const int Rb = Epi::PERM ? ((R & ~31) + perm32(R & 31)) : R;
        voffA[i] = (unsigned)(R * K + C) * 2u; voffB[i] = (unsigned)(Rb * K + C) * 2u; }
    const size_t kstep = (size_t)(BK * 2);
    const size_t hstep = (size_t)HALF * K * 2;
    const size_t tstep = 2 * hstep;
    const unsigned ldsw = (unsigned)wid * 1024u;
    const int aoff = lds_byte(wr * 64 + fr, fq * 8), boff = lds_byte(wc * 32 + fr, fq * 8);
#define PG8_SA(b, h) (((b) * 2 + (h)) * HTB)
#define PG8_SB(b, h) ((4 + (b) * 2 + (h)) * HTB)
#define PG8_STAGE(bufoff, gbase, voff) do { _Pragma("unroll") for (int _i = 0; _i < 2; ++_i) \
        __builtin_amdgcn_global_load_lds((const unsigned*)((const char*)(gbase) + (voff)[_i]), (PG8_LAS unsigned*)(lds + (bufoff) + ldsw + _i * 8192), 16, 0, 0); } while (0)
#define PG8_LDA(dst, b, h) do { _Pragma("unroll") for (int m = 0; m < 4; ++m) _Pragma("unroll") for (int k = 0; k < 2; ++k) dst[m][k] = *(const PG8_LAS bf16x8*)(lds + PG8_SA(b, h) + aoff + m * 2048 + k * 1024); } while (0)
#define PG8_LDB(dst, b, h) do { _Pragma("unroll") for (int n = 0; n < 2; ++n) _Pragma("unroll") for (int k = 0; k < 2; ++k) dst[n][k] = *(const PG8_LAS bf16x8*)(lds + PG8_SB(b, h) + boff + n * 2048 + k * 1024); } while (0)
#define PG8_MMA(ai, bj, At, Bt) do { __builtin_amdgcn_s_setprio(1); _Pragma("unroll") for (int m = 0; m < 4; ++m) _Pragma("unroll") for (int n = 0; n < 2; ++n) _Pragma("unroll") for (int k = 0; k < 2; ++k) \
        acc[ai][bj][m][n] = __builtin_amdgcn_mfma_f32_16x16x32_bf16(Bt[n][k], At[m][k], acc[ai][bj][m][n], 0, 0, 0); __builtin_amdgcn_s_setprio(0); } while (0)
#define PG8_WAIT_V(n) asm volatile("s_waitcnt vmcnt(" #n ")" ::: "memory")
#define PG8_WAIT_L(n) asm volatile("s_waitcnt lgkmcnt(" #n ")" ::: "memory")
#define PG8_BAR __builtin_amdgcn_s_barrier()
#define PG8_SCHED __builtin_amdgcn_sched_barrier(0)
    Unit cur, nxt; int ui = 0;
    if (!S.next(0, cur)) return;
    f32x4 acc[2][2][4][2];
#pragma unroll
    for (int a = 0; a < 2; ++a)
#pragma unroll
        for (int b = 0; b < 2; ++b)
#pragma unroll
            for (int m = 0; m < 4; ++m)
#pragma unroll
                for (int n = 0; n < 2; ++n) acc[a][b][m][n] = (f32x4){0.f, 0.f, 0.f, 0.f};
    bf16x8 At[4][2], B0[2][2], B1[2][2];
    const char* cA = (const char*)g.A + (size_t)cur.pm * tstep; const char* cB = (const char*)g.Bt + (size_t)cur.pn * tstep;
    S.a_ready(cur);
    if constexpr (SP2) {
        PG8_STAGE(PG8_SB(0, 0), cB, voffB); PG8_STAGE(PG8_SB(0, 1), cB + hstep, voffB); PG8_STAGE(PG8_SA(0, 0), cA, voffA); PG8_STAGE(PG8_SA(0, 1), cA + hstep, voffA);
        if (wr == 1) PG8_BAR;
        PG8_WAIT_V(2); PG8_BAR;
        PG8_STAGE(PG8_SB(1, 0), cB + kstep, voffB); PG8_STAGE(PG8_SA(1, 0), cA + kstep, voffA); PG8_STAGE(PG8_SB(1, 1), cB + hstep + kstep, voffB);
        PG8_WAIT_V(6); PG8_BAR;
    } else {
        PG8_STAGE(PG8_SB(0, 0), cB, voffB); PG8_STAGE(PG8_SA(0, 0), cA, voffA); PG8_STAGE(PG8_SB(0, 1), cB + hstep, voffB); PG8_STAGE(PG8_SA(0, 1), cA + hstep, voffA);
        if (wr == 1) PG8_BAR;
        PG8_WAIT_V(4); PG8_BAR;
        PG8_STAGE(PG8_SB(1, 0), cB + kstep, voffB); PG8_STAGE(PG8_SA(1, 0), cA + kstep, voffA); PG8_STAGE(PG8_SB(1, 1), cB + hstep + kstep, voffB);
        PG8_WAIT_V(6); PG8_BAR;
    }
    for (;;) {
        const bool has_next = S.next(ui + 1, nxt);
        const char* nA = has_next ? (const char*)g.A + (size_t)nxt.pm * tstep : cA; const char* nB = has_next ? (const char*)g.Bt + (size_t)nxt.pn * tstep : cB;
        for (int t = 0; t < nt; t += 2) {
            const bool last = (t == nt - 2);
            const char* a1 = cA + (size_t)(t + 1) * kstep;
            const char* a2 = last ? nA : cA + (size_t)(t + 2) * kstep; const char* b2 = last ? nB : cB + (size_t)(t + 2) * kstep;
            const char* a3 = a2 + kstep; const char* b3 = b2 + kstep;
            if (last && has_next) S.a_ready(nxt);
            if constexpr (SP2) {
            PG8_LDB(B0, 0, 0); PG8_LDB(B1, 0, 1); PG8_SCHED; PG8_LDA(At, 0, 0); PG8_STAGE(PG8_SA(1, 1), a1 + hstep, voffA);
            PG8_WAIT_V(8); PG8_WAIT_L(0); PG8_BAR; PG8_MMA(0, 0, At, B0); PG8_MMA(0, 1, At, B1); PG8_BAR; PG8_SCHED;
            PG8_LDA(At, 0, 1); PG8_STAGE(PG8_SB(0, 0), b2, voffB); PG8_STAGE(PG8_SB(0, 1), b2 + hstep, voffB); PG8_STAGE(PG8_SA(0, 0), a2, voffA);
            PG8_WAIT_V(8); PG8_WAIT_L(0); PG8_BAR; PG8_MMA(1, 0, At, B0); PG8_MMA(1, 1, At, B1); PG8_BAR; PG8_SCHED;
            PG8_LDB(B0, 1, 0); PG8_LDB(B1, 1, 1); PG8_SCHED; PG8_LDA(At, 1, 0); PG8_STAGE(PG8_SA(0, 1), a2 + hstep, voffA);
            PG8_WAIT_V(8); PG8_WAIT_L(0); PG8_BAR; PG8_MMA(0, 0, At, B0); PG8_MMA(0, 1, At, B1); PG8_BAR; PG8_SCHED;
            PG8_LDA(At, 1, 1); PG8_STAGE(PG8_SB(1, 0), b3, voffB); PG8_STAGE(PG8_SB(1, 1), b3 + hstep, voffB); PG8_STAGE(PG8_SA(1, 0), a3, voffA);
            PG8_WAIT_V(8); PG8_WAIT_L(0); PG8_BAR; PG8_MMA(1, 0, At, B0); PG8_MMA(1, 1, At, B1); PG8_BAR; PG8_SCHED;
            } else {
            PG8_LDB(B0, 0, 0); PG8_SCHED; PG8_LDA(At, 0, 0); PG8_STAGE(PG8_SA(1, 1), a1 + hstep, voffA);
            PG8_WAIT_L(8); PG8_BAR; PG8_WAIT_L(0); PG8_MMA(0, 0, At, B0); PG8_BAR; PG8_SCHED;
            PG8_LDB(B1, 0, 1); PG8_STAGE(PG8_SB(0, 0), b2, voffB);
            PG8_BAR; PG8_WAIT_L(0); PG8_MMA(0, 1, At, B1); PG8_BAR;
            PG8_LDA(At, 0, 1); PG8_STAGE(PG8_SA(0, 0), a2, voffA);
            PG8_BAR; PG8_WAIT_L(0); PG8_MMA(1, 0, At, B0); PG8_BAR; PG8_SCHED;
            PG8_STAGE(PG8_SB(0, 1), b2 + hstep, voffB);
            PG8_WAIT_V(6); PG8_BAR; PG8_MMA(1, 1, At, B1); PG8_BAR;
            PG8_LDB(B0, 1, 0); PG8_SCHED; PG8_LDA(At, 1, 0); PG8_STAGE(PG8_SA(0, 1), a2 + hstep, voffA);
            PG8_WAIT_L(8); PG8_BAR; PG8_WAIT_L(0); PG8_MMA(0, 0, At, B0); PG8_BAR; PG8_SCHED;
            PG8_LDB(B1, 1, 1); PG8_STAGE(PG8_SB(1, 0), b3, voffB);
            PG8_BAR; PG8_WAIT_L(0); PG8_MMA(0, 1, At, B1); PG8_BAR;
            PG8_LDA(At, 1, 1); PG8_STAGE(PG8_SA(1, 0), a3, voffA);
            PG8_BAR; PG8_WAIT_L(0); PG8_MMA(1, 0, At, B0); PG8_BAR; PG8_SCHED;
            PG8_STAGE(PG8_SB(1, 1), b3 + hstep, voffB);
            PG8_WAIT_V(6); PG8_BAR; PG8_MMA(1, 1, At, B1); PG8_BAR;
            }
        }
        if constexpr (ALIGN_EPI) { if (wr == 0) PG8_BAR; }
        if constexpr (!Epi::AFTER_DRAIN) { E(acc, cur, wr, wc, fr, fq); S.done(cur); }
        if (!has_next) break;
#pragma unroll
        for (int a = 0; a < 2; ++a)
#pragma unroll
            for (int b = 0; b < 2; ++b)
#pragma unroll
                for (int m = 0; m < 4; ++m)
#pragma unroll
                    for (int n = 0; n < 2; ++n) acc[a][b][m][n] = (f32x4){0.f, 0.f, 0.f, 0.f};
        cur = nxt; cA = nA; cB = nB; ++ui;
        if constexpr (ALIGN_EPI) { if (wr == 1) PG8_BAR; }
    }
    PG8_WAIT_V(0);
    if constexpr (!ALIGN_EPI) { if (wr == 0) PG8_BAR; }
    PG8_BAR;
    if constexpr (Epi::AFTER_DRAIN) { E.fused(acc, cur, wr, wc, fr, fq, lds, wid, lane); S.done(cur); }
#undef PG8_SA
#undef PG8_SB
#undef PG8_STAGE
#undef PG8_LDA
#undef PG8_LDB
#undef PG8_MMA
#undef PG8_WAIT_V
#undef PG8_WAIT_L
#undef PG8_BAR
#undef PG8_SCHED
}
}

#define LAS __attribute__((address_space(3)))
typedef unsigned short bf16_t;
typedef short bf16x8 __attribute__((ext_vector_type(8)));
typedef short s16x4 __attribute__((ext_vector_type(4)));
typedef float f32x4 __attribute__((ext_vector_type(4)));
typedef float f32x16 __attribute__((ext_vector_type(16)));
typedef unsigned u32x4 __attribute__((ext_vector_type(4)));
typedef unsigned u32x2 __attribute__((ext_vector_type(2)));
typedef LAS unsigned char* ldsp;
constexpr int NWAVES = 8, NTHREADS = 512, LDS_BYTES = 147456;
#define MFMA32(a, b, c) __builtin_amdgcn_mfma_f32_32x32x16_bf16((a), (b), (c), 0, 0, 0)
#define MFMA16(a, b, c) __builtin_amdgcn_mfma_f32_16x16x32_bf16((a), (b), (c), 0, 0, 0)
__device__ __forceinline__ int crow(int r, int hi) { return (r & 3) + 8 * (r >> 2) + 4 * hi; }
__device__ __forceinline__ unsigned f2bf(float f) { return pkbf(f, 0.f) & 0xffffu; }
__device__ __forceinline__ float wave_sum(float v) {
#pragma unroll
    for (int o = 1; o < 64; o <<= 1) v += __shfl_xor(v, o);
    return v;
}
__device__ __forceinline__ bf16x8 pack8(const f32x16& x, int s) {
    u32x4 p; p.x = pkbf(x[8 * s], x[8 * s + 1]); p.y = pkbf(x[8 * s + 2], x[8 * s + 3]); p.z = pkbf(x[8 * s + 4], x[8 * s + 5]); p.w = pkbf(x[8 * s + 6], x[8 * s + 7]);
    return __builtin_bit_cast(bf16x8, p);
}

struct Args {
    const float* in[34]; float* out; unsigned char* ws; int ph_lo, ph_hi;
};
typedef const __attribute__((address_space(4))) Args* KA;
enum { I_XP = 0, I_XS, I_CSK, I_CSV, I_CMK, I_CMV, I_SLC, I_SLH, I_SFC, I_MEMP, I_GMIX, I_WIN, I_WLC, I_BLC, I_WLA, I_BLA, I_WLX, I_BLX, I_LAM, I_SINK, I_WOUT, I_GCROSS, I_GMEM,
       I_WMQ, I_WMK, I_WMV, I_WMO, I_GFFN, I_WFG, I_WFU, I_WFC, I_BFC, I_WFD, I_GFIN };

#define RLX_AGENT __ATOMIC_RELAXED, __HIP_MEMORY_SCOPE_AGENT
constexpr size_t WS_BAR = 896 * 1024, BAR_ZERO_BYTES = 16384;
constexpr int MISC_OFF = LDS_BYTES - 64;
#define XB_TMO      128
#define XB_XCNT(j)  (256  + 64 * (j))
#define XB_XSUB(j)  (1280 + 64 * (j))
#define XB_XGEN(j)  (2304 + 64 * (j))
#define XB_TOP      3328
#define XB_TOPGEN   3392
#define XCD_BAR_WORDS 3456
#define XB_SPIN_CAP (1u << 18)

__device__ __forceinline__ unsigned xb_ld(unsigned* p)              { return __hip_atomic_load(p, __ATOMIC_RELAXED, __HIP_MEMORY_SCOPE_AGENT); }
__device__ __forceinline__ unsigned xb_add(unsigned* p, unsigned v) { return __hip_atomic_fetch_add(p, v, __ATOMIC_RELAXED, __HIP_MEMORY_SCOPE_AGENT); }
__device__ __forceinline__ unsigned xb_xcc_id() { return (unsigned)__builtin_amdgcn_s_getreg((3 << 11) | 20) & 0xFu; }
#define XB_SPIN(cond, bar) do { unsigned _sp = 0; while (cond) { __builtin_amdgcn_s_sleep(1); \
    if ((++_sp & 255u) == 0u) { if (xb_ld(&(bar)[XB_TMO])) break; if (_sp > XB_SPIN_CAP) { atomicAdd(&(bar)[XB_TMO], 1u); break; } } } } while (0)

struct XcdBarrier {
    unsigned* bar; unsigned x;
    volatile LAS unsigned* st;
};

__device__ __forceinline__ XcdBarrier xcd_barrier_post(unsigned* bar, volatile LAS unsigned* st) {
    XcdBarrier b; b.bar = bar; b.x = xb_xcc_id(); b.st = st;
    if (threadIdx.x == 0) (void)xb_add(&bar[XB_XCNT(b.x)], 1u);
    return b;
}
__device__ __forceinline__ void xcd_barrier_complete(unsigned* bar, unsigned x, unsigned& nloc, unsigned& nx) {
    const unsigned G = gridDim.x * gridDim.y * gridDim.z;
    unsigned sum, cnt, mine, sp = 0u;
    for (;;) {
        sum = 0u; cnt = 0u; mine = 0u;
#pragma unroll
        for (unsigned j = 0; j < 16; ++j) { const unsigned c = xb_ld(&bar[XB_XCNT(j)]); sum += c; cnt += (c > 0u) ? 1u : 0u; mine = (j == x) ? c : mine; }
        if (sum == G) break;
        __builtin_amdgcn_s_sleep(1);
        if ((++sp & 255u) == 0u) { if (xb_ld(&bar[XB_TMO])) break; if (sp > XB_SPIN_CAP) { atomicAdd(&bar[XB_TMO], 1u); break; } }
    }
    nloc = mine > 0u ? mine : 1u; nx = cnt > 0u ? cnt : 1u;
}

__device__ __forceinline__ void xcd_barrier(const XcdBarrier& b) {
    asm volatile("s_waitcnt vmcnt(0)" ::: "memory");
    __syncthreads();
    if (threadIdx.x == 0) {
        unsigned* bar = b.bar;
        __builtin_amdgcn_s_waitcnt(0);
        unsigned nloc = b.st[0], nx = b.st[1];
        if (nloc == 0u) { xcd_barrier_complete(bar, b.x, nloc, nx); b.st[0] = nloc; b.st[1] = nx; }
        const unsigned old = xb_add(&bar[XB_XSUB(b.x)], 1u);
        const unsigned gen = old / nloc;
        if (old + 1u == (gen + 1u) * nloc) {
            __builtin_amdgcn_fence(__ATOMIC_RELEASE, "agent");
            asm volatile("s_waitcnt vmcnt(0)" ::: "memory");
            const unsigned og = xb_add(&bar[XB_TOP], 1u);
            const unsigned tg = og / nx;
            if (og + 1u == (tg + 1u) * nx) xb_add(&bar[XB_TOPGEN], 1u);
            else XB_SPIN(xb_ld(&bar[XB_TOPGEN]) == tg, bar);
            __builtin_amdgcn_fence(__ATOMIC_ACQUIRE, "agent");
            xb_add(&bar[XB_XGEN(b.x)], 1u);
            asm volatile("s_waitcnt vmcnt(0)" ::: "memory");
        } else {
            XB_SPIN(xb_ld(&bar[XB_XGEN(b.x)]) == gen, bar);
            __builtin_amdgcn_fence(__ATOMIC_ACQUIRE, "agent");
            asm volatile("s_waitcnt vmcnt(0)" ::: "memory");
        }
    }
    __syncthreads();
}

__device__ __forceinline__ void p0_transpose_item(const float* W, const float* g, int K, int N, bf16_t* WT, int row_off, int ilv, LAS float* scr, int item, int lane) {
    const int nblk = N / 32, kb = item / nblk, nb = item % nblk, k0 = 64 * kb, n0 = 32 * nb;
#pragma unroll 8
    for (int i = 0; i < 32; ++i) { const int kk = 2 * i + (lane >> 5); const float s = g ? g[k0 + kk] : 1.0f; scr[kk * 33 + (lane & 31)] = W[(size_t)(k0 + kk) * N + n0 + (lane & 31)] * s; }
    asm volatile("s_waitcnt lgkmcnt(0)" ::: "memory");
    const int c = lane & 7;
    const int rbase = ilv ? (((n0 >> 7) << 8) + (n0 & 127) + (ilv == 2 ? 128 : 0)) : (row_off + n0);
#pragma unroll
    for (int j = 0; j < 4; ++j) { const int n = (lane >> 3) + 8 * j; const LAS float* s = scr + (8 * c) * 33 + n;
        u32x4 o; o.x = pkbf(s[0 * 33], s[1 * 33]); o.y = pkbf(s[2 * 33], s[3 * 33]); o.z = pkbf(s[4 * 33], s[5 * 33]); o.w = pkbf(s[6 * 33], s[7 * 33]);
        *(u32x4*)(WT + (size_t)(rbase + n) * K + k0 + 8 * c) = o; }
    asm volatile("s_waitcnt lgkmcnt(0)" ::: "memory");
}
__device__ __forceinline__ void row_to_bf16(const float* xrow, bf16_t* orow, float* ssq, int lane) {
    const f32x4* xr = (const f32x4*)xrow + lane;
    f32x4 v[4]; float s = 0.f;
#pragma unroll
    for (int j = 0; j < 4; ++j) { v[j] = xr[64 * j]; s += (v[j].x * v[j].x + v[j].y * v[j].y) + (v[j].z * v[j].z + v[j].w * v[j].w); }
    s = wave_sum(s);
    u32x2* o8 = (u32x2*)orow + lane;
#pragma unroll
    for (int j = 0; j < 4; ++j) { u32x2 w; w.x = pkbf(v[j].x, v[j].y); w.y = pkbf(v[j].z, v[j].w); o8[64 * j] = w; }
    if (lane == 0) *ssq = s;
}
__device__ __forceinline__ void p0_prologue(KA a, ldsp lds, int tid, int lane, int wave) {
    unsigned char* ws = a->ws;
    LAS float* scr = (LAS float*)(lds + wave * 16384);
    const int gw = blockIdx.x * NWAVES + wave, NGW = gridDim.x * NWAVES;
    constexpr int I_IN = 16 * 56, I_OUT = 16 * 32, I_Q = 16 * 16, I_MO = 8 * 32, I_G = 16 * 96, I_D = 48 * 32;
    constexpr int NITEMS = I_IN + I_OUT + 3 * I_Q + I_MO + 2 * I_G + I_D;
    for (int it = gw; it < NITEMS; it += NGW) {
        int r = it;
        if (r < I_IN) { p0_transpose_item(a->in[I_WIN], a->in[I_GMIX], 1024, DIN, (bf16_t*)(ws + WS_WIN), 0, 0, scr, r, lane); continue; } r -= I_IN;
        if (r < I_OUT) { p0_transpose_item(a->in[I_WOUT], nullptr, 1024, 1024, (bf16_t*)(ws + WS_WOUT), 0, 0, scr, r, lane); continue; } r -= I_OUT;
        if (r < I_Q) { p0_transpose_item(a->in[I_WMQ], a->in[I_GCROSS], 1024, 512, (bf16_t*)(ws + WS_WQ), 0, 0, scr, r, lane); continue; } r -= I_Q;
        if (r < I_Q) { p0_transpose_item(a->in[I_WMK], a->in[I_GMEM], 1024, 512, (bf16_t*)(ws + WS_WKV), 0, 0, scr, r, lane); continue; } r -= I_Q;
        if (r < I_Q) { p0_transpose_item(a->in[I_WMV], a->in[I_GMEM], 1024, 512, (bf16_t*)(ws + WS_WKV), 512, 0, scr, r, lane); continue; } r -= I_Q;
        if (r < I_MO) { p0_transpose_item(a->in[I_WMO], nullptr, 512, 1024, (bf16_t*)(ws + WS_WMO), 0, 0, scr, r, lane); continue; } r -= I_MO;
        if (r < I_G) { p0_transpose_item(a->in[I_WFG], a->in[I_GFFN], 1024, DFF, (bf16_t*)(ws + WS_WGU), 0, 1, scr, r, lane); continue; } r -= I_G;
        if (r < I_G) { p0_transpose_item(a->in[I_WFU], a->in[I_GFFN], 1024, DFF, (bf16_t*)(ws + WS_WGU), 0, 2, scr, r, lane); continue; } r -= I_G;
        p0_transpose_item(a->in[I_WFD], nullptr, DFF, 1024, (bf16_t*)(ws + WS_WD), 0, 0, scr, r, lane);
    }
    bf16_t* xb = (bf16_t*)(ws + WS_XB); float* ssq0 = (float*)(ws + WS_SSQ0);
    for (int m = gw; m < MT + 512; m += NGW) {
        if (m < MP) row_to_bf16(a->in[I_XP] + (size_t)m * 1024, xb + (size_t)m * 1024, ssq0 + m, lane);
        else if (m < MT) row_to_bf16(a->in[I_XS] + (size_t)(m - MP) * 1024, xb + (size_t)m * 1024, ssq0 + m, lane);
        else { const int r = m - MT; row_to_bf16(a->in[I_MEMP] + (size_t)r * 1024, (bf16_t*)(ws + WS_MEMA) + (size_t)r * 1024, (float*)(ws + WS_SSQM) + r, lane); }
    }
    for (int i = blockIdx.x * NTHREADS + tid; i < MT; i += gridDim.x * NTHREADS) { ((float*)(ws + WS_SSQ1))[i] = 0.f; ((float*)(ws + WS_SSQ2))[i] = 0.f; ((float*)(ws + WS_SSQ3))[i] = 0.f; }
}

template <bool SAMPLE, int PASS>
__device__ __forceinline__ void lru_unit(KA a, ldsp lds, int unit, int tid, int lane, int w) {
    constexpr int NTOK = SAMPLE ? 64 : 256, NROW = SAMPLE ? (NTOK / 4) * 7 : NTOK + 3, RS = 272;
    const ldsp XR = lds, XC = lds + 259 * RS;
    unsigned char* ws = a->ws;
    const bf16_t* proj = (const bf16_t*)(ws + WS_PROJ);
    int b = 0, chunk, bp;
    if (!SAMPLE) { b = unit >> 7; chunk = (unit >> 2) & 31; bp = unit & 3; } else { chunk = unit >> 2; bp = unit & 3; }
    const int c0 = bp * 128;
    const int row0 = SAMPLE ? MP + chunk * 64 : b * SEQ + chunk * 256;
    __syncthreads();
    for (int it = tid; it < NROW * 16; it += NTHREADS) {
        const int r = it >> 4, cq = it & 15;
        u32x4 v = {0u, 0u, 0u, 0u};
        if (!SAMPLE) { const int t = chunk * 256 - 3 + r; if (t >= 0) v = *(const u32x4*)(proj + (size_t)(b * SEQ + t) * DIN + c0 + cq * 8); }
        else { const int bl = r / 7, rr = r % 7, bs = chunk * 16 + bl;
            if (rr >= 3) v = *(const u32x4*)(proj + (size_t)(MP + bs * 4 + rr - 3) * DIN + c0 + cq * 8);
            else { const float* s = a->in[I_SLC] + (size_t)(bs * 3 + rr) * 512 + c0 + cq * 8; const f32x4 s0 = *(const f32x4*)s, s1 = *(const f32x4*)(s + 4);
                v.x = pkbf(s0[0], s0[1]); v.y = pkbf(s0[2], s0[3]); v.z = pkbf(s1[0], s1[1]); v.w = pkbf(s1[2], s1[3]); } }
        *(LAS u32x4*)(XR + r * RS + cq * 16) = v;
    }
    __syncthreads();
    {
        const int cq = tid & 15, tg = tid >> 4;
        float wk[4][8], bb[8];
#pragma unroll
        for (int j = 0; j < 8; ++j) { bb[j] = a->in[I_BLC][c0 + cq * 8 + j];
#pragma unroll
            for (int k = 0; k < 4; ++k) wk[k][j] = a->in[I_WLC][k * 512 + c0 + cq * 8 + j]; }
#pragma unroll
        for (int q = 0; q < NTOK / 32; ++q) {
            const int tok = tg * (NTOK / 32) + q; const int base = SAMPLE ? (tok >> 2) * 7 + (tok & 3) : tok;
            float x[8];
#pragma unroll
            for (int j = 0; j < 8; ++j) x[j] = bb[j];
#pragma unroll
            for (int k = 0; k < 4; ++k) { const u32x4 v = *(const LAS u32x4*)(XR + (base + k) * RS + cq * 16);
                x[0] += wk[k][0] * bflo(v.x); x[1] += wk[k][1] * bfhi(v.x); x[2] += wk[k][2] * bflo(v.y); x[3] += wk[k][3] * bfhi(v.y);
                x[4] += wk[k][4] * bflo(v.z); x[5] += wk[k][5] * bfhi(v.z); x[6] += wk[k][6] * bflo(v.w); x[7] += wk[k][7] * bfhi(v.w); }
            u32x4 o; o.x = pkbf(x[0], x[1]); o.y = pkbf(x[2], x[3]); o.z = pkbf(x[4], x[5]); o.w = pkbf(x[6], x[7]);
            *(LAS u32x4*)(XC + tok * RS + cq * 16) = o;
        }
    }
    __syncthreads();
    const int nb = w >> 2, jt = w & 3, n = bp * 2 + nb, fr = lane & 15, fq = lane >> 4;
    const int ch = n * 64 + jt * 16 + fr, chl = nb * 64 + jt * 16 + fr;
    bf16x8 bA[2], bX[2];
#pragma unroll
    for (int kh = 0; kh < 2; ++kh)
#pragma unroll
        for (int j = 0; j < 8; ++j) { const int c = kh * 32 + 8 * fq + j; const size_t o = (size_t)(n * 64 + c) * 64 + jt * 16 + fr;
            bA[kh][j] = (short)f2bf(a->in[I_WLA][o]); bX[kh][j] = (short)f2bf(a->in[I_WLX][o]); }
    const float ba_ = a->in[I_BLA][ch], bx_ = a->in[I_BLX][ch];
    const float lam = a->in[I_LAM][ch];
    const float sp = (lam > 15.f) ? __expf(-lam) : log1pf(__expf(-lam));
    const float k8 = -8.0f * sp * LOG2E;
    const float wc0 = a->in[I_WLC][ch], wc1 = a->in[I_WLC][512 + ch], wc2 = a->in[I_WLC][1024 + ch], wc3 = a->in[I_WLC][1536 + ch], bcv = a->in[I_BLC][ch];
    float hc = 0.f, Atot = 1.f, Htot = 0.f;
    float* summ = (float*)(ws + WS_SUMM);
    if (!SAMPLE && PASS == 2) { for (int j = 0; j < chunk; ++j) { const float A = summ[((size_t)(b * 32 + j) * 512 + ch) * 2], H = summ[((size_t)(b * 32 + j) * 512 + ch) * 2 + 1]; hc = A * hc + H; } }
    bf16_t* mix = (bf16_t*)(ws + WS_MIX);
    for (int s = 0; s < NTOK / 16; ++s) {
        bf16x8 aF[2];
#pragma unroll
        for (int kh = 0; kh < 2; ++kh) aF[kh] = *(const LAS bf16x8*)(XC + (16 * s + fr) * RS + (nb * 64 + kh * 32 + 8 * fq) * 2);
        f32x4 accA = {0.f, 0.f, 0.f, 0.f}, accX = {0.f, 0.f, 0.f, 0.f};
        accA = MFMA16(aF[0], bA[0], accA); accA = MFMA16(aF[1], bA[1], accA);
        accX = MFMA16(aF[0], bX[0], accX); accX = MFMA16(aF[1], bX[1], accX);
        const int base = SAMPLE ? (4 * s + fq) * 7 : 16 * s + 4 * fq;
        float x7[7];
#pragma unroll
        for (int q = 0; q < 7; ++q) x7[q] = bf2f(*(const LAS unsigned short*)(XR + (base + q) * RS + chl * 2));
        float av[4], bv[4];
#pragma unroll
        for (int r = 0; r < 4; ++r) {
            const float xc = bcv + wc0 * x7[r] + wc1 * x7[r + 1] + wc2 * x7[r + 2] + wc3 * x7[r + 3];
            const float rg = sigmoidf_(accA[r] + ba_), ig = sigmoidf_(accX[r] + bx_);
            const float a_ = fexp2(k8 * rg);
            av[r] = a_; bv[r] = __builtin_sqrtf(fmaxf(1.0f - a_ * a_, 0.f)) * (ig * xc);
        }
        float hv[4];
        if (SAMPLE) {
            const int bs = chunk * 16 + 4 * s + fq;
            float h = a->in[I_SLH][(size_t)bs * 512 + ch];
#pragma unroll
            for (int r = 0; r < 4; ++r) { h = av[r] * h + bv[r]; hv[r] = h; }
            a->out[O_SLH + (size_t)bs * 512 + ch] = h;
        } else {
            float Ai = av[0] * av[1] * av[2] * av[3], Hi = 0.f;
#pragma unroll
            for (int r = 0; r < 4; ++r) Hi = av[r] * Hi + bv[r];
            float tA = __shfl_up(Ai, 16), tH = __shfl_up(Hi, 16);
            if (fq >= 1) { Hi = Ai * tH + Hi; Ai = Ai * tA; }
            tA = __shfl_up(Ai, 32); tH = __shfl_up(Hi, 32);
            if (fq >= 2) { Hi = Ai * tH + Hi; Ai = Ai * tA; }
            float Ae = __shfl_up(Ai, 16), He = __shfl_up(Hi, 16);
            if (fq == 0) { Ae = 1.f; He = 0.f; }
            const float At = __shfl(Ai, 48 + fr), Ht = __shfl(Hi, 48 + fr);
            if (PASS == 1) { Htot = At * Htot + Ht; Atot *= At; }
            else {
                float h = Ae * hc + He;
#pragma unroll
                for (int r = 0; r < 4; ++r) { h = av[r] * h + bv[r]; hv[r] = h; }
                hc = At * hc + Ht;
            }
        }
        if (SAMPLE || PASS == 2) {
#pragma unroll
            for (int r = 0; r < 4; ++r) {
                const size_t row = (size_t)row0 + 16 * s + 4 * fq + r;
                const float gt = bf2f(proj[row * DIN + 512 + ch]);
                mix[row * 1024 + ch] = (bf16_t)f2bf(hv[r] * gelu_tanh(gt));
            }
        }
    }
    if (!SAMPLE && PASS == 1 && fq == 0) { summ[((size_t)(b * 32 + chunk) * 512 + ch) * 2] = Atot; summ[((size_t)(b * 32 + chunk) * 512 + ch) * 2 + 1] = Htot; }
    if (!SAMPLE && PASS == 2 && chunk == 31 && fq == 0) a->out[O_PLH + (size_t)b * 512 + ch] = hc;
}

__device__ __forceinline__ void swa_prompt_unit(KA a, ldsp lds, int unit, int tid, int lane, int w) {
    constexpr int KRS = 144, VRS = 400;
    const ldsp Ks = lds, VT = lds + 192 * KRS;
    const bf16_t* proj = (const bf16_t*)(a->ws + WS_PROJ);
    const int b = unit >> 8, hk = (unit >> 7) & 1, qb = unit & 127, t0 = qb * 64;
    __syncthreads();
    for (int it = tid; it < 192 * 8; it += NTHREADS) {
        const int kl = it >> 3, cq = it & 7, t = t0 - 128 + kl;
        u32x4 kv = {0u, 0u, 0u, 0u}, vv = {0u, 0u, 0u, 0u};
        if (t >= 0) { const bf16_t* p = proj + (size_t)(b * SEQ + t) * DIN; kv = *(const u32x4*)(p + 1536 + hk * 64 + cq * 8); vv = *(const u32x4*)(p + 1664 + hk * 64 + cq * 8); }
        *(LAS u32x4*)(Ks + kl * KRS + cq * 16) = kv;
#pragma unroll
        for (int e = 0; e < 8; ++e) *(LAS unsigned short*)(VT + (cq * 8 + e) * VRS + kl * 2) = (unsigned short)(vv[e >> 1] >> (16 * (e & 1)));
    }
    __syncthreads();
    const int g = w >> 1, hf = w & 1, hq = hk * 4 + g, j = lane & 31, hi = lane >> 5;
    const size_t qrow = (size_t)b * SEQ + t0 + 32 * hf + j;
    bf16x8 qf[4];
#pragma unroll
    for (int ks = 0; ks < 4; ++ks) qf[ks] = *(const bf16x8*)(proj + qrow * DIN + 1024 + hq * 64 + 16 * ks + 8 * hi);
    const float slope2 = fexp2(-(float)(hq + 1)) * LOG2E, sink2 = a->in[I_SINK][hq] * LOG2E;
    float mx = sink2;
    f32x16 st[5];
#pragma unroll
    for (int kt = 0; kt < 5; ++kt) {
        f32x16 acc = {};
#pragma unroll
        for (int ks = 0; ks < 4; ++ks) { const bf16x8 kf = *(const LAS bf16x8*)(Ks + (32 * hf + 32 * kt + j) * KRS + (16 * ks + 8 * hi) * 2); acc = MFMA32(kf, qf[ks], acc); }
        int dbase = 128 + j - 32 * kt - 4 * hi;
        int kpb = t0 - 128 + 32 * hf + 32 * kt + 4 * hi;
        asm volatile("" : "+v"(dbase), "+v"(kpb));
#pragma unroll
        for (int r = 0; r < 16; ++r) {
            const int cr = (r & 3) + 8 * (r >> 2), dist = dbase - cr;
            const bool valid = (unsigned)dist < 128u && (kpb + cr) >= 0;
            float s = acc[r] * LOG2E - slope2 * (float)dist; s = valid ? s : -1e30f; acc[r] = s; mx = fmaxf(mx, s);
        }
        st[kt] = acc;
        __builtin_amdgcn_sched_barrier(0);
    }
    mx = fmaxf(mx, __shfl_xor(mx, 32));
    float l = 0.f;
#pragma unroll
    for (int kt = 0; kt < 5; ++kt)
#pragma unroll
        for (int r = 0; r < 16; ++r) { const float p = fexp2(st[kt][r] - mx); st[kt][r] = p; l += p; }
    l += __shfl_xor(l, 32); l += fexp2(sink2 - mx);
    const float inv = frcp(l);
    f32x16 o[2] = {};
#pragma unroll
    for (int kt = 0; kt < 5; ++kt)
#pragma unroll
        for (int s = 0; s < 2; ++s) {
            const bf16x8 pf = pack8(st[kt], s);
#pragma unroll
            for (int dt = 0; dt < 2; ++dt) {
                const int d = 32 * dt + j, kb = 32 * hf + 32 * kt + 16 * s + 4 * hi;
                const s16x4 lo = *(const LAS s16x4*)(VT + d * VRS + kb * 2), hi4 = *(const LAS s16x4*)(VT + d * VRS + (kb + 8) * 2);
                const bf16x8 vf = __builtin_shufflevector(lo, hi4, 0, 1, 2, 3, 4, 5, 6, 7);
                o[dt] = MFMA32(vf, pf, o[dt]);
            }
            __builtin_amdgcn_sched_barrier(0);
        }
    bf16_t* mix = (bf16_t*)(a->ws + WS_MIX);
#pragma unroll
    for (int dt = 0; dt < 2; ++dt)
#pragma unroll
        for (int rg = 0; rg < 4; ++rg) {
            u32x2 wv; wv.x = pkbf(o[dt][4 * rg] * inv, o[dt][4 * rg + 1] * inv); wv.y = pkbf(o[dt][4 * rg + 2] * inv, o[dt][4 * rg + 3] * inv);
            *(u32x2*)(mix + qrow * 1024 + 512 + hq * 64 + 32 * dt + 8 * rg + 4 * hi) = wv;
        }
}

__device__ __forceinline__ void swa_sample_unit(KA a, ldsp lds, int bs, int tid) {
    LAS float* Kc = (LAS float*)lds;
    LAS float* Vc = (LAS float*)(lds + 69696);
    LAS float* Qs = (LAS float*)(lds + 137280);
    LAS float* P = Kc;
    const bf16_t* proj = (const bf16_t*)(a->ws + WS_PROJ);
    __syncthreads();
    for (int it = tid; it < 128 * 32; it += NTHREADS) {
        const int r = it >> 5, c4 = (it & 31) * 4;
        const f32x4 kv = *(const f32x4*)(a->in[I_CSK] + (size_t)(bs * 128 + r) * 128 + c4), vv = *(const f32x4*)(a->in[I_CSV] + (size_t)(bs * 128 + r) * 128 + c4);
        *(LAS f32x4*)(Kc + r * 132 + c4) = kv; *(LAS f32x4*)(Vc + r * 128 + c4) = vv;
        if (r >= 4) { *(f32x4*)(a->out + O_SSK + (size_t)(bs * 128 + r - 4) * 128 + c4) = kv; *(f32x4*)(a->out + O_SSV + (size_t)(bs * 128 + r - 4) * 128 + c4) = vv; }
    }
    { const int i = tid >> 7, c = tid & 127; const bf16_t* p = proj + (size_t)(MP + bs * 4 + i) * DIN; Kc[(128 + i) * 132 + c] = bf2f(p[1536 + c]); Vc[(128 + i) * 128 + c] = bf2f(p[1664 + c]); }
    for (int e = tid; e < 2048; e += NTHREADS) { const int rq = e >> 6, d = e & 63, hq = rq >> 2, i = rq & 3; Qs[rq * 64 + d] = bf2f(proj[(size_t)(MP + bs * 4 + i) * DIN + 1024 + hq * 64 + d]); }
    __syncthreads();
    float sc[16];
    const int key = tid % 132, hk = tid / 132;
#pragma unroll
    for (int q = 0; q < 16; ++q) sc[q] = 0.f;
    if (tid < 264) {
#pragma unroll 1
        for (int c = 0; c < 16; ++c) {
            const f32x4 k4 = *(const LAS f32x4*)(Kc + key * 132 + hk * 64 + 4 * c);
#pragma unroll
            for (int q = 0; q < 16; ++q) { const f32x4 q4 = *(const LAS f32x4*)(Qs + (hk * 16 + q) * 64 + 4 * c); sc[q] += (k4[0] * q4[0] + k4[1] * q4[1]) + (k4[2] * q4[2] + k4[3] * q4[3]); }
        }
    }
    __syncthreads();
    if (tid < 264) {
#pragma unroll
        for (int q = 0; q < 16; ++q) { const int hq = hk * 4 + (q >> 2), i = q & 3, dist = i + 128 - key; const bool valid = dist >= 0 && dist < 128;
            const float s = sc[q] * LOG2E - fexp2(-(float)(hq + 1)) * LOG2E * (float)dist; P[(hk * 16 + q) * 132 + key] = valid ? s : -1e30f; }
    }
    __syncthreads();
    {
        const int row = tid >> 4, sub = tid & 15, hq = row >> 2; const float sink2 = a->in[I_SINK][hq] * LOG2E;
        float v[9], m = sink2;
#pragma unroll
        for (int jj = 0; jj < 9; ++jj) { const int k2 = sub + 16 * jj; v[jj] = k2 < 132 ? P[row * 132 + k2] : -1e30f; m = fmaxf(m, v[jj]); }
#pragma unroll
        for (int o = 8; o >= 1; o >>= 1) m = fmaxf(m, __shfl_xor(m, o));
        float l = 0.f;
#pragma unroll
        for (int jj = 0; jj < 9; ++jj) { v[jj] = fexp2(v[jj] - m); l += v[jj]; }
#pragma unroll
        for (int o = 8; o >= 1; o >>= 1) l += __shfl_xor(l, o);
        l += fexp2(sink2 - m);
        const float inv = 1.0f / l;
#pragma unroll
        for (int jj = 0; jj < 9; ++jj) { const int k2 = sub + 16 * jj; if (k2 < 132) P[row * 132 + k2] = v[jj] * inv; }
    }
    __syncthreads();
    {
        const int row = tid >> 4, d4 = (tid & 15) * 4, hq = row >> 2, hk2 = hq >> 2, i = row & 3;
        f32x4 acc = {0.f, 0.f, 0.f, 0.f};
#pragma unroll 4
        for (int k2 = 0; k2 < 132; ++k2) acc += P[row * 132 + k2] * *(const LAS f32x4*)(Vc + k2 * 128 + hk2 * 64 + d4);
        u32x2 wv; wv.x = pkbf(acc[0], acc[1]); wv.y = pkbf(acc[2], acc[3]);
        *(u32x2*)((bf16_t*)(a->ws + WS_MIX) + (size_t)(MP + bs * 4 + i) * 1024 + 512 + hq * 64 + d4) = wv;
    }
}

__device__ __forceinline__ void xattn_prompt_unit(KA a, ldsp lds, int unit, int tid, int lane, int w) {
    constexpr int KRS = 272, VRS = 528;
    const ldsp Km = lds, VmT = lds + 256 * KRS;
    const bf16_t* memkv = (const bf16_t*)(a->ws + WS_MEMKV);
    const bf16_t* qcb = (const bf16_t*)(a->ws + WS_QC);
    const int b = unit >> 7, h = (unit >> 5) & 3, qc = unit & 31;
    __syncthreads();
    for (int it = tid; it < 256 * 16; it += NTHREADS) {
        const int key = it >> 4, cq = it & 15; const bf16_t* p = memkv + (size_t)(b * 256 + key) * 1024 + h * 128 + cq * 8;
        const u32x4 kv = *(const u32x4*)p, vv = *(const u32x4*)(p + 512);
        *(LAS u32x4*)(Km + key * KRS + cq * 16) = kv;
#pragma unroll
        for (int e = 0; e < 8; ++e) *(LAS unsigned short*)(VmT + (cq * 8 + e) * VRS + key * 2) = (unsigned short)(vv[e >> 1] >> (16 * (e & 1)));
    }
    __syncthreads();
    const int j = lane & 31, hi = lane >> 5;
    const size_t qrow = (size_t)b * SEQ + qc * 256 + 32 * w + j;
    bf16x8 qf[8];
#pragma unroll
    for (int ks = 0; ks < 8; ++ks) qf[ks] = *(const bf16x8*)(qcb + qrow * 512 + h * 128 + 16 * ks + 8 * hi);
    float m = -1e30f, l = 0.f;
    f32x16 o[4] = {};
#pragma unroll
    for (int kh = 0; kh < 2; ++kh) {
        f32x16 st[4];
        float mx = -1e30f;
#pragma unroll
        for (int kt = 0; kt < 4; ++kt) {
            f32x16 acc = {};
#pragma unroll
            for (int ks = 0; ks < 8; ++ks) { const bf16x8 kf = *(const LAS bf16x8*)(Km + (128 * kh + 32 * kt + j) * KRS + (16 * ks + 8 * hi) * 2); acc = MFMA32(kf, qf[ks], acc); }
#pragma unroll
            for (int r = 0; r < 16; ++r) { acc[r] *= LOG2E; mx = fmaxf(mx, acc[r]); }
            st[kt] = acc;
        }
        mx = fmaxf(mx, __shfl_xor(mx, 32));
        const float mn = fmaxf(m, mx), scl = fexp2(m - mn);
        m = mn; l *= scl;
#pragma unroll
        for (int dt = 0; dt < 4; ++dt) o[dt] *= scl;
#pragma unroll
        for (int kt = 0; kt < 4; ++kt)
#pragma unroll
            for (int r = 0; r < 16; ++r) { const float p = fexp2(st[kt][r] - m); st[kt][r] = p; l += p; }
#pragma unroll
        for (int kt = 0; kt < 4; ++kt)
#pragma unroll
            for (int s = 0; s < 2; ++s) {
                const bf16x8 pf = pack8(st[kt], s);
#pragma unroll
                for (int dt = 0; dt < 4; ++dt) {
                    const int d = 32 * dt + j, kb = 128 * kh + 32 * kt + 16 * s + 4 * hi;
                    const s16x4 lo = *(const LAS s16x4*)(VmT + d * VRS + kb * 2), hi4 = *(const LAS s16x4*)(VmT + d * VRS + (kb + 8) * 2);
                    const bf16x8 vf = __builtin_shufflevector(lo, hi4, 0, 1, 2, 3, 4, 5, 6, 7);
                    o[dt] = MFMA32(vf, pf, o[dt]);
                }
            }
    }
    l += __shfl_xor(l, 32);
    const float inv = frcp(l);
    bf16_t* oc = (bf16_t*)(a->ws + WS_OC);
#pragma unroll
    for (int dt = 0; dt < 4; ++dt)
#pragma unroll
        for (int rg = 0; rg < 4; ++rg) {
            u32x2 wv; wv.x = pkbf(o[dt][4 * rg] * inv, o[dt][4 * rg + 1] * inv); wv.y = pkbf(o[dt][4 * rg + 2] * inv, o[dt][4 * rg + 3] * inv);
            *(u32x2*)(oc + qrow * 512 + h * 128 + 32 * dt + 8 * rg + 4 * hi) = wv;
        }
}
__device__ __forceinline__ void xattn_sample_unit(KA a, ldsp lds, int unit, int tid, int lane, int w) {
    LAS float* Qs = (LAS float*)lds;
    LAS float* S = (LAS float*)(lds + 2048);
    LAS float* RED = (LAS float*)(lds + 8192);
    const bf16_t* qcb = (const bf16_t*)(a->ws + WS_QC);
    const int bs = unit >> 2, h = unit & 3;
    __syncthreads();
    { const int i = tid >> 7, d = tid & 127; Qs[i * 128 + d] = bf2f(qcb[(size_t)(MP + bs * 4 + i) * 512 + h * 128 + d]); }
    __syncthreads();
    {
        const int key = tid >> 1, hf = tid & 1; const float* kp = a->in[I_CMK] + ((size_t)(bs * 256 + key) * 4 + h) * 128 + hf * 64;
        float s0 = 0.f, s1 = 0.f, s2 = 0.f, s3 = 0.f;
#pragma unroll
        for (int c = 0; c < 16; ++c) {
            const f32x4 k4 = *(const f32x4*)(kp + 4 * c);
            const f32x4 q0 = *(const LAS f32x4*)(Qs + hf * 64 + 4 * c), q1 = *(const LAS f32x4*)(Qs + 128 + hf * 64 + 4 * c), q2 = *(const LAS f32x4*)(Qs + 256 + hf * 64 + 4 * c), q3 = *(const LAS f32x4*)(Qs + 384 + hf * 64 + 4 * c);
            s0 += (k4[0] * q0[0] + k4[1] * q0[1]) + (k4[2] * q0[2] + k4[3] * q0[3]); s1 += (k4[0] * q1[0] + k4[1] * q1[1]) + (k4[2] * q1[2] + k4[3] * q1[3]);
            s2 += (k4[0] * q2[0] + k4[1] * q2[1]) + (k4[2] * q2[2] + k4[3] * q2[3]); s3 += (k4[0] * q3[0] + k4[1] * q3[1]) + (k4[2] * q3[2] + k4[3] * q3[3]);
        }
        s0 += __shfl_xor(s0, 1); s1 += __shfl_xor(s1, 1); s2 += __shfl_xor(s2, 1); s3 += __shfl_xor(s3, 1);
        if (hf == 0) { S[key] = s0 * LOG2E; S[256 + key] = s1 * LOG2E; S[512 + key] = s2 * LOG2E; S[768 + key] = s3 * LOG2E; }
    }
    __syncthreads();
    if (w < 4) {
        f32x4 v = *(const LAS f32x4*)(S + w * 256 + lane * 4);
        float m = fmaxf(fmaxf(v[0], v[1]), fmaxf(v[2], v[3]));
#pragma unroll
        for (int o = 32; o >= 1; o >>= 1) m = fmaxf(m, __shfl_xor(m, o));
        v[0] = fexp2(v[0] - m); v[1] = fexp2(v[1] - m); v[2] = fexp2(v[2] - m); v[3] = fexp2(v[3] - m);
        const float l = wave_sum((v[0] + v[1]) + (v[2] + v[3]));
        v *= (1.0f / l);
        *(LAS f32x4*)(S + w * 256 + lane * 4) = v;
    }
    __syncthreads();
    {
        const int dq = tid & 31, kg = tid >> 5; const float* vp = a->in[I_CMV] + ((size_t)(bs * 256 + kg * 16) * 4 + h) * 128 + dq * 4;
        f32x4 a0 = {0.f, 0.f, 0.f, 0.f}, a1 = a0, a2 = a0, a3 = a0;
#pragma unroll
        for (int kk = 0; kk < 16; ++kk) { const f32x4 v4 = *(const f32x4*)(vp + (size_t)kk * 512); const int k2 = kg * 16 + kk;
            a0 += S[k2] * v4; a1 += S[256 + k2] * v4; a2 += S[512 + k2] * v4; a3 += S[768 + k2] * v4; }
        *(LAS f32x4*)(RED + (kg * 4 + 0) * 128 + dq * 4) = a0; *(LAS f32x4*)(RED + (kg * 4 + 1) * 128 + dq * 4) = a1;
        *(LAS f32x4*)(RED + (kg * 4 + 2) * 128 + dq * 4) = a2; *(LAS f32x4*)(RED + (kg * 4 + 3) * 128 + dq * 4) = a3;
    }
    __syncthreads();
    { const int i = tid >> 7, d = tid & 127; float s = 0.f;
#pragma unroll
        for (int kg = 0; kg < 16; ++kg) s += RED[(kg * 4 + i) * 128 + d];
        ((bf16_t*)(a->ws + WS_OC))[(size_t)(MP + bs * 4 + i) * 512 + h * 128 + d] = (bf16_t)f2bf(s); }
}

__device__ __forceinline__ void ffn_fixup_tile(KA a, int pm, int tid) {
    const float* edge = (const float*)(a->ws + WS_EDGE); bf16_t* hb = (bf16_t*)(a->ws + WS_H);
    const float* wconv = a->in[I_WFC]; const float* bconv = a->in[I_BFC];
    for (int it = tid; it < 4 * 2 * 768; it += NTHREADS) {
        const int q = it / 1536, rem = it % 1536, rr = rem / 768, c4 = (rem % 768) * 4;
        const int blk = pm * 4 + q; const bool hasprev = (blk & 127) != 0;
        const f32x4 z = {0.f, 0.f, 0.f, 0.f};
        const f32x4 G0 = *(const f32x4*)(edge + ((size_t)blk * 6 + 0) * DFF + c4), G1 = *(const f32x4*)(edge + ((size_t)blk * 6 + 1) * DFF + c4);
        const f32x4 Gm2 = hasprev ? *(const f32x4*)(edge + ((size_t)(blk - 1) * 6 + 2) * DFF + c4) : z, Gm1 = hasprev ? *(const f32x4*)(edge + ((size_t)(blk - 1) * 6 + 3) * DFF + c4) : z;
        const f32x4 U = *(const f32x4*)(edge + ((size_t)blk * 6 + 4 + rr) * DFF + c4);
        const f32x4 w0 = *(const f32x4*)(wconv + c4), w1 = *(const f32x4*)(wconv + DFF + c4), w2 = *(const f32x4*)(wconv + 2 * DFF + c4), bc = *(const f32x4*)(bconv + c4);
        const f32x4 gc = rr == 0 ? (bc + w0 * Gm2 + w1 * Gm1 + w2 * G0) : (bc + w0 * Gm1 + w1 * G0 + w2 * G1);
        u32x2 wv; wv.x = pkbf(gelu_tanh(gc[0]) * U[0], gelu_tanh(gc[1]) * U[1]); wv.y = pkbf(gelu_tanh(gc[2]) * U[2], gelu_tanh(gc[3]) * U[3]);
        *(u32x2*)(hb + ((size_t)blk * 64 + rr) * DFF + c4) = wv;
    }
}

__global__ void __launch_bounds__(NTHREADS, 2) hymba_fwd(Args a_unused) {
    const KA a = (KA)__builtin_amdgcn_kernarg_segment_ptr();
    extern __shared__ __attribute__((aligned(16))) unsigned char smem[];
    const ldsp lds = (ldsp)smem;
    const int tid = threadIdx.x, lane = tid & 63, w = __builtin_amdgcn_readfirstlane(tid >> 6);
    const int G = gridDim.x, bx = blockIdx.x;
    unsigned char* ws = a->ws;
    const int lo = a->ph_lo, hi = a->ph_hi;
#ifndef PHASE_MASK
#define PHASE_MASK 0xfff
#endif
#define IN(k) (((PHASE_MASK >> (k)) & 1) && lo <= (k) && (k) < hi)
#ifndef REP_MASK
#define REP_MASK 0
#endif
#ifndef EXTRA_SYNCS
#define EXTRA_SYNCS 0
#endif
#define REPS(k) (1 + ((REP_MASK >> (k)) & 1))
#define SEAM(k) do { if (IN(k) && IN((k) + 1)) { XcdBarrier bar_; bar_.bar = (unsigned*)(a->ws + WS_BAR); bar_.x = xb_xcc_id(); bar_.st = (volatile LAS unsigned*)(lds + MISC_OFF); xcd_barrier(bar_); } } while (0)
    bf16_t* XB = (bf16_t*)(ws + WS_XB);
    if (tid < 16) ((LAS unsigned*)(lds + MISC_OFF))[tid] = 0u;
    __syncthreads();
    (void)xcd_barrier_post((unsigned*)(ws + WS_BAR), (volatile LAS unsigned*)(lds + MISC_OFF));
    if (hi > 1000) cg::this_grid().sync();
    if (IN(0)) { for (int rep = 0; rep < REPS(0); ++rep) p0_prologue(a, lds, tid, lane, w); }
    for (int es = 0; es < EXTRA_SYNCS; ++es) { XcdBarrier bar_; bar_.bar = (unsigned*)(a->ws + WS_BAR); bar_.x = xb_xcc_id(); bar_.st = (volatile LAS unsigned*)(lds + MISC_OFF); xcd_barrier(bar_); }
    SEAM(0);
    if (IN(1)) for (int rep = 0; rep < REPS(1); ++rep) {
        { pg8::Gemm g{XB, (const bf16_t*)(ws + WS_WIN), MT, DIN, 1024}; pg8::StaticOrder S; S.init(MT, DIN, G, bx);
          pg8::EpiProj E{(bf16_t*)(ws + WS_PROJ), (const float*)(ws + WS_SSQ0), a->out};
          pg8::gemm_phase<pg8::EpiProj, pg8::StaticOrder, true, true>(lds, g, S, E); }
        { pg8::Gemm g{(const bf16_t*)(ws + WS_MEMA), (const bf16_t*)(ws + WS_WKV), 512, 1024, 1024}; pg8::StaticOrder S; S.init(512, 1024, G, G - 1 - bx);
          pg8::EpiMemKV E{(bf16_t*)(ws + WS_MEMKV), (const float*)(ws + WS_SSQM), a->out};
          pg8::gemm_phase<pg8::EpiMemKV, pg8::StaticOrder, true, true>(lds, g, S, E); }
    }
    SEAM(1);
    if (IN(2)) for (int rep = 0; rep < REPS(2); ++rep) {
        for (int u = bx; u < 416; u += G) {
            if (u < 256) lru_unit<false, 1>(a, lds, u, tid, lane, w);
            else if (u < 288) lru_unit<true, 2>(a, lds, u - 256, tid, lane, w);
            else swa_sample_unit(a, lds, u - 288, tid);
        }
    }
    SEAM(2);
    if (IN(3)) for (int rep = 0; rep < REPS(3); ++rep) {
        for (int u = bx; u < 768; u += G) {
            if (u < 256) lru_unit<false, 2>(a, lds, u, tid, lane, w);
            else swa_prompt_unit(a, lds, u - 256, tid, lane, w);
        }
    }
    SEAM(3);
    if (IN(4)) {
        pg8::Gemm g{(const bf16_t*)(ws + WS_MIX), (const bf16_t*)(ws + WS_WOUT), MT, 1024, 1024}; pg8::StaticOrder S; S.init(MT, 1024, G, bx);
        pg8::EpiRes<true> E{a->in[I_XP], a->in[I_XS], a->out, XB, (float*)(ws + WS_SSQ1)};
        pg8::gemm_phase<pg8::EpiRes<true>, pg8::StaticOrder, true, true>(lds, g, S, E);
    }
    SEAM(4);
    if (IN(5)) for (int rep = 0; rep < REPS(5); ++rep) {
        pg8::Gemm g{XB, (const bf16_t*)(ws + WS_WQ), MT, 512, 1024}; pg8::StaticOrder S; S.init(MT, 512, G, bx);
        pg8::EpiQ E{(bf16_t*)(ws + WS_QC), (const float*)(ws + WS_SSQ1)};
        pg8::gemm_phase<pg8::EpiQ, pg8::StaticOrder, true, true>(lds, g, S, E);
    }
    SEAM(5);
    if (IN(6)) for (int rep = 0; rep < REPS(6); ++rep) {
        for (int u = bx; u < 768; u += G) {
            if (u < 256) xattn_prompt_unit(a, lds, u, tid, lane, w);
            else xattn_sample_unit(a, lds, u - 256, tid, lane, w);
        }
    }
    SEAM(6);
    if (IN(7)) {
        pg8::Gemm g{(const bf16_t*)(ws + WS_OC), (const bf16_t*)(ws + WS_WMO), MT, 1024, 512}; pg8::StaticOrder S; S.init(MT, 1024, G, bx);
        pg8::EpiRes<true> E{a->out, a->out + O_YS, a->out, XB, (float*)(ws + WS_SSQ2)};
        pg8::gemm_phase<pg8::EpiRes<true>, pg8::StaticOrder, true, true>(lds, g, S, E);
    }
    SEAM(7);
    if (IN(8)) for (int rep = 0; rep < REPS(8); ++rep) {
        pg8::Gemm g{XB, (const bf16_t*)(ws + WS_WGU), MT, 2 * DFF, 1024}; pg8::StaticOrder S; S.init(MT, 2 * DFF, G, bx);
        pg8::EpiGU E{(bf16_t*)(ws + WS_H), (const float*)(ws + WS_SSQ2), (float*)(ws + WS_EDGE), a->in[I_WFC], a->in[I_BFC], a->in[I_SFC], a->out};
        pg8::gemm_phase<pg8::EpiGU, pg8::StaticOrder, true, true>(lds, g, S, E);
    }
    SEAM(8);
    if (IN(9)) {
        pg8::Gemm g{(const bf16_t*)(ws + WS_H), (const bf16_t*)(ws + WS_WD), MT, 1024, DFF}; pg8::StaticOrder S; S.init(MT, 1024, G, bx);
        pg8::Unit u;
        for (int i = 0; S.next(i, u); ++i) if (u.pm < MP / 256) ffn_fixup_tile(a, u.pm, tid);
        __builtin_amdgcn_fence(__ATOMIC_RELEASE, "agent");
        asm volatile("s_waitcnt vmcnt(0)" ::: "memory");
        __syncthreads();
        __builtin_amdgcn_fence(__ATOMIC_ACQUIRE, "agent");
        pg8::EpiRes<false> E{a->out, a->out + O_YS, a->out, nullptr, (float*)(ws + WS_SSQ3)};
        pg8::gemm_phase<pg8::EpiRes<false>, pg8::StaticOrder, true, true>(lds, g, S, E);
    }
    SEAM(9);
    if (IN(10)) {
        const float* ssq3 = (const float*)(ws + WS_SSQ3); const float* gf = a->in[I_GFIN];
        f32x4 gv[4];
#pragma unroll
        for (int j = 0; j < 4; ++j) gv[j] = *((const f32x4*)gf + lane + 64 * j);
        for (int m = bx * NWAVES + w; m < MT; m += G * NWAVES) {
            const float rs = __builtin_amdgcn_rsqf(ssq3[m] * (1.0f / 1024.0f) + EPS);
            f32x4* xr = (f32x4*)(a->out + (size_t)m * 1024) + lane;
#pragma unroll
            for (int j = 0; j < 4; ++j) xr[64 * j] = xr[64 * j] * rs * gv[j];
        }
    }
#undef IN
#undef SEAM
}
constexpr int N_PHASES = 11;

extern "C" void kernel_launch(void* const* d_in, const int* in_sizes, int n_in, void* d_out, int out_size, void* d_ws, size_t ws_size, hipStream_t stream) {
    static int grid = 0;
    if (grid == 0) {
        if (n_in != 34 || ws_size < WS_END) { fprintf(stderr, "kernel_launch: unexpected n_in %d / ws %zu\n", n_in, ws_size); grid = -1; return; }
        int dev = 0, cus = 0, per_cu = 0;
        if (hipGetDevice(&dev) != hipSuccess || hipDeviceGetAttribute(&cus, hipDeviceAttributeMultiprocessorCount, dev) != hipSuccess) { grid = -1; return; }
        if (hipFuncSetAttribute((const void*)hymba_fwd, hipFuncAttributeMaxDynamicSharedMemorySize, LDS_BYTES) != hipSuccess) { fprintf(stderr, "kernel_launch: hipFuncSetAttribute failed\n"); grid = -1; return; }
        if (hipOccupancyMaxActiveBlocksPerMultiprocessor(&per_cu, (const void*)hymba_fwd, NTHREADS, LDS_BYTES) != hipSuccess || per_cu < 1) { fprintf(stderr, "kernel_launch: occupancy query says %d\n", per_cu); per_cu = 1; }
        (void)hipGetLastError();
        grid = cus;
    }
    if (grid < 0) return;
    Args a{};
    for (int i = 0; i < 34; ++i) a.in[i] = (const float*)d_in[i];
    a.out = (float*)d_out; a.ws = (unsigned char*)d_ws;
    if (hipMemsetAsync((char*)d_ws + WS_BAR, 0, BAR_ZERO_BYTES, stream) != hipSuccess) { fprintf(stderr, "kernel_launch: memset failed\n"); return; }
#if MK_N_LAUNCHES == 1
    a.ph_lo = 0; a.ph_hi = N_PHASES;
    void* args[] = {&a};
    hipError_t e = hipLaunchCooperativeKernel((const void*)hymba_fwd, dim3(grid), dim3(NTHREADS), args, LDS_BYTES, stream);
    if (e != hipSuccess) fprintf(stderr, "kernel_launch: cooperative launch failed: %s (grid %d)\n", hipGetErrorString(e), grid);
#else
    for (int p = 0; p < N_PHASES; ++p) { a.ph_lo = p; a.ph_hi = p + 1; hipLaunchKernelGGL(hymba_fwd, dim3(grid), dim3(NTHREADS), LDS_BYTES, stream, a); }
#endif
}
```

```cpp
#include <hip/hip_runtime.h>
#include <hip/hip_cooperative_groups.h>
#include <cstdio>
#include <cstdint>
namespace cg = cooperative_groups;

#ifndef MK_N_LAUNCHES
#define MK_N_LAUNCHES 1
#endif

constexpr int MP = 16384, MS = 512, MT = MP + MS;
constexpr int DM = 1024, SEQ = 8192, DIN = 1792, DFF = 3072, DLRU = 512;
constexpr float EPS = 1e-6f;
constexpr float LOG2E = 1.4426950408889634f;
constexpr size_t O_YP = 0, O_YS = 16777216, O_PSK = 17301504, O_PSV = 17334272, O_PMK = 17367040, O_PMV = 17629184, O_PLC = 17891328,
                 O_PLH = 17894400, O_PFC = 17895424, O_SSK = 17907712, O_SSV = 20004864, O_SLC = 22102016, O_SLH = 22298624, O_SFC = 22364160;
constexpr size_t MiB = 1u << 20;
constexpr size_t WS_SSQ0 = 0, WS_SSQ1 = 128 * 1024, WS_SSQ2 = 256 * 1024, WS_SSQ3 = 384 * 1024, WS_SSQM = 512 * 1024, WS_SUMM = 640 * 1024;
constexpr size_t WS_WIN = 1 * MiB, WS_WOUT = 5 * MiB, WS_WQ = 7 * MiB, WS_WKV = 8 * MiB, WS_WMO = 10 * MiB, WS_WGU = 11 * MiB, WS_WD = 23 * MiB;
constexpr size_t WS_MEMA = 29 * MiB, WS_MEMKV = 30 * MiB, WS_EDGE = 31 * MiB, WS_XB = 50 * MiB, WS_PROJ = 83 * MiB, WS_MIX = 141 * MiB, WS_QC = 174 * MiB, WS_OC = 191 * MiB;
constexpr size_t WS_H = 83 * MiB;
constexpr size_t WS_END = 208 * MiB;
static_assert(WS_EDGE + (size_t)264 * 6 * 3072 * 4 <= WS_XB && WS_XB + (size_t)MT * 1024 * 2 <= WS_PROJ && WS_PROJ + (size_t)MT * DIN * 2 <= WS_MIX &&
              WS_MIX + (size_t)MT * 1024 * 2 <= WS_QC && WS_QC + (size_t)MT * 512 * 2 <= WS_OC && WS_OC + (size_t)MT * 512 * 2 <= WS_END && WS_H + (size_t)MT * DFF * 2 <= WS_OC, "ws map");

__device__ __forceinline__ unsigned pkbf(float lo, float hi) {
    typedef float f2_t __attribute__((ext_vector_type(2))); typedef __bf16 b2_t __attribute__((ext_vector_type(2)));
    f2_t v = {lo, hi}; b2_t b = __builtin_convertvector(v, b2_t); return __builtin_bit_cast(unsigned, b);
}
__device__ __forceinline__ float bf2f(unsigned short x) { return __uint_as_float((unsigned)x << 16); }
__device__ __forceinline__ float bflo(unsigned x) { return __uint_as_float(x << 16); }
__device__ __forceinline__ float bfhi(unsigned x) { return __uint_as_float(x & 0xffff0000u); }
__device__ __forceinline__ float fexp2(float x) { return __builtin_amdgcn_exp2f(x); }
__device__ __forceinline__ float frcp(float x) { return __builtin_amdgcn_rcpf(x); }
__device__ __forceinline__ float sigmoidf_(float x) { return frcp(1.0f + fexp2(-LOG2E * x)); }
__device__ __forceinline__ float gelu_tanh(float x) {
    const float t = x * (1.0f + 0.044715f * x * x);
    return x * frcp(1.0f + fexp2(-2.302208198f * t));
}
namespace pg8 {
#define PG8_LAS __attribute__((address_space(3)))
typedef unsigned short bf16_t;
typedef short bf16x8 __attribute__((ext_vector_type(8)));
typedef float f32x4 __attribute__((ext_vector_type(4)));
typedef unsigned u32x4 __attribute__((ext_vector_type(4)));
constexpr int BM = 256, BK = 64, HALF = 128, HTB = HALF * BK * 2  , STAGE_BYTES = 8 * HTB, NXCD = 8, WGM = 8;

__host__ __device__ __forceinline__ int lds_byte(int r, int c) { const int st = (r >> 4) * 2 + (c >> 5), rr = r & 15, cc = c & 31, ob = rr * 64 + cc * 2; return st * 1024 + (ob ^ (((ob >> 9) & 1) << 5)); }
__host__ __device__ __forceinline__ void stage_rc(int b, int& R, int& C) { const int st = b / 1024, sb = b % 1024, swz = sb ^ (((sb >> 9) & 1) << 5); R = (st >> 1) * 16 + swz / 64; C = (st & 1) * 32 + (swz % 64) / 2; }
__host__ __device__ __forceinline__ int perm32(int rho) { const int n = rho >> 4, i = rho & 15; return 8 * (i >> 2) + 4 * n + (i & 3); }

struct Unit { int pm, pn; };
struct Gemm { const bf16_t* A; const bf16_t* Bt; int M, N, K; };

struct StaticOrder {
    int nM, nN, nwg, G, c;
    __host__ __device__ __forceinline__ void init(int M, int N, int G_, int c_) { nM = M / BM; nN = N / BM; nwg = nM * nN; G = G_; c = c_; }
    __host__ __device__ __forceinline__ bool next(int i, Unit& u) const {
        const long L = (long)i * G + c; if (L >= nwg) return false;
        int wgid = (int)L; { const int q = nwg / NXCD, r = nwg % NXCD, xcd = wgid % NXCD, off = wgid / NXCD; wgid = (xcd < r ? xcd * (q + 1) : r * (q + 1) + (xcd - r) * q) + off; }
        const int nig = WGM * nN, gid = wgid / nig, fm = gid * WGM, gsz = (nM - fm) < WGM ? (nM - fm) : WGM;
        u.pm = fm + ((wgid % nig) % gsz); u.pn = (wgid % nig) / gsz; return true;
    }
    __device__ __forceinline__ void a_ready(const Unit&) const {}
    __device__ __forceinline__ void done(const Unit&) const {}
};

#define EPI_ROW(u, ai, m) ((u).pm * BM + (ai) * HALF + wr * 64 + (m) * 16 + fr)
__device__ __forceinline__ void st_bf16x8(bf16_t* p, f32x4 v0, f32x4 v1) { u32x4 w; w.x = pkbf(v0[0], v0[1]); w.y = pkbf(v0[2], v0[3]); w.z = pkbf(v1[0], v1[1]); w.w = pkbf(v1[2], v1[3]); *(u32x4*)p = w; }

struct EpiProj {
    static constexpr bool PERM = true, AFTER_DRAIN = false;
    bf16_t* proj; const float* ssq; float* out;
    __device__ __forceinline__ void operator()(const f32x4 (&acc)[2][2][4][2], const Unit& u, int wr, int wc, int fr, int fq) const {
        const int colb = u.pn * BM + wc * 32 + 8 * fq;
        const float qs = (u.pn == 4 || u.pn == 5) ? 0.125f : 1.0f;
#pragma unroll
        for (int ai = 0; ai < 2; ++ai)
#pragma unroll
            for (int m = 0; m < 4; ++m) {
                const int row = EPI_ROW(u, ai, m);
                const float rs = __builtin_amdgcn_rsqf(ssq[row] * (1.0f / 1024.0f) + EPS) * qs;
#pragma unroll
                for (int bj = 0; bj < 2; ++bj) {
                    const int col = colb + bj * HALF;
                    const f32x4 v0 = acc[ai][bj][m][0] * rs, v1 = acc[ai][bj][m][1] * rs;
                    st_bf16x8(proj + (size_t)row * DIN + col, v0, v1);
                    float* dst = nullptr;
                    if (u.pn == 6) {
                        const int kc = wc * 32 + 8 * fq;
                        if (row < MP) { const int t = row & 8191, b = row >> 13; if (t >= 8064) dst = out + (bj ? O_PSV : O_PSK) + (size_t)(b * 128 + t - 8064) * 128 + kc; }
                        else { const int r2 = row - MP, b = r2 >> 2, t = r2 & 3; dst = out + (bj ? O_SSV : O_SSK) + (size_t)(b * 128 + 124 + t) * 128 + kc; }
                    } else if (u.pn < 2) {
                        if (row < MP) { const int t = row & 8191, b = row >> 13; if (t >= 8189) dst = out + O_PLC + (size_t)(b * 3 + t - 8189) * 512 + col; }
                        else { const int r2 = row - MP, b = r2 >> 2, t = r2 & 3; if (t >= 1) dst = out + O_SLC + (size_t)(b * 3 + t - 1) * 512 + col; }
                    }
                    if (dst) { *(f32x4*)dst = v0; *(f32x4*)(dst + 4) = v1; }
                }
            }
    }
};
struct EpiMemKV {
    static constexpr bool PERM = true, AFTER_DRAIN = false;
    bf16_t* memkv; const float* ssq; float* out;
    __device__ __forceinline__ void operator()(const f32x4 (&acc)[2][2][4][2], const Unit& u, int wr, int wc, int fr, int fq) const {
        const int colb = u.pn * BM + wc * 32 + 8 * fq;
#pragma unroll
        for (int ai = 0; ai < 2; ++ai)
#pragma unroll
            for (int m = 0; m < 4; ++m) {
                const int row = EPI_ROW(u, ai, m);
                const float rs = __builtin_amdgcn_rsqf(ssq[row] * (1.0f / 1024.0f) + EPS);
#pragma unroll
                for (int bj = 0; bj < 2; ++bj) {
                    const int col = colb + bj * HALF;
                    const f32x4 v0 = acc[ai][bj][m][0] * rs, v1 = acc[ai][bj][m][1] * rs;
                    st_bf16x8(memkv + (size_t)row * 1024 + col, v0, v1);
                    float* dst = out + (col < 512 ? O_PMK + (size_t)row * 512 + col : O_PMV + (size_t)row * 512 + (col - 512));
                    *(f32x4*)dst = v0; *(f32x4*)(dst + 4) = v1;
                }
            }
    }
};
template <int MODE, bool DRY = false> struct EpiRes {
    static constexpr bool PERM = true, AFTER_DRAIN = false;
    const float* resp; float* xout; bf16_t* xb; float* ssq;
    __device__ __forceinline__ void operator()(const f32x4 (&acc)[2][2][4][2], const Unit& u, int wr, int wc, int fr, int fq) const {
        const int colb = u.pn * BM + wc * 32 + 8 * fq;
#pragma unroll
        for (int ai = 0; ai < 2; ++ai)
#pragma unroll
            for (int m = 0; m < 4; ++m) {
                const int row = EPI_ROW(u, ai, m);
                float sq = 0.f;
#pragma unroll
                for (int bj = 0; bj < 2; ++bj) {
                    const int col = colb + bj * HALF;
                    f32x4 v0, v1;
                    if (MODE == 0) { const float* rp = resp + (size_t)row * 1024 + col; v0 = acc[ai][bj][m][0] + *(const f32x4*)rp; v1 = acc[ai][bj][m][1] + *(const f32x4*)(rp + 4); }
                    else { const u32x4 r = *(const u32x4*)(xb + (size_t)row * 1024 + col);
                        v0 = acc[ai][bj][m][0] + (f32x4){bflo(r.x), bfhi(r.x), bflo(r.y), bfhi(r.y)}; v1 = acc[ai][bj][m][1] + (f32x4){bflo(r.z), bfhi(r.z), bflo(r.w), bfhi(r.w)}; }
                    if (!DRY) {
                        if (MODE == 2) { float* op = xout + (size_t)row * 1024 + col; *(f32x4*)op = v0; *(f32x4*)(op + 4) = v1; }
                        else st_bf16x8(xb + (size_t)row * 1024 + col, v0, v1);
                    }
                    sq += (v0[0] * v0[0] + v0[1] * v0[1]) + (v0[2] * v0[2] + v0[3] * v0[3]) + (v1[0] * v1[0] + v1[1] * v1[1]) + (v1[2] * v1[2] + v1[3] * v1[3]);
                }
                if (MODE != 2 || DRY) {
                    sq += __shfl_xor(sq, 16); sq += __shfl_xor(sq, 32);
                    if (!DRY) { if (fq == 0) __hip_atomic_fetch_add(ssq + row, sq, __ATOMIC_RELAXED, __HIP_MEMORY_SCOPE_AGENT); }
                    else if (sq == 12345.678f) ssq[row] = sq;
                }
            }
    }
};
struct EpiQ {
    static constexpr bool PERM = true, AFTER_DRAIN = false;
    bf16_t* qc; const float* ssq;
    __device__ __forceinline__ void operator()(const f32x4 (&acc)[2][2][4][2], const Unit& u, int wr, int wc, int fr, int fq) const {
        const int colb = u.pn * BM + wc * 32 + 8 * fq;
#pragma unroll
        for (int ai = 0; ai < 2; ++ai)
#pragma unroll
            for (int m = 0; m < 4; ++m) {
                const int row = EPI_ROW(u, ai, m);
                const float rs = __builtin_amdgcn_rsqf(ssq[row] * (1.0f / 1024.0f) + EPS) * 0.08838834764831845f;
#pragma unroll
                for (int bj = 0; bj < 2; ++bj) st_bf16x8(qc + (size_t)row * 512 + colb + bj * HALF, acc[ai][bj][m][0] * rs, acc[ai][bj][m][1] * rs);
            }
    }
};
__device__ __forceinline__ float dpp_ror1(float v) { return __builtin_bit_cast(float, __builtin_amdgcn_update_dpp(0, __builtin_bit_cast(int, v), 0x121, 0xf, 0xf, false)); }
__device__ __forceinline__ float dpp_ror2(float v) { return __builtin_bit_cast(float, __builtin_amdgcn_update_dpp(0, __builtin_bit_cast(int, v), 0x122, 0xf, 0xf, false)); }
struct EpiGU {
    static constexpr bool PERM = true, AFTER_DRAIN = false;
    bf16_t* h; const float* ssq; float* edge; const float* wconv; const float* bconv; const float* state; float* out;
    __device__ __forceinline__ void operator()(const f32x4 (&acc)[2][2][4][2], const Unit& u, int wr, int wc, int fr, int fq) const {
        const int chb = u.pn * HALF + wc * 32 + 8 * fq;
        const bool sample = u.pm >= MP / BM;
#pragma unroll
        for (int n = 0; n < 2; ++n) {
            const int ch = chb + 4 * n;
            const f32x4 w0 = *(const f32x4*)(wconv + ch), w1 = *(const f32x4*)(wconv + DFF + ch), w2 = *(const f32x4*)(wconv + 2 * DFF + ch), bc = *(const f32x4*)(bconv + ch);
#pragma unroll
            for (int ai = 0; ai < 2; ++ai) {
                f32x4 p1p = {0.f, 0.f, 0.f, 0.f}, p2p = {0.f, 0.f, 0.f, 0.f};
#pragma unroll
                for (int m = 0; m < 4; ++m) {
                    const int row = EPI_ROW(u, ai, m);
                    const float rs = __builtin_amdgcn_rsqf(ssq[row] * (1.0f / 1024.0f) + EPS);
                    const f32x4 g = acc[ai][0][m][n] * rs, up = acc[ai][1][m][n] * rs;
                    f32x4 p1, p2, g1, g2;
#pragma unroll
                    for (int j = 0; j < 4; ++j) { p1[j] = dpp_ror1(g[j]); p2[j] = dpp_ror2(g[j]); }
                    if (!sample) {
                        g1 = fr >= 1 ? p1 : p1p; g2 = fr >= 2 ? p2 : p2p; p1p = p1; p2p = p2;
                        const int blk = row >> 6;
                        if (m == 0 && fr < 2) { *(f32x4*)(edge + ((size_t)blk * 6 + fr) * DFF + ch) = g; *(f32x4*)(edge + ((size_t)blk * 6 + 4 + fr) * DFF + ch) = up; }
                        if (m == 3 && fr >= 14) {
                            *(f32x4*)(edge + ((size_t)blk * 6 + 2 + (fr - 14)) * DFF + ch) = g;
                            if ((blk & 127) == 127) *(f32x4*)(out + O_PFC + (size_t)((blk >> 7) * 2 + (fr - 14)) * DFF + ch) = g;
                        }
                    } else {
                        const int r2 = row - MP, bs = r2 >> 2, t = r2 & 3;
                        f32x4 s1 = {0.f, 0.f, 0.f, 0.f}, s0 = {0.f, 0.f, 0.f, 0.f};
                        if (t < 2) s1 = *(const f32x4*)(state + ((size_t)bs * 2 + 1) * DFF + ch);
                        if (t == 0) s0 = *(const f32x4*)(state + ((size_t)bs * 2 + 0) * DFF + ch);
                        g1 = t >= 1 ? p1 : s1; g2 = t >= 2 ? p2 : (t == 1 ? s1 : s0);
                        if (t >= 2) *(f32x4*)(out + O_SFC + ((size_t)bs * 2 + (t - 2)) * DFF + ch) = g;
                    }
                    const f32x4 gc = bc + w0 * g2 + w1 * g1 + w2 * g;
                    f32x4 hv;
#pragma unroll
                    for (int j = 0; j < 4; ++j) hv[j] = gelu_tanh(gc[j]) * up[j];
                    typedef unsigned u32x2_t __attribute__((ext_vector_type(2)));
                    u32x2_t w; w.x = pkbf(hv[0], hv[1]); w.y = pkbf(hv[2], hv[3]);
                    *(u32x2_t*)(h + (size_t)row * DFF + ch) = w;
                }
            }
        }
    }
};
template <class Epi, class Sched, bool ALIGN_EPI = false, bool SP2 = false>
__device__ __forceinline__ void gemm_phase(PG8_LAS unsigned char* lds, const Gemm g, const Sched& S, const Epi& E) {
    const int tid = threadIdx.x, wid = __builtin_amdgcn_readfirstlane(tid >> 6), lane = tid & 63, wr = wid >> 2, wc = wid & 3, fr = lane & 15, fq = lane >> 4;
    const int K = g.K, nt = K / BK;
    unsigned voffA[2], voffB[2];
#pragma unroll
    for (int i = 0; i < 2; ++i) { int R, C; stage_rc(tid * 16 + i * 8192, R, C); const int Rb = Epi::PERM ? ((R & ~31) + perm32(R & 31)) : R;
        voffA[i] = (unsigned)(R * K + C) * 2u; voffB[i] = (unsigned)(Rb * K + C) * 2u; }
    const size_t kstep = (size_t)(BK * 2);
    const size_t hstep = (size_t)HALF * K * 2;
    const size_t tstep = 2 * hstep;
    const unsigned ldsw = (unsigned)wid * 1024u;
    const int aoff = lds_byte(wr * 64 + fr, fq * 8), boff = lds_byte(wc * 32 + fr, fq * 8);
#define PG8_SA(b, h) (((b) * 2 + (h)) * HTB)
#define PG8_SB(b, h) ((4 + (b) * 2 + (h)) * HTB)
#define PG8_STAGE(bufoff, gbase, voff) do { _Pragma("unroll") for (int _i = 0; _i < 2; ++_i) \
        __builtin_amdgcn_global_load_lds((const unsigned*)((const char*)(gbase) + (voff)[_i]), (PG8_LAS unsigned*)(lds + (bufoff) + ldsw + _i * 8192), 16, 0, 0); } while (0)
#define PG8_LDA(dst, b, h) do { _Pragma("unroll") for (int m = 0; m < 4; ++m) _Pragma("unroll") for (int k = 0; k < 2; ++k) dst[m][k] = *(const PG8_LAS bf16x8*)(lds + PG8_SA(b, h) + aoff + m * 2048 + k * 1024); } while (0)
#define PG8_LDB(dst, b, h) do { _Pragma("unroll") for (int n = 0; n < 2; ++n) _Pragma("unroll") for (int k = 0; k < 2; ++k) dst[n][k] = *(const PG8_LAS bf16x8*)(lds + PG8_SB(b, h) + boff + n * 2048 + k * 1024); } while (0)
#define PG8_MMA(ai, bj, At, Bt) do { __builtin_amdgcn_s_setprio(1); _Pragma("unroll") for (int m = 0; m < 4; ++m) _Pragma("unroll") for (int n = 0; n < 2; ++n) _Pragma("unroll") for (int k = 0; k < 2; ++k) \
        acc[ai][bj][m][n] = __builtin_amdgcn_mfma_f32_16x16x32_bf16(Bt[n][k], At[m][k], acc[ai][bj][m][n], 0, 0, 0); __builtin_amdgcn_s_setprio(0); } while (0)
#define PG8_WAIT_V(n) asm volatile("s_waitcnt vmcnt(" #n ")" ::: "memory")
#define PG8_WAIT_L(n) asm volatile("s_waitcnt lgkmcnt(" #n ")" ::: "memory")
#define PG8_BAR __builtin_amdgcn_s_barrier()
#define PG8_SCHED __builtin_amdgcn_sched_barrier(0)
    Unit cur, nxt; int ui = 0;
    if (!S.next(0, cur)) return;
    f32x4 acc[2][2][4][2];
#pragma unroll
    for (int a = 0; a < 2; ++a)
#pragma unroll
        for (int b = 0; b < 2; ++b)
#pragma unroll
            for (int m = 0; m < 4; ++m)
#pragma unroll
                for (int n = 0; n < 2; ++n) acc[a][b][m][n] = (f32x4){0.f, 0.f, 0.f, 0.f};
    bf16x8 At[4][2], B0[2][2], B1[2][2];
    const char* cA = (const char*)g.A + (size_t)cur.pm * tstep; const char* cB = (const char*)g.Bt + (size_t)cur.pn * tstep;
    S.a_ready(cur);
    if constexpr (SP2) {
        PG8_STAGE(PG8_SB(0, 0), cB, voffB); PG8_STAGE(PG8_SB(0, 1), cB + hstep, voffB); PG8_STAGE(PG8_SA(0, 0), cA, voffA); PG8_STAGE(PG8_SA(0, 1), cA + hstep, voffA);
        if (wr == 1) PG8_BAR;
        PG8_WAIT_V(2); PG8_BAR;
        PG8_STAGE(PG8_SB(1, 0), cB + kstep, voffB); PG8_STAGE(PG8_SA(1, 0), cA + kstep, voffA); PG8_STAGE(PG8_SB(1, 1), cB + hstep + kstep, voffB);
        PG8_WAIT_V(6); PG8_BAR;
    } else {
        PG8_STAGE(PG8_SB(0, 0), cB, voffB); PG8_STAGE(PG8_SA(0, 0), cA, voffA); PG8_STAGE(PG8_SB(0, 1), cB + hstep, voffB); PG8_STAGE(PG8_SA(0, 1), cA + hstep, voffA);
        if (wr == 1) PG8_BAR;
        PG8_WAIT_V(4); PG8_BAR;
        PG8_STAGE(PG8_SB(1, 0), cB + kstep, voffB); PG8_STAGE(PG8_SA(1, 0), cA + kstep, voffA); PG8_STAGE(PG8_SB(1, 1), cB + hstep + kstep, voffB);
        PG8_WAIT_V(6); PG8_BAR;
    }
    for (;;) {
        const bool has_next = S.next(ui + 1, nxt);
        const char* nA = has_next ? (const char*)g.A + (size_t)nxt.pm * tstep : cA; const char* nB = has_next ? (const char*)g.Bt + (size_t)nxt.pn * tstep : cB;
        for (int t = 0; t < nt; t += 2) {
            const bool last = (t == nt - 2);
            const char* a1 = cA + (size_t)(t + 1) * kstep;
            const char* a2 = last ? nA : cA + (size_t)(t + 2) * kstep; const char* b2 = last ? nB : cB + (size_t)(t + 2) * kstep;
            const char* a3 = a2 + kstep; const char* b3 = b2 + kstep;
            if (last && has_next) S.a_ready(nxt);
            if constexpr (SP2) {
            PG8_LDB(B0, 0, 0); PG8_LDB(B1, 0, 1); PG8_SCHED; PG8_LDA(At, 0, 0); PG8_STAGE(PG8_SA(1, 1), a1 + hstep, voffA);
            PG8_WAIT_V(8); PG8_WAIT_L(0); PG8_BAR; PG8_MMA(0, 0, At, B0); PG8_MMA(0, 1, At, B1); PG8_BAR; PG8_SCHED;
            PG8_LDA(At, 0, 1); PG8_STAGE(PG8_SB(0, 0), b2, voffB); PG8_STAGE(PG8_SB(0, 1), b2 + hstep, voffB); PG8_STAGE(PG8_SA(0, 0), a2, voffA);
            PG8_WAIT_V(8); PG8_WAIT_L(0); PG8_BAR; PG8_MMA(1, 0, At, B0); PG8_MMA(1, 1, At, B1); PG8_BAR; PG8_SCHED;
            PG8_LDB(B0, 1, 0); PG8_LDB(B1, 1, 1); PG8_SCHED; PG8_LDA(At, 1, 0); PG8_STAGE(PG8_SA(0, 1), a2 + hstep, voffA);
            PG8_WAIT_V(8); PG8_WAIT_L(0); PG8_BAR; PG8_MMA(0, 0, At, B0); PG8_MMA(0, 1, At, B1); PG8_BAR; PG8_SCHED;
            PG8_LDA(At, 1, 1); PG8_STAGE(PG8_SB(1, 0), b3, voffB); PG8_STAGE(PG8_SB(1, 1), b3 + hstep, voffB); PG8_STAGE(PG8_SA(1, 0), a3, voffA);
            PG8_WAIT_V(8); PG8_WAIT_L(0); PG8_BAR; PG8_MMA(1, 0, At, B0); PG8_MMA(1, 1, At, B1); PG8_BAR; PG8_SCHED;
            } else {
            PG8_LDB(B0, 0, 0); PG8_SCHED; PG8_LDA(At, 0, 0); PG8_STAGE(PG8_SA(1, 1), a1 + hstep, voffA);
            PG8_WAIT_L(8); PG8_BAR; PG8_WAIT_L(0); PG8_MMA(0, 0, At, B0); PG8_BAR; PG8_SCHED;
            PG8_LDB(B1, 0, 1); PG8_STAGE(PG8_SB(0, 0), b2, voffB);
            PG8_BAR; PG8_WAIT_L(0); PG8_MMA(0, 1, At, B1); PG8_BAR;
            PG8_LDA(At, 0, 1); PG8_STAGE(PG8_SA(0, 0), a2, voffA);
            PG8_BAR; PG8_WAIT_L(0); PG8_MMA(1, 0, At, B0); PG8_BAR; PG8_SCHED;
            PG8_STAGE(PG8_SB(0, 1), b2 + hstep, voffB);
            PG8_WAIT_V(6); PG8_BAR; PG8_MMA(1, 1, At, B1); PG8_BAR;
            PG8_LDB(B0, 1, 0); PG8_SCHED; PG8_LDA(At, 1, 0); PG8_STAGE(PG8_SA(0, 1), a2 + hstep, voffA);
            PG8_WAIT_L(8); PG8_BAR; PG8_WAIT_L(0); PG8_MMA(0, 0, At, B0); PG8_BAR; PG8_SCHED;
            PG8_LDB(B1, 1, 1); PG8_STAGE(PG8_SB(1, 0), b3, voffB);
            PG8_BAR; PG8_WAIT_L(0); PG8_MMA(0, 1, At, B1); PG8_BAR;
            PG8_LDA(At, 1, 1); PG8_STAGE(PG8_SA(1, 0), a3, voffA);
            PG8_BAR; PG8_WAIT_L(0); PG8_MMA(1, 0, At, B0); PG8_BAR; PG8_SCHED;
            PG8_STAGE(PG8_SB(1, 1), b3 + hstep, voffB);
            PG8_WAIT_V(6); PG8_BAR; PG8_MMA(1, 1, At, B1); PG8_BAR;
            }
        }
        if constexpr (ALIGN_EPI) { if (wr == 0) PG8_BAR; }
        if constexpr (!Epi::AFTER_DRAIN) { E(acc, cur, wr, wc, fr, fq); S.done(cur); }
        if (!has_next) break;
#pragma unroll
        for (int a = 0; a < 2; ++a)
#pragma unroll
            for (int b = 0; b < 2; ++b)
#pragma unroll
                for (int m = 0; m < 4; ++m)
#pragma unroll
                    for (int n = 0; n < 2; ++n) acc[a][b][m][n] = (f32x4){0.f, 0.f, 0.f, 0.f};
        cur = nxt; cA = nA; cB = nB; ++ui;
        if constexpr (ALIGN_EPI) { if (wr == 1) PG8_BAR; }
    }
    PG8_WAIT_V(0);
    if constexpr (!ALIGN_EPI) { if (wr == 0) PG8_BAR; }
    PG8_BAR;
    if constexpr (Epi::AFTER_DRAIN) { E.fused(acc, cur, wr, wc, fr, fq, lds, wid, lane); S.done(cur); }
#undef PG8_SA
#undef PG8_SB
#undef PG8_STAGE
#undef PG8_LDA
#undef PG8_LDB
#undef PG8_MMA
#undef PG8_WAIT_V
#undef PG8_WAIT_L
#undef PG8_BAR
#undef PG8_SCHED
}
}

#define LAS __attribute__((address_space(3)))
typedef unsigned short bf16_t;
typedef short bf16x8 __attribute__((ext_vector_type(8)));
typedef short s16x4 __attribute__((ext_vector_type(4)));
typedef float f32x4 __attribute__((ext_vector_type(4)));
typedef float f32x16 __attribute__((ext_vector_type(16)));
typedef unsigned u32x4 __attribute__((ext_vector_type(4)));
typedef unsigned u32x2 __attribute__((ext_vector_type(2)));
typedef LAS unsigned char* ldsp;
constexpr int NWAVES = 8, NTHREADS = 512, LDS_BYTES = 147456;
#define MFMA32(a, b, c) __builtin_amdgcn_mfma_f32_32x32x16_bf16((a), (b), (c), 0, 0, 0)
#define MFMA16(a, b, c) __builtin_amdgcn_mfma_f32_16x16x32_bf16((a), (b), (c), 0, 0, 0)
__device__ __forceinline__ int crow(int r, int hi) { return (r & 3) + 8 * (r >> 2) + 4 * hi; }
__device__ __forceinline__ unsigned f2bf(float f) { return pkbf(f, 0.f) & 0xffffu; }
__device__ __forceinline__ float wave_sum(float v) {
#pragma unroll
    for (int o = 1; o < 64; o <<= 1) v += __shfl_xor(v, o);
    return v;
}
__device__ __forceinline__ bf16x8 pack8(const f32x16& x, int s) {
    u32x4 p; p.x = pkbf(x[8 * s], x[8 * s + 1]); p.y = pkbf(x[8 * s + 2], x[8 * s + 3]); p.z = pkbf(x[8 * s + 4], x[8 * s + 5]); p.w = pkbf(x[8 * s + 6], x[8 * s + 7]);
    return __builtin_bit_cast(bf16x8, p);
}

struct Args {
    const float* in[34]; float* out; unsigned char* ws; int ph_lo, ph_hi;
};
typedef const __attribute__((address_space(4))) Args* KA;
enum { I_XP = 0, I_XS, I_CSK, I_CSV, I_CMK, I_CMV, I_SLC, I_SLH, I_SFC, I_MEMP, I_GMIX, I_WIN, I_WLC, I_BLC, I_WLA, I_BLA, I_WLX, I_BLX, I_LAM, I_SINK, I_WOUT, I_GCROSS, I_GMEM,
       I_WMQ, I_WMK, I_WMV, I_WMO, I_GFFN, I_WFG, I_WFU, I_WFC, I_BFC, I_WFD, I_GFIN };

#define RLX_AGENT __ATOMIC_RELAXED, __HIP_MEMORY_SCOPE_AGENT
constexpr size_t WS_BAR = 896 * 1024, BAR_ZERO_BYTES = 16384;
constexpr int MISC_OFF = LDS_BYTES - 64;
#define XB_TMO      128
#define XB_XCNT(j)  (256  + 64 * (j))
#define XB_XSUB(j)  (1280 + 64 * (j))
#define XB_XGEN(j)  (2304 + 64 * (j))
#define XB_TOP      3328
#define XB_TOPGEN   3392
#define XCD_BAR_WORDS 3456
#define XB_SPIN_CAP (1u << 18)

__device__ __forceinline__ unsigned xb_ld(unsigned* p)              { return __hip_atomic_load(p, __ATOMIC_RELAXED, __HIP_MEMORY_SCOPE_AGENT); }
__device__ __forceinline__ unsigned xb_add(unsigned* p, unsigned v) { return __hip_atomic_fetch_add(p, v, __ATOMIC_RELAXED, __HIP_MEMORY_SCOPE_AGENT); }
__device__ __forceinline__ unsigned xb_xcc_id() { return (unsigned)__builtin_amdgcn_s_getreg((3 << 11) | 20) & 0xFu; }
#define XB_SPIN(cond, bar) do { unsigned _sp = 0; while (cond) { __builtin_amdgcn_s_sleep(1); \
    if ((++_sp & 255u) == 0u) { if (xb_ld(&(bar)[XB_TMO])) break; if (_sp > XB_SPIN_CAP) { atomicAdd(&(bar)[XB_TMO], 1u); break; } } } } while (0)

struct XcdBarrier {
    unsigned* bar; unsigned x;
    volatile LAS unsigned* st;
};

__device__ __forceinline__ XcdBarrier xcd_barrier_post(unsigned* bar, volatile LAS unsigned* st) {
    XcdBarrier b; b.bar = bar; b.x = xb_xcc_id(); b.st = st;
    if (threadIdx.x == 0) (void)xb_add(&bar[XB_XCNT(b.x)], 1u);
    return b;
}
__device__ __forceinline__ void xcd_barrier_complete(unsigned* bar, unsigned x, unsigned& nloc, unsigned& nx) {
    const unsigned G = gridDim.x * gridDim.y * gridDim.z;
    unsigned sum, cnt, mine, sp = 0u;
    for (;;) {
        sum = 0u; cnt = 0u; mine = 0u;
#pragma unroll
        for (unsigned j = 0; j < 16; ++j) { const unsigned c = xb_ld(&bar[XB_XCNT(j)]); sum += c; cnt += (c > 0u) ? 1u : 0u; mine = (j == x) ? c : mine; }
        if (sum == G) break;
        __builtin_amdgcn_s_sleep(1);
        if ((++sp & 255u) == 0u) { if (xb_ld(&bar[XB_TMO])) break; if (sp > XB_SPIN_CAP) { atomicAdd(&bar[XB_TMO], 1u); break; } }
    }
    nloc = mine > 0u ? mine : 1u; nx = cnt > 0u ? cnt : 1u;
}

__device__ __forceinline__ void xcd_barrier(const XcdBarrier& b) {
    asm volatile("s_waitcnt vmcnt(0)" ::: "memory");
    __syncthreads();
    if (threadIdx.x == 0) {
        unsigned* bar = b.bar;
        __builtin_amdgcn_s_waitcnt(0);
        unsigned nloc = b.st[0], nx = b.st[1];
        if (nloc == 0u) { xcd_barrier_complete(bar, b.x, nloc, nx); b.st[0] = nloc; b.st[1] = nx; }
        const unsigned old = xb_add(&bar[XB_XSUB(b.x)], 1u);
        const unsigned gen = old / nloc;
        if (old + 1u == (gen + 1u) * nloc) {
            __builtin_amdgcn_fence(__ATOMIC_RELEASE, "agent");
            asm volatile("s_waitcnt vmcnt(0)" ::: "memory");
            const unsigned og = xb_add(&bar[XB_TOP], 1u);
            const unsigned tg = og / nx;
            if (og + 1u == (tg + 1u) * nx) xb_add(&bar[XB_TOPGEN], 1u);
            else XB_SPIN(xb_ld(&bar[XB_TOPGEN]) == tg, bar);
            __builtin_amdgcn_fence(__ATOMIC_ACQUIRE, "agent");
            xb_add(&bar[XB_XGEN(b.x)], 1u);
            asm volatile("s_waitcnt vmcnt(0)" ::: "memory");
        } else {
            XB_SPIN(xb_ld(&bar[XB_XGEN(b.x)]) == gen, bar);
            __builtin_amdgcn_fence(__ATOMIC_ACQUIRE, "agent");
            asm volatile("s_waitcnt vmcnt(0)" ::: "memory");
        }
    }
    __syncthreads();
}

__device__ __forceinline__ void p0_transpose_item(const float* W, const float* g, int K, int N, bf16_t* WT, int row_off, int ilv, LAS float* scr, int item, int lane) {
    const int nblk = N / 32, kb = item / nblk, nb = item % nblk, k0 = 64 * kb, n0 = 32 * nb;
#pragma unroll 8
    for (int i = 0; i < 32; ++i) { const int kk = 2 * i + (lane >> 5); const float s = g ? g[k0 + kk] : 1.0f; scr[kk * 33 + (lane & 31)] = W[(size_t)(k0 + kk) * N + n0 + (lane & 31)] * s; }
    asm volatile("s_waitcnt lgkmcnt(0)" ::: "memory");
    const int c = lane & 7;
    const int rbase = ilv ? (((n0 >> 7) << 8) + (n0 & 127) + (ilv == 2 ? 128 : 0)) : (row_off + n0);
#pragma unroll
    for (int j = 0; j < 4; ++j) { const int n = (lane >> 3) + 8 * j; const LAS float* s = scr + (8 * c) * 33 + n;
        u32x4 o; o.x = pkbf(s[0 * 33], s[1 * 33]); o.y = pkbf(s[2 * 33], s[3 * 33]); o.z = pkbf(s[4 * 33], s[5 * 33]); o.w = pkbf(s[6 * 33], s[7 * 33]);
        *(u32x4*)(WT + (size_t)(rbase + n) * K + k0 + 8 * c) = o; }
    asm volatile("s_waitcnt lgkmcnt(0)" ::: "memory");
}
__device__ __forceinline__ void row_to_bf16(const float* xrow, bf16_t* orow, float* ssq, int lane) {
    const f32x4* xr = (const f32x4*)xrow + lane;
    f32x4 v[4]; float s = 0.f;
#pragma unroll
    for (int j = 0; j < 4; ++j) { v[j] = xr[64 * j]; s += (v[j].x * v[j].x + v[j].y * v[j].y) + (v[j].z * v[j].z + v[j].w * v[j].w); }
    s = wave_sum(s);
    u32x2* o8 = (u32x2*)orow + lane;
#pragma unroll
    for (int j = 0; j < 4; ++j) { u32x2 w; w.x = pkbf(v[j].x, v[j].y); w.y = pkbf(v[j].z, v[j].w); o8[64 * j] = w; }
    if (lane == 0) *ssq = s;
}
__device__ __forceinline__ void p0_prologue(KA a, ldsp lds, int tid, int lane, int wave) {
    unsigned char* ws = a->ws;
    LAS float* scr = (LAS float*)(lds + wave * 16384);
    const int gw = blockIdx.x * NWAVES + wave, NGW = gridDim.x * NWAVES;
    constexpr int I_IN = 16 * 56, I_OUT = 16 * 32, I_Q = 16 * 16, I_MO = 8 * 32, I_G = 16 * 96, I_D = 48 * 32;
    constexpr int NITEMS = I_IN + I_OUT + 3 * I_Q + I_MO + 2 * I_G + I_D;
    for (int it = gw; it < NITEMS; it += NGW) {
        int r = it;
        if (r < I_IN) { p0_transpose_item(a->in[I_WIN], a->in[I_GMIX], 1024, DIN, (bf16_t*)(ws + WS_WIN), 0, 0, scr, r, lane); continue; } r -= I_IN;
        if (r < I_OUT) { p0_transpose_item(a->in[I_WOUT], nullptr, 1024, 1024, (bf16_t*)(ws + WS_WOUT), 0, 0, scr, r, lane); continue; } r -= I_OUT;
        if (r < I_Q) { p0_transpose_item(a->in[I_WMQ], a->in[I_GCROSS], 1024, 512, (bf16_t*)(ws + WS_WQ), 0, 0, scr, r, lane); continue; } r -= I_Q;
        if (r < I_Q) { p0_transpose_item(a->in[I_WMK], a->in[I_GMEM], 1024, 512, (bf16_t*)(ws + WS_WKV), 0, 0, scr, r, lane); continue; } r -= I_Q;
        if (r < I_Q) { p0_transpose_item(a->in[I_WMV], a->in[I_GMEM], 1024, 512, (bf16_t*)(ws + WS_WKV), 512, 0, scr, r, lane); continue; } r -= I_Q;
        if (r < I_MO) { p0_transpose_item(a->in[I_WMO], nullptr, 512, 1024, (bf16_t*)(ws + WS_WMO), 0, 0, scr, r, lane); continue; } r -= I_MO;
        if (r < I_G) { p0_transpose_item(a->in[I_WFG], a->in[I_GFFN], 1024, DFF, (bf16_t*)(ws + WS_WGU), 0, 1, scr, r, lane); continue; } r -= I_G;
        if (r < I_G) { p0_transpose_item(a->in[I_WFU], a->in[I_GFFN], 1024, DFF, (bf16_t*)(ws + WS_WGU), 0, 2, scr, r, lane); continue; } r -= I_G;
        p0_transpose_item(a->in[I_WFD], nullptr, DFF, 1024, (bf16_t*)(ws + WS_WD), 0, 0, scr, r, lane);
    }
    bf16_t* xb = (bf16_t*)(ws + WS_XB); float* ssq0 = (float*)(ws + WS_SSQ0);
    for (int m = gw; m < MT + 512; m += NGW) {
        if (m < MP) row_to_bf16(a->in[I_XP] + (size_t)m * 1024, xb + (size_t)m * 1024, ssq0 + m, lane);
        else if (m < MT) row_to_bf16(a->in[I_XS] + (size_t)(m - MP) * 1024, xb + (size_t)m * 1024, ssq0 + m, lane);
        else { const int r = m - MT; row_to_bf16(a->in[I_MEMP] + (size_t)r * 1024, (bf16_t*)(ws + WS_MEMA) + (size_t)r * 1024, (float*)(ws + WS_SSQM) + r, lane); }
    }
    for (int i = blockIdx.x * NTHREADS + tid; i < MT; i += gridDim.x * NTHREADS) { ((float*)(ws + WS_SSQ1))[i] = 0.f; ((float*)(ws + WS_SSQ2))[i] = 0.f; ((float*)(ws + WS_SSQ3))[i] = 0.f; }
}

template <bool SAMPLE, int PASS>
__device__ __forceinline__ void lru_unit(KA a, ldsp lds, int unit, int tid, int lane, int w) {
    constexpr int NTOK = SAMPLE ? 64 : 256, NROW = SAMPLE ? (NTOK / 4) * 7 : NTOK + 3, RS = 272;
    const ldsp XR = lds, XC = lds + 259 * RS;
    unsigned char* ws = a->ws;
    const bf16_t* proj = (const bf16_t*)(ws + WS_PROJ);
    int b = 0, chunk, bp;
    if (!SAMPLE) { b = unit >> 7; chunk = (unit >> 2) & 31; bp = unit & 3; } else { chunk = unit >> 2; bp = unit & 3; }
    const int c0 = bp * 128;
    const int row0 = SAMPLE ? MP + chunk * 64 : b * SEQ + chunk * 256;
    __syncthreads();
    for (int it = tid; it < NROW * 16; it += NTHREADS) {
        const int r = it >> 4, cq = it & 15;
        u32x4 v = {0u, 0u, 0u, 0u};
        if (!SAMPLE) { const int t = chunk * 256 - 3 + r; if (t >= 0) v = *(const u32x4*)(proj + (size_t)(b * SEQ + t) * DIN + c0 + cq * 8); }
        else { const int bl = r / 7, rr = r % 7, bs = chunk * 16 + bl;
            if (rr >= 3) v = *(const u32x4*)(proj + (size_t)(MP + bs * 4 + rr - 3) * DIN + c0 + cq * 8);
            else { const float* s = a->in[I_SLC] + (size_t)(bs * 3 + rr) * 512 + c0 + cq * 8; const f32x4 s0 = *(const f32x4*)s, s1 = *(const f32x4*)(s + 4);
                v.x = pkbf(s0[0], s0[1]); v.y = pkbf(s0[2], s0[3]); v.z = pkbf(s1[0], s1[1]); v.w = pkbf(s1[2], s1[3]); } }
        *(LAS u32x4*)(XR + r * RS + cq * 16) = v;
    }
    __syncthreads();
    {
        const int cq = tid & 15, tg = tid >> 4;
        float wk[4][8], bb[8];
#pragma unroll
        for (int j = 0; j < 8; ++j) { bb[j] = a->in[I_BLC][c0 + cq * 8 + j];
#pragma unroll
            for (int k = 0; k < 4; ++k) wk[k][j] = a->in[I_WLC][k * 512 + c0 + cq * 8 + j]; }
#pragma unroll
        for (int q = 0; q < NTOK / 32; ++q) {
            const int tok = tg * (NTOK / 32) + q; const int base = SAMPLE ? (tok >> 2) * 7 + (tok & 3) : tok;
            float x[8];
#pragma unroll
            for (int j = 0; j < 8; ++j) x[j] = bb[j];
#pragma unroll
            for (int k = 0; k < 4; ++k) { const u32x4 v = *(const LAS u32x4*)(XR + (base + k) * RS + cq * 16);
                x[0] += wk[k][0] * bflo(v.x); x[1] += wk[k][1] * bfhi(v.x); x[2] += wk[k][2] * bflo(v.y); x[3] += wk[k][3] * bfhi(v.y);
                x[4] += wk[k][4] * bflo(v.z); x[5] += wk[k][5] * bfhi(v.z); x[6] += wk[k][6] * bflo(v.w); x[7] += wk[k][7] * bfhi(v.w); }
            u32x4 o; o.x = pkbf(x[0], x[1]); o.y = pkbf(x[2], x[3]); o.z = pkbf(x[4], x[5]); o.w = pkbf(x[6], x[7]);
            *(LAS u32x4*)(XC + tok * RS + cq * 16) = o;
        }
    }
    __syncthreads();
    const int nb = w >> 2, jt = w & 3, n = bp * 2 + nb, fr = lane & 15, fq = lane >> 4;
    const int ch = n * 64 + jt * 16 + fr, chl = nb * 64 + jt * 16 + fr;
    bf16x8 bA[2], bX[2];
#pragma unroll
    for (int kh = 0; kh < 2; ++kh)
#pragma unroll
        for (int j = 0; j < 8; ++j) { const int c = kh * 32 + 8 * fq + j; const size_t o = (size_t)(n * 64 + c) * 64 + jt * 16 + fr;
            bA[kh][j] = (short)f2bf(a->in[I_WLA][o]); bX[kh][j] = (short)f2bf(a->in[I_WLX][o]); }
    const float ba_ = a->in[I_BLA][ch], bx_ = a->in[I_BLX][ch];
    const float lam = a->in[I_LAM][ch];
    const float sp = (lam > 15.f) ? __expf(-lam) : log1pf(__expf(-lam));
    const float k8 = -8.0f * sp * LOG2E;
    const float wc0 = a->in[I_WLC][ch], wc1 = a->in[I_WLC][512 + ch], wc2 = a->in[I_WLC][1024 + ch], wc3 = a->in[I_WLC][1536 + ch], bcv = a->in[I_BLC][ch];
    float hc = 0.f, Atot = 1.f, Htot = 0.f;
    float* summ = (float*)(ws + WS_SUMM);
    if (!SAMPLE && PASS == 2) { for (int j = 0; j < chunk; ++j) { const float A = summ[((size_t)(b * 32 + j) * 512 + ch) * 2], H = summ[((size_t)(b * 32 + j) * 512 + ch) * 2 + 1]; hc = A * hc + H; } }
    bf16_t* mix = (bf16_t*)(ws + WS_MIX);
    for (int s = 0; s < NTOK / 16; ++s) {
        bf16x8 aF[2];
#pragma unroll
        for (int kh = 0; kh < 2; ++kh) aF[kh] = *(const LAS bf16x8*)(XC + (16 * s + fr) * RS + (nb * 64 + kh * 32 + 8 * fq) * 2);
        f32x4 accA = {0.f, 0.f, 0.f, 0.f}, accX = {0.f, 0.f, 0.f, 0.f};
        accA = MFMA16(aF[0], bA[0], accA); accA = MFMA16(aF[1], bA[1], accA);
        accX = MFMA16(aF[0], bX[0], accX); accX = MFMA16(aF[1], bX[1], accX);
        const int base = SAMPLE ? (4 * s + fq) * 7 : 16 * s + 4 * fq;
        float x7[7];
#pragma unroll
        for (int q = 0; q < 7; ++q) x7[q] = bf2f(*(const LAS unsigned short*)(XR + (base + q) * RS + chl * 2));
        float av[4], bv[4];
#pragma unroll
        for (int r = 0; r < 4; ++r) {
            const float xc = bcv + wc0 * x7[r] + wc1 * x7[r + 1] + wc2 * x7[r + 2] + wc3 * x7[r + 3];
            const float rg = sigmoidf_(accA[r] + ba_), ig = sigmoidf_(accX[r] + bx_);
            const float a_ = fexp2(k8 * rg);
            av[r] = a_; bv[r] = __builtin_sqrtf(fmaxf(1.0f - a_ * a_, 0.f)) * (ig * xc);
        }
        float hv[4];
        if (SAMPLE) {
            const int bs = chunk * 16 + 4 * s + fq;
            float h = a->in[I_SLH][(size_t)bs * 512 + ch];
#pragma unroll
            for (int r = 0; r < 4; ++r) { h = av[r] * h + bv[r]; hv[r] = h; }
            a->out[O_SLH + (size_t)bs * 512 + ch] = h;
        } else {
            float Ai = av[0] * av[1] * av[2] * av[3], Hi = 0.f;
#pragma unroll
            for (int r = 0; r < 4; ++r) Hi = av[r] * Hi + bv[r];
            float tA = __shfl_up(Ai, 16), tH = __shfl_up(Hi, 16);
            if (fq >= 1) { Hi = Ai * tH + Hi; Ai = Ai * tA; }
            tA = __shfl_up(Ai, 32); tH = __shfl_up(Hi, 32);
            if (fq >= 2) { Hi = Ai * tH + Hi; Ai = Ai * tA; }
            float Ae = __shfl_up(Ai, 16), He = __shfl_up(Hi, 16);
            if (fq == 0) { Ae = 1.f; He = 0.f; }
            const float At = __shfl(Ai, 48 + fr), Ht = __shfl(Hi, 48 + fr);
            if (PASS == 1) { Htot = At * Htot + Ht; Atot *= At; }
            else {
                float h = Ae * hc + He;
#pragma unroll
                for (int r = 0; r < 4; ++r) { h = av[r] * h + bv[r]; hv[r] = h; }
                hc = At * hc + Ht;
            }
        }
        if (SAMPLE || PASS == 2) {
#pragma unroll
            for (int r = 0; r < 4; ++r) {
                const size_t row = (size_t)row0 + 16 * s + 4 * fq + r;
                const float gt = bf2f(proj[row * DIN + 512 + ch]);
                mix[row * 1024 + ch] = (bf16_t)f2bf(hv[r] * gelu_tanh(gt));
            }
        }
    }
    if (!SAMPLE && PASS == 1 && fq == 0) { summ[((size_t)(b * 32 + chunk) * 512 + ch) * 2] = Atot; summ[((size_t)(b * 32 + chunk) * 512 + ch) * 2 + 1] = Htot; }
    if (!SAMPLE && PASS == 2 && chunk == 31 && fq == 0) a->out[O_PLH + (size_t)b * 512 + ch] = hc;
}

__device__ __forceinline__ void swa_prompt_unit(KA a, ldsp lds, int unit, int tid, int lane, int w) {
    constexpr int KRS = 144, VRS = 400;
    const ldsp Ks = lds, VT = lds + 192 * KRS;
    const bf16_t* proj = (const bf16_t*)(a->ws + WS_PROJ);
    const int b = unit >> 8, hk = (unit >> 7) & 1, qb = unit & 127, t0 = qb * 64;
    __syncthreads();
    for (int it = tid; it < 192 * 8; it += NTHREADS) {
        const int kl = it >> 3, cq = it & 7, t = t0 - 128 + kl;
        u32x4 kv = {0u, 0u, 0u, 0u}, vv = {0u, 0u, 0u, 0u};
        if (t >= 0) { const bf16_t* p = proj + (size_t)(b * SEQ + t) * DIN; kv = *(const u32x4*)(p + 1536 + hk * 64 + cq * 8); vv = *(const u32x4*)(p + 1664 + hk * 64 + cq * 8); }
        *(LAS u32x4*)(Ks + kl * KRS + cq * 16) = kv;
#pragma unroll
        for (int e = 0; e < 8; ++e) *(LAS unsigned short*)(VT + (cq * 8 + e) * VRS + kl * 2) = (unsigned short)(vv[e >> 1] >> (16 * (e & 1)));
    }
    __syncthreads();
    const int g = w >> 1, hf = w & 1, hq = hk * 4 + g, j = lane & 31, hi = lane >> 5;
    const size_t qrow = (size_t)b * SEQ + t0 + 32 * hf + j;
    bf16x8 qf[4];
#pragma unroll
    for (int ks = 0; ks < 4; ++ks) qf[ks] = *(const bf16x8*)(proj + qrow * DIN + 1024 + hq * 64 + 16 * ks + 8 * hi);
    const float slope2 = fexp2(-(float)(hq + 1)) * LOG2E, sink2 = a->in[I_SINK][hq] * LOG2E;
    float mx = sink2;
    f32x16 st[5];
#pragma unroll
    for (int kt = 0; kt < 5; ++kt) {
        f32x16 acc = {};
#pragma unroll
        for (int ks = 0; ks < 4; ++ks) { const bf16x8 kf = *(const LAS bf16x8*)(Ks + (32 * hf + 32 * kt + j) * KRS + (16 * ks + 8 * hi) * 2); acc = MFMA32(kf, qf[ks], acc); }
        int dbase = 128 + j - 32 * kt - 4 * hi;
        int kpb = t0 - 128 + 32 * hf + 32 * kt + 4 * hi;
        asm volatile("" : "+v"(dbase), "+v"(kpb));
#pragma unroll
        for (int r = 0; r < 16; ++r) {
            const int cr = (r & 3) + 8 * (r >> 2), dist = dbase - cr;
            const bool valid = (unsigned)dist < 128u && (kpb + cr) >= 0;
            float s = acc[r] * LOG2E - slope2 * (float)dist; s = valid ? s : -1e30f; acc[r] = s; mx = fmaxf(mx, s);
        }
        st[kt] = acc;
        __builtin_amdgcn_sched_barrier(0);
    }
    mx = fmaxf(mx, __shfl_xor(mx, 32));
    float l = 0.f;
#pragma unroll
    for (int kt = 0; kt < 5; ++kt)
#pragma unroll
        for (int r = 0; r < 16; ++r) { const float p = fexp2(st[kt][r] - mx); st[kt][r] = p; l += p; }
    l += __shfl_xor(l, 32); l += fexp2(sink2 - mx);
    const float inv = frcp(l);
    f32x16 o[2] = {};
#pragma unroll
    for (int kt = 0; kt < 5; ++kt)
#pragma unroll
        for (int s = 0; s < 2; ++s) {
            const bf16x8 pf = pack8(st[kt], s);
#pragma unroll
            for (int dt = 0; dt < 2; ++dt) {
                const int d = 32 * dt + j, kb = 32 * hf + 32 * kt + 16 * s + 4 * hi;
                const s16x4 lo = *(const LAS s16x4*)(VT + d * VRS + kb * 2), hi4 = *(const LAS s16x4*)(VT + d * VRS + (kb + 8) * 2);
                const bf16x8 vf = __builtin_shufflevector(lo, hi4, 0, 1, 2, 3, 4, 5, 6, 7);
                o[dt] = MFMA32(vf, pf, o[dt]);
            }
            __builtin_amdgcn_sched_barrier(0);
        }
    bf16_t* mix = (bf16_t*)(a->ws + WS_MIX);
#pragma unroll
    for (int dt = 0; dt < 2; ++dt)
#pragma unroll
        for (int rg = 0; rg < 4; ++rg) {
            u32x2 wv; wv.x = pkbf(o[dt][4 * rg] * inv, o[dt][4 * rg + 1] * inv); wv.y = pkbf(o[dt][4 * rg + 2] * inv, o[dt][4 * rg + 3] * inv);
            *(u32x2*)(mix + qrow * 1024 + 512 + hq * 64 + 32 * dt + 8 * rg + 4 * hi) = wv;
        }
}

__device__ __forceinline__ void swa_sample_unit(KA a, ldsp lds, int bs, int tid) {
    LAS float* Kc = (LAS float*)lds;
    LAS float* Vc = (LAS float*)(lds + 69696);
    LAS float* Qs = (LAS float*)(lds + 137280);
    LAS float* P = Kc;
    const bf16_t* proj = (const bf16_t*)(a->ws + WS_PROJ);
    __syncthreads();
    for (int it = tid; it < 128 * 32; it += NTHREADS) {
        const int r = it >> 5, c4 = (it & 31) * 4;
        const f32x4 kv = *(const f32x4*)(a->in[I_CSK] + (size_t)(bs * 128 + r) * 128 + c4), vv = *(const f32x4*)(a->in[I_CSV] + (size_t)(bs * 128 + r) * 128 + c4);
        *(LAS f32x4*)(Kc + r * 132 + c4) = kv; *(LAS f32x4*)(Vc + r * 128 + c4) = vv;
        if (r >= 4) { *(f32x4*)(a->out + O_SSK + (size_t)(bs * 128 + r - 4) * 128 + c4) = kv; *(f32x4*)(a->out + O_SSV + (size_t)(bs * 128 + r - 4) * 128 + c4) = vv; }
    }
    { const int i = tid >> 7, c = tid & 127; const bf16_t* p = proj + (size_t)(MP + bs * 4 + i) * DIN; Kc[(128 + i) * 132 + c] = bf2f(p[1536 + c]); Vc[(128 + i) * 128 + c] = bf2f(p[1664 + c]); }
    for (int e = tid; e < 2048; e += NTHREADS) { const int rq = e >> 6, d = e & 63, hq = rq >> 2, i = rq & 3; Qs[rq * 64 + d] = bf2f(proj[(size_t)(MP + bs * 4 + i) * DIN + 1024 + hq * 64 + d]); }
    __syncthreads();
    float sc[16];
    const int key = tid % 132, hk = tid / 132;
#pragma unroll
    for (int q = 0; q < 16; ++q) sc[q] = 0.f;
    if (tid < 264) {
#pragma unroll 1
        for (int c = 0; c < 16; ++c) {
            const f32x4 k4 = *(const LAS f32x4*)(Kc + key * 132 + hk * 64 + 4 * c);
#pragma unroll
            for (int q = 0; q < 16; ++q) { const f32x4 q4 = *(const LAS f32x4*)(Qs + (hk * 16 + q) * 64 + 4 * c); sc[q] += (k4[0] * q4[0] + k4[1] * q4[1]) + (k4[2] * q4[2] + k4[3] * q4[3]); }
        }
    }
    __syncthreads();
    if (tid < 264) {
#pragma unroll
        for (int q = 0; q < 16; ++q) { const int hq = hk * 4 + (q >> 2), i = q & 3, dist = i + 128 - key; const bool valid = dist >= 0 && dist < 128;
            const float s = sc[q] * LOG2E - fexp2(-(float)(hq + 1)) * LOG2E * (float)dist; P[(hk * 16 + q) * 132 + key] = valid ? s : -1e30f; }
    }
    __syncthreads();
    {
        const int row = tid >> 4, sub = tid & 15, hq = row >> 2; const float sink2 = a->in[I_SINK][hq] * LOG2E;
        float v[9], m = sink2;
#pragma unroll
        for (int jj = 0; jj < 9; ++jj) { const int k2 = sub + 16 * jj; v[jj] = k2 < 132 ? P[row * 132 + k2] : -1e30f; m = fmaxf(m, v[jj]); }
#pragma unroll
        for (int o = 8; o >= 1; o >>= 1) m = fmaxf(m, __shfl_xor(m, o));
        float l = 0.f;
#pragma unroll
        for (int jj = 0; jj < 9; ++jj) { v[jj] = fexp2(v[jj] - m); l += v[jj]; }
#pragma unroll
        for (int o = 8; o >= 1; o >>= 1) l += __shfl_xor(l, o);
        l += fexp2(sink2 - m);
        const float inv = 1.0f / l;
#pragma unroll
        for (int jj = 0; jj < 9; ++jj) { const int k2 = sub + 16 * jj; if (k2 < 132) P[row * 132 + k2] = v[jj] * inv; }
    }
    __syncthreads();
    {
        const int row = tid >> 4, d4 = (tid & 15) * 4, hq = row >> 2, hk2 = hq >> 2, i = row & 3;
        f32x4 acc = {0.f, 0.f, 0.f, 0.f};
#pragma unroll 4
        for (int k2 = 0; k2 < 132; ++k2) acc += P[row * 132 + k2] * *(const LAS f32x4*)(Vc + k2 * 128 + hk2 * 64 + d4);
        u32x2 wv; wv.x = pkbf(acc[0], acc[1]); wv.y = pkbf(acc[2], acc[3]);
        *(u32x2*)((bf16_t*)(a->ws + WS_MIX) + (size_t)(MP + bs * 4 + i) * 1024 + 512 + hq * 64 + d4) = wv;
    }
}

__device__ __forceinline__ void xattn_prompt_unit(KA a, ldsp lds, int unit, int tid, int lane, int w) {
    constexpr int KRS = 272, VRS = 528;
    const ldsp Km = lds, VmT = lds + 256 * KRS;
    const bf16_t* memkv = (const bf16_t*)(a->ws + WS_MEMKV);
    const bf16_t* qcb = (const bf16_t*)(a->ws + WS_QC);
    const int b = unit >> 7, h = (unit >> 5) & 3, qc = unit & 31;
    __syncthreads();
    for (int it = tid; it < 256 * 16; it += NTHREADS) {
        const int key = it >> 4, cq = it & 15; const bf16_t* p = memkv + (size_t)(b * 256 + key) * 1024 + h * 128 + cq * 8;
        const u32x4 kv = *(const u32x4*)p, vv = *(const u32x4*)(p + 512);
        *(LAS u32x4*)(Km + key * KRS + cq * 16) = kv;
#pragma unroll
        for (int e = 0; e < 8; ++e) *(LAS unsigned short*)(VmT + (cq * 8 + e) * VRS + key * 2) = (unsigned short)(vv[e >> 1] >> (16 * (e & 1)));
    }
    __syncthreads();
    const int j = lane & 31, hi = lane >> 5;
    const size_t qrow = (size_t)b * SEQ + qc * 256 + 32 * w + j;
    bf16x8 qf[8];
#pragma unroll
    for (int ks = 0; ks < 8; ++ks) qf[ks] = *(const bf16x8*)(qcb + qrow * 512 + h * 128 + 16 * ks + 8 * hi);
    float m = -1e30f, l = 0.f;
    f32x16 o[4] = {};
#pragma unroll
    for (int kh = 0; kh < 2; ++kh) {
        f32x16 st[4];
        float mx = -1e30f;
#pragma unroll
        for (int kt = 0; kt < 4; ++kt) {
            f32x16 acc = {};
#pragma unroll
            for (int ks = 0; ks < 8; ++ks) { const bf16x8 kf = *(const LAS bf16x8*)(Km + (128 * kh + 32 * kt + j) * KRS + (16 * ks + 8 * hi) * 2); acc = MFMA32(kf, qf[ks], acc); }
#pragma unroll
            for (int r = 0; r < 16; ++r) { acc[r] *= LOG2E; mx = fmaxf(mx, acc[r]); }
            st[kt] = acc;
        }
        mx = fmaxf(mx, __shfl_xor(mx, 32));
        const float mn = fmaxf(m, mx), scl = fexp2(m - mn);
        m = mn; l *= scl;
#pragma unroll
        for (int dt = 0; dt < 4; ++dt) o[dt] *= scl;
#pragma unroll
        for (int kt = 0; kt < 4; ++kt)
#pragma unroll
            for (int r = 0; r < 16; ++r) { const float p = fexp2(st[kt][r] - m); st[kt][r] = p; l += p; }
#pragma unroll
        for (int kt = 0; kt < 4; ++kt)
#pragma unroll
            for (int s = 0; s < 2; ++s) {
                const bf16x8 pf = pack8(st[kt], s);
#pragma unroll
                for (int dt = 0; dt < 4; ++dt) {
                    const int d = 32 * dt + j, kb = 128 * kh + 32 * kt + 16 * s + 4 * hi;
                    const s16x4 lo = *(const LAS s16x4*)(VmT + d * VRS + kb * 2), hi4 = *(const LAS s16x4*)(VmT + d * VRS + (kb + 8) * 2);
                    const bf16x8 vf = __builtin_shufflevector(lo, hi4, 0, 1, 2, 3, 4, 5, 6, 7);
                    o[dt] = MFMA32(vf, pf, o[dt]);
                }
            }
    }
    l += __shfl_xor(l, 32);
    const float inv = frcp(l);
    bf16_t* oc = (bf16_t*)(a->ws + WS_OC);
#pragma unroll
    for (int dt = 0; dt < 4; ++dt)
#pragma unroll
        for (int rg = 0; rg < 4; ++rg) {
            u32x2 wv; wv.x = pkbf(o[dt][4 * rg] * inv, o[dt][4 * rg + 1] * inv); wv.y = pkbf(o[dt][4 * rg + 2] * inv, o[dt][4 * rg + 3] * inv);
            *(u32x2*)(oc + qrow * 512 + h * 128 + 32 * dt + 8 * rg + 4 * hi) = wv;
        }
}
__device__ __forceinline__ void xattn_sample_unit(KA a, ldsp lds, int unit, int tid, int lane, int w) {
    LAS float* Qs = (LAS float*)lds;
    LAS float* S = (LAS float*)(lds + 2048);
    LAS float* RED = (LAS float*)(lds + 8192);
    const bf16_t* qcb = (const bf16_t*)(a->ws + WS_QC);
    const int bs = unit >> 2, h = unit & 3;
    __syncthreads();
    { const int i = tid >> 7, d = tid & 127; Qs[i * 128 + d] = bf2f(qcb[(size_t)(MP + bs * 4 + i) * 512 + h * 128 + d]); }
    __syncthreads();
    {
        const int key = tid >> 1, hf = tid & 1; const float* kp = a->in[I_CMK] + ((size_t)(bs * 256 + key) * 4 + h) * 128 + hf * 64;
        float s0 = 0.f, s1 = 0.f, s2 = 0.f, s3 = 0.f;
#pragma unroll
        for (int c = 0; c < 16; ++c) {
            const f32x4 k4 = *(const f32x4*)(kp + 4 * c);
            const f32x4 q0 = *(const LAS f32x4*)(Qs + hf * 64 + 4 * c), q1 = *(const LAS f32x4*)(Qs + 128 + hf * 64 + 4 * c), q2 = *(const LAS f32x4*)(Qs + 256 + hf * 64 + 4 * c), q3 = *(const LAS f32x4*)(Qs + 384 + hf * 64 + 4 * c);
            s0 += (k4[0] * q0[0] + k4[1] * q0[1]) + (k4[2] * q0[2] + k4[3] * q0[3]); s1 += (k4[0] * q1[0] + k4[1] * q1[1]) + (k4[2] * q1[2] + k4[3] * q1[3]);
            s2 += (k4[0] * q2[0] + k4[1] * q2[1]) + (k4[2] * q2[2] + k4[3] * q2[3]); s3 += (k4[0] * q3[0] + k4[1] * q3[1]) + (k4[2] * q3[2] + k4[3] * q3[3]);
        }
        s0 += __shfl_xor(s0, 1); s1 += __shfl_xor(s1, 1); s2 += __shfl_xor(s2, 1); s3 += __shfl_xor(s3, 1);
        if (hf == 0) { S[key] = s0 * LOG2E; S[256 + key] = s1 * LOG2E; S[512 + key] = s2 * LOG2E; S[768 + key] = s3 * LOG2E; }
    }
    __syncthreads();
    if (w < 4) {
        f32x4 v = *(const LAS f32x4*)(S + w * 256 + lane * 4);
        float m = fmaxf(fmaxf(v[0], v[1]), fmaxf(v[2], v[3]));
#pragma unroll
        for (int o = 32; o >= 1; o >>= 1) m = fmaxf(m, __shfl_xor(m, o));
        v[0] = fexp2(v[0] - m); v[1] = fexp2(v[1] - m); v[2] = fexp2(v[2] - m); v[3] = fexp2(v[3] - m);
        const float l = wave_sum((v[0] + v[1]) + (v[2] + v[3]));
        v *= (1.0f / l);
        *(LAS f32x4*)(S + w * 256 + lane * 4) = v;
    }
    __syncthreads();
    {
        const int dq = tid & 31, kg = tid >> 5; const float* vp = a->in[I_CMV] + ((size_t)(bs * 256 + kg * 16) * 4 + h) * 128 + dq * 4;
        f32x4 a0 = {0.f, 0.f, 0.f, 0.f}, a1 = a0, a2 = a0, a3 = a0;
#pragma unroll
        for (int kk = 0; kk < 16; ++kk) { const f32x4 v4 = *(const f32x4*)(vp + (size_t)kk * 512); const int k2 = kg * 16 + kk;
            a0 += S[k2] * v4; a1 += S[256 + k2] * v4; a2 += S[512 + k2] * v4; a3 += S[768 + k2] * v4; }
        *(LAS f32x4*)(RED + (kg * 4 + 0) * 128 + dq * 4) = a0; *(LAS f32x4*)(RED + (kg * 4 + 1) * 128 + dq * 4) = a1;
        *(LAS f32x4*)(RED + (kg * 4 + 2) * 128 + dq * 4) = a2; *(LAS f32x4*)(RED + (kg * 4 + 3) * 128 + dq * 4) = a3;
    }
    __syncthreads();
    { const int i = tid >> 7, d = tid & 127; float s = 0.f;
#pragma unroll
        for (int kg = 0; kg < 16; ++kg) s += RED[(kg * 4 + i) * 128 + d];
        ((bf16_t*)(a->ws + WS_OC))[(size_t)(MP + bs * 4 + i) * 512 + h * 128 + d] = (bf16_t)f2bf(s); }
}


template <class Post> __device__ __forceinline__ void sk_tile(ldsp lds, const bf16_t* A, int lda, const bf16_t* B0, const bf16_t* B1, int K, const Post& post, int tid, int lane, int w) {
    const int fr = lane & 15, fq = lane >> 4, kper = K >> 3;
    const bf16_t* ap = A + (size_t)fr * lda + w * kper + 16 * fq;
    const bf16_t* bp0 = B0 + (size_t)fr * K + w * kper + 16 * fq;
    const bf16_t* bp1 = B1 + (size_t)fr * K + w * kper + 16 * fq;
    f32x4 acc[2][8];
#pragma unroll
    for (int i = 0; i < 2; ++i)
#pragma unroll
        for (int j = 0; j < 8; ++j) acc[i][j] = (f32x4){0.f, 0.f, 0.f, 0.f};
    for (int k0 = 0; k0 < kper; k0 += 128) {
        bf16x8 af[2][2][2], bf[2][8][2];
#pragma unroll
        for (int c = 0; c < 2; ++c) {
            const int kk = k0 + 64 * c;
            if (kk < kper) {
#pragma unroll
                for (int i = 0; i < 2; ++i) { af[c][i][0] = *(const bf16x8*)(ap + (size_t)(16 * i) * lda + kk); af[c][i][1] = *(const bf16x8*)(ap + (size_t)(16 * i) * lda + kk + 8); }
#pragma unroll
                for (int j = 0; j < 4; ++j) { bf[c][j][0] = *(const bf16x8*)(bp0 + (size_t)(16 * j) * K + kk); bf[c][j][1] = *(const bf16x8*)(bp0 + (size_t)(16 * j) * K + kk + 8);
                    bf[c][4 + j][0] = *(const bf16x8*)(bp1 + (size_t)(16 * j) * K + kk); bf[c][4 + j][1] = *(const bf16x8*)(bp1 + (size_t)(16 * j) * K + kk + 8); }
            }
        }
#pragma unroll
        for (int c = 0; c < 2; ++c) {
            if (k0 + 64 * c < kper) {
#pragma unroll
                for (int hl = 0; hl < 2; ++hl)
#pragma unroll
                    for (int i = 0; i < 2; ++i)
#pragma unroll
                        for (int j = 0; j < 8; ++j) acc[i][j] = MFMA16(af[c][i][hl], bf[c][j][hl], acc[i][j]);
            }
        }
    }
    LAS float* PART = (LAS float*)lds;
    __syncthreads();
#pragma unroll
    for (int i = 0; i < 2; ++i)
#pragma unroll
        for (int j = 0; j < 8; ++j)
#pragma unroll
            for (int r = 0; r < 4; ++r) PART[(w * 32 + 16 * i + 4 * fq + r) * 132 + 16 * j + fr] = acc[i][j][r];
    __syncthreads();
    const int row = tid >> 4, cc = tid & 15;
    f32x4 v0 = *(const LAS f32x4*)(PART + row * 132 + 4 * cc), v1 = *(const LAS f32x4*)(PART + row * 132 + 64 + 4 * cc);
#pragma unroll
    for (int p = 1; p < 8; ++p) { v0 += *(const LAS f32x4*)(PART + (p * 32 + row) * 132 + 4 * cc); v1 += *(const LAS f32x4*)(PART + (p * 32 + row) * 132 + 64 + 4 * cc); }
    post(row, cc, v0, v1);
}
__device__ __forceinline__ void st4bf(bf16_t* p, f32x4 v) { u32x2 w_; w_.x = pkbf(v[0], v[1]); w_.y = pkbf(v[2], v[3]); *(u32x2*)p = w_; }
struct SkProj {
    bf16_t* proj; const float* ssq; float* out; int mt, n0;
    __device__ __forceinline__ void operator()(int row, int cc, f32x4 va, f32x4 vb) const {
        const int grow = MP + 32 * mt + row, r2 = grow - MP, b = r2 >> 2, t = r2 & 3;
        const float rs0 = __builtin_amdgcn_rsqf(ssq[grow] * (1.0f / 1024.0f) + EPS);
#pragma unroll
        for (int hh = 0; hh < 2; ++hh) {
            const int col = n0 + hh * 64 + 4 * cc; const float rs = rs0 * ((col >= 1024 && col < 1536) ? 0.125f : 1.0f);
            const f32x4 v = (hh ? vb : va) * rs;
            st4bf(proj + (size_t)grow * DIN + col, v);
            float* dst = nullptr;
            if (col >= 1536) dst = out + (col < 1664 ? O_SSK + (size_t)(b * 128 + 124 + t) * 128 + (col - 1536) : O_SSV + (size_t)(b * 128 + 124 + t) * 128 + (col - 1664));
            else if (col < 512 && t >= 1) dst = out + O_SLC + (size_t)(b * 3 + t - 1) * 512 + col;
            if (dst) *(f32x4*)dst = v;
        }
    }
};
template <int MODE> struct SkRes {
    const float* res; float* xout; bf16_t* xb; float* ssq; int mt, n0;
    __device__ __forceinline__ void operator()(int row, int cc, f32x4 va, f32x4 vb) const {
        const int grow = MP + 32 * mt + row; float sq = 0.f;
#pragma unroll
        for (int hh = 0; hh < 2; ++hh) {
            const int col = n0 + hh * 64 + 4 * cc;
            f32x4 v = hh ? vb : va;
            if (MODE == 0) v += *(const f32x4*)(res + (size_t)grow * 1024 + col);
            else { const u32x2 rr = *(const u32x2*)(xb + (size_t)grow * 1024 + col); v += (f32x4){bflo(rr.x), bfhi(rr.x), bflo(rr.y), bfhi(rr.y)}; }
            if (MODE == 2) *(f32x4*)(xout + (size_t)grow * 1024 + col) = v; else st4bf(xb + (size_t)grow * 1024 + col, v);
            sq += (v[0] * v[0] + v[1] * v[1]) + (v[2] * v[2] + v[3] * v[3]);
        }
        if (MODE != 2) {
            sq += __shfl_xor(sq, 1); sq += __shfl_xor(sq, 2); sq += __shfl_xor(sq, 4); sq += __shfl_xor(sq, 8);
            if (cc == 0) __hip_atomic_fetch_add(ssq + grow, sq, __ATOMIC_RELAXED, __HIP_MEMORY_SCOPE_AGENT);
        }
    }
};
struct SkQ {
    bf16_t* qc; const float* ssq; int mt, n0;
    __device__ __forceinline__ void operator()(int row, int cc, f32x4 va, f32x4 vb) const {
        const int grow = MP + 32 * mt + row; const float rs = __builtin_amdgcn_rsqf(ssq[grow] * (1.0f / 1024.0f) + EPS) * 0.08838834764831845f;
        st4bf(qc + (size_t)grow * 512 + n0 + 4 * cc, va * rs); st4bf(qc + (size_t)grow * 512 + n0 + 64 + 4 * cc, vb * rs);
    }
};
struct SkGU {
    bf16_t* h; const float* ssq; const float* wconv; const float* bconv; const float* state; float* out; int mt, ch0;
    __device__ __forceinline__ void operator()(int row, int cc, f32x4 va, f32x4 vb) const {
        const int grow = MP + 32 * mt + row, r2 = grow - MP, bs = r2 >> 2, t = r2 & 3, c = ch0 + 4 * cc;
        const float rs = __builtin_amdgcn_rsqf(ssq[grow] * (1.0f / 1024.0f) + EPS);
        const f32x4 g = va * rs, up = vb * rs;
        f32x4 p1, p2;
#pragma unroll
        for (int j = 0; j < 4; ++j) { p1[j] = __shfl_up(g[j], 16); p2[j] = __shfl_up(g[j], 32); }
        f32x4 s1 = {0.f, 0.f, 0.f, 0.f}, s0 = {0.f, 0.f, 0.f, 0.f};
        if (t < 2) s1 = *(const f32x4*)(state + ((size_t)bs * 2 + 1) * DFF + c);
        if (t == 0) s0 = *(const f32x4*)(state + ((size_t)bs * 2 + 0) * DFF + c);
        const f32x4 g1 = t >= 1 ? p1 : s1, g2 = t >= 2 ? p2 : (t == 1 ? s1 : s0);
        if (t >= 2) *(f32x4*)(out + O_SFC + ((size_t)bs * 2 + (t - 2)) * DFF + c) = g;
        const f32x4 w0 = *(const f32x4*)(wconv + c), w1 = *(const f32x4*)(wconv + DFF + c), w2 = *(const f32x4*)(wconv + 2 * DFF + c), bc = *(const f32x4*)(bconv + c);
        const f32x4 gc = bc + w0 * g2 + w1 * g1 + w2 * g;
        u32x2 wv; wv.x = pkbf(gelu_tanh(gc[0]) * up[0], gelu_tanh(gc[1]) * up[1]); wv.y = pkbf(gelu_tanh(gc[2]) * up[2], gelu_tanh(gc[3]) * up[3]);
        *(u32x2*)(h + (size_t)grow * DFF + c) = wv;
    }
};

__device__ __forceinline__ void ffn_fixup_tile(KA a, int pm, int tid) {
    const float* edge = (const float*)(a->ws + WS_EDGE); bf16_t* hb = (bf16_t*)(a->ws + WS_H);
    const float* wconv = a->in[I_WFC]; const float* bconv = a->in[I_BFC];
#pragma unroll 4
    for (int it = tid; it < 4 * 2 * 768; it += NTHREADS) {
        const int q = it / 1536, rem = it % 1536, rr = rem / 768, c4 = (rem % 768) * 4;
        const int blk = pm * 4 + q; const bool hasprev = (blk & 127) != 0;
        const f32x4 z = {0.f, 0.f, 0.f, 0.f};
        const f32x4 G0 = *(const f32x4*)(edge + ((size_t)blk * 6 + 0) * DFF + c4), G1 = *(const f32x4*)(edge + ((size_t)blk * 6 + 1) * DFF + c4);
        const f32x4 Gm2 = hasprev ? *(const f32x4*)(edge + ((size_t)(blk - 1) * 6 + 2) * DFF + c4) : z, Gm1 = hasprev ? *(const f32x4*)(edge + ((size_t)(blk - 1) * 6 + 3) * DFF + c4) : z;
        const f32x4 U = *(const f32x4*)(edge + ((size_t)blk * 6 + 4 + rr) * DFF + c4);
        const f32x4 w0 = *(const f32x4*)(wconv + c4), w1 = *(const f32x4*)(wconv + DFF + c4), w2 = *(const f32x4*)(wconv + 2 * DFF + c4), bc = *(const f32x4*)(bconv + c4);
        const f32x4 gc = rr == 0 ? (bc + w0 * Gm2 + w1 * Gm1 + w2 * G0) : (bc + w0 * Gm1 + w1 * G0 + w2 * G1);
        u32x2 wv; wv.x = pkbf(gelu_tanh(gc[0]) * U[0], gelu_tanh(gc[1]) * U[1]); wv.y = pkbf(gelu_tanh(gc[2]) * U[2], gelu_tanh(gc[3]) * U[3]);
        *(u32x2*)(hb + ((size_t)blk * 64 + rr) * DFF + c4) = wv;
    }
}

__global__ void __launch_bounds__(NTHREADS, 2) hymba_fwd(Args a_unused) {
    const KA a = (KA)__builtin_amdgcn_kernarg_segment_ptr();
    extern __shared__ __attribute__((aligned(16))) unsigned char smem[];
    const ldsp lds = (ldsp)smem;
    const int tid = threadIdx.x, lane = tid & 63, w = __builtin_amdgcn_readfirstlane(tid >> 6);
    const int G = gridDim.x, bx = blockIdx.x;
    unsigned char* ws = a->ws;
    const int lo = a->ph_lo, hi = a->ph_hi;
#ifndef PHASE_MASK
#define PHASE_MASK 0xfff
#endif
#define IN(k) (((PHASE_MASK >> (k)) & 1) && lo <= (k) && (k) < hi)
#ifndef SREP
#define SREP 0
#endif
#ifndef REP_MASK
#define REP_MASK 0
#endif
#ifndef EXTRA_SYNCS
#define EXTRA_SYNCS 0
#endif
#define REPS(k) (1 + ((REP_MASK >> (k)) & 1))
#ifdef TPROBE
#define TSTAMP(i) do { if (bx == 0 && tid == 0) ((LAS unsigned long long*)(lds + LDS_BYTES - 192))[i] = __builtin_amdgcn_s_memrealtime(); } while (0)
#else
#define TSTAMP(i) do {} while (0)
#endif
#define SEAM(k) do { if (IN(k) && IN((k) + 1)) { XcdBarrier bar_; bar_.bar = (unsigned*)(a->ws + WS_BAR); bar_.x = xb_xcc_id(); bar_.st = (volatile LAS unsigned*)(lds + MISC_OFF); xcd_barrier(bar_); } TSTAMP((k) + 1); } while (0)
    bf16_t* XB = (bf16_t*)(ws + WS_XB);
    if (tid < 16) ((LAS unsigned*)(lds + MISC_OFF))[tid] = 0u;
    __syncthreads();
    (void)xcd_barrier_post((unsigned*)(ws + WS_BAR), (volatile LAS unsigned*)(lds + MISC_OFF));
    if (hi > 1000) cg::this_grid().sync();
    TSTAMP(0);
    if (IN(0)) { for (int rep = 0; rep < REPS(0); ++rep) p0_prologue(a, lds, tid, lane, w); }
    for (int es = 0; es < EXTRA_SYNCS; ++es) { XcdBarrier bar_; bar_.bar = (unsigned*)(a->ws + WS_BAR); bar_.x = xb_xcc_id(); bar_.st = (volatile LAS unsigned*)(lds + MISC_OFF); xcd_barrier(bar_); }
    SEAM(0);
    if (IN(1)) for (int rep = 0; rep < REPS(1); ++rep) {
        { for (int srep = 0; srep < 1 + SREP; ++srep) for (int t = (G == 256) ? ((bx >= 192 && bx < 248) ? bx - 192 : 1 << 30) : G - 1 - bx; t < 16 * 14; t += (G == 256) ? 56 : G) { const int mt = t / 14, nt = t % 14; const bf16_t* Bt = (const bf16_t*)(ws + WS_WIN) + (size_t)(nt * 128) * 1024;
              SkProj P{(bf16_t*)(ws + WS_PROJ), (const float*)(ws + WS_SSQ0), a->out, mt, nt * 128}; sk_tile(lds, XB + (size_t)(MP + 32 * mt) * 1024, 1024, Bt, Bt + 64 * 1024, 1024, P, tid, lane, w); }
          __syncthreads();
          pg8::Gemm g{XB, (const bf16_t*)(ws + WS_WIN), MP, DIN, 1024}; pg8::StaticOrder S; S.init(MP, DIN, G, bx);
          pg8::EpiProj E{(bf16_t*)(ws + WS_PROJ), (const float*)(ws + WS_SSQ0), a->out};
          pg8::gemm_phase<pg8::EpiProj, pg8::StaticOrder, true, true>(lds, g, S, E); }
        { pg8::Gemm g{(const bf16_t*)(ws + WS_MEMA), (const bf16_t*)(ws + WS_WKV), 512, 1024, 1024}; pg8::StaticOrder S; S.init(512, 1024, G, G - 1 - bx);
          pg8::EpiMemKV E{(bf16_t*)(ws + WS_MEMKV), (const float*)(ws + WS_SSQM), a->out};
          pg8::gemm_phase<pg8::EpiMemKV, pg8::StaticOrder, true, true>(lds, g, S, E); }
    }
    SEAM(1);
    if (IN(2)) for (int rep = 0; rep < REPS(2); ++rep) {
        for (int u = bx; u < 416; u += G) {
            if (u < 256) lru_unit<false, 1>(a, lds, u, tid, lane, w);
            else if (u < 288) lru_unit<true, 2>(a, lds, u - 256, tid, lane, w);
            else swa_sample_unit(a, lds, u - 288, tid);
        }
    }
    SEAM(2);
    if (IN(3)) for (int rep = 0; rep < REPS(3); ++rep) {
        for (int u = bx; u < 768; u += G) {
            if (u < 256) lru_unit<false, 2>(a, lds, u, tid, lane, w);
            else swa_prompt_unit(a, lds, u - 256, tid, lane, w);
        }
    }
    SEAM(3);
    if (IN(4)) {
        for (int t = G - 1 - bx; t < 128; t += G) { const int mt = t >> 3, nt = t & 7; const bf16_t* Bt = (const bf16_t*)(ws + WS_WOUT) + (size_t)(nt * 128) * 1024;
            SkRes<0> P{a->in[I_XS] - (size_t)MP * 1024, a->out, XB, (float*)(ws + WS_SSQ1), mt, nt * 128}; sk_tile(lds, (const bf16_t*)(ws + WS_MIX) + (size_t)(MP + 32 * mt) * 1024, 1024, Bt, Bt + 64 * 1024, 1024, P, tid, lane, w); }
        __syncthreads();
        pg8::Gemm g{(const bf16_t*)(ws + WS_MIX), (const bf16_t*)(ws + WS_WOUT), MP, 1024, 1024}; pg8::StaticOrder S; S.init(MP, 1024, G, bx);
        pg8::EpiRes<0> E{a->in[I_XP], a->out, XB, (float*)(ws + WS_SSQ1)};
        pg8::gemm_phase<pg8::EpiRes<0>, pg8::StaticOrder, true, true>(lds, g, S, E);
        if (REPS(4) > 1) { pg8::EpiRes<0, true> E2{a->in[I_XP], a->out, XB, (float*)(ws + WS_SSQ1)}; pg8::gemm_phase<pg8::EpiRes<0, true>, pg8::StaticOrder, true, true>(lds, g, S, E2); }
    }
    SEAM(4);
    if (IN(5)) for (int rep = 0; rep < REPS(5); ++rep) {
        for (int srep = 0; srep < 1 + SREP; ++srep) for (int t = G - 1 - bx; t < 64; t += G) { const int mt = t >> 2, nt = t & 3; const bf16_t* Bt = (const bf16_t*)(ws + WS_WQ) + (size_t)(nt * 128) * 1024;
            SkQ P{(bf16_t*)(ws + WS_QC), (const float*)(ws + WS_SSQ1), mt, nt * 128}; sk_tile(lds, XB + (size_t)(MP + 32 * mt) * 1024, 1024, Bt, Bt + 64 * 1024, 1024, P, tid, lane, w); }
        __syncthreads();
        pg8::Gemm g{XB, (const bf16_t*)(ws + WS_WQ), MP, 512, 1024}; pg8::StaticOrder S; S.init(MP, 512, G, bx);
        pg8::EpiQ E{(bf16_t*)(ws + WS_QC), (const float*)(ws + WS_SSQ1)};
        pg8::gemm_phase<pg8::EpiQ, pg8::StaticOrder, true, true>(lds, g, S, E);
    }
    SEAM(5);
    if (IN(6)) for (int rep = 0; rep < REPS(6); ++rep) {
        for (int u = bx; u < 768; u += G) {
            if (u < 256) xattn_prompt_unit(a, lds, u, tid, lane, w);
            else xattn_sample_unit(a, lds, u - 256, tid, lane, w);
        }
    }
    SEAM(6);
    if (IN(7)) {
        for (int t = G - 1 - bx; t < 128; t += G) { const int mt = t >> 3, nt = t & 7; const bf16_t* Bt = (const bf16_t*)(ws + WS_WMO) + (size_t)(nt * 128) * 512;
            SkRes<1> P{a->out, a->out, XB, (float*)(ws + WS_SSQ2), mt, nt * 128}; sk_tile(lds, (const bf16_t*)(ws + WS_OC) + (size_t)(MP + 32 * mt) * 512, 512, Bt, Bt + 64 * 512, 512, P, tid, lane, w); }
        __syncthreads();
        pg8::Gemm g{(const bf16_t*)(ws + WS_OC), (const bf16_t*)(ws + WS_WMO), MP, 1024, 512}; pg8::StaticOrder S; S.init(MP, 1024, G, bx);
        pg8::EpiRes<1> E{nullptr, a->out, XB, (float*)(ws + WS_SSQ2)};
        pg8::gemm_phase<pg8::EpiRes<1>, pg8::StaticOrder, true, true>(lds, g, S, E);
        if (REPS(7) > 1) { pg8::EpiRes<1, true> E2{nullptr, a->out, XB, (float*)(ws + WS_SSQ2)}; pg8::gemm_phase<pg8::EpiRes<1, true>, pg8::StaticOrder, true, true>(lds, g, S, E2); }
    }
    SEAM(7);
    if (IN(8)) for (int rep = 0; rep < REPS(8); ++rep) {
        for (int srep = 0; srep < 1 + SREP; ++srep) for (int t = G - 1 - bx; t < 16 * 48; t += G) { const int mt = t / 48, cb = t % 48; const bf16_t* Bg = (const bf16_t*)(ws + WS_WGU) + (size_t)((cb >> 1) * 256 + (cb & 1) * 64) * 1024;
            SkGU P{(bf16_t*)(ws + WS_H), (const float*)(ws + WS_SSQ2), a->in[I_WFC], a->in[I_BFC], a->in[I_SFC], a->out, mt, cb * 64}; sk_tile(lds, XB + (size_t)(MP + 32 * mt) * 1024, 1024, Bg, Bg + 128 * 1024, 1024, P, tid, lane, w); }
        __syncthreads();
        pg8::Gemm g{XB, (const bf16_t*)(ws + WS_WGU), MP, 2 * DFF, 1024}; pg8::StaticOrder S; S.init(MP, 2 * DFF, G, bx);
        pg8::EpiGU E{(bf16_t*)(ws + WS_H), (const float*)(ws + WS_SSQ2), (float*)(ws + WS_EDGE), a->in[I_WFC], a->in[I_BFC], a->in[I_SFC], a->out};
        pg8::gemm_phase<pg8::EpiGU, pg8::StaticOrder, true, true>(lds, g, S, E);
    }
    SEAM(8);
    if (IN(9)) {
        for (int t = G - 1 - bx; t < 128; t += G) { const int mt = t >> 3, nt = t & 7; const bf16_t* Bt = (const bf16_t*)(ws + WS_WD) + (size_t)(nt * 128) * DFF;
            SkRes<2> P{a->out, a->out, XB, (float*)(ws + WS_SSQ3), mt, nt * 128}; sk_tile(lds, (const bf16_t*)(ws + WS_H) + (size_t)(MP + 32 * mt) * DFF, DFF, Bt, Bt + 64 * DFF, DFF, P, tid, lane, w); }
        __syncthreads();
        pg8::Gemm g{(const bf16_t*)(ws + WS_H), (const bf16_t*)(ws + WS_WD), MP, 1024, DFF}; pg8::StaticOrder S; S.init(MP, 1024, G, bx);
        pg8::Unit u;
        for (int i = 0; S.next(i, u); ++i) if (u.pm < MP / 256) ffn_fixup_tile(a, u.pm, tid);
        __builtin_amdgcn_fence(__ATOMIC_RELEASE, "agent");
        asm volatile("s_waitcnt vmcnt(0)" ::: "memory");
        __syncthreads();
        __builtin_amdgcn_fence(__ATOMIC_ACQUIRE, "agent");
        pg8::EpiRes<2> E{nullptr, a->out, XB, (float*)(ws + WS_SSQ3)};
        pg8::gemm_phase<pg8::EpiRes<2>, pg8::StaticOrder, true, true>(lds, g, S, E);
        if (REPS(9) > 1) { pg8::EpiRes<2, true> E2{nullptr, a->out, XB, (float*)(ws + WS_SSQ3)}; pg8::gemm_phase<pg8::EpiRes<2, true>, pg8::StaticOrder, true, true>(lds, g, S, E2); }
    }
    SEAM(9);
    if (IN(10)) {
        const float* ssq3 = (const float*)(ws + WS_SSQ3); const float* gf = a->in[I_GFIN];
        f32x4 gv[4];
#pragma unroll
        for (int j = 0; j < 4; ++j) gv[j] = *((const f32x4*)gf + lane + 64 * j);
        for (int m = bx * NWAVES + w; m < MT; m += G * NWAVES) {
            f32x4* xr = (f32x4*)(a->out + (size_t)m * 1024) + lane;
            f32x4 v[4]; float s = 0.f;
#pragma unroll
            for (int j = 0; j < 4; ++j) { v[j] = xr[64 * j]; s += (v[j].x * v[j].x + v[j].y * v[j].y) + (v[j].z * v[j].z + v[j].w * v[j].w); }
            const float rs = __builtin_amdgcn_rsqf(wave_sum(s) * (1.0f / 1024.0f) + EPS);
#pragma unroll
            for (int j = 0; j < 4; ++j) xr[64 * j] = v[j] * rs * gv[j];
        }
    }
#ifdef TPROBE
    TSTAMP(11);
    if (bx == 0) {
        __syncthreads();
        const LAS unsigned long long* ts = (const LAS unsigned long long*)(lds + LDS_BYTES - 192);
        const float eps = (float)(ts[TA_HI] - ts[TA_LO]) * 1e-5f, dd = (float)(ts[TB_HI] - ts[TB_LO]) * 1e-4f;
        for (int i = tid; i < 1024; i += NTHREADS) a->out[O_PLH + i] *= (1.0f + eps);
        if (tid == 0) a->out[O_PLC] += dd;
    }
#endif
#undef IN
#undef SEAM
}
constexpr int N_PHASES = 11;

extern "C" void kernel_launch(void* const* d_in, const int* in_sizes, int n_in, void* d_out, int out_size, void* d_ws, size_t ws_size, hipStream_t stream) {
    static int grid = 0;
    if (grid == 0) {
        if (n_in != 34 || ws_size < WS_END) { fprintf(stderr, "kernel_launch: unexpected n_in %d / ws %zu\n", n_in, ws_size); grid = -1; return; }
        int dev = 0, cus = 0, per_cu = 0;
        if (hipGetDevice(&dev) != hipSuccess || hipDeviceGetAttribute(&cus, hipDeviceAttributeMultiprocessorCount, dev) != hipSuccess) { grid = -1; return; }
        if (hipFuncSetAttribute((const void*)hymba_fwd, hipFuncAttributeMaxDynamicSharedMemorySize, LDS_BYTES) != hipSuccess) { fprintf(stderr, "kernel_launch: hipFuncSetAttribute failed\n"); grid = -1; return; }
        if (hipOccupancyMaxActiveBlocksPerMultiprocessor(&per_cu, (const void*)hymba_fwd, NTHREADS, LDS_BYTES) != hipSuccess || per_cu < 1) { fprintf(stderr, "kernel_launch: occupancy query says %d\n", per_cu); per_cu = 1; }
        (void)hipGetLastError();
        grid = cus;
    }
    if (grid < 0) return;
    Args a{};
    for (int i = 0; i < 34; ++i) a.in[i] = (const float*)d_in[i];
    a.out = (float*)d_out; a.ws = (unsigned char*)d_ws;
    if (hipMemsetAsync((char*)d_ws + WS_BAR, 0, BAR_ZERO_BYTES, stream) != hipSuccess) { fprintf(stderr, "kernel_launch: memset failed\n"); return; }
#if MK_N_LAUNCHES == 1
    a.ph_lo = 0; a.ph_hi = N_PHASES;
    void* args[] = {&a};
    hipError_t e = hipLaunchCooperativeKernel((const void*)hymba_fwd, dim3(grid), dim3(NTHREADS), args, LDS_BYTES, stream);
    if (e != hipSuccess) fprintf(stderr, "kernel_launch: cooperative launch failed: %s (grid %d)\n", hipGetErrorString(e), grid);
#else
    for (int p = 0; p < N_PHASES; ++p) { a.ph_lo = p; a.ph_hi = p + 1; hipLaunchKernelGGL(hymba_fwd, dim3(grid), dim3(NTHREADS), LDS_BYTES, stream, a); }
#endif
}
```

```cpp
#include <hip/hip_runtime.h>
#include <hip/hip_cooperative_groups.h>
#include <cstdio>
#include <cstdint>
namespace cg = cooperative_groups;

#ifndef MK_N_LAUNCHES
#define MK_N_LAUNCHES 1
#endif

constexpr int MP = 16384, MS = 512, MT = MP + MS;
constexpr int DM = 1024, SEQ = 8192, DIN = 1792, DFF = 3072, DLRU = 512;
constexpr float EPS = 1e-6f;
constexpr float LOG2E = 1.4426950408889634f;
constexpr size_t O_YP = 0, O_YS = 16777216, O_PSK = 17301504, O_PSV = 17334272, O_PMK = 17367040, O_PMV = 17629184, O_PLC = 17891328,
                 O_PLH = 17894400, O_PFC = 17895424, O_SSK = 17907712, O_SSV = 20004864, O_SLC = 22102016, O_SLH = 22298624, O_SFC = 22364160;
constexpr size_t MiB = 1u << 20;
constexpr size_t WS_SSQ0 = 0, WS_SSQ1 = 128 * 1024, WS_SSQ2 = 256 * 1024, WS_SSQ3 = 384 * 1024, WS_SSQM = 512 * 1024, WS_SUMM = 640 * 1024;
constexpr size_t WS_WIN = 1 * MiB, WS_WOUT = 5 * MiB, WS_WQ = 7 * MiB, WS_WKV = 8 * MiB, WS_WMO = 10 * MiB, WS_WGU = 11 * MiB, WS_WD = 23 * MiB;
constexpr size_t WS_MEMA = 29 * MiB, WS_MEMKV = 30 * MiB, WS_EDGE = 31 * MiB, WS_XB = 50 * MiB, WS_PROJ = 83 * MiB, WS_MIX = 141 * MiB, WS_QC = 174 * MiB, WS_OC = 191 * MiB;
constexpr size_t WS_H = 83 * MiB;
constexpr size_t WS_END = 208 * MiB;
static_assert(WS_EDGE + (size_t)264 * 6 * 3072 * 4 <= WS_XB && WS_XB + (size_t)MT * 1024 * 2 <= WS_PROJ && WS_PROJ + (size_t)MT * DIN * 2 <= WS_MIX &&
              WS_MIX + (size_t)MT * 1024 * 2 <= WS_QC && WS_QC + (size_t)MT * 512 * 2 <= WS_OC && WS_OC + (size_t)MT * 512 * 2 <= WS_END && WS_H + (size_t)MT * DFF * 2 <= WS_OC, "ws map");

__device__ __forceinline__ unsigned pkbf(float lo, float hi) {
    typedef float f2_t __attribute__((ext_vector_type(2))); typedef __bf16 b2_t __attribute__((ext_vector_type(2)));
    f2_t v = {lo, hi}; b2_t b = __builtin_convertvector(v, b2_t); return __builtin_bit_cast(unsigned, b);
}
__device__ __forceinline__ float bf2f(unsigned short x) { return __uint_as_float((unsigned)x << 16); }
__device__ __forceinline__ float bflo(unsigned x) { return __uint_as_float(x << 16); }
__device__ __forceinline__ float bfhi(unsigned x) { return __uint_as_float(x & 0xffff0000u); }
__device__ __forceinline__ float fexp2(float x) { return __builtin_amdgcn_exp2f(x); }
__device__ __forceinline__ float frcp(float x) { return __builtin_amdgcn_rcpf(x); }
__device__ __forceinline__ float sigmoidf_(float x) { return frcp(1.0f + fexp2(-LOG2E * x)); }
__device__ __forceinline__ float gelu_tanh(float x) {
    const float t = x * (1.0f + 0.044715f * x * x);
    return x * frcp(1.0f + fexp2(-2.302208198f * t));
}
namespace pg8 {
#define PG8_LAS __attribute__((address_space(3)))
typedef unsigned short bf16_t;
typedef short bf16x8 __attribute__((ext_vector_type(8)));
typedef float f32x4 __attribute__((ext_vector_type(4)));
typedef unsigned u32x4 __attribute__((ext_vector_type(4)));
constexpr int BM = 256, BK = 64, HALF = 128, HTB = HALF * BK * 2  , STAGE_BYTES = 8 * HTB, NXCD = 8, WGM = 8;

__host__ __device__ __forceinline__ int lds_byte(int r, int c) { const int st = (r >> 4) * 2 + (c >> 5), rr = r & 15, cc = c & 31, ob = rr * 64 + cc * 2; return st * 1024 + (ob ^ (((ob >> 9) & 1) << 5)); }
__host__ __device__ __forceinline__ void stage_rc(int b, int& R, int& C) { const int st = b / 1024, sb = b % 1024, swz = sb ^ (((sb >> 9) & 1) << 5); R = (st >> 1) * 16 + swz / 64; C = (st & 1) * 32 + (swz % 64) / 2; }
__host__ __device__ __forceinline__ int perm32(int rho) { const int n = rho >> 4, i = rho & 15; return 8 * (i >> 2) + 4 * n + (i & 3); }

struct Unit { int pm, pn; };
struct Gemm { const bf16_t* A; const bf16_t* Bt; int M, N, K; };

struct StaticOrder {
    int nM, nN, nwg, G, c;
    __host__ __device__ __forceinline__ void init(int M, int N, int G_, int c_) { nM = M / BM; nN = N / BM; nwg = nM * nN; G = G_; c = c_; }
    __host__ __device__ __forceinline__ bool next(int i, Unit& u) const {
        const long L = (long)i * G + c; if (L >= nwg) return false;
        int wgid = (int)L; { const int q = nwg / NXCD, r = nwg % NXCD, xcd = wgid % NXCD, off = wgid / NXCD; wgid = (xcd < r ? xcd * (q + 1) : r * (q + 1) + (xcd - r) * q) + off; }
        const int nig = WGM * nN, gid = wgid / nig, fm = gid * WGM, gsz = (nM - fm) < WGM ? (nM - fm) : WGM;
        u.pm = fm + ((wgid % nig) % gsz); u.pn = (wgid % nig) / gsz; return true;
    }
    __device__ __forceinline__ void a_ready(const Unit&) const {}
    __device__ __forceinline__ void done(const Unit&) const {}
};

#define EPI_ROW(u, ai, m) ((u).pm * BM + (ai) * HALF + wr * 64 + (m) * 16 + fr)
__device__ __forceinline__ void st_bf16x8(bf16_t* p, f32x4 v0, f32x4 v1) { u32x4 w; w.x = pkbf(v0[0], v0[1]); w.y = pkbf(v0[2], v0[3]); w.z = pkbf(v1[0], v1[1]); w.w = pkbf(v1[2], v1[3]); *(u32x4*)p = w; }

struct EpiProj {
    static constexpr bool PERM = true, AFTER_DRAIN = false;
    bf16_t* proj; const float* ssq; float* out;
    __device__ __forceinline__ void operator()(const f32x4 (&acc)[2][2][4][2], const Unit& u, int wr, int wc, int fr, int fq) const {
        float rsv[2][4];
#pragma unroll
        for (int ai = 0; ai < 2; ++ai)
#pragma unroll
            for (int m = 0; m < 4; ++m) rsv[ai][m] = ssq[EPI_ROW(u, ai, m)];
        const int colb = u.pn * BM + wc * 32 + 8 * fq;
        const float qs = (u.pn == 4 || u.pn == 5) ? 0.125f : 1.0f;
#pragma unroll
        for (int ai = 0; ai < 2; ++ai)
#pragma unroll
            for (int m = 0; m < 4; ++m) {
                const int row = EPI_ROW(u, ai, m);
                const float rs = __builtin_amdgcn_rsqf(rsv[ai][m] * (1.0f / 1024.0f) + EPS) * qs;
#pragma unroll
                for (int bj = 0; bj < 2; ++bj) {
                    const int col = colb + bj * HALF;
                    const f32x4 v0 = acc[ai][bj][m][0] * rs, v1 = acc[ai][bj][m][1] * rs;
                    st_bf16x8(proj + (size_t)row * DIN + col, v0, v1);
                    float* dst = nullptr;
                    if (u.pn == 6) {
                        const int kc = wc * 32 + 8 * fq;
                        if (row < MP) { const int t = row & 8191, b = row >> 13; if (t >= 8064) dst = out + (bj ? O_PSV : O_PSK) + (size_t)(b * 128 + t - 8064) * 128 + kc; }
                        else { const int r2 = row - MP, b = r2 >> 2, t = r2 & 3; dst = out + (bj ? O_SSV : O_SSK) + (size_t)(b * 128 + 124 + t) * 128 + kc; }
                    } else if (u.pn < 2) {
                        if (row < MP) { const int t = row & 8191, b = row >> 13; if (t >= 8189) dst = out + O_PLC + (size_t)(b * 3 + t - 8189) * 512 + col; }
                        else { const int r2 = row - MP, b = r2 >> 2, t = r2 & 3; if (t >= 1) dst = out + O_SLC + (size_t)(b * 3 + t - 1) * 512 + col; }
                    }
                    if (dst) { *(f32x4*)dst = v0; *(f32x4*)(dst + 4) = v1; }
                }
            }
    }
};
struct EpiMemKV {
    static constexpr bool PERM = true, AFTER_DRAIN = false;
    bf16_t* memkv; const float* ssq; float* out;
    __device__ __forceinline__ void operator()(const f32x4 (&acc)[2][2][4][2], const Unit& u, int wr, int wc, int fr, int fq) const {
        float rsv[2][4];
#pragma unroll
        for (int ai = 0; ai < 2; ++ai)
#pragma unroll
            for (int m = 0; m < 4; ++m) rsv[ai][m] = ssq[EPI_ROW(u, ai, m)];
        const int colb = u.pn * BM + wc * 32 + 8 * fq;
#pragma unroll
        for (int ai = 0; ai < 2; ++ai)
#pragma unroll
            for (int m = 0; m < 4; ++m) {
                const int row = EPI_ROW(u, ai, m);
                const float rs = __builtin_amdgcn_rsqf(rsv[ai][m] * (1.0f / 1024.0f) + EPS);
#pragma unroll
                for (int bj = 0; bj < 2; ++bj) {
                    const int col = colb + bj * HALF;
                    const f32x4 v0 = acc[ai][bj][m][0] * rs, v1 = acc[ai][bj][m][1] * rs;
                    st_bf16x8(memkv + (size_t)row * 1024 + col, v0, v1);
                    float* dst = out + (col < 512 ? O_PMK + (size_t)row * 512 + col : O_PMV + (size_t)row * 512 + (col - 512));
                    *(f32x4*)dst = v0; *(f32x4*)(dst + 4) = v1;
                }
            }
    }
};
template <int MODE, bool DRY = false> struct EpiRes {
    static constexpr bool PERM = true, AFTER_DRAIN = false;
    const float* resp; float* xout; bf16_t* xb; float* ssq;
    __device__ __forceinline__ void operator()(const f32x4 (&acc)[2][2][4][2], const Unit& u, int wr, int wc, int fr, int fq) const {
        const int colb = u.pn * BM + wc * 32 + 8 * fq;
#pragma unroll
        for (int ai = 0; ai < 2; ++ai) {
            f32x4 rf[4][2][2]; u32x4 rb[4][2];
#pragma unroll
            for (int m = 0; m < 4; ++m)
#pragma unroll
                for (int bj = 0; bj < 2; ++bj) {
                    const int row = EPI_ROW(u, ai, m), col = colb + bj * HALF;
                    if (MODE == 0) { const float* rp = resp + (size_t)row * 1024 + col; rf[m][bj][0] = *(const f32x4*)rp; rf[m][bj][1] = *(const f32x4*)(rp + 4); }
                    else rb[m][bj] = *(const u32x4*)(xb + (size_t)row * 1024 + col);
                }
#pragma unroll
            for (int m = 0; m < 4; ++m) {
                const int row = EPI_ROW(u, ai, m);
                float sq = 0.f;
#pragma unroll
                for (int bj = 0; bj < 2; ++bj) {
                    const int col = colb + bj * HALF;
                    f32x4 v0, v1;
                    if (MODE == 0) { v0 = acc[ai][bj][m][0] + rf[m][bj][0]; v1 = acc[ai][bj][m][1] + rf[m][bj][1]; }
                    else { const u32x4 r = rb[m][bj];
                        v0 = acc[ai][bj][m][0] + (f32x4){bflo(r.x), bfhi(r.x), bflo(r.y), bfhi(r.y)}; v1 = acc[ai][bj][m][1] + (f32x4){bflo(r.z), bfhi(r.z), bflo(r.w), bfhi(r.w)}; }
                    if (!DRY) {
                        if (MODE == 2) { float* op = xout + (size_t)row * 1024 + col; *(f32x4*)op = v0; *(f32x4*)(op + 4) = v1; }
                        else st_bf16x8(xb + (size_t)row * 1024 + col, v0, v1);
                    }
                    sq += (v0[0] * v0[0] + v0[1] * v0[1]) + (v0[2] * v0[2] + v0[3] * v0[3]) + (v1[0] * v1[0] + v1[1] * v1[1]) + (v1[2] * v1[2] + v1[3] * v1[3]);
                }
                if (MODE != 2 || DRY) {
                    sq += __shfl_xor(sq, 16); sq += __shfl_xor(sq, 32);
                    if (!DRY) { if (fq == 0) __hip_atomic_fetch_add(ssq + row, sq, __ATOMIC_RELAXED, __HIP_MEMORY_SCOPE_AGENT); }
                    else if (sq == 12345.678f) ssq[row] = sq;
                }
            }
        }
    }
};
struct EpiQ {
    static constexpr bool PERM = true, AFTER_DRAIN = false;
    bf16_t* qc; const float* ssq;
    __device__ __forceinline__ void operator()(const f32x4 (&acc)[2][2][4][2], const Unit& u, int wr, int wc, int fr, int fq) const {
        float rsv[2][4];
#pragma unroll
        for (int ai = 0; ai < 2; ++ai)
#pragma unroll
            for (int m = 0; m < 4; ++m) rsv[ai][m] = ssq[EPI_ROW(u, ai, m)];
        const int colb = u.pn * BM + wc * 32 + 8 * fq;
#pragma unroll
        for (int ai = 0; ai < 2; ++ai)
#pragma unroll
            for (int m = 0; m < 4; ++m) {
                const int row = EPI_ROW(u, ai, m);
                const float rs = __builtin_amdgcn_rsqf(rsv[ai][m] * (1.0f / 1024.0f) + EPS) * 0.08838834764831845f;
#pragma unroll
                for (int bj = 0; bj < 2; ++bj) st_bf16x8(qc + (size_t)row * 512 + colb + bj * HALF, acc[ai][bj][m][0] * rs, acc[ai][bj][m][1] * rs);
            }
    }
};
__device__ __forceinline__ float dpp_ror1(float v) { return __builtin_bit_cast(float, __builtin_amdgcn_update_dpp(0, __builtin_bit_cast(int, v), 0x121, 0xf, 0xf, false)); }
__device__ __forceinline__ float dpp_ror2(float v) { return __builtin_bit_cast(float, __builtin_amdgcn_update_dpp(0, __builtin_bit_cast(int, v), 0x122, 0xf, 0xf, false)); }
struct EpiGU {
    static constexpr bool PERM = true, AFTER_DRAIN = false;
    bf16_t* h; const float* ssq; float* edge; const float* wconv; const float* bconv; const float* state; float* out;
    __device__ __forceinline__ void operator()(const f32x4 (&acc)[2][2][4][2], const Unit& u, int wr, int wc, int fr, int fq) const {
        float rsv[2][4];
#pragma unroll
        for (int ai = 0; ai < 2; ++ai)
#pragma unroll
            for (int m = 0; m < 4; ++m) rsv[ai][m] = ssq[EPI_ROW(u, ai, m)];
        const int chb = u.pn * HALF + wc * 32 + 8 * fq;
        const bool sample = u.pm >= MP / BM;
#pragma unroll
        for (int n = 0; n < 2; ++n) {
            const int ch = chb + 4 * n;
            const f32x4 w0 = *(const f32x4*)(wconv + ch), w1 = *(const f32x4*)(wconv + DFF + ch), w2 = *(const f32x4*)(wconv + 2 * DFF + ch), bc = *(const f32x4*)(bconv + ch);
#pragma unroll
            for (int ai = 0; ai < 2; ++ai) {
                f32x4 p1p = {0.f, 0.f, 0.f, 0.f}, p2p = {0.f, 0.f, 0.f, 0.f};
#pragma unroll
                for (int m = 0; m < 4; ++m) {
                    const int row = EPI_ROW(u, ai, m);
                    const float rs = __builtin_amdgcn_rsqf(ssq[row] * (1.0f / 1024.0f) + EPS);
                    const f32x4 g = acc[ai][0][m][n] * rs, up = acc[ai][1][m][n] * rs;
                    f32x4 p1, p2, g1, g2;
#pragma unroll
                    for (int j = 0; j < 4; ++j) { p1[j] = dpp_ror1(g[j]); p2[j] = dpp_ror2(g[j]); }
                    if (!sample) {
                        g1 = fr >= 1 ? p1 : p1p; g2 = fr >= 2 ? p2 : p2p; p1p = p1; p2p = p2;
                        const int blk = row >> 6;
                        if (m == 0 && fr < 2) { *(f32x4*)(edge + ((size_t)blk * 6 + fr) * DFF + ch) = g; *(f32x4*)(edge + ((size_t)blk * 6 + 4 + fr) * DFF + ch) = up; }
                        if (m == 3 && fr >= 14) {
                            *(f32x4*)(edge + ((size_t)blk * 6 + 2 + (fr - 14)) * DFF + ch) = g;
                            if ((blk & 127) == 127) *(f32x4*)(out + O_PFC + (size_t)((blk >> 7) * 2 + (fr - 14)) * DFF + ch) = g;
                        }
                    } else {
                        const int r2 = row - MP, bs = r2 >> 2, t = r2 & 3;
                        f32x4 s1 = {0.f, 0.f, 0.f, 0.f}, s0 = {0.f, 0.f, 0.f, 0.f};
                        if (t < 2) s1 = *(const f32x4*)(state + ((size_t)bs * 2 + 1) * DFF + ch);
                        if (t == 0) s0 = *(const f32x4*)(state + ((size_t)bs * 2 + 0) * DFF + ch);
                        g1 = t >= 1 ? p1 : s1; g2 = t >= 2 ? p2 : (t == 1 ? s1 : s0);
                        if (t >= 2) *(f32x4*)(out + O_SFC + ((size_t)bs * 2 + (t - 2)) * DFF + ch) = g;
                    }
                    const f32x4 gc = bc + w0 * g2 + w1 * g1 + w2 * g;
                    f32x4 hv;
#pragma unroll
                    for (int j = 0; j < 4; ++j) hv[j] = gelu_tanh(gc[j]) * up[j];
                    typedef unsigned u32x2_t __attribute__((ext_vector_type(2)));
                    u32x2_t w; w.x = pkbf(hv[0], hv[1]); w.y = pkbf(hv[2], hv[3]);
                    *(u32x2_t*)(h + (size_t)row * DFF + ch) = w;
                }
            }
        }
    }
};
template <class Epi, class Sched, bool ALIGN_EPI = false, bool SP2 = false>
__device__ __forceinline__ void gemm_phase(PG8_LAS unsigned char* lds, const Gemm g, const Sched& S, const Epi& E) {
    const int tid = threadIdx.x, wid = __builtin_amdgcn_readfirstlane(tid >> 6), lane = tid & 63, wr = wid >> 2, wc = wid & 3, fr = lane & 15, fq = lane >> 4;
    const int K = g.K, nt = K / BK;
    unsigned voffA[2], voffB[2];
#pragma unroll
    for (int i = 0; i < 2; ++i) { int R, C; stage_rc(tid * 16 + i * 8192, R, C); const int Rb = Epi::PERM ? ((R & ~31) + perm32(R & 31)) : R;
        voffA[i] = (unsigned)(R * K + C) * 2u; voffB[i] = (unsigned)(Rb * K + C) * 2u; }
    const size_t kstep = (size_t)(BK * 2);
    const size_t hstep = (size_t)HALF * K * 2;
    const size_t tstep = 2 * hstep;
    const unsigned ldsw = (unsigned)wid * 1024u;
    const int aoff = lds_byte(wr * 64 + fr, fq * 8), boff = lds_byte(wc * 32 + fr, fq * 8);
#define PG8_SA(b, h) (((b) * 2 + (h)) * HTB)
#define PG8_SB(b, h) ((4 + (b) * 2 + (h)) * HTB)
#define PG8_STAGE(bufoff, gbase, voff) do { _Pragma("unroll") for (int _i = 0; _i < 2; ++_i) \
        __builtin_amdgcn_global_load_lds((const unsigned*)((const char*)(gbase) + (voff)[_i]), (PG8_LAS unsigned*)(lds + (bufoff) + ldsw + _i * 8192), 16, 0, 0); } while (0)
#define PG8_LDA(dst, b, h) do { _Pragma("unroll") for (int m = 0; m < 4; ++m) _Pragma("unroll") for (int k = 0; k < 2; ++k) dst[m][k] = *(const PG8_LAS bf16x8*)(lds + PG8_SA(b, h) + aoff + m * 2048 + k * 1024); } while (0)
#define PG8_LDB(dst, b, h) do { _Pragma("unroll") for (int n = 0; n < 2; ++n) _Pragma("unroll") for (int k = 0; k < 2; ++k) dst[n][k] = *(const PG8_LAS bf16x8*)(lds + PG8_SB(b, h) + boff + n * 2048 + k * 1024); } while (0)
#define PG8_MMA(ai, bj, At, Bt) do { __builtin_amdgcn_s_setprio(1); _Pragma("unroll") for (int m = 0; m < 4; ++m) _Pragma("unroll") for (int n = 0; n < 2; ++n) _Pragma("unroll") for (int k = 0; k < 2; ++k) \
        acc[ai][bj][m][n] = __builtin_amdgcn_mfma_f32_16x16x32_bf16(Bt[n][k], At[m][k], acc[ai][bj][m][n], 0, 0, 0); __builtin_amdgcn_s_setprio(0); } while (0)
#define PG8_WAIT_V(n) asm volatile("s_waitcnt vmcnt(" #n ")" ::: "memory")
#define PG8_WAIT_L(n) asm volatile("s_waitcnt lgkmcnt(" #n ")" ::: "memory")
#define PG8_BAR __builtin_amdgcn_s_barrier()
#define PG8_SCHED __builtin_amdgcn_sched_barrier(0)
    Unit cur, nxt; int ui = 0;
    if (!S.next(0, cur)) return;
    f32x4 acc[2][2][4][2];
#pragma unroll
    for (int a = 0; a < 2; ++a)
#pragma unroll
        for (int b = 0; b < 2; ++b)
#pragma unroll
            for (int m = 0; m < 4; ++m)
#pragma unroll
                for (int n = 0; n < 2; ++n) acc[a][b][m][n] = (f32x4){0.f, 0.f, 0.f, 0.f};
    bf16x8 At[4][2], B0[2][2], B1[2][2];
    const char* cA = (const char*)g.A + (size_t)cur.pm * tstep; const char* cB = (const char*)g.Bt + (size_t)cur.pn * tstep;
    S.a_ready(cur);
    if constexpr (SP2) {
        PG8_STAGE(PG8_SB(0, 0), cB, voffB); PG8_STAGE(PG8_SB(0, 1), cB + hstep, voffB); PG8_STAGE(PG8_SA(0, 0), cA, voffA); PG8_STAGE(PG8_SA(0, 1), cA + hstep, voffA);
        if (wr == 1) PG8_BAR;
        PG8_WAIT_V(2); PG8_BAR;
        PG8_STAGE(PG8_SB(1, 0), cB + kstep, voffB); PG8_STAGE(PG8_SA(1, 0), cA + kstep, voffA); PG8_STAGE(PG8_SB(1, 1), cB + hstep + kstep, voffB);
        PG8_WAIT_V(6); PG8_BAR;
    } else {
        PG8_STAGE(PG8_SB(0, 0), cB, voffB); PG8_STAGE(PG8_SA(0, 0), cA, voffA); PG8_STAGE(PG8_SB(0, 1), cB + hstep, voffB); PG8_STAGE(PG8_SA(0, 1), cA + hstep, voffA);
        if (wr == 1) PG8_BAR;
        PG8_WAIT_V(4); PG8_BAR;
        PG8_STAGE(PG8_SB(1, 0), cB + kstep, voffB); PG8_STAGE(PG8_SA(1, 0), cA + kstep, voffA); PG8_STAGE(PG8_SB(1, 1), cB + hstep + kstep, voffB);
        PG8_WAIT_V(6); PG8_BAR;
    }
    for (;;) {
        const bool has_next = S.next(ui + 1, nxt);
        const char* nA = has_next ? (const char*)g.A + (size_t)nxt.pm * tstep : cA; const char* nB = has_next ? (const char*)g.Bt + (size_t)nxt.pn * tstep : cB;
        for (int t = 0; t < nt; t += 2) {
            const bool last = (t == nt - 2);
            const char* a1 = cA + (size_t)(t + 1) * kstep;
            const char* a2 = last ? nA : cA + (size_t)(t + 2) * kstep; const char* b2 = last ? nB : cB + (size_t)(t + 2) * kstep;
            const char* a3 = a2 + kstep; const char* b3 = b2 + kstep;
            if (last && has_next) S.a_ready(nxt);
            if constexpr (SP2) {
            PG8_LDB(B0, 0, 0); PG8_LDB(B1, 0, 1); PG8_SCHED; PG8_LDA(At, 0, 0); PG8_STAGE(PG8_SA(1, 1), a1 + hstep, voffA);
            PG8_WAIT_V(8); PG8_WAIT_L(0); PG8_BAR; PG8_MMA(0, 0, At, B0); PG8_MMA(0, 1, At, B1); PG8_BAR; PG8_SCHED;
            PG8_LDA(At, 0, 1); PG8_STAGE(PG8_SB(0, 0), b2, voffB); PG8_STAGE(PG8_SB(0, 1), b2 + hstep, voffB); PG8_STAGE(PG8_SA(0, 0), a2, voffA);
            PG8_WAIT_V(8); PG8_WAIT_L(0); PG8_BAR; PG8_MMA(1, 0, At, B0); PG8_MMA(1, 1, At, B1); PG8_BAR; PG8_SCHED;
            PG8_LDB(B0, 1, 0); PG8_LDB(B1, 1, 1); PG8_SCHED; PG8_LDA(At, 1, 0); PG8_STAGE(PG8_SA(0, 1), a2 + hstep, voffA);
            PG8_WAIT_V(8); PG8_WAIT_L(0); PG8_BAR; PG8_MMA(0, 0, At, B0); PG8_MMA(0, 1, At, B1); PG8_BAR; PG8_SCHED;
            PG8_LDA(At, 1, 1); PG8_STAGE(PG8_SB(1, 0), b3, voffB); PG8_STAGE(PG8_SB(1, 1), b3 + hstep, voffB); PG8_STAGE(PG8_SA(1, 0), a3, voffA);
            PG8_WAIT_V(8); PG8_WAIT_L(0); PG8_BAR; PG8_MMA(1, 0, At, B0); PG8_MMA(1, 1, At, B1); PG8_BAR; PG8_SCHED;
            } else {
            PG8_LDB(B0, 0, 0); PG8_SCHED; PG8_LDA(At, 0, 0); PG8_STAGE(PG8_SA(1, 1), a1 + hstep, voffA);
            PG8_WAIT_L(8); PG8_BAR; PG8_WAIT_L(0); PG8_MMA(0, 0, At, B0); PG8_BAR; PG8_SCHED;
            PG8_LDB(B1, 0, 1); PG8_STAGE(PG8_SB(0, 0), b2, voffB);
            PG8_BAR; PG8_WAIT_L(0); PG8_MMA(0, 1, At, B1); PG8_BAR;
            PG8_LDA(At, 0, 1); PG8_STAGE(PG8_SA(0, 0), a2, voffA);
            PG8_BAR; PG8_WAIT_L(0); PG8_MMA(1, 0, At, B0); PG8_BAR; PG8_SCHED;
            PG8_STAGE(PG8_SB(0, 1), b2 + hstep, voffB);
            PG8_WAIT_V(6); PG8_BAR; PG8_MMA(1, 1, At, B1); PG8_BAR;
            PG8_LDB(B0, 1, 0); PG8_SCHED; PG8_LDA(At, 1, 0); PG8_STAGE(PG8_SA(0, 1), a2 + hstep, voffA);
            PG8_WAIT_L(8); PG8_BAR; PG8_WAIT_L(0); PG8_MMA(0, 0, At, B0); PG8_BAR; PG8_SCHED;
            PG8_LDB(B1, 1, 1); PG8_STAGE(PG8_SB(1, 0), b3, voffB);
            PG8_BAR; PG8_WAIT_L(0); PG8_MMA(0, 1, At, B1); PG8_BAR;
            PG8_LDA(At, 1, 1); PG8_STAGE(PG8_SA(1, 0), a3, voffA);
            PG8_BAR; PG8_WAIT_L(0); PG8_MMA(1, 0, At, B0); PG8_BAR; PG8_SCHED;
            PG8_STAGE(PG8_SB(1, 1), b3 + hstep, voffB);
            PG8_WAIT_V(6); PG8_BAR; PG8_MMA(1, 1, At, B1); PG8_BAR;
            }
        }
        if constexpr (ALIGN_EPI) { if (wr == 0) PG8_BAR; }
        if constexpr (!Epi::AFTER_DRAIN) { E(acc, cur, wr, wc, fr, fq); S.done(cur); }
        if (!has_next) break;
#pragma unroll
        for (int a = 0; a < 2; ++a)
#pragma unroll
            for (int b = 0; b < 2; ++b)
#pragma unroll
                for (int m = 0; m < 4; ++m)
#pragma unroll
                    for (int n = 0; n < 2; ++n) acc[a][b][m][n] = (f32x4){0.f, 0.f, 0.f, 0.f};
        cur = nxt; cA = nA; cB = nB; ++ui;
        if constexpr (ALIGN_EPI) { if (wr == 1) PG8_BAR; }
    }
    PG8_WAIT_V(0);
    if constexpr (!ALIGN_EPI) { if (wr == 0) PG8_BAR; }
    PG8_BAR;
    if constexpr (Epi::AFTER_DRAIN) { E.fused(acc, cur, wr, wc, fr, fq, lds, wid, lane); S.done(cur); }
#undef PG8_SA
#undef PG8_SB
#undef PG8_STAGE
#undef PG8_LDA
#undef PG8_LDB
#undef PG8_MMA
#undef PG8_WAIT_V
#undef PG8_WAIT_L
#undef PG8_BAR
#undef PG8_SCHED
}
}

#define LAS __attribute__((address_space(3)))
typedef unsigned short bf16_t;
typedef short bf16x8 __attribute__((ext_vector_type(8)));
typedef short s16x4 __attribute__((ext_vector_type(4)));
typedef float f32x4 __attribute__((ext_vector_type(4)));
typedef float f32x16 __attribute__((ext_vector_type(16)));
typedef unsigned u32x4 __attribute__((ext_vector_type(4)));
typedef unsigned u32x2 __attribute__((ext_vector_type(2)));
typedef LAS unsigned char* ldsp;
constexpr int NWAVES = 8, NTHREADS = 512, LDS_BYTES = 147456;
#define MFMA32(a, b, c) __builtin_amdgcn_mfma_f32_32x32x16_bf16((a), (b), (c), 0, 0, 0)
#define MFMA16(a, b, c) __builtin_amdgcn_mfma_f32_16x16x32_bf16((a), (b), (c), 0, 0, 0)
__device__ __forceinline__ int crow(int r, int hi) { return (r & 3) + 8 * (r >> 2) + 4 * hi; }
__device__ __forceinline__ unsigned f2bf(float f) { return pkbf(f, 0.f) & 0xffffu; }
__device__ __forceinline__ float wave_sum(float v) {
#pragma unroll
    for (int o = 1; o < 64; o <<= 1) v += __shfl_xor(v, o);
    return v;
}
__device__ __forceinline__ bf16x8 pack8(const f32x16& x, int s) {
    u32x4 p; p.x = pkbf(x[8 * s], x[8 * s + 1]); p.y = pkbf(x[8 * s + 2], x[8 * s + 3]); p.z = pkbf(x[8 * s + 4], x[8 * s + 5]); p.w = pkbf(x[8 * s + 6], x[8 * s + 7]);
    return __builtin_bit_cast(bf16x8, p);
}

struct Args {
    const float* in[34]; float* out; unsigned char* ws; int ph_lo, ph_hi;
};
typedef const __attribute__((address_space(4))) Args* KA;
enum { I_XP = 0, I_XS, I_CSK, I_CSV, I_CMK, I_CMV, I_SLC, I_SLH, I_SFC, I_MEMP, I_GMIX, I_WIN, I_WLC, I_BLC, I_WLA, I_BLA, I_WLX, I_BLX, I_LAM, I_SINK, I_WOUT, I_GCROSS, I_GMEM,
       I_WMQ, I_WMK, I_WMV, I_WMO, I_GFFN, I_WFG, I_WFU, I_WFC, I_BFC, I_WFD, I_GFIN };

#define RLX_AGENT __ATOMIC_RELAXED, __HIP_MEMORY_SCOPE_AGENT
constexpr size_t WS_BAR = 896 * 1024, BAR_ZERO_BYTES = 16384;
constexpr int MISC_OFF = LDS_BYTES - 64;
#define XB_TMO      128
#define XB_XCNT(j)  (256  + 64 * (j))
#define XB_XSUB(j)  (1280 + 64 * (j))
#define XB_XGEN(j)  (2304 + 64 * (j))
#define XB_TOP      3328
#define XB_TOPGEN   3392
#define XCD_BAR_WORDS 3456
#define XB_SPIN_CAP (1u << 18)

__device__ __forceinline__ unsigned xb_ld(unsigned* p)              { return __hip_atomic_load(p, __ATOMIC_RELAXED, __HIP_MEMORY_SCOPE_AGENT); }
__device__ __forceinline__ unsigned xb_add(unsigned* p, unsigned v) { return __hip_atomic_fetch_add(p, v, __ATOMIC_RELAXED, __HIP_MEMORY_SCOPE_AGENT); }
__device__ __forceinline__ unsigned xb_xcc_id() { return (unsigned)__builtin_amdgcn_s_getreg((3 << 11) | 20) & 0xFu; }
#define XB_SPIN(cond, bar) do { unsigned _sp = 0; while (cond) { __builtin_amdgcn_s_sleep(1); \
    if ((++_sp & 255u) == 0u) { if (xb_ld(&(bar)[XB_TMO])) break; if (_sp > XB_SPIN_CAP) { atomicAdd(&(bar)[XB_TMO], 1u); break; } } } } while (0)

struct XcdBarrier {
    unsigned* bar; unsigned x;
    volatile LAS unsigned* st;
};

__device__ __forceinline__ XcdBarrier xcd_barrier_post(unsigned* bar, volatile LAS unsigned* st) {
    XcdBarrier b; b.bar = bar; b.x = xb_xcc_id(); b.st = st;
    if (threadIdx.x == 0) (void)xb_add(&bar[XB_XCNT(b.x)], 1u);
    return b;
}
__device__ __forceinline__ void xcd_barrier_complete(unsigned* bar, unsigned x, unsigned& nloc, unsigned& nx) {
    const unsigned G = gridDim.x * gridDim.y * gridDim.z;
    unsigned sum, cnt, mine, sp = 0u;
    for (;;) {
        sum = 0u; cnt = 0u; mine = 0u;
#pragma unroll
        for (unsigned j = 0; j < 16; ++j) { const unsigned c = xb_ld(&bar[XB_XCNT(j)]); sum += c; cnt += (c > 0u) ? 1u : 0u; mine = (j == x) ? c : mine; }
        if (sum == G) break;
        __builtin_amdgcn_s_sleep(1);
        if ((++sp & 255u) == 0u) { if (xb_ld(&bar[XB_TMO])) break; if (sp > XB_SPIN_CAP) { atomicAdd(&bar[XB_TMO], 1u); break; } }
    }
    nloc = mine > 0u ? mine : 1u; nx = cnt > 0u ? cnt : 1u;
}

__device__ __forceinline__ void xcd_barrier(const XcdBarrier& b) {
    asm volatile("s_waitcnt vmcnt(0)" ::: "memory");
    __syncthreads();
    if (threadIdx.x == 0) {
        unsigned* bar = b.bar;
        __builtin_amdgcn_s_waitcnt(0);
        unsigned nloc = b.st[0], nx = b.st[1];
        if (nloc == 0u) { xcd_barrier_complete(bar, b.x, nloc, nx); b.st[0] = nloc; b.st[1] = nx; }
        const unsigned old = xb_add(&bar[XB_XSUB(b.x)], 1u);
        const unsigned gen = old / nloc;
        if (old + 1u == (gen + 1u) * nloc) {
            __builtin_amdgcn_fence(__ATOMIC_RELEASE, "agent");
            asm volatile("s_waitcnt vmcnt(0)" ::: "memory");
            const unsigned og = xb_add(&bar[XB_TOP], 1u);
            const unsigned tg = og / nx;
            if (og + 1u == (tg + 1u) * nx) xb_add(&bar[XB_TOPGEN], 1u);
            else XB_SPIN(xb_ld(&bar[XB_TOPGEN]) == tg, bar);
            __builtin_amdgcn_fence(__ATOMIC_ACQUIRE, "agent");
            xb_add(&bar[XB_XGEN(b.x)], 1u);
            asm volatile("s_waitcnt vmcnt(0)" ::: "memory");
        } else {
            XB_SPIN(xb_ld(&bar[XB_XGEN(b.x)]) == gen, bar);
            __builtin_amdgcn_fence(__ATOMIC_ACQUIRE, "agent");
            asm volatile("s_waitcnt vmcnt(0)" ::: "memory");
        }
    }
    __syncthreads();
}

__device__ __forceinline__ void p0_transpose_item(const float* W, const float* g, int K, int N, bf16_t* WT, int row_off, int ilv, LAS float* scr, int item, int lane) {
    const int nblk = N / 32, kb = item / nblk, nb = item % nblk, k0 = 64 * kb, n0 = 32 * nb;
#pragma unroll
    for (int i = 0; i < 32; ++i) { const int kk = 2 * i + (lane >> 5); const float s = g ? g[k0 + kk] : 1.0f; scr[kk * 33 + (lane & 31)] = W[(size_t)(k0 + kk) * N + n0 + (lane & 31)] * s; }
    asm volatile("s_waitcnt lgkmcnt(0)" ::: "memory");
    const int c = lane & 7;
    const int rbase = ilv ? (((n0 >> 7) << 8) + (n0 & 127) + (ilv == 2 ? 128 : 0)) : (row_off + n0);
#pragma unroll
    for (int j = 0; j < 4; ++j) { const int n = (lane >> 3) + 8 * j; const LAS float* s = scr + (8 * c) * 33 + n;
        u32x4 o; o.x = pkbf(s[0 * 33], s[1 * 33]); o.y = pkbf(s[2 * 33], s[3 * 33]); o.z = pkbf(s[4 * 33], s[5 * 33]); o.w = pkbf(s[6 * 33], s[7 * 33]);
        *(u32x4*)(WT + (size_t)(rbase + n) * K + k0 + 8 * c) = o; }
    asm volatile("s_waitcnt lgkmcnt(0)" ::: "memory");
}
__device__ __forceinline__ void row_to_bf16(const float* xrow, bf16_t* orow, float* ssq, int lane) {
    const f32x4* xr = (const f32x4*)xrow + lane;
    f32x4 v[4]; float s = 0.f;
#pragma unroll
    for (int j = 0; j < 4; ++j) { v[j] = xr[64 * j]; s += (v[j].x * v[j].x + v[j].y * v[j].y) + (v[j].z * v[j].z + v[j].w * v[j].w); }
    s = wave_sum(s);
    u32x2* o8 = (u32x2*)orow + lane;
#pragma unroll
    for (int j = 0; j < 4; ++j) { u32x2 w; w.x = pkbf(v[j].x, v[j].y); w.y = pkbf(v[j].z, v[j].w); o8[64 * j] = w; }
    if (lane == 0) *ssq = s;
}
__device__ __forceinline__ void p0_prologue(KA a, ldsp lds, int tid, int lane, int wave) {
    unsigned char* ws = a->ws;
    LAS float* scr = (LAS float*)(lds + wave * 16384);
    const int gw = blockIdx.x * NWAVES + wave, NGW = gridDim.x * NWAVES;
    constexpr int I_IN = 16 * 56, I_OUT = 16 * 32, I_Q = 16 * 16, I_MO = 8 * 32, I_G = 16 * 96, I_D = 48 * 32;
    constexpr int NITEMS = I_IN + I_OUT + 3 * I_Q + I_MO + 2 * I_G + I_D;
    for (int it = gw; it < NITEMS; it += NGW) {
        int r = it;
        if (r < I_IN) { p0_transpose_item(a->in[I_WIN], a->in[I_GMIX], 1024, DIN, (bf16_t*)(ws + WS_WIN), 0, 0, scr, r, lane); continue; } r -= I_IN;
        if (r < I_OUT) { p0_transpose_item(a->in[I_WOUT], nullptr, 1024, 1024, (bf16_t*)(ws + WS_WOUT), 0, 0, scr, r, lane); continue; } r -= I_OUT;
        if (r < I_Q) { p0_transpose_item(a->in[I_WMQ], a->in[I_GCROSS], 1024, 512, (bf16_t*)(ws + WS_WQ), 0, 0, scr, r, lane); continue; } r -= I_Q;
        if (r < I_Q) { p0_transpose_item(a->in[I_WMK], a->in[I_GMEM], 1024, 512, (bf16_t*)(ws + WS_WKV), 0, 0, scr, r, lane); continue; } r -= I_Q;
        if (r < I_Q) { p0_transpose_item(a->in[I_WMV], a->in[I_GMEM], 1024, 512, (bf16_t*)(ws + WS_WKV), 512, 0, scr, r, lane); continue; } r -= I_Q;
        if (r < I_MO) { p0_transpose_item(a->in[I_WMO], nullptr, 512, 1024, (bf16_t*)(ws + WS_WMO), 0, 0, scr, r, lane); continue; } r -= I_MO;
        if (r < I_G) { p0_transpose_item(a->in[I_WFG], a->in[I_GFFN], 1024, DFF, (bf16_t*)(ws + WS_WGU), 0, 1, scr, r, lane); continue; } r -= I_G;
        if (r < I_G) { p0_transpose_item(a->in[I_WFU], a->in[I_GFFN], 1024, DFF, (bf16_t*)(ws + WS_WGU), 0, 2, scr, r, lane); continue; } r -= I_G;
        p0_transpose_item(a->in[I_WFD], nullptr, DFF, 1024, (bf16_t*)(ws + WS_WD), 0, 0, scr, r, lane);
    }
    bf16_t* xb = (bf16_t*)(ws + WS_XB); float* ssq0 = (float*)(ws + WS_SSQ0);
    for (int m0 = gw; m0 < MT + 512; m0 += 2 * NGW) {
        const float* src[2]; bf16_t* dst[2]; float* sq[2]; bool ok[2];
#pragma unroll
        for (int q = 0; q < 2; ++q) { const int m = m0 + q * NGW; ok[q] = m < MT + 512;
            if (m < MP) { src[q] = a->in[I_XP] + (size_t)m * 1024; dst[q] = xb + (size_t)m * 1024; sq[q] = ssq0 + m; }
            else if (m < MT) { src[q] = a->in[I_XS] + (size_t)(m - MP) * 1024; dst[q] = xb + (size_t)m * 1024; sq[q] = ssq0 + m; }
            else { const int rr = ok[q] ? m - MT : 0; src[q] = a->in[I_MEMP] + (size_t)rr * 1024; dst[q] = (bf16_t*)(ws + WS_MEMA) + (size_t)rr * 1024; sq[q] = (float*)(ws + WS_SSQM) + rr; } }
        f32x4 v[2][4]; float s[2] = {0.f, 0.f};
#pragma unroll
        for (int q = 0; q < 2; ++q)
#pragma unroll
            for (int j = 0; j < 4; ++j) v[q][j] = ((const f32x4*)src[q] + lane)[64 * j];
#pragma unroll
        for (int q = 0; q < 2; ++q) {
#pragma unroll
            for (int j = 0; j < 4; ++j) s[q] += (v[q][j].x * v[q][j].x + v[q][j].y * v[q][j].y) + (v[q][j].z * v[q][j].z + v[q][j].w * v[q][j].w);
            s[q] = wave_sum(s[q]);
            if (ok[q]) {
#pragma unroll
                for (int j = 0; j < 4; ++j) { u32x2 wv; wv.x = pkbf(v[q][j].x, v[q][j].y); wv.y = pkbf(v[q][j].z, v[q][j].w); ((u32x2*)dst[q] + lane)[64 * j] = wv; }
                if (lane == 0) *sq[q] = s[q];
            }
        }
    }
    for (int i = blockIdx.x * NTHREADS + tid; i < MT; i += gridDim.x * NTHREADS) { ((float*)(ws + WS_SSQ1))[i] = 0.f; ((float*)(ws + WS_SSQ2))[i] = 0.f; ((float*)(ws + WS_SSQ3))[i] = 0.f; }
}

template <bool SAMPLE, int PASS>
__device__ __forceinline__ void lru_unit(KA a, ldsp lds, int unit, int tid, int lane, int w) {
    constexpr int NTOK = SAMPLE ? 64 : 256, NROW = SAMPLE ? (NTOK / 4) * 7 : NTOK + 3, RS = 272;
    const ldsp XR = lds, XC = lds + 259 * RS;
    unsigned char* ws = a->ws;
    const bf16_t* proj = (const bf16_t*)(ws + WS_PROJ);
    int b = 0, chunk, bp;
    if (!SAMPLE) { b = unit >> 7; chunk = (unit >> 2) & 31; bp = unit & 3; } else { chunk = unit >> 2; bp = unit & 3; }
    const int c0 = bp * 128;
    const int row0 = SAMPLE ? MP + chunk * 64 : b * SEQ + chunk * 256;
    __syncthreads();
#pragma unroll
    for (int it = tid; it < NROW * 16; it += NTHREADS) {
        const int r = it >> 4, cq = it & 15;
        u32x4 v = {0u, 0u, 0u, 0u};
        if (!SAMPLE) { const int t = chunk * 256 - 3 + r; if (t >= 0) v = *(const u32x4*)(proj + (size_t)(b * SEQ + t) * DIN + c0 + cq * 8); }
        else { const int bl = r / 7, rr = r % 7, bs = chunk * 16 + bl;
            if (rr >= 3) v = *(const u32x4*)(proj + (size_t)(MP + bs * 4 + rr - 3) * DIN + c0 + cq * 8);
            else { const float* s = a->in[I_SLC] + (size_t)(bs * 3 + rr) * 512 + c0 + cq * 8; const f32x4 s0 = *(const f32x4*)s, s1 = *(const f32x4*)(s + 4);
                v.x = pkbf(s0[0], s0[1]); v.y = pkbf(s0[2], s0[3]); v.z = pkbf(s1[0], s1[1]); v.w = pkbf(s1[2], s1[3]); } }
        *(LAS u32x4*)(XR + r * RS + cq * 16) = v;
    }
    __syncthreads();
    {
        const int cq = tid & 15, tg = tid >> 4;
        float wk[4][8], bb[8];
#pragma unroll
        for (int j = 0; j < 8; ++j) { bb[j] = a->in[I_BLC][c0 + cq * 8 + j];
#pragma unroll
            for (int k = 0; k < 4; ++k) wk[k][j] = a->in[I_WLC][k * 512 + c0 + cq * 8 + j]; }
#pragma unroll
        for (int q = 0; q < NTOK / 32; ++q) {
            const int tok = tg * (NTOK / 32) + q; const int base = SAMPLE ? (tok >> 2) * 7 + (tok & 3) : tok;
            float x[8];
#pragma unroll
            for (int j = 0; j < 8; ++j) x[j] = bb[j];
#pragma unroll
            for (int k = 0; k < 4; ++k) { const u32x4 v = *(const LAS u32x4*)(XR + (base + k) * RS + cq * 16);
                x[0] += wk[k][0] * bflo(v.x); x[1] += wk[k][1] * bfhi(v.x); x[2] += wk[k][2] * bflo(v.y); x[3] += wk[k][3] * bfhi(v.y);
                x[4] += wk[k][4] * bflo(v.z); x[5] += wk[k][5] * bfhi(v.z); x[6] += wk[k][6] * bflo(v.w); x[7] += wk[k][7] * bfhi(v.w); }
            u32x4 o; o.x = pkbf(x[0], x[1]); o.y = pkbf(x[2], x[3]); o.z = pkbf(x[4], x[5]); o.w = pkbf(x[6], x[7]);
            *(LAS u32x4*)(XC + tok * RS + cq * 16) = o;
        }
    }
    __syncthreads();
    const int nb = w >> 2, jt = w & 3, n = bp * 2 + nb, fr = lane & 15, fq = lane >> 4;
    const int ch = n * 64 + jt * 16 + fr, chl = nb * 64 + jt * 16 + fr;
    bf16x8 bA[2], bX[2];
#pragma unroll
    for (int kh = 0; kh < 2; ++kh)
#pragma unroll
        for (int j = 0; j < 8; ++j) { const int c = kh * 32 + 8 * fq + j; const size_t o = (size_t)(n * 64 + c) * 64 + jt * 16 + fr;
            bA[kh][j] = (short)f2bf(a->in[I_WLA][o]); bX[kh][j] = (short)f2bf(a->in[I_WLX][o]); }
    const float ba_ = a->in[I_BLA][ch], bx_ = a->in[I_BLX][ch];
    const float lam = a->in[I_LAM][ch];
    const float sp = (lam > 15.f) ? __expf(-lam) : log1pf(__expf(-lam));
    const float k8 = -8.0f * sp * LOG2E;
    const float wc0 = a->in[I_WLC][ch], wc1 = a->in[I_WLC][512 + ch], wc2 = a->in[I_WLC][1024 + ch], wc3 = a->in[I_WLC][1536 + ch], bcv = a->in[I_BLC][ch];
    float hc = 0.f, Atot = 1.f, Htot = 0.f;
    float* summ = (float*)(ws + WS_SUMM);
    if (!SAMPLE && PASS == 2) {
        typedef float f32x2_ __attribute__((ext_vector_type(2)));
        f32x2_ ah[32];
#pragma unroll
        for (int j = 0; j < 32; ++j) ah[j] = *(const f32x2_*)(summ + ((size_t)(b * 32 + j) * 512 + ch) * 2);
#pragma unroll
        for (int j = 0; j < 32; ++j) if (j < chunk) hc = ah[j].x * hc + ah[j].y;
    }
    bf16_t* mix = (bf16_t*)(ws + WS_MIX);
    unsigned short gcur[4] = {0, 0, 0, 0}, gnxt[4] = {0, 0, 0, 0};
    if (SAMPLE || PASS == 2) {
#pragma unroll
        for (int r = 0; r < 4; ++r) gcur[r] = proj[((size_t)row0 + 4 * fq + r) * DIN + 512 + ch];
    }
#pragma unroll 2
    for (int s = 0; s < NTOK / 16; ++s) {
        if ((SAMPLE || PASS == 2) && s + 1 < NTOK / 16) {
#pragma unroll
            for (int r = 0; r < 4; ++r) gnxt[r] = proj[((size_t)row0 + 16 * (s + 1) + 4 * fq + r) * DIN + 512 + ch];
        }
        bf16x8 aF[2];
#pragma unroll
        for (int kh = 0; kh < 2; ++kh) aF[kh] = *(const LAS bf16x8*)(XC + (16 * s + fr) * RS + (nb * 64 + kh * 32 + 8 * fq) * 2);
        f32x4 accA = {0.f, 0.f, 0.f, 0.f}, accX = {0.f, 0.f, 0.f, 0.f};
        accA = MFMA16(aF[0], bA[0], accA); accA = MFMA16(aF[1], bA[1], accA);
        accX = MFMA16(aF[0], bX[0], accX); accX = MFMA16(aF[1], bX[1], accX);
        const int base = SAMPLE ? (4 * s + fq) * 7 : 16 * s + 4 * fq;
        float x7[7];
#pragma unroll
        for (int q = 0; q < 7; ++q) x7[q] = bf2f(*(const LAS unsigned short*)(XR + (base + q) * RS + chl * 2));
        float av[4], bv[4];
#pragma unroll
        for (int r = 0; r < 4; ++r) {
            const float xc = bcv + wc0 * x7[r] + wc1 * x7[r + 1] + wc2 * x7[r + 2] + wc3 * x7[r + 3];
            const float rg = sigmoidf_(accA[r] + ba_), ig = sigmoidf_(accX[r] + bx_);
            const float a_ = fexp2(k8 * rg);
            av[r] = a_; bv[r] = __builtin_sqrtf(fmaxf(1.0f - a_ * a_, 0.f)) * (ig * xc);
        }
        float hv[4];
        if (SAMPLE) {
            const int bs = chunk * 16 + 4 * s + fq;
            float h = a->in[I_SLH][(size_t)bs * 512 + ch];
#pragma unroll
            for (int r = 0; r < 4; ++r) { h = av[r] * h + bv[r]; hv[r] = h; }
            a->out[O_SLH + (size_t)bs * 512 + ch] = h;
        } else {
            float Ai = av[0] * av[1] * av[2] * av[3], Hi = 0.f;
#pragma unroll
            for (int r = 0; r < 4; ++r) Hi = av[r] * Hi + bv[r];
            float tA = __shfl_up(Ai, 16), tH = __shfl_up(Hi, 16);
            if (fq >= 1) { Hi = Ai * tH + Hi; Ai = Ai * tA; }
            tA = __shfl_up(Ai, 32); tH = __shfl_up(Hi, 32);
            if (fq >= 2) { Hi = Ai * tH + Hi; Ai = Ai * tA; }
            float Ae = __shfl_up(Ai, 16), He = __shfl_up(Hi, 16);
            if (fq == 0) { Ae = 1.f; He = 0.f; }
            const float At = __shfl(Ai, 48 + fr), Ht = __shfl(Hi, 48 + fr);
            if (PASS == 1) { Htot = At * Htot + Ht; Atot *= At; }
            else {
                float h = Ae * hc + He;
#pragma unroll
                for (int r = 0; r < 4; ++r) { h = av[r] * h + bv[r]; hv[r] = h; }
                hc = At * hc + Ht;
            }
        }
        if (SAMPLE || PASS == 2) {
#pragma unroll
            for (int r = 0; r < 4; ++r) {
                const size_t row = (size_t)row0 + 16 * s + 4 * fq + r;
                mix[row * 1024 + ch] = (bf16_t)f2bf(hv[r] * gelu_tanh(bf2f(gcur[r])));
            }
#pragma unroll
            for (int r = 0; r < 4; ++r) gcur[r] = gnxt[r];
        }
    }
    if (!SAMPLE && PASS == 1 && fq == 0) { summ[((size_t)(b * 32 + chunk) * 512 + ch) * 2] = Atot; summ[((size_t)(b * 32 + chunk) * 512 + ch) * 2 + 1] = Htot; }
    if (!SAMPLE && PASS == 2 && chunk == 31 && fq == 0) a->out[O_PLH + (size_t)b * 512 + ch] = hc;
}

__device__ __forceinline__ void swa_prompt_unit(KA a, ldsp lds, int unit, int tid, int lane, int w) {
    constexpr int KRS = 144, VRS = 400;
    const ldsp Ks = lds, VT = lds + 192 * KRS;
    const bf16_t* proj = (const bf16_t*)(a->ws + WS_PROJ);
    const int b = unit >> 8, hk = (unit >> 7) & 1, qb = unit & 127, t0 = qb * 64;
    __syncthreads();
#pragma unroll
    for (int it = tid; it < 192 * 8; it += NTHREADS) {
        const int kl = it >> 3, cq = it & 7, t = t0 - 128 + kl;
        u32x4 kv = {0u, 0u, 0u, 0u}, vv = {0u, 0u, 0u, 0u};
        if (t >= 0) { const bf16_t* p = proj + (size_t)(b * SEQ + t) * DIN; kv = *(const u32x4*)(p + 1536 + hk * 64 + cq * 8); vv = *(const u32x4*)(p + 1664 + hk * 64 + cq * 8); }
        *(LAS u32x4*)(Ks + kl * KRS + cq * 16) = kv;
#pragma unroll
        for (int e = 0; e < 8; ++e) *(LAS unsigned short*)(VT + (cq * 8 + e) * VRS + kl * 2) = (unsigned short)(vv[e >> 1] >> (16 * (e & 1)));
    }
    __syncthreads();
    const int g = w >> 1, hf = w & 1, hq = hk * 4 + g, j = lane & 31, hi = lane >> 5;
    const size_t qrow = (size_t)b * SEQ + t0 + 32 * hf + j;
    bf16x8 qf[4];
#pragma unroll
    for (int ks = 0; ks < 4; ++ks) qf[ks] = *(const bf16x8*)(proj + qrow * DIN + 1024 + hq * 64 + 16 * ks + 8 * hi);
    const float slope2 = fexp2(-(float)(hq + 1)) * LOG2E, sink2 = a->in[I_SINK][hq] * LOG2E;
    float mx = sink2;
    f32x16 st[5];
#pragma unroll
    for (int kt = 0; kt < 5; ++kt) {
        f32x16 acc = {};
#pragma unroll
        for (int ks = 0; ks < 4; ++ks) { const bf16x8 kf = *(const LAS bf16x8*)(Ks + (32 * hf + 32 * kt + j) * KRS + (16 * ks + 8 * hi) * 2); acc = MFMA32(kf, qf[ks], acc); }
        int dbase = 128 + j - 32 * kt - 4 * hi;
        int kpb = t0 - 128 + 32 * hf + 32 * kt + 4 * hi;
        asm volatile("" : "+v"(dbase), "+v"(kpb));
#pragma unroll
        for (int r = 0; r < 16; ++r) {
            const int cr = (r & 3) + 8 * (r >> 2), dist = dbase - cr;
            const bool valid = (unsigned)dist < 128u && (kpb + cr) >= 0;
            float s = acc[r] * LOG2E - slope2 * (float)dist; s = valid ? s : -1e30f; acc[r] = s; mx = fmaxf(mx, s);
        }
        st[kt] = acc;
        __builtin_amdgcn_sched_barrier(0);
    }
    mx = fmaxf(mx, __shfl_xor(mx, 32));
    float l = 0.f;
#pragma unroll
    for (int kt = 0; kt < 5; ++kt)
#pragma unroll
        for (int r = 0; r < 16; ++r) { const float p = fexp2(st[kt][r] - mx); st[kt][r] = p; l += p; }
    l += __shfl_xor(l, 32); l += fexp2(sink2 - mx);
    const float inv = frcp(l);
    f32x16 o[2] = {};
#pragma unroll
    for (int kt = 0; kt < 5; ++kt)
#pragma unroll
        for (int s = 0; s < 2; ++s) {
            const bf16x8 pf = pack8(st[kt], s);
#pragma unroll
            for (int dt = 0; dt < 2; ++dt) {
                const int d = 32 * dt + j, kb = 32 * hf + 32 * kt + 16 * s + 4 * hi;
                const s16x4 lo = *(const LAS s16x4*)(VT + d * VRS + kb * 2), hi4 = *(const LAS s16x4*)(VT + d * VRS + (kb + 8) * 2);
                const bf16x8 vf = __builtin_shufflevector(lo, hi4, 0, 1, 2, 3, 4, 5, 6, 7);
                o[dt] = MFMA32(vf, pf, o[dt]);
            }
            __builtin_amdgcn_sched_barrier(0);
        }
    bf16_t* mix = (bf16_t*)(a->ws + WS_MIX);
#pragma unroll
    for (int dt = 0; dt < 2; ++dt)
#pragma unroll
        for (int rg = 0; rg < 4; ++rg) {
            u32x2 wv; wv.x = pkbf(o[dt][4 * rg] * inv, o[dt][4 * rg + 1] * inv); wv.y = pkbf(o[dt][4 * rg + 2] * inv, o[dt][4 * rg + 3] * inv);
            *(u32x2*)(mix + qrow * 1024 + 512 + hq * 64 + 32 * dt + 8 * rg + 4 * hi) = wv;
        }
}

__device__ __forceinline__ void swa_sample_unit(KA a, ldsp lds, int bs, int tid) {
    LAS float* Kc = (LAS float*)lds;
    LAS float* Vc = (LAS float*)(lds + 69696);
    LAS float* Qs = (LAS float*)(lds + 137280);
    LAS float* P = Kc;
    const bf16_t* proj = (const bf16_t*)(a->ws + WS_PROJ);
    __syncthreads();
    {
        f32x4 kvv[8], vvv[8];
#pragma unroll
        for (int q = 0; q < 8; ++q) { const int it = tid + q * NTHREADS, r = it >> 5, c4 = (it & 31) * 4;
            kvv[q] = *(const f32x4*)(a->in[I_CSK] + (size_t)(bs * 128 + r) * 128 + c4); vvv[q] = *(const f32x4*)(a->in[I_CSV] + (size_t)(bs * 128 + r) * 128 + c4); }
#pragma unroll
        for (int q = 0; q < 8; ++q) { const int it = tid + q * NTHREADS, r = it >> 5, c4 = (it & 31) * 4;
            *(LAS f32x4*)(Kc + r * 132 + c4) = kvv[q]; *(LAS f32x4*)(Vc + r * 128 + c4) = vvv[q];
            if (r >= 4) { *(f32x4*)(a->out + O_SSK + (size_t)(bs * 128 + r - 4) * 128 + c4) = kvv[q]; *(f32x4*)(a->out + O_SSV + (size_t)(bs * 128 + r - 4) * 128 + c4) = vvv[q]; } }
    }
    { const int i = tid >> 7, c = tid & 127; const bf16_t* p = proj + (size_t)(MP + bs * 4 + i) * DIN; Kc[(128 + i) * 132 + c] = bf2f(p[1536 + c]); Vc[(128 + i) * 128 + c] = bf2f(p[1664 + c]); }
    for (int e = tid; e < 2048; e += NTHREADS) { const int rq = e >> 6, d = e & 63, hq = rq >> 2, i = rq & 3; Qs[rq * 64 + d] = bf2f(proj[(size_t)(MP + bs * 4 + i) * DIN + 1024 + hq * 64 + d]); }
    __syncthreads();
    float sc[16];
    const int key = tid % 132, hk = tid / 132;
#pragma unroll
    for (int q = 0; q < 16; ++q) sc[q] = 0.f;
    if (tid < 264) {
#pragma unroll 1
        for (int c = 0; c < 16; ++c) {
            const f32x4 k4 = *(const LAS f32x4*)(Kc + key * 132 + hk * 64 + 4 * c);
#pragma unroll
            for (int q = 0; q < 16; ++q) { const f32x4 q4 = *(const LAS f32x4*)(Qs + (hk * 16 + q) * 64 + 4 * c); sc[q] += (k4[0] * q4[0] + k4[1] * q4[1]) + (k4[2] * q4[2] + k4[3] * q4[3]); }
        }
    }
    __syncthreads();
    if (tid < 264) {
#pragma unroll
        for (int q = 0; q < 16; ++q) { const int hq = hk * 4 + (q >> 2), i = q & 3, dist = i + 128 - key; const bool valid = dist >= 0 && dist < 128;
            const float s = sc[q] * LOG2E - fexp2(-(float)(hq + 1)) * LOG2E * (float)dist; P[(hk * 16 + q) * 132 + key] = valid ? s : -1e30f; }
    }
    __syncthreads();
    {
        const int row = tid >> 4, sub = tid & 15, hq = row >> 2; const float sink2 = a->in[I_SINK][hq] * LOG2E;
        float v[9], m = sink2;
#pragma unroll
        for (int jj = 0; jj < 9; ++jj) { const int k2 = sub + 16 * jj; v[jj] = k2 < 132 ? P[row * 132 + k2] : -1e30f; m = fmaxf(m, v[jj]); }
#pragma unroll
        for (int o = 8; o >= 1; o >>= 1) m = fmaxf(m, __shfl_xor(m, o));
        float l = 0.f;
#pragma unroll
        for (int jj = 0; jj < 9; ++jj) { v[jj] = fexp2(v[jj] - m); l += v[jj]; }
#pragma unroll
        for (int o = 8; o >= 1; o >>= 1) l += __shfl_xor(l, o);
        l += fexp2(sink2 - m);
        const float inv = 1.0f / l;
#pragma unroll
        for (int jj = 0; jj < 9; ++jj) { const int k2 = sub + 16 * jj; if (k2 < 132) P[row * 132 + k2] = v[jj] * inv; }
    }
    __syncthreads();
    {
        const int row = tid >> 4, d4 = (tid & 15) * 4, hq = row >> 2, hk2 = hq >> 2, i = row & 3;
        f32x4 acc = {0.f, 0.f, 0.f, 0.f};
#pragma unroll 4
        for (int k2 = 0; k2 < 132; ++k2) acc += P[row * 132 + k2] * *(const LAS f32x4*)(Vc + k2 * 128 + hk2 * 64 + d4);
        u32x2 wv; wv.x = pkbf(acc[0], acc[1]); wv.y = pkbf(acc[2], acc[3]);
        *(u32x2*)((bf16_t*)(a->ws + WS_MIX) + (size_t)(MP + bs * 4 + i) * 1024 + 512 + hq * 64 + d4) = wv;
    }
}

__device__ __forceinline__ void xattn_prompt_unit(KA a, ldsp lds, int unit, int tid, int lane, int w) {
    constexpr int KRS = 272, VRS = 528;
    const ldsp Km = lds, VmT = lds + 256 * KRS;
    const bf16_t* memkv = (const bf16_t*)(a->ws + WS_MEMKV);
    const bf16_t* qcb = (const bf16_t*)(a->ws + WS_QC);
    const int b = unit >> 7, h = (unit >> 5) & 3, qc = unit & 31;
    __syncthreads();
#pragma unroll
    for (int it = tid; it < 256 * 16; it += NTHREADS) {
        const int key = it >> 4, cq = it & 15; const bf16_t* p = memkv + (size_t)(b * 256 + key) * 1024 + h * 128 + cq * 8;
        const u32x4 kv = *(const u32x4*)p, vv = *(const u32x4*)(p + 512);
        *(LAS u32x4*)(Km + key * KRS + cq * 16) = kv;
#pragma unroll
        for (int e = 0; e < 8; ++e) *(LAS unsigned short*)(VmT + (cq * 8 + e) * VRS + key * 2) = (unsigned short)(vv[e >> 1] >> (16 * (e & 1)));
    }
    __syncthreads();
    const int j = lane & 31, hi = lane >> 5;
    const size_t qrow = (size_t)b * SEQ + qc * 256 + 32 * w + j;
    bf16x8 qf[8];
#pragma unroll
    for (int ks = 0; ks < 8; ++ks) qf[ks] = *(const bf16x8*)(qcb + qrow * 512 + h * 128 + 16 * ks + 8 * hi);
    float m = -1e30f, l = 0.f;
    f32x16 o[4] = {};
#pragma unroll
    for (int kh = 0; kh < 2; ++kh) {
        f32x16 st[4];
        float mx = -1e30f;
#pragma unroll
        for (int kt = 0; kt < 4; ++kt) {
            f32x16 acc = {};
#pragma unroll
            for (int ks = 0; ks < 8; ++ks) { const bf16x8 kf = *(const LAS bf16x8*)(Km + (128 * kh + 32 * kt + j) * KRS + (16 * ks + 8 * hi) * 2); acc = MFMA32(kf, qf[ks], acc); }
#pragma unroll
            for (int r = 0; r < 16; ++r) { acc[r] *= LOG2E; mx = fmaxf(mx, acc[r]); }
            st[kt] = acc;
        }
        mx = fmaxf(mx, __shfl_xor(mx, 32));
        const float mn = fmaxf(m, mx), scl = fexp2(m - mn);
        m = mn; l *= scl;
#pragma unroll
        for (int dt = 0; dt < 4; ++dt) o[dt] *= scl;
#pragma unroll
        for (int kt = 0; kt < 4; ++kt)
#pragma unroll
            for (int r = 0; r < 16; ++r) { const float p = fexp2(st[kt][r] - m); st[kt][r] = p; l += p; }
#pragma unroll
        for (int kt = 0; kt < 4; ++kt)
#pragma unroll
            for (int s = 0; s < 2; ++s) {
                const bf16x8 pf = pack8(st[kt], s);
#pragma unroll
                for (int dt = 0; dt < 4; ++dt) {
                    const int d = 32 * dt + j, kb = 128 * kh + 32 * kt + 16 * s + 4 * hi;
                    const s16x4 lo = *(const LAS s16x4*)(VmT + d * VRS + kb * 2), hi4 = *(const LAS s16x4*)(VmT + d * VRS + (kb + 8) * 2);
                    const bf16x8 vf = __builtin_shufflevector(lo, hi4, 0, 1, 2, 3, 4, 5, 6, 7);
                    o[dt] = MFMA32(vf, pf, o[dt]);
                }
            }
    }
    l += __shfl_xor(l, 32);
    const float inv = frcp(l);
    bf16_t* oc = (bf16_t*)(a->ws + WS_OC);
#pragma unroll
    for (int dt = 0; dt < 4; ++dt)
#pragma unroll
        for (int rg = 0; rg < 4; ++rg) {
            u32x2 wv; wv.x = pkbf(o[dt][4 * rg] * inv, o[dt][4 * rg + 1] * inv); wv.y = pkbf(o[dt][4 * rg + 2] * inv, o[dt][4 * rg + 3] * inv);
            *(u32x2*)(oc + qrow * 512 + h * 128 + 32 * dt + 8 * rg + 4 * hi) = wv;
        }
}
__device__ __forceinline__ void xattn_sample_unit(KA a, ldsp lds, int unit, int tid, int lane, int w) {
    LAS float* Qs = (LAS float*)lds;
    LAS float* S = (LAS float*)(lds + 2048);
    LAS float* RED = (LAS float*)(lds + 8192);
    const bf16_t* qcb = (const bf16_t*)(a->ws + WS_QC);
    const int bs = unit >> 2, h = unit & 3;
    __syncthreads();
    { const int i = tid >> 7, d = tid & 127; Qs[i * 128 + d] = bf2f(qcb[(size_t)(MP + bs * 4 + i) * 512 + h * 128 + d]); }
    __syncthreads();
    {
        const int key = tid >> 1, hf = tid & 1; const float* kp = a->in[I_CMK] + ((size_t)(bs * 256 + key) * 4 + h) * 128 + hf * 64;
        float s0 = 0.f, s1 = 0.f, s2 = 0.f, s3 = 0.f;
#pragma unroll
        for (int c = 0; c < 16; ++c) {
            const f32x4 k4 = *(const f32x4*)(kp + 4 * c);
            const f32x4 q0 = *(const LAS f32x4*)(Qs + hf * 64 + 4 * c), q1 = *(const LAS f32x4*)(Qs + 128 + hf * 64 + 4 * c), q2 = *(const LAS f32x4*)(Qs + 256 + hf * 64 + 4 * c), q3 = *(const LAS f32x4*)(Qs + 384 + hf * 64 + 4 * c);
            s0 += (k4[0] * q0[0] + k4[1] * q0[1]) + (k4[2] * q0[2] + k4[3] * q0[3]); s1 += (k4[0] * q1[0] + k4[1] * q1[1]) + (k4[2] * q1[2] + k4[3] * q1[3]);
            s2 += (k4[0] * q2[0] + k4[1] * q2[1]) + (k4[2] * q2[2] + k4[3] * q2[3]); s3 += (k4[0] * q3[0] + k4[1] * q3[1]) + (k4[2] * q3[2] + k4[3] * q3[3]);
        }
        s0 += __shfl_xor(s0, 1); s1 += __shfl_xor(s1, 1); s2 += __shfl_xor(s2, 1); s3 += __shfl_xor(s3, 1);
        if (hf == 0) { S[key] = s0 * LOG2E; S[256 + key] = s1 * LOG2E; S[512 + key] = s2 * LOG2E; S[768 + key] = s3 * LOG2E; }
    }
    __syncthreads();
    if (w < 4) {
        f32x4 v = *(const LAS f32x4*)(S + w * 256 + lane * 4);
        float m = fmaxf(fmaxf(v[0], v[1]), fmaxf(v[2], v[3]));
#pragma unroll
        for (int o = 32; o >= 1; o >>= 1) m = fmaxf(m, __shfl_xor(m, o));
        v[0] = fexp2(v[0] - m); v[1] = fexp2(v[1] - m); v[2] = fexp2(v[2] - m); v[3] = fexp2(v[3] - m);
        const float l = wave_sum((v[0] + v[1]) + (v[2] + v[3]));
        v *= (1.0f / l);
        *(LAS f32x4*)(S + w * 256 + lane * 4) = v;
    }
    __syncthreads();
    {
        const int dq = tid & 31, kg = tid >> 5; const float* vp = a->in[I_CMV] + ((size_t)(bs * 256 + kg * 16) * 4 + h) * 128 + dq * 4;
        f32x4 a0 = {0.f, 0.f, 0.f, 0.f}, a1 = a0, a2 = a0, a3 = a0;
#pragma unroll
        for (int kk = 0; kk < 16; ++kk) { const f32x4 v4 = *(const f32x4*)(vp + (size_t)kk * 512); const int k2 = kg * 16 + kk;
            a0 += S[k2] * v4; a1 += S[256 + k2] * v4; a2 += S[512 + k2] * v4; a3 += S[768 + k2] * v4; }
        *(LAS f32x4*)(RED + (kg * 4 + 0) * 128 + dq * 4) = a0; *(LAS f32x4*)(RED + (kg * 4 + 1) * 128 + dq * 4) = a1;
        *(LAS f32x4*)(RED + (kg * 4 + 2) * 128 + dq * 4) = a2; *(LAS f32x4*)(RED + (kg * 4 + 3) * 128 + dq * 4) = a3;
    }
    __syncthreads();
    { const int i = tid >> 7, d = tid & 127; float s = 0.f;
#pragma unroll
        for (int kg = 0; kg < 16; ++kg) s += RED[(kg * 4 + i) * 128 + d];
        ((bf16_t*)(a->ws + WS_OC))[(size_t)(MP + bs * 4 + i) * 512 + h * 128 + d] = (bf16_t)f2bf(s); }
}


template <class Post> __device__ __forceinline__ void sk_tile(ldsp lds, const bf16_t* A, int lda, const bf16_t* B0, const bf16_t* B1, int K, const Post& post, int tid, int lane, int w) {
    const int fr = lane & 15, fq = lane >> 4, kper = K >> 3;
    const bf16_t* ap = A + (size_t)fr * lda + w * kper + 16 * fq;
    const bf16_t* bp0 = B0 + (size_t)fr * K + w * kper + 16 * fq;
    const bf16_t* bp1 = B1 + (size_t)fr * K + w * kper + 16 * fq;
    f32x4 acc[2][8];
#pragma unroll
    for (int i = 0; i < 2; ++i)
#pragma unroll
        for (int j = 0; j < 8; ++j) acc[i][j] = (f32x4){0.f, 0.f, 0.f, 0.f};
    for (int k0 = 0; k0 < kper; k0 += 128) {
        bf16x8 af[2][2][2], bf[2][8][2];
#pragma unroll
        for (int c = 0; c < 2; ++c) {
            const int kk = k0 + 64 * c;
            if (kk < kper) {
#pragma unroll
                for (int i = 0; i < 2; ++i) { af[c][i][0] = *(const bf16x8*)(ap + (size_t)(16 * i) * lda + kk); af[c][i][1] = *(const bf16x8*)(ap + (size_t)(16 * i) * lda + kk + 8); }
#pragma unroll
                for (int j = 0; j < 4; ++j) { bf[c][j][0] = *(const bf16x8*)(bp0 + (size_t)(16 * j) * K + kk); bf[c][j][1] = *(const bf16x8*)(bp0 + (size_t)(16 * j) * K + kk + 8);
                    bf[c][4 + j][0] = *(const bf16x8*)(bp1 + (size_t)(16 * j) * K + kk); bf[c][4 + j][1] = *(const bf16x8*)(bp1 + (size_t)(16 * j) * K + kk + 8); }
            }
        }
#pragma unroll
        for (int c = 0; c < 2; ++c) {
            if (k0 + 64 * c < kper) {
#pragma unroll
                for (int hl = 0; hl < 2; ++hl)
#pragma unroll
                    for (int i = 0; i < 2; ++i)
#pragma unroll
                        for (int j = 0; j < 8; ++j) acc[i][j] = MFMA16(af[c][i][hl], bf[c][j][hl], acc[i][j]);
            }
        }
    }
    LAS float* PART = (LAS float*)lds;
    __syncthreads();
#pragma unroll
    for (int i = 0; i < 2; ++i)
#pragma unroll
        for (int j = 0; j < 8; ++j)
#pragma unroll
            for (int r = 0; r < 4; ++r) PART[(w * 32 + 16 * i + 4 * fq + r) * 132 + 16 * j + fr] = acc[i][j][r];
    __syncthreads();
    const int row = tid >> 4, cc = tid & 15;
    f32x4 v0 = *(const LAS f32x4*)(PART + row * 132 + 4 * cc), v1 = *(const LAS f32x4*)(PART + row * 132 + 64 + 4 * cc);
#pragma unroll
    for (int p = 1; p < 8; ++p) { v0 += *(const LAS f32x4*)(PART + (p * 32 + row) * 132 + 4 * cc); v1 += *(const LAS f32x4*)(PART + (p * 32 + row) * 132 + 64 + 4 * cc); }
    post(row, cc, v0, v1);
}
__device__ __forceinline__ void st4bf(bf16_t* p, f32x4 v) { u32x2 w_; w_.x = pkbf(v[0], v[1]); w_.y = pkbf(v[2], v[3]); *(u32x2*)p = w_; }
struct SkProj {
    bf16_t* proj; const float* ssq; float* out; int mt, n0;
    __device__ __forceinline__ void operator()(int row, int cc, f32x4 va, f32x4 vb) const {
        const int grow = MP + 32 * mt + row, r2 = grow - MP, b = r2 >> 2, t = r2 & 3;
        const float rs0 = __builtin_amdgcn_rsqf(ssq[grow] * (1.0f / 1024.0f) + EPS);
#pragma unroll
        for (int hh = 0; hh < 2; ++hh) {
            const int col = n0 + hh * 64 + 4 * cc; const float rs = rs0 * ((col >= 1024 && col < 1536) ? 0.125f : 1.0f);
            const f32x4 v = (hh ? vb : va) * rs;
            st4bf(proj + (size_t)grow * DIN + col, v);
            float* dst = nullptr;
            if (col >= 1536) dst = out + (col < 1664 ? O_SSK + (size_t)(b * 128 + 124 + t) * 128 + (col - 1536) : O_SSV + (size_t)(b * 128 + 124 + t) * 128 + (col - 1664));
            else if (col < 512 && t >= 1) dst = out + O_SLC + (size_t)(b * 3 + t - 1) * 512 + col;
            if (dst) *(f32x4*)dst = v;
        }
    }
};
template <int MODE> struct SkRes {
    const float* res; float* xout; bf16_t* xb; float* ssq; int mt, n0;
    __device__ __forceinline__ void operator()(int row, int cc, f32x4 va, f32x4 vb) const {
        const int grow = MP + 32 * mt + row; float sq = 0.f;
#pragma unroll
        for (int hh = 0; hh < 2; ++hh) {
            const int col = n0 + hh * 64 + 4 * cc;
            f32x4 v = hh ? vb : va;
            if (MODE == 0) v += *(const f32x4*)(res + (size_t)grow * 1024 + col);
            else { const u32x2 rr = *(const u32x2*)(xb + (size_t)grow * 1024 + col); v += (f32x4){bflo(rr.x), bfhi(rr.x), bflo(rr.y), bfhi(rr.y)}; }
            if (MODE == 2) *(f32x4*)(xout + (size_t)grow * 1024 + col) = v; else st4bf(xb + (size_t)grow * 1024 + col, v);
            sq += (v[0] * v[0] + v[1] * v[1]) + (v[2] * v[2] + v[3] * v[3]);
        }
        if (MODE != 2) {
            sq += __shfl_xor(sq, 1); sq += __shfl_xor(sq, 2); sq += __shfl_xor(sq, 4); sq += __shfl_xor(sq, 8);
            if (cc == 0) __hip_atomic_fetch_add(ssq + grow, sq, __ATOMIC_RELAXED, __HIP_MEMORY_SCOPE_AGENT);
        }
    }
};
struct SkQ {
    bf16_t* qc; const float* ssq; int mt, n0;
    __device__ __forceinline__ void operator()(int row, int cc, f32x4 va, f32x4 vb) const {
        const int grow = MP + 32 * mt + row; const float rs = __builtin_amdgcn_rsqf(ssq[grow] * (1.0f / 1024.0f) + EPS) * 0.08838834764831845f;
        st4bf(qc + (size_t)grow * 512 + n0 + 4 * cc, va * rs); st4bf(qc + (size_t)grow * 512 + n0 + 64 + 4 * cc, vb * rs);
    }
};
struct SkGU {
    bf16_t* h; const float* ssq; const float* wconv; const float* bconv; const float* state; float* out; int mt, ch0;
    __device__ __forceinline__ void operator()(int row, int cc, f32x4 va, f32x4 vb) const {
        const int grow = MP + 32 * mt + row, r2 = grow - MP, bs = r2 >> 2, t = r2 & 3, c = ch0 + 4 * cc;
        const float rs = __builtin_amdgcn_rsqf(ssq[grow] * (1.0f / 1024.0f) + EPS);
        const f32x4 g = va * rs, up = vb * rs;
        f32x4 p1, p2;
#pragma unroll
        for (int j = 0; j < 4; ++j) { p1[j] = __shfl_up(g[j], 16); p2[j] = __shfl_up(g[j], 32); }
        f32x4 s1 = {0.f, 0.f, 0.f, 0.f}, s0 = {0.f, 0.f, 0.f, 0.f};
        if (t < 2) s1 = *(const f32x4*)(state + ((size_t)bs * 2 + 1) * DFF + c);
        if (t == 0) s0 = *(const f32x4*)(state + ((size_t)bs * 2 + 0) * DFF + c);
        const f32x4 g1 = t >= 1 ? p1 : s1, g2 = t >= 2 ? p2 : (t == 1 ? s1 : s0);
        if (t >= 2) *(f32x4*)(out + O_SFC + ((size_t)bs * 2 + (t - 2)) * DFF + c) = g;
        const f32x4 w0 = *(const f32x4*)(wconv + c), w1 = *(const f32x4*)(wconv + DFF + c), w2 = *(const f32x4*)(wconv + 2 * DFF + c), bc = *(const f32x4*)(bconv + c);
        const f32x4 gc = bc + w0 * g2 + w1 * g1 + w2 * g;
        u32x2 wv; wv.x = pkbf(gelu_tanh(gc[0]) * up[0], gelu_tanh(gc[1]) * up[1]); wv.y = pkbf(gelu_tanh(gc[2]) * up[2], gelu_tanh(gc[3]) * up[3]);
        *(u32x2*)(h + (size_t)grow * DFF + c) = wv;
    }
};

__device__ __forceinline__ void ffn_fixup_tile(KA a, int pm, int tid) {
    const float* edge = (const float*)(a->ws + WS_EDGE); bf16_t* hb = (bf16_t*)(a->ws + WS_H);
    const float* wconv = a->in[I_WFC]; const float* bconv = a->in[I_BFC];
#pragma unroll 4
    for (int it = tid; it < 4 * 2 * 768; it += NTHREADS) {
        const int q = it / 1536, rem = it % 1536, rr = rem / 768, c4 = (rem % 768) * 4;
        const int blk = pm * 4 + q; const bool hasprev = (blk & 127) != 0;
        const f32x4 z = {0.f, 0.f, 0.f, 0.f};
        const f32x4 G0 = *(const f32x4*)(edge + ((size_t)blk * 6 + 0) * DFF + c4), G1 = *(const f32x4*)(edge + ((size_t)blk * 6 + 1) * DFF + c4);
        const f32x4 Gm2 = hasprev ? *(const f32x4*)(edge + ((size_t)(blk - 1) * 6 + 2) * DFF + c4) : z, Gm1 = hasprev ? *(const f32x4*)(edge + ((size_t)(blk - 1) * 6 + 3) * DFF + c4) : z;
        const f32x4 U = *(const f32x4*)(edge + ((size_t)blk * 6 + 4 + rr) * DFF + c4);
        const f32x4 w0 = *(const f32x4*)(wconv + c4), w1 = *(const f32x4*)(wconv + DFF + c4), w2 = *(const f32x4*)(wconv + 2 * DFF + c4), bc = *(const f32x4*)(bconv + c4);
        const f32x4 gc = rr == 0 ? (bc + w0 * Gm2 + w1 * Gm1 + w2 * G0) : (bc + w0 * Gm1 + w1 * G0 + w2 * G1);
        u32x2 wv; wv.x = pkbf(gelu_tanh(gc[0]) * U[0], gelu_tanh(gc[1]) * U[1]); wv.y = pkbf(gelu_tanh(gc[2]) * U[2], gelu_tanh(gc[3]) * U[3]);
        *(u32x2*)(hb + ((size_t)blk * 64 + rr) * DFF + c4) = wv;
    }
}

__global__ void __launch_bounds__(NTHREADS, 2) hymba_fwd(Args a_unused) {
    const KA a = (KA)__builtin_amdgcn_kernarg_segment_ptr();
    extern __shared__ __attribute__((aligned(16))) unsigned char smem[];
    const ldsp lds = (ldsp)smem;
    const int tid = threadIdx.x, lane = tid & 63, w = __builtin_amdgcn_readfirstlane(tid >> 6);
    const int G = gridDim.x, bx = blockIdx.x;
    unsigned char* ws = a->ws;
    const int lo = a->ph_lo, hi = a->ph_hi;
#ifndef PHASE_MASK
#define PHASE_MASK 0xfff
#endif
#define IN(k) (((PHASE_MASK >> (k)) & 1) && lo <= (k) && (k) < hi)
#ifndef SREP
#define SREP 0
#endif
#ifndef REP_MASK
#define REP_MASK 0
#endif
#ifndef EXTRA_SYNCS
#define EXTRA_SYNCS 0
#endif
#define REPS(k) (1 + ((REP_MASK >> (k)) & 1))
#ifdef TPROBE
#define TSTAMP(i) do { if (bx == 0 && tid == 0) ((LAS unsigned long long*)(lds + LDS_BYTES - 192))[i] = __builtin_amdgcn_s_memrealtime(); } while (0)
#else
#define TSTAMP(i) do {} while (0)
#endif
#define SEAM(k) do { if (IN(k) && IN((k) + 1)) { XcdBarrier bar_; bar_.bar = (unsigned*)(a->ws + WS_BAR); bar_.x = xb_xcc_id(); bar_.st = (volatile LAS unsigned*)(lds + MISC_OFF); xcd_barrier(bar_); } TSTAMP((k) + 1); } while (0)
    bf16_t* XB = (bf16_t*)(ws + WS_XB);
    if (tid < 16) ((LAS unsigned*)(lds + MISC_OFF))[tid] = 0u;
    __syncthreads();
    (void)xcd_barrier_post((unsigned*)(ws + WS_BAR), (volatile LAS unsigned*)(lds + MISC_OFF));
    if (hi > 1000) cg::this_grid().sync();
    TSTAMP(0);
    if (IN(0)) { for (int rep = 0; rep < REPS(0); ++rep) p0_prologue(a, lds, tid, lane, w); }
    for (int es = 0; es < EXTRA_SYNCS; ++es) { XcdBarrier bar_; bar_.bar = (unsigned*)(a->ws + WS_BAR); bar_.x = xb_xcc_id(); bar_.st = (volatile LAS unsigned*)(lds + MISC_OFF); xcd_barrier(bar_); }
    SEAM(0);
    if (IN(1)) for (int rep = 0; rep < REPS(1); ++rep) {
        { for (int srep = 0; srep < 1 + SREP; ++srep) for (int t = (G == 256) ? ((bx >= 192 && bx < 248) ? bx - 192 : 1 << 30) : G - 1 - bx; t < 16 * 14; t += (G == 256) ? 56 : G) { const int mt = t / 14, nt = t % 14; const bf16_t* Bt = (const bf16_t*)(ws + WS_WIN) + (size_t)(nt * 128) * 1024;
              SkProj P{(bf16_t*)(ws + WS_PROJ), (const float*)(ws + WS_SSQ0), a->out, mt, nt * 128}; sk_tile(lds, XB + (size_t)(MP + 32 * mt) * 1024, 1024, Bt, Bt + 64 * 1024, 1024, P, tid, lane, w); }
          __syncthreads();
          pg8::Gemm g{XB, (const bf16_t*)(ws + WS_WIN), MP, DIN, 1024}; pg8::StaticOrder S; S.init(MP, DIN, G, bx);
          pg8::EpiProj E{(bf16_t*)(ws + WS_PROJ), (const float*)(ws + WS_SSQ0), a->out};
          pg8::gemm_phase<pg8::EpiProj, pg8::StaticOrder, true, true>(lds, g, S, E); }
        { pg8::Gemm g{(const bf16_t*)(ws + WS_MEMA), (const bf16_t*)(ws + WS_WKV), 512, 1024, 1024}; pg8::StaticOrder S; S.init(512, 1024, G, G - 1 - bx);
          pg8::EpiMemKV E{(bf16_t*)(ws + WS_MEMKV), (const float*)(ws + WS_SSQM), a->out};
          pg8::gemm_phase<pg8::EpiMemKV, pg8::StaticOrder, true, true>(lds, g, S, E); }
    }
    SEAM(1);
    if (IN(2)) for (int rep = 0; rep < REPS(2); ++rep) {
        for (int u = bx; u < 416; u += G) {
            if (u < 256) lru_unit<false, 1>(a, lds, u, tid, lane, w);
            else if (u < 288) lru_unit<true, 2>(a, lds, u - 256, tid, lane, w);
            else swa_sample_unit(a, lds, u - 288, tid);
        }
    }
    SEAM(2);
    if (IN(3)) for (int rep = 0; rep < REPS(3); ++rep) {
        for (int u = bx; u < 768; u += G) {
            if (u < 256) lru_unit<false, 2>(a, lds, u, tid, lane, w);
            else swa_prompt_unit(a, lds, u - 256, tid, lane, w);
        }
    }
    SEAM(3);
    if (IN(4)) {
        for (int t = G - 1 - bx; t < 128; t += G) { const int mt = t >> 3, nt = t & 7; const bf16_t* Bt = (const bf16_t*)(ws + WS_WOUT) + (size_t)(nt * 128) * 1024;
            SkRes<0> P{a->in[I_XS] - (size_t)MP * 1024, a->out, XB, (float*)(ws + WS_SSQ1), mt, nt * 128}; sk_tile(lds, (const bf16_t*)(ws + WS_MIX) + (size_t)(MP + 32 * mt) * 1024, 1024, Bt, Bt + 64 * 1024, 1024, P, tid, lane, w); }
        __syncthreads();
        pg8::Gemm g{(const bf16_t*)(ws + WS_MIX), (const bf16_t*)(ws + WS_WOUT), MP, 1024, 1024}; pg8::StaticOrder S; S.init(MP, 1024, G, bx);
        pg8::EpiRes<0> E{a->in[I_XP], a->out, XB, (float*)(ws + WS_SSQ1)};
        pg8::gemm_phase<pg8::EpiRes<0>, pg8::StaticOrder, true, true>(lds, g, S, E);
        if (REPS(4) > 1) { pg8::EpiRes<0, true> E2{a->in[I_XP], a->out, XB, (float*)(ws + WS_SSQ1)}; pg8::gemm_phase<pg8::EpiRes<0, true>, pg8::StaticOrder, true, true>(lds, g, S, E2); }
    }
    SEAM(4);
    if (IN(5)) for (int rep = 0; rep < REPS(5); ++rep) {
        for (int srep = 0; srep < 1 + SREP; ++srep) for (int t = G - 1 - bx; t < 64; t += G) { const int mt = t >> 2, nt = t & 3; const bf16_t* Bt = (const bf16_t*)(ws + WS_WQ) + (size_t)(nt * 128) * 1024;
            SkQ P{(bf16_t*)(ws + WS_QC), (const float*)(ws + WS_SSQ1), mt, nt * 128}; sk_tile(lds, XB + (size_t)(MP + 32 * mt) * 1024, 1024, Bt, Bt + 64 * 1024, 1024, P, tid, lane, w); }
        __syncthreads();
        pg8::Gemm g{XB, (const bf16_t*)(ws + WS_WQ), MP, 512, 1024}; pg8::StaticOrder S; S.init(MP, 512, G, bx);
        pg8::EpiQ E{(bf16_t*)(ws + WS_QC), (const float*)(ws + WS_SSQ1)};
        pg8::gemm_phase<pg8::EpiQ, pg8::StaticOrder, true, true>(lds, g, S, E);
    }
    SEAM(5);
    if (IN(6)) for (int rep = 0; rep < REPS(6); ++rep) {
        for (int u = bx; u < 768; u += G) {
            if (u < 256) xattn_prompt_unit(a, lds, u, tid, lane, w);
            else xattn_sample_unit(a, lds, u - 256, tid, lane, w);
        }
    }
    SEAM(6);
    if (IN(7)) {
        for (int t = G - 1 - bx; t < 128; t += G) { const int mt = t >> 3, nt = t & 7; const bf16_t* Bt = (const bf16_t*)(ws + WS_WMO) + (size_t)(nt * 128) * 512;
            SkRes<1> P{a->out, a->out, XB, (float*)(ws + WS_SSQ2), mt, nt * 128}; sk_tile(lds, (const bf16_t*)(ws + WS_OC) + (size_t)(MP + 32 * mt) * 512, 512, Bt, Bt + 64 * 512, 512, P, tid, lane, w); }
        __syncthreads();
        pg8::Gemm g{(const bf16_t*)(ws + WS_OC), (const bf16_t*)(ws + WS_WMO), MP, 1024, 512}; pg8::StaticOrder S; S.init(MP, 1024, G, bx);
        pg8::EpiRes<1> E{nullptr, a->out, XB, (float*)(ws + WS_SSQ2)};
        pg8::gemm_phase<pg8::EpiRes<1>, pg8::StaticOrder, true, true>(lds, g, S, E);
        if (REPS(7) > 1) { pg8::EpiRes<1, true> E2{nullptr, a->out, XB, (float*)(ws + WS_SSQ2)}; pg8::gemm_phase<pg8::EpiRes<1, true>, pg8::StaticOrder, true, true>(lds, g, S, E2); }
    }
    SEAM(7);
    if (IN(8)) for (int rep = 0; rep < REPS(8); ++rep) {
        for (int srep = 0; srep < 1 + SREP; ++srep) for (int t = G - 1 - bx; t < 16 * 48; t += G) { const int mt = t / 48, cb = t % 48; const bf16_t* Bg = (const bf16_t*)(ws + WS_WGU) + (size_t)((cb >> 1) * 256 + (cb & 1) * 64) * 1024;
            SkGU P{(bf16_t*)(ws + WS_H), (const float*)(ws + WS_SSQ2), a->in[I_WFC], a->in[I_BFC], a->in[I_SFC], a->out, mt, cb * 64}; sk_tile(lds, XB + (size_t)(MP + 32 * mt) * 1024, 1024, Bg, Bg + 128 * 1024, 1024, P, tid, lane, w); }
        __syncthreads();
        pg8::Gemm g{XB, (const bf16_t*)(ws + WS_WGU), MP, 2 * DFF, 1024}; pg8::StaticOrder S; S.init(MP, 2 * DFF, G, bx);
        pg8::EpiGU E{(bf16_t*)(ws + WS_H), (const float*)(ws + WS_SSQ2), (float*)(ws + WS_EDGE), a->in[I_WFC], a->in[I_BFC], a->in[I_SFC], a->out};
        pg8::gemm_phase<pg8::EpiGU, pg8::StaticOrder, true, true>(lds, g, S, E);
    }
    SEAM(8);
    if (IN(9)) {
        for (int t = G - 1 - bx; t < 128; t += G) { const int mt = t >> 3, nt = t & 7; const bf16_t* Bt = (const bf16_t*)(ws + WS_WD) + (size_t)(nt * 128) * DFF;
            SkRes<2> P{a->out, a->out, XB, (float*)(ws + WS_SSQ3), mt, nt * 128}; sk_tile(lds, (const bf16_t*)(ws + WS_H) + (size_t)(MP + 32 * mt) * DFF, DFF, Bt, Bt + 64 * DFF, DFF, P, tid, lane, w); }
        __syncthreads();
        pg8::Gemm g{(const bf16_t*)(ws + WS_H), (const bf16_t*)(ws + WS_WD), MP, 1024, DFF}; pg8::StaticOrder S; S.init(MP, 1024, G, bx);
        pg8::Unit u;
        for (int i = 0; S.next(i, u); ++i) if (u.pm < MP / 256) ffn_fixup_tile(a, u.pm, tid);
        asm volatile("s_waitcnt vmcnt(0)" ::: "memory");
        __syncthreads();
        pg8::EpiRes<2> E{nullptr, a->out, XB, (float*)(ws + WS_SSQ3)};
        pg8::gemm_phase<pg8::EpiRes<2>, pg8::StaticOrder, true, true>(lds, g, S, E);
        if (REPS(9) > 1) { pg8::EpiRes<2, true> E2{nullptr, a->out, XB, (float*)(ws + WS_SSQ3)}; pg8::gemm_phase<pg8::EpiRes<2, true>, pg8::StaticOrder, true, true>(lds, g, S, E2); }
    }
    SEAM(9);
    if (IN(10)) {
        const float* ssq3 = (const float*)(ws + WS_SSQ3); const float* gf = a->in[I_GFIN];
        f32x4 gv[4];
#pragma unroll
        for (int j = 0; j < 4; ++j) gv[j] = *((const f32x4*)gf + lane + 64 * j);
        for (int m0 = bx * NWAVES + w; m0 < MT; m0 += 2 * G * NWAVES) {
            const int m1 = m0 + G * NWAVES; const bool ok1 = m1 < MT;
            f32x4* xr0 = (f32x4*)(a->out + (size_t)m0 * 1024) + lane; f32x4* xr1 = (f32x4*)(a->out + (size_t)(ok1 ? m1 : m0) * 1024) + lane;
            f32x4 v0[4], v1[4]; float s0 = 0.f, s1 = 0.f;
#pragma unroll
            for (int j = 0; j < 4; ++j) { v0[j] = xr0[64 * j]; v1[j] = xr1[64 * j]; }
#pragma unroll
            for (int j = 0; j < 4; ++j) { s0 += (v0[j].x * v0[j].x + v0[j].y * v0[j].y) + (v0[j].z * v0[j].z + v0[j].w * v0[j].w); s1 += (v1[j].x * v1[j].x + v1[j].y * v1[j].y) + (v1[j].z * v1[j].z + v1[j].w * v1[j].w); }
            const float rs0 = __builtin_amdgcn_rsqf(wave_sum(s0) * (1.0f / 1024.0f) + EPS), rs1 = __builtin_amdgcn_rsqf(wave_sum(s1) * (1.0f / 1024.0f) + EPS);
#pragma unroll
            for (int j = 0; j < 4; ++j) xr0[64 * j] = v0[j] * rs0 * gv[j];
            if (ok1) {
#pragma unroll
                for (int j = 0; j < 4; ++j) xr1[64 * j] = v1[j] * rs1 * gv[j];
            }
        }
    }
#ifdef TPROBE
    TSTAMP(11);
    if (bx == 0) {
        __syncthreads();
        const LAS unsigned long long* ts = (const LAS unsigned long long*)(lds + LDS_BYTES - 192);
        const float eps = (float)(ts[TA_HI] - ts[TA_LO]) * 1e-5f, dd = (float)(ts[TB_HI] - ts[TB_LO]) * 1e-4f;
        for (int i = tid; i < 1024; i += NTHREADS) a->out[O_PLH + i] *= (1.0f + eps);
        if (tid == 0) a->out[O_PLC] += dd;
    }
#endif
#undef IN
#undef SEAM
}
constexpr int N_PHASES = 11;

extern "C" void kernel_launch(void* const* d_in, const int* in_sizes, int n_in, void* d_out, int out_size, void* d_ws, size_t ws_size, hipStream_t stream) {
    static int grid = 0;
    if (grid == 0) {
        if (n_in != 34 || ws_size < WS_END) { fprintf(stderr, "kernel_launch: unexpected n_in %d / ws %zu\n", n_in, ws_size); grid = -1; return; }
        int dev = 0, cus = 0, per_cu = 0;
        if (hipGetDevice(&dev) != hipSuccess || hipDeviceGetAttribute(&cus, hipDeviceAttributeMultiprocessorCount, dev) != hipSuccess) { grid = -1; return; }
        if (hipFuncSetAttribute((const void*)hymba_fwd, hipFuncAttributeMaxDynamicSharedMemorySize, LDS_BYTES) != hipSuccess) { fprintf(stderr, "kernel_launch: hipFuncSetAttribute failed\n"); grid = -1; return; }
        if (hipOccupancyMaxActiveBlocksPerMultiprocessor(&per_cu, (const void*)hymba_fwd, NTHREADS, LDS_BYTES) != hipSuccess || per_cu < 1) { fprintf(stderr, "kernel_launch: occupancy query says %d\n", per_cu); per_cu = 1; }
        (void)hipGetLastError();
        grid = cus;
    }
    if (grid < 0) return;
    Args a{};
    for (int i = 0; i < 34; ++i) a.in[i] = (const float*)d_in[i];
    a.out = (float*)d_out; a.ws = (unsigned char*)d_ws;
    if (hipMemsetAsync((char*)d_ws + WS_BAR, 0, BAR_ZERO_BYTES, stream) != hipSuccess) { fprintf(stderr, "kernel_launch: memset failed\n"); return; }
#if MK_N_LAUNCHES == 1
    a.ph_lo = 0; a.ph_hi = N_PHASES;
    void* args[] = {&a};
    hipError_t e = hipLaunchCooperativeKernel((const void*)hymba_fwd, dim3(grid), dim3(NTHREADS), args, LDS_BYTES, stream);
    if (e != hipSuccess) fprintf(stderr, "kernel_launch: cooperative launch failed: %s (grid %d)\n", hipGetErrorString(e), grid);
#else
    for (int p = 0; p < N_PHASES; ++p) { a.ph_lo = p; a.ph_hi = p + 1; hipLaunchKernelGGL(hymba_fwd, dim3(grid), dim3(NTHREADS), LDS_BYTES, stream, a); }
#endif
}
```

```cpp
#include <hip/hip_runtime.h>
#include <hip/hip_cooperative_groups.h>
#include <cstdio>
#include <cstdint>
namespace cg = cooperative_groups;

#ifndef MK_N_LAUNCHES
#define MK_N_LAUNCHES 1
#endif

constexpr int MP = 16384, MS = 512, MT = MP + MS;
constexpr int DM = 1024, SEQ = 8192, DIN = 1792, DFF = 3072, DLRU = 512;
constexpr float EPS = 1e-6f;
constexpr float LOG2E = 1.4426950408889634f;
constexpr size_t O_YP = 0, O_YS = 16777216, O_PSK = 17301504, O_PSV = 17334272, O_PMK = 17367040, O_PMV = 17629184, O_PLC = 17891328,
                 O_PLH = 17894400, O_PFC = 17895424, O_SSK = 17907712, O_SSV = 20004864, O_SLC = 22102016, O_SLH = 22298624, O_SFC = 22364160;
constexpr size_t MiB = 1u << 20;
constexpr size_t WS_SSQ0 = 0, WS_SSQ1 = 128 * 1024, WS_SSQ2 = 256 * 1024, WS_SSQ3 = 384 * 1024, WS_SSQM = 512 * 1024, WS_SUMM = 640 * 1024;
constexpr size_t WS_WIN = 1 * MiB, WS_WOUT = 5 * MiB, WS_WQ = 7 * MiB, WS_WKV = 8 * MiB, WS_WMO = 10 * MiB, WS_WGU = 11 * MiB, WS_WD = 23 * MiB;
constexpr size_t WS_MEMA = 29 * MiB, WS_MEMKV = 30 * MiB, WS_EDGE = 31 * MiB, WS_XB = 50 * MiB, WS_PROJ = 83 * MiB, WS_MIX = 141 * MiB, WS_QC = 174 * MiB, WS_OC = 191 * MiB;
constexpr size_t WS_H = 83 * MiB;
constexpr size_t WS_END = 208 * MiB;
static_assert(WS_EDGE + (size_t)264 * 6 * 3072 * 4 <= WS_XB && WS_XB + (size_t)MT * 1024 * 2 <= WS_PROJ && WS_PROJ + (size_t)MT * DIN * 2 <= WS_MIX &&
              WS_MIX + (size_t)MT * 1024 * 2 <= WS_QC && WS_QC + (size_t)MT * 512 * 2 <= WS_OC && WS_OC + (size_t)MT * 512 * 2 <= WS_END && WS_H + (size_t)MT * DFF * 2 <= WS_OC, "ws map");

__device__ __forceinline__ unsigned pkbf(float lo, float hi) {
    typedef float f2_t __attribute__((ext_vector_type(2))); typedef __bf16 b2_t __attribute__((ext_vector_type(2)));
    f2_t v = {lo, hi}; b2_t b = __builtin_convertvector(v, b2_t); return __builtin_bit_cast(unsigned, b);
}
__device__ __forceinline__ float bf2f(unsigned short x) { return __uint_as_float((unsigned)x << 16); }
__device__ __forceinline__ float bflo(unsigned x) { return __uint_as_float(x << 16); }
__device__ __forceinline__ float bfhi(unsigned x) { return __uint_as_float(x & 0xffff0000u); }
__device__ __forceinline__ float fexp2(float x) { return __builtin_amdgcn_exp2f(x); }
__device__ __forceinline__ float frcp(float x) { return __builtin_amdgcn_rcpf(x); }
__device__ __forceinline__ float sigmoidf_(float x) { return frcp(1.0f + fexp2(-LOG2E * x)); }
__device__ __forceinline__ float gelu_tanh(float x) {
    const float t = x * (1.0f + 0.044715f * x * x);
    return x * frcp(1.0f + fexp2(-2.302208198f * t));
}
namespace pg8 {
#define PG8_LAS __attribute__((address_space(3)))
typedef unsigned short bf16_t;
typedef short bf16x8 __attribute__((ext_vector_type(8)));
typedef float f32x4 __attribute__((ext_vector_type(4)));
typedef unsigned u32x4 __attribute__((ext_vector_type(4)));
constexpr int BM = 256, BK = 64, HALF = 128, HTB = HALF * BK * 2  , STAGE_BYTES = 8 * HTB, NXCD = 8, WGM = 8;

__host__ __device__ __forceinline__ int lds_byte(int r, int c) { const int st = (r >> 4) * 2 + (c >> 5), rr = r & 15, cc = c & 31, ob = rr * 64 + cc * 2; return st * 1024 + (ob ^ (((ob >> 9) & 1) << 5)); }
__host__ __device__ __forceinline__ void stage_rc(int b, int& R, int& C) { const int st = b / 1024, sb = b % 1024, swz = sb ^ (((sb >> 9) & 1) << 5); R = (st >> 1) * 16 + swz / 64; C = (st & 1) * 32 + (swz % 64) / 2; }
__host__ __device__ __forceinline__ int perm32(int rho) { const int n = rho >> 4, i = rho & 15; return 8 * (i >> 2) + 4 * n + (i & 3); }

struct Unit { int pm, pn; };
struct Gemm { const bf16_t* A; const bf16_t* Bt; int M, N, K; };

struct StaticOrder {
    int nM, nN, nwg, G, c;
    __host__ __device__ __forceinline__ void init(int M, int N, int G_, int c_) { nM = M / BM; nN = N / BM; nwg = nM * nN; G = G_; c = c_; }
    __host__ __device__ __forceinline__ bool next(int i, Unit& u) const {
        const long L = (long)i * G + c; if (L >= nwg) return false;
        int wgid = (int)L; { const int q = nwg / NXCD, r = nwg % NXCD, xcd = wgid % NXCD, off = wgid / NXCD; wgid = (xcd < r ? xcd * (q + 1) : r * (q + 1) + (xcd - r) * q) + off; }
        const int nig = WGM * nN, gid = wgid / nig, fm = gid * WGM, gsz = (nM - fm) < WGM ? (nM - fm) : WGM;
        u.pm = fm + ((wgid % nig) % gsz); u.pn = (wgid % nig) / gsz; return true;
    }
    __device__ __forceinline__ void a_ready(const Unit&) const {}
    __device__ __forceinline__ void done(const Unit&) const {}
};

#define EPI_ROW(u, ai, m) ((u).pm * BM + (ai) * HALF + wr * 64 + (m) * 16 + fr)
__device__ __forceinline__ void st_bf16x8(bf16_t* p, f32x4 v0, f32x4 v1) { u32x4 w; w.x = pkbf(v0[0], v0[1]); w.y = pkbf(v0[2], v0[3]); w.z = pkbf(v1[0], v1[1]); w.w = pkbf(v1[2], v1[3]); *(u32x4*)p = w; }

struct EpiProj {
    static constexpr bool PERM = true, AFTER_DRAIN = false;
    bf16_t* proj; const float* ssq; float* out;
    __device__ __forceinline__ void operator()(const f32x4 (&acc)[2][2][4][2], const Unit& u, int wr, int wc, int fr, int fq) const {
        float rsv[2][4];
#pragma unroll
        for (int ai = 0; ai < 2; ++ai)
#pragma unroll
            for (int m = 0; m < 4; ++m) rsv[ai][m] = ssq[EPI_ROW(u, ai, m)];
        const int colb = u.pn * BM + wc * 32 + 8 * fq;
        const float qs = (u.pn == 4 || u.pn == 5) ? 0.125f : 1.0f;
#pragma unroll
        for (int ai = 0; ai < 2; ++ai)
#pragma unroll
            for (int m = 0; m < 4; ++m) {
                const int row = EPI_ROW(u, ai, m);
                const float rs = __builtin_amdgcn_rsqf(rsv[ai][m] * (1.0f / 1024.0f) + EPS) * qs;
#pragma unroll
                for (int bj = 0; bj < 2; ++bj) {
                    const int col = colb + bj * HALF;
                    const f32x4 v0 = acc[ai][bj][m][0] * rs, v1 = acc[ai][bj][m][1] * rs;
                    st_bf16x8(proj + (size_t)row * DIN + col, v0, v1);
                    float* dst = nullptr;
                    if (u.pn == 6) {
                        const int kc = wc * 32 + 8 * fq;
                        if (row < MP) { const int t = row & 8191, b = row >> 13; if (t >= 8064) dst = out + (bj ? O_PSV : O_PSK) + (size_t)(b * 128 + t - 8064) * 128 + kc; }
                        else { const int r2 = row - MP, b = r2 >> 2, t = r2 & 3; dst = out + (bj ? O_SSV : O_SSK) + (size_t)(b * 128 + 124 + t) * 128 + kc; }
                    } else if (u.pn < 2) {
                        if (row < MP) { const int t = row & 8191, b = row >> 13; if (t >= 8189) dst = out + O_PLC + (size_t)(b * 3 + t - 8189) * 512 + col; }
                        else { const int r2 = row - MP, b = r2 >> 2, t = r2 & 3; if (t >= 1) dst = out + O_SLC + (size_t)(b * 3 + t - 1) * 512 + col; }
                    }
                    if (dst) { *(f32x4*)dst = v0; *(f32x4*)(dst + 4) = v1; }
                }
            }
    }
};
struct EpiMemKV {
    static constexpr bool PERM = true, AFTER_DRAIN = false;
    bf16_t* memkv; const float* ssq; float* out;
    __device__ __forceinline__ void operator()(const f32x4 (&acc)[2][2][4][2], const Unit& u, int wr, int wc, int fr, int fq) const {
        float rsv[2][4];
#pragma unroll
        for (int ai = 0; ai < 2; ++ai)
#pragma unroll
            for (int m = 0; m < 4; ++m) rsv[ai][m] = ssq[EPI_ROW(u, ai, m)];
        const int colb = u.pn * BM + wc * 32 + 8 * fq;
#pragma unroll
        for (int ai = 0; ai < 2; ++ai)
#pragma unroll
            for (int m = 0; m < 4; ++m) {
                const int row = EPI_ROW(u, ai, m);
                const float rs = __builtin_amdgcn_rsqf(rsv[ai][m] * (1.0f / 1024.0f) + EPS);
#pragma unroll
                for (int bj = 0; bj < 2; ++bj) {
                    const int col = colb + bj * HALF;
                    const f32x4 v0 = acc[ai][bj][m][0] * rs, v1 = acc[ai][bj][m][1] * rs;
                    st_bf16x8(memkv + (size_t)row * 1024 + col, v0, v1);
                    float* dst = out + (col < 512 ? O_PMK + (size_t)row * 512 + col : O_PMV + (size_t)row * 512 + (col - 512));
                    *(f32x4*)dst = v0; *(f32x4*)(dst + 4) = v1;
                }
            }
    }
};
template <int MODE, bool DRY = false> struct EpiRes {
    static constexpr bool PERM = true, AFTER_DRAIN = false;
    const float* resp; float* xout; bf16_t* xb; float* ssq;
    __device__ __forceinline__ void operator()(const f32x4 (&acc)[2][2][4][2], const Unit& u, int wr, int wc, int fr, int fq) const {
        const int colb = u.pn * BM + wc * 32 + 8 * fq;
#pragma unroll
        for (int ai = 0; ai < 2; ++ai) {
            f32x4 rf[4][2][2]; u32x4 rb[4][2];
#pragma unroll
            for (int m = 0; m < 4; ++m)
#pragma unroll
                for (int bj = 0; bj < 2; ++bj) {
                    const int row = EPI_ROW(u, ai, m), col = colb + bj * HALF;
                    if (MODE == 0) { const float* rp = resp + (size_t)row * 1024 + col; rf[m][bj][0] = *(const f32x4*)rp; rf[m][bj][1] = *(const f32x4*)(rp + 4); }
                    else rb[m][bj] = *(const u32x4*)(xb + (size_t)row * 1024 + col);
                }
#pragma unroll
            for (int m = 0; m < 4; ++m) {
                const int row = EPI_ROW(u, ai, m);
                float sq = 0.f;
#pragma unroll
                for (int bj = 0; bj < 2; ++bj) {
                    const int col = colb + bj * HALF;
                    f32x4 v0, v1;
                    if (MODE == 0) { v0 = acc[ai][bj][m][0] + rf[m][bj][0]; v1 = acc[ai][bj][m][1] + rf[m][bj][1]; }
                    else { const u32x4 r = rb[m][bj];
                        v0 = acc[ai][bj][m][0] + (f32x4){bflo(r.x), bfhi(r.x), bflo(r.y), bfhi(r.y)}; v1 = acc[ai][bj][m][1] + (f32x4){bflo(r.z), bfhi(r.z), bflo(r.w), bfhi(r.w)}; }
                    if (!DRY) {
                        if (MODE == 2) { float* op = xout + (size_t)row * 1024 + col; *(f32x4*)op = v0; *(f32x4*)(op + 4) = v1; }
                        else st_bf16x8(xb + (size_t)row * 1024 + col, v0, v1);
                    }
                    sq += (v0[0] * v0[0] + v0[1] * v0[1]) + (v0[2] * v0[2] + v0[3] * v0[3]) + (v1[0] * v1[0] + v1[1] * v1[1]) + (v1[2] * v1[2] + v1[3] * v1[3]);
                }
                if (MODE != 2 || DRY) {
                    sq += __shfl_xor(sq, 16); sq += __shfl_xor(sq, 32);
                    if (!DRY) { if (fq == 0) __hip_atomic_fetch_add(ssq + row, sq, __ATOMIC_RELAXED, __HIP_MEMORY_SCOPE_AGENT); }
                    else if (sq == 12345.678f) ssq[row] = sq;
                }
            }
        }
    }
};
struct EpiQ {
    static constexpr bool PERM = true, AFTER_DRAIN = false;
    bf16_t* qc; const float* ssq;
    __device__ __forceinline__ void operator()(const f32x4 (&acc)[2][2][4][2], const Unit& u, int wr, int wc, int fr, int fq) const {
        float rsv[2][4];
#pragma unroll
        for (int ai = 0; ai < 2; ++ai)
#pragma unroll
            for (int m = 0; m < 4; ++m) rsv[ai][m] = ssq[EPI_ROW(u, ai, m)];
        const int colb = u.pn * BM + wc * 32 + 8 * fq;
#pragma unroll
        for (int ai = 0; ai < 2; ++ai)
#pragma unroll
            for (int m = 0; m < 4; ++m) {
                const int row = EPI_ROW(u, ai, m);
                const float rs = __builtin_amdgcn_rsqf(rsv[ai][m] * (1.0f / 1024.0f) + EPS) * 0.08838834764831845f;
#pragma unroll
                for (int bj = 0; bj < 2; ++bj) st_bf16x8(qc + (size_t)row * 512 + colb + bj * HALF, acc[ai][bj][m][0] * rs, acc[ai][bj][m][1] * rs);
            }
    }
};
__device__ __forceinline__ float dpp_ror1(float v) { return __builtin_bit_cast(float, __builtin_amdgcn_update_dpp(0, __builtin_bit_cast(int, v), 0x121, 0xf, 0xf, false)); }
__device__ __forceinline__ float dpp_ror2(float v) { return __builtin_bit_cast(float, __builtin_amdgcn_update_dpp(0, __builtin_bit_cast(int, v), 0x122, 0xf, 0xf, false)); }
struct EpiGU {
    static constexpr bool PERM = true, AFTER_DRAIN = false;
    bf16_t* h; const float* ssq; float* edge; const float* wconv; const float* bconv; const float* state; float* out;
    __device__ __forceinline__ void operator()(const f32x4 (&acc)[2][2][4][2], const Unit& u, int wr, int wc, int fr, int fq) const {
        float rsv[2][4];
#pragma unroll
        for (int ai = 0; ai < 2; ++ai)
#pragma unroll
            for (int m = 0; m < 4; ++m) rsv[ai][m] = ssq[EPI_ROW(u, ai, m)];
        const int chb = u.pn * HALF + wc * 32 + 8 * fq;
        const bool sample = u.pm >= MP / BM;
#pragma unroll
        for (int n = 0; n < 2; ++n) {
            const int ch = chb + 4 * n;
            const f32x4 w0 = *(const f32x4*)(wconv + ch), w1 = *(const f32x4*)(wconv + DFF + ch), w2 = *(const f32x4*)(wconv + 2 * DFF + ch), bc = *(const f32x4*)(bconv + ch);
#pragma unroll
            for (int ai = 0; ai < 2; ++ai) {
                f32x4 p1p = {0.f, 0.f, 0.f, 0.f}, p2p = {0.f, 0.f, 0.f, 0.f};
#pragma unroll
                for (int m = 0; m < 4; ++m) {
                    const int row = EPI_ROW(u, ai, m);
                    const float rs = __builtin_amdgcn_rsqf(ssq[row] * (1.0f / 1024.0f) + EPS);
                    const f32x4 g = acc[ai][0][m][n] * rs, up = acc[ai][1][m][n] * rs;
                    f32x4 p1, p2, g1, g2;
#pragma unroll
                    for (int j = 0; j < 4; ++j) { p1[j] = dpp_ror1(g[j]); p2[j] = dpp_ror2(g[j]); }
                    if (!sample) {
                        g1 = fr >= 1 ? p1 : p1p; g2 = fr >= 2 ? p2 : p2p; p1p = p1; p2p = p2;
                        const int blk = row >> 6;
                        if (m == 0 && fr < 2) { *(f32x4*)(edge + ((size_t)blk * 6 + fr) * DFF + ch) = g; *(f32x4*)(edge + ((size_t)blk * 6 + 4 + fr) * DFF + ch) = up; }
                        if (m == 3 && fr >= 14) {
                            *(f32x4*)(edge + ((size_t)blk * 6 + 2 + (fr - 14)) * DFF + ch) = g;
                            if ((blk & 127) == 127) *(f32x4*)(out + O_PFC + (size_t)((blk >> 7) * 2 + (fr - 14)) * DFF + ch) = g;
                        }
                    } else {
                        const int r2 = row - MP, bs = r2 >> 2, t = r2 & 3;
                        f32x4 s1 = {0.f, 0.f, 0.f, 0.f}, s0 = {0.f, 0.f, 0.f, 0.f};
                        if (t < 2) s1 = *(const f32x4*)(state + ((size_t)bs * 2 + 1) * DFF + ch);
                        if (t == 0) s0 = *(const f32x4*)(state + ((size_t)bs * 2 + 0) * DFF + ch);
                        g1 = t >= 1 ? p1 : s1; g2 = t >= 2 ? p2 : (t == 1 ? s1 : s0);
                        if (t >= 2) *(f32x4*)(out + O_SFC + ((size_t)bs * 2 + (t - 2)) * DFF + ch) = g;
                    }
                    const f32x4 gc = bc + w0 * g2 + w1 * g1 + w2 * g;
                    f32x4 hv;
#pragma unroll
                    for (int j = 0; j < 4; ++j) hv[j] = gelu_tanh(gc[j]) * up[j];
                    typedef unsigned u32x2_t __attribute__((ext_vector_type(2)));
                    u32x2_t w; w.x = pkbf(hv[0], hv[1]); w.y = pkbf(hv[2], hv[3]);
                    *(u32x2_t*)(h + (size_t)row * DFF + ch) = w;
                }
            }
        }
    }
};
template <class Epi, class Sched, bool ALIGN_EPI = false, bool SP2 = false>
__device__ __forceinline__ void gemm_phase(PG8_LAS unsigned char* lds, const Gemm g, const Sched& S, const Epi& E) {
    const int tid = threadIdx.x, wid = __builtin_amdgcn_readfirstlane(tid >> 6), lane = tid & 63, wr = wid >> 2, wc = wid & 3, fr = lane & 15, fq = lane >> 4;
    const int K = g.K, nt = K / BK;
    unsigned voffA[2], voffB[2];
#pragma unroll
    for (int i = 0; i < 2; ++i) { int R, C; stage_rc(tid * 16 + i * 8192, R, C); const int Rb = Epi::PERM ? ((R & ~31) + perm32(R & 31)) : R;
        voffA[i] = (unsigned)(R * K + C) * 2u; voffB[i] = (unsigned)(Rb * K + C) * 2u; }
    const size_t kstep = (size_t)(BK * 2);
    const size_t hstep = (size_t)HALF * K * 2;
    const size_t tstep = 2 * hstep;
    const unsigned ldsw = (unsigned)wid * 1024u;
    const int aoff = lds_byte(wr * 64 + fr, fq * 8), boff = lds_byte(wc * 32 + fr, fq * 8);
#define PG8_SA(b, h) (((b) * 2 + (h)) * HTB)
#define PG8_SB(b, h) ((4 + (b) * 2 + (h)) * HTB)
#define PG8_STAGE(bufoff, gbase, voff) do { _Pragma("unroll") for (int _i = 0; _i < 2; ++_i) \
        __builtin_amdgcn_global_load_lds((const unsigned*)((const char*)(gbase) + (voff)[_i]), (PG8_LAS unsigned*)(lds + (bufoff) + ldsw + _i * 8192), 16, 0, 0); } while (0)
#define PG8_LDA(dst, b, h) do { _Pragma("unroll") for (int m = 0; m < 4; ++m) _Pragma("unroll") for (int k = 0; k < 2; ++k) dst[m][k] = *(const PG8_LAS bf16x8*)(lds + PG8_SA(b, h) + aoff + m * 2048 + k * 1024); } while (0)
#define PG8_LDB(dst, b, h) do { _Pragma("unroll") for (int n = 0; n < 2; ++n) _Pragma("unroll") for (int k = 0; k < 2; ++k) dst[n][k] = *(const PG8_LAS bf16x8*)(lds + PG8_SB(b, h) + boff + n * 2048 + k * 1024); } while (0)
#define PG8_MMA(ai, bj, At, Bt) do { __builtin_amdgcn_s_setprio(1); _Pragma("unroll") for (int m = 0; m < 4; ++m) _Pragma("unroll") for (int n = 0; n < 2; ++n) _Pragma("unroll") for (int k = 0; k < 2; ++k) \
        acc[ai][bj][m][n] = __builtin_amdgcn_mfma_f32_16x16x32_bf16(Bt[n][k], At[m][k], acc[ai][bj][m][n], 0, 0, 0); __builtin_amdgcn_s_setprio(0); } while (0)
#define PG8_WAIT_V(n) asm volatile("s_waitcnt vmcnt(" #n ")" ::: "memory")
#define PG8_WAIT_L(n) asm volatile("s_waitcnt lgkmcnt(" #n ")" ::: "memory")
#define PG8_BAR __builtin_amdgcn_s_barrier()
#define PG8_SCHED __builtin_amdgcn_sched_barrier(0)
    Unit cur, nxt; int ui = 0;
    if (!S.next(0, cur)) return;
    f32x4 acc[2][2][4][2];
#pragma unroll
    for (int a = 0; a < 2; ++a)
#pragma unroll
        for (int b = 0; b < 2; ++b)
#pragma unroll
            for (int m = 0; m < 4; ++m)
#pragma unroll
                for (int n = 0; n < 2; ++n) acc[a][b][m][n] = (f32x4){0.f, 0.f, 0.f, 0.f};
    bf16x8 At[4][2], B0[2][2], B1[2][2];
    const char* cA = (const char*)g.A + (size_t)cur.pm * tstep; const char* cB = (const char*)g.Bt + (size_t)cur.pn * tstep;
    S.a_ready(cur);
    if constexpr (SP2) {
        PG8_STAGE(PG8_SB(0, 0), cB, voffB); PG8_STAGE(PG8_SB(0, 1), cB + hstep, voffB); PG8_STAGE(PG8_SA(0, 0), cA, voffA); PG8_STAGE(PG8_SA(0, 1), cA + hstep, voffA);
        if (wr == 1) PG8_BAR;
        PG8_WAIT_V(2); PG8_BAR;
        PG8_STAGE(PG8_SB(1, 0), cB + kstep, voffB); PG8_STAGE(PG8_SA(1, 0), cA + kstep, voffA); PG8_STAGE(PG8_SB(1, 1), cB + hstep + kstep, voffB);
        PG8_WAIT_V(6); PG8_BAR;
    } else {
        PG8_STAGE(PG8_SB(0, 0), cB, voffB); PG8_STAGE(PG8_SA(0, 0), cA, voffA); PG8_STAGE(PG8_SB(0, 1), cB + hstep, voffB); PG8_STAGE(PG8_SA(0, 1), cA + hstep, voffA);
        if (wr == 1) PG8_BAR;
        PG8_WAIT_V(4); PG8_BAR;
        PG8_STAGE(PG8_SB(1, 0), cB + kstep, voffB); PG8_STAGE(PG8_SA(1, 0), cA + kstep, voffA); PG8_STAGE(PG8_SB(1, 1), cB + hstep + kstep, voffB);
        PG8_WAIT_V(6); PG8_BAR;
    }
    for (;;) {
        const bool has_next = S.next(ui + 1, nxt);
        const char* nA = has_next ? (const char*)g.A + (size_t)nxt.pm * tstep : cA; const char* nB = has_next ? (const char*)g.Bt + (size_t)nxt.pn * tstep : cB;
        for (int t = 0; t < nt; t += 2) {
            const bool last = (t == nt - 2);
            const char* a1 = cA + (size_t)(t + 1) * kstep;
            const char* a2 = last ? nA : cA + (size_t)(t + 2) * kstep; const char* b2 = last ? nB : cB + (size_t)(t + 2) * kstep;
            const char* a3 = a2 + kstep; const char* b3 = b2 + kstep;
            if (last && has_next) S.a_ready(nxt);
            if constexpr (SP2) {
            PG8_LDB(B0, 0, 0); PG8_LDB(B1, 0, 1); PG8_SCHED; PG8_LDA(At, 0, 0); PG8_STAGE(PG8_SA(1, 1), a1 + hstep, voffA);
            PG8_WAIT_V(8); PG8_WAIT_L(0); PG8_BAR; PG8_MMA(0, 0, At, B0); PG8_MMA(0, 1, At, B1); PG8_BAR; PG8_SCHED;
            PG8_LDA(At, 0, 1); PG8_STAGE(PG8_SB(0, 0), b2, voffB); PG8_STAGE(PG8_SB(0, 1), b2 + hstep, voffB); PG8_STAGE(PG8_SA(0, 0), a2, voffA);
            PG8_WAIT_V(8); PG8_WAIT_L(0); PG8_BAR; PG8_MMA(1, 0, At, B0); PG8_MMA(1, 1, At, B1); PG8_BAR; PG8_SCHED;
            PG8_LDB(B0, 1, 0); PG8_LDB(B1, 1, 1); PG8_SCHED; PG8_LDA(At, 1, 0); PG8_STAGE(PG8_SA(0, 1), a2 + hstep, voffA);
            PG8_WAIT_V(8); PG8_WAIT_L(0); PG8_BAR; PG8_MMA(0, 0, At, B0); PG8_MMA(0, 1, At, B1); PG8_BAR; PG8_SCHED;
            PG8_LDA(At, 1, 1); PG8_STAGE(PG8_SB(1, 0), b3, voffB); PG8_STAGE(PG8_SB(1, 1), b3 + hstep, voffB); PG8_STAGE(PG8_SA(1, 0), a3, voffA);
            PG8_WAIT_V(8); PG8_WAIT_L(0); PG8_BAR; PG8_MMA(1, 0, At, B0); PG8_MMA(1, 1, At, B1); PG8_BAR; PG8_SCHED;
            } else {
            PG8_LDB(B0, 0, 0); PG8_SCHED; PG8_LDA(At, 0, 0); PG8_STAGE(PG8_SA(1, 1), a1 + hstep, voffA);
            PG8_WAIT_L(8); PG8_BAR; PG8_WAIT_L(0); PG8_MMA(0, 0, At, B0); PG8_BAR; PG8_SCHED;
            PG8_LDB(B1, 0, 1); PG8_STAGE(PG8_SB(0, 0), b2, voffB);
            PG8_BAR; PG8_WAIT_L(0); PG8_MMA(0, 1, At, B1); PG8_BAR;
            PG8_LDA(At, 0, 1); PG8_STAGE(PG8_SA(0, 0), a2, voffA);
            PG8_BAR; PG8_WAIT_L(0); PG8_MMA(1, 0, At, B0); PG8_BAR; PG8_SCHED;
            PG8_STAGE(PG8_SB(0, 1), b2 + hstep, voffB);
            PG8_WAIT_V(6); PG8_BAR; PG8_MMA(1, 1, At, B1); PG8_BAR;
            PG8_LDB(B0, 1, 0); PG8_SCHED; PG8_LDA(At, 1, 0); PG8_STAGE(PG8_SA(0, 1), a2 + hstep, voffA);
            PG8_WAIT_L(8); PG8_BAR; PG8_WAIT_L(0); PG8_MMA(0, 0, At, B0); PG8_BAR; PG8_SCHED;
            PG8_LDB(B1, 1, 1); PG8_STAGE(PG8_SB(1, 0), b3, voffB);
            PG8_BAR; PG8_WAIT_L(0); PG8_MMA(0, 1, At, B1); PG8_BAR;
            PG8_LDA(At, 1, 1); PG8_STAGE(PG8_SA(1, 0), a3, voffA);
            PG8_BAR; PG8_WAIT_L(0); PG8_MMA(1, 0, At, B0); PG8_BAR; PG8_SCHED;
            PG8_STAGE(PG8_SB(1, 1), b3 + hstep, voffB);
            PG8_WAIT_V(6); PG8_BAR; PG8_MMA(1, 1, At, B1); PG8_BAR;
            }
        }
        if constexpr (ALIGN_EPI) { if (wr == 0) PG8_BAR; }
        if constexpr (!Epi::AFTER_DRAIN) { E(acc, cur, wr, wc, fr, fq); S.done(cur); }
        if (!has_next) break;
#pragma unroll
        for (int a = 0; a < 2; ++a)
#pragma unroll
            for (int b = 0; b < 2; ++b)
#pragma unroll
                for (int m = 0; m < 4; ++m)
#pragma unroll
                    for (int n = 0; n < 2; ++n) acc[a][b][m][n] = (f32x4){0.f, 0.f, 0.f, 0.f};
        cur = nxt; cA = nA; cB = nB; ++ui;
        if constexpr (ALIGN_EPI) { if (wr == 1) PG8_BAR; }
    }
    PG8_WAIT_V(0);
    if constexpr (!ALIGN_EPI) { if (wr == 0) PG8_BAR; }
    PG8_BAR;
    if constexpr (Epi::AFTER_DRAIN) { E.fused(acc, cur, wr, wc, fr, fq, lds, wid, lane); S.done(cur); }
#undef PG8_SA
#undef PG8_SB
#undef PG8_STAGE
#undef PG8_LDA
#undef PG8_LDB
#undef PG8_MMA
#undef PG8_WAIT_V
#undef PG8_WAIT_L
#undef PG8_BAR
#undef PG8_SCHED
}
}

#define LAS __attribute__((address_space(3)))
typedef unsigned short bf16_t;
typedef short bf16x8 __attribute__((ext_vector_type(8)));
typedef short s16x4 __attribute__((ext_vector_type(4)));
typedef float f32x4 __attribute__((ext_vector_type(4)));
typedef float f32x16 __attribute__((ext_vector_type(16)));
typedef unsigned u32x4 __attribute__((ext_vector_type(4)));
typedef unsigned u32x2 __attribute__((ext_vector_type(2)));
typedef LAS unsigned char* ldsp;
constexpr int NWAVES = 8, NTHREADS = 512, LDS_BYTES = 147456;
#define MFMA32(a, b, c) __builtin_amdgcn_mfma_f32_32x32x16_bf16((a), (b), (c), 0, 0, 0)
#define MFMA16(a, b, c) __builtin_amdgcn_mfma_f32_16x16x32_bf16((a), (b), (c), 0, 0, 0)
__device__ __forceinline__ int crow(int r, int hi) { return (r & 3) + 8 * (r >> 2) + 4 * hi; }
__device__ __forceinline__ unsigned f2bf(float f) { return pkbf(f, 0.f) & 0xffffu; }
__device__ __forceinline__ float wave_sum(float v) {
#pragma unroll
    for (int o = 1; o < 64; o <<= 1) v += __shfl_xor(v, o);
    return v;
}
__device__ __forceinline__ bf16x8 pack8(const f32x16& x, int s) {
    u32x4 p; p.x = pkbf(x[8 * s], x[8 * s + 1]); p.y = pkbf(x[8 * s + 2], x[8 * s + 3]); p.z = pkbf(x[8 * s + 4], x[8 * s + 5]); p.w = pkbf(x[8 * s + 6], x[8 * s + 7]);
    return __builtin_bit_cast(bf16x8, p);
}

struct Args {
    const float* in[34]; float* out; unsigned char* ws; int ph_lo, ph_hi;
};
typedef const __attribute__((address_space(4))) Args* KA;
enum { I_XP = 0, I_XS, I_CSK, I_CSV, I_CMK, I_CMV, I_SLC, I_SLH, I_SFC, I_MEMP, I_GMIX, I_WIN, I_WLC, I_BLC, I_WLA, I_BLA, I_WLX, I_BLX, I_LAM, I_SINK, I_WOUT, I_GCROSS, I_GMEM,
       I_WMQ, I_WMK, I_WMV, I_WMO, I_GFFN, I_WFG, I_WFU, I_WFC, I_BFC, I_WFD, I_GFIN };

#define RLX_AGENT __ATOMIC_RELAXED, __HIP_MEMORY_SCOPE_AGENT
constexpr size_t WS_BAR = 896 * 1024, BAR_ZERO_BYTES = 16384;
constexpr int MISC_OFF = LDS_BYTES - 64;
#define XB_TMO      128
#define XB_XCNT(j)  (256  + 64 * (j))
#define XB_XSUB(j)  (1280 + 64 * (j))
#define XB_XGEN(j)  (2304 + 64 * (j))
#define XB_TOP      3328
#define XB_TOPGEN   3392
#define XCD_BAR_WORDS 3456
#define XB_SPIN_CAP (1u << 18)

__device__ __forceinline__ unsigned xb_ld(unsigned* p)              { return __hip_atomic_load(p, __ATOMIC_RELAXED, __HIP_MEMORY_SCOPE_AGENT); }
__device__ __forceinline__ unsigned xb_add(unsigned* p, unsigned v) { return __hip_atomic_fetch_add(p, v, __ATOMIC_RELAXED, __HIP_MEMORY_SCOPE_AGENT); }
__device__ __forceinline__ unsigned xb_xcc_id() { return (unsigned)__builtin_amdgcn_s_getreg((3 << 11) | 20) & 0xFu; }
#define XB_SPIN(cond, bar) do { unsigned _sp = 0; while (cond) { __builtin_amdgcn_s_sleep(1); \
    if ((++_sp & 255u) == 0u) { if (xb_ld(&(bar)[XB_TMO])) break; if (_sp > XB_SPIN_CAP) { atomicAdd(&(bar)[XB_TMO], 1u); break; } } } } while (0)

struct XcdBarrier {
    unsigned* bar; unsigned x;
    volatile LAS unsigned* st;
};

__device__ __forceinline__ XcdBarrier xcd_barrier_post(unsigned* bar, volatile LAS unsigned* st) {
    XcdBarrier b; b.bar = bar; b.x = xb_xcc_id(); b.st = st;
    if (threadIdx.x == 0) (void)xb_add(&bar[XB_XCNT(b.x)], 1u);
    return b;
}
__device__ __forceinline__ void xcd_barrier_complete(unsigned* bar, unsigned x, unsigned& nloc, unsigned& nx) {
    const unsigned G = gridDim.x * gridDim.y * gridDim.z;
    unsigned sum, cnt, mine, sp = 0u;
    for (;;) {
        sum = 0u; cnt = 0u; mine = 0u;
#pragma unroll
        for (unsigned j = 0; j < 16; ++j) { const unsigned c = xb_ld(&bar[XB_XCNT(j)]); sum += c; cnt += (c > 0u) ? 1u : 0u; mine = (j == x) ? c : mine; }
        if (sum == G) break;
        __builtin_amdgcn_s_sleep(1);
        if ((++sp & 255u) == 0u) { if (xb_ld(&bar[XB_TMO])) break; if (sp > XB_SPIN_CAP) { atomicAdd(&bar[XB_TMO], 1u); break; } }
    }
    nloc = mine > 0u ? mine : 1u; nx = cnt > 0u ? cnt : 1u;
}

__device__ __forceinline__ void xcd_barrier(const XcdBarrier& b) {
    asm volatile("s_waitcnt vmcnt(0)" ::: "memory");
    __syncthreads();
    if (threadIdx.x == 0) {
        unsigned* bar = b.bar;
        __builtin_amdgcn_s_waitcnt(0);
        unsigned nloc = b.st[0], nx = b.st[1];
        if (nloc == 0u) { xcd_barrier_complete(bar, b.x, nloc, nx); b.st[0] = nloc; b.st[1] = nx; }
        const unsigned old = xb_add(&bar[XB_XSUB(b.x)], 1u);
        const unsigned gen = old / nloc;
        if (old + 1u == (gen + 1u) * nloc) {
            __builtin_amdgcn_fence(__ATOMIC_RELEASE, "agent");
            asm volatile("s_waitcnt vmcnt(0)" ::: "memory");
            const unsigned og = xb_add(&bar[XB_TOP], 1u);
            const unsigned tg = og / nx;
            if (og + 1u == (tg + 1u) * nx) xb_add(&bar[XB_TOPGEN], 1u);
            else XB_SPIN(xb_ld(&bar[XB_TOPGEN]) == tg, bar);
            __builtin_amdgcn_fence(__ATOMIC_ACQUIRE, "agent");
            xb_add(&bar[XB_XGEN(b.x)], 1u);
            asm volatile("s_waitcnt vmcnt(0)" ::: "memory");
        } else {
            XB_SPIN(xb_ld(&bar[XB_XGEN(b.x)]) == gen, bar);
            __builtin_amdgcn_fence(__ATOMIC_ACQUIRE, "agent");
            asm volatile("s_waitcnt vmcnt(0)" ::: "memory");
        }
    }
    __syncthreads();
}

__device__ __forceinline__ void p0_transpose_item(const float* W, const float* g, int K, int N, bf16_t* WT, int row_off, int ilv, LAS float* scr, int item, int lane) {
    const int nblk = N / 32, kb = item / nblk, nb = item % nblk, k0 = 64 * kb, n0 = 32 * nb;
#pragma unroll
    for (int i = 0; i < 32; ++i) { const int kk = 2 * i + (lane >> 5); const float s = g ? g[k0 + kk] : 1.0f; scr[kk * 33 + (lane & 31)] = W[(size_t)(k0 + kk) * N + n0 + (lane & 31)] * s; }
    asm volatile("s_waitcnt lgkmcnt(0)" ::: "memory");
    const int c = lane & 7;
    const int rbase = ilv ? (((n0 >> 7) << 8) + (n0 & 127) + (ilv == 2 ? 128 : 0)) : (row_off + n0);
#pragma unroll
    for (int j = 0; j < 4; ++j) { const int n = (lane >> 3) + 8 * j; const LAS float* s = scr + (8 * c) * 33 + n;
        u32x4 o; o.x = pkbf(s[0 * 33], s[1 * 33]); o.y = pkbf(s[2 * 33], s[3 * 33]); o.z = pkbf(s[4 * 33], s[5 * 33]); o.w = pkbf(s[6 * 33], s[7 * 33]);
        *(u32x4*)(WT + (size_t)(rbase + n) * K + k0 + 8 * c) = o; }
    asm volatile("s_waitcnt lgkmcnt(0)" ::: "memory");
}
__device__ __forceinline__ void row_to_bf16(const float* xrow, bf16_t* orow, float* ssq, int lane) {
    const f32x4* xr = (const f32x4*)xrow + lane;
    f32x4 v[4]; float s = 0.f;
#pragma unroll
    for (int j = 0; j < 4; ++j) { v[j] = xr[64 * j]; s += (v[j].x * v[j].x + v[j].y * v[j].y) + (v[j].z * v[j].z + v[j].w * v[j].w); }
    s = wave_sum(s);
    u32x2* o8 = (u32x2*)orow + lane;
#pragma unroll
    for (int j = 0; j < 4; ++j) { u32x2 w; w.x = pkbf(v[j].x, v[j].y); w.y = pkbf(v[j].z, v[j].w); o8[64 * j] = w; }
    if (lane == 0) *ssq = s;
}
__device__ __forceinline__ void p0_prologue(KA a, ldsp lds, int tid, int lane, int wave) {
    unsigned char* ws = a->ws;
    LAS float* scr = (LAS float*)(lds + wave * 16384);
    const int gw = blockIdx.x * NWAVES + wave, NGW = gridDim.x * NWAVES;
    constexpr int I_IN = 16 * 56, I_OUT = 16 * 32, I_Q = 16 * 16, I_MO = 8 * 32, I_G = 16 * 96, I_D = 48 * 32;
    constexpr int NITEMS = I_IN + I_OUT + 3 * I_Q + I_MO + 2 * I_G + I_D;
#ifndef P0REP
#define P0REP 0
#endif
    for (int prep = 0; prep < ((P0REP & 1) ? 2 : 1); ++prep)
    for (int it = gw; it < NITEMS; it += NGW) {
        int r = it;
        if (r < I_IN) { p0_transpose_item(a->in[I_WIN], a->in[I_GMIX], 1024, DIN, (bf16_t*)(ws + WS_WIN), 0, 0, scr, r, lane); continue; } r -= I_IN;
        if (r < I_OUT) { p0_transpose_item(a->in[I_WOUT], nullptr, 1024, 1024, (bf16_t*)(ws + WS_WOUT), 0, 0, scr, r, lane); continue; } r -= I_OUT;
        if (r < I_Q) { p0_transpose_item(a->in[I_WMQ], a->in[I_GCROSS], 1024, 512, (bf16_t*)(ws + WS_WQ), 0, 0, scr, r, lane); continue; } r -= I_Q;
        if (r < I_Q) { p0_transpose_item(a->in[I_WMK], a->in[I_GMEM], 1024, 512, (bf16_t*)(ws + WS_WKV), 0, 0, scr, r, lane); continue; } r -= I_Q;
        if (r < I_Q) { p0_transpose_item(a->in[I_WMV], a->in[I_GMEM], 1024, 512, (bf16_t*)(ws + WS_WKV), 512, 0, scr, r, lane); continue; } r -= I_Q;
        if (r < I_MO) { p0_transpose_item(a->in[I_WMO], nullptr, 512, 1024, (bf16_t*)(ws + WS_WMO), 0, 0, scr, r, lane); continue; } r -= I_MO;
        if (r < I_G) { p0_transpose_item(a->in[I_WFG], a->in[I_GFFN], 1024, DFF, (bf16_t*)(ws + WS_WGU), 0, 1, scr, r, lane); continue; } r -= I_G;
        if (r < I_G) { p0_transpose_item(a->in[I_WFU], a->in[I_GFFN], 1024, DFF, (bf16_t*)(ws + WS_WGU), 0, 2, scr, r, lane); continue; } r -= I_G;
        p0_transpose_item(a->in[I_WFD], nullptr, DFF, 1024, (bf16_t*)(ws + WS_WD), 0, 0, scr, r, lane);
    }
    bf16_t* xb = (bf16_t*)(ws + WS_XB); float* ssq0 = (float*)(ws + WS_SSQ0);
    for (int prep2 = 0; prep2 < ((P0REP & 2) ? 2 : 1); ++prep2)
    for (int m0 = gw; m0 < MT + 512; m0 += 2 * NGW) {
        const float* src[2]; bf16_t* dst[2]; float* sq[2]; bool ok[2];
#pragma unroll
        for (int q = 0; q < 2; ++q) { const int m = m0 + q * NGW; ok[q] = m < MT + 512;
            if (m < MP) { src[q] = a->in[I_XP] + (size_t)m * 1024; dst[q] = xb + (size_t)m * 1024; sq[q] = ssq0 + m; }
            else if (m < MT) { src[q] = a->in[I_XS] + (size_t)(m - MP) * 1024; dst[q] = xb + (size_t)m * 1024; sq[q] = ssq0 + m; }
            else { const int rr = ok[q] ? m - MT : 0; src[q] = a->in[I_MEMP] + (size_t)rr * 1024; dst[q] = (bf16_t*)(ws + WS_MEMA) + (size_t)rr * 1024; sq[q] = (float*)(ws + WS_SSQM) + rr; } }
        f32x4 v[2][4]; float s[2] = {0.f, 0.f};
#pragma unroll
        for (int q = 0; q < 2; ++q)
#pragma unroll
            for (int j = 0; j < 4; ++j) v[q][j] = ((const f32x4*)src[q] + lane)[64 * j];
#pragma unroll
        for (int q = 0; q < 2; ++q) {
#pragma unroll
            for (int j = 0; j < 4; ++j) s[q] += (v[q][j].x * v[q][j].x + v[q][j].y * v[q][j].y) + (v[q][j].z * v[q][j].z + v[q][j].w * v[q][j].w);
            s[q] = wave_sum(s[q]);
            if (ok[q]) {
#pragma unroll
                for (int j = 0; j < 4; ++j) { u32x2 wv; wv.x = pkbf(v[q][j].x, v[q][j].y); wv.y = pkbf(v[q][j].z, v[q][j].w); ((u32x2*)dst[q] + lane)[64 * j] = wv; }
                if (lane == 0) *sq[q] = s[q];
            }
        }
    }
    for (int i = blockIdx.x * NTHREADS + tid; i < MT; i += gridDim.x * NTHREADS) { ((float*)(ws + WS_SSQ1))[i] = 0.f; ((float*)(ws + WS_SSQ2))[i] = 0.f; ((float*)(ws + WS_SSQ3))[i] = 0.f; }
}

template <bool SAMPLE, int PASS>
__device__ __forceinline__ void lru_unit(KA a, ldsp lds, int unit, int tid, int lane, int w) {
    constexpr int NTOK = SAMPLE ? 64 : 256, NROW = SAMPLE ? (NTOK / 4) * 7 : NTOK + 3, RS = 272;
    const ldsp XR = lds, XC = lds + 259 * RS;
    unsigned char* ws = a->ws;
    const bf16_t* proj = (const bf16_t*)(ws + WS_PROJ);
    int b = 0, chunk, bp;
    if (!SAMPLE) { b = unit >> 7; chunk = (unit >> 2) & 31; bp = unit & 3; } else { chunk = unit >> 2; bp = unit & 3; }
    const int c0 = bp * 128;
    const int row0 = SAMPLE ? MP + chunk * 64 : b * SEQ + chunk * 256;
    const int nb = w >> 2, jt = w & 3, n = bp * 2 + nb, fr = lane & 15, fq = lane >> 4;
    const int ch = n * 64 + jt * 16 + fr, chl = nb * 64 + jt * 16 + fr;
    float wA[2][8], wX[2][8];
#pragma unroll
    for (int kh = 0; kh < 2; ++kh)
#pragma unroll
        for (int j = 0; j < 8; ++j) { const int c = kh * 32 + 8 * fq + j; const size_t o = (size_t)(n * 64 + c) * 64 + jt * 16 + fr; wA[kh][j] = a->in[I_WLA][o]; wX[kh][j] = a->in[I_WLX][o]; }
    const float ba_ = a->in[I_BLA][ch], bx_ = a->in[I_BLX][ch];
    const float lam = a->in[I_LAM][ch];
    const float wc0 = a->in[I_WLC][ch], wc1 = a->in[I_WLC][512 + ch], wc2 = a->in[I_WLC][1024 + ch], wc3 = a->in[I_WLC][1536 + ch], bcv = a->in[I_BLC][ch];
    float hc = 0.f, Atot = 1.f, Htot = 0.f;
    float* summ = (float*)(ws + WS_SUMM);
    typedef float f32x2_ __attribute__((ext_vector_type(2)));
    f32x2_ ah[32];
    if (!SAMPLE && PASS == 2) {
#pragma unroll
        for (int j = 0; j < 32; ++j) ah[j] = *(const f32x2_*)(summ + ((size_t)(b * 32 + j) * 512 + ch) * 2);
    }
    __syncthreads();
#pragma unroll
    for (int it = tid; it < NROW * 16; it += NTHREADS) {
        const int r = it >> 4, cq = it & 15;
        u32x4 v = {0u, 0u, 0u, 0u};
        if (!SAMPLE) { const int t = chunk * 256 - 3 + r; if (t >= 0) v = *(const u32x4*)(proj + (size_t)(b * SEQ + t) * DIN + c0 + cq * 8); }
        else { const int bl = r / 7, rr = r % 7, bs = chunk * 16 + bl;
            if (rr >= 3) v = *(const u32x4*)(proj + (size_t)(MP + bs * 4 + rr - 3) * DIN + c0 + cq * 8);
            else { const float* s = a->in[I_SLC] + (size_t)(bs * 3 + rr) * 512 + c0 + cq * 8; const f32x4 s0 = *(const f32x4*)s, s1 = *(const f32x4*)(s + 4);
                v.x = pkbf(s0[0], s0[1]); v.y = pkbf(s0[2], s0[3]); v.z = pkbf(s1[0], s1[1]); v.w = pkbf(s1[2], s1[3]); } }
        *(LAS u32x4*)(XR + r * RS + cq * 16) = v;
    }
    __syncthreads();
    {
        const int cq = tid & 15, tg = tid >> 4;
        float wk[4][8], bb[8];
#pragma unroll
        for (int j = 0; j < 8; ++j) { bb[j] = a->in[I_BLC][c0 + cq * 8 + j];
#pragma unroll
            for (int k = 0; k < 4; ++k) wk[k][j] = a->in[I_WLC][k * 512 + c0 + cq * 8 + j]; }
#pragma unroll
        for (int q = 0; q < NTOK / 32; ++q) {
            const int tok = tg * (NTOK / 32) + q; const int base = SAMPLE ? (tok >> 2) * 7 + (tok & 3) : tok;
            float x[8];
#pragma unroll
            for (int j = 0; j < 8; ++j) x[j] = bb[j];
#pragma unroll
            for (int k = 0; k < 4; ++k) { const u32x4 v = *(const LAS u32x4*)(XR + (base + k) * RS + cq * 16);
                x[0] += wk[k][0] * bflo(v.x); x[1] += wk[k][1] * bfhi(v.x); x[2] += wk[k][2] * bflo(v.y); x[3] += wk[k][3] * bfhi(v.y);
                x[4] += wk[k][4] * bflo(v.z); x[5] += wk[k][5] * bfhi(v.z); x[6] += wk[k][6] * bflo(v.w); x[7] += wk[k][7] * bfhi(v.w); }
            u32x4 o; o.x = pkbf(x[0], x[1]); o.y = pkbf(x[2], x[3]); o.z = pkbf(x[4], x[5]); o.w = pkbf(x[6], x[7]);
            *(LAS u32x4*)(XC + tok * RS + cq * 16) = o;
        }
    }
    __syncthreads();
    const float sp = (lam > 15.f) ? __expf(-lam) : log1pf(__expf(-lam));
    const float k8 = -8.0f * sp * LOG2E;
    bf16x8 bA[2], bX[2];
#pragma unroll
    for (int kh = 0; kh < 2; ++kh)
#pragma unroll
        for (int j = 0; j < 8; ++j) { bA[kh][j] = (short)f2bf(wA[kh][j]); bX[kh][j] = (short)f2bf(wX[kh][j]); }
    if (!SAMPLE && PASS == 2) {
#pragma unroll
        for (int j = 0; j < 32; ++j) if (j < chunk) hc = ah[j].x * hc + ah[j].y;
    }
    bf16_t* mix = (bf16_t*)(ws + WS_MIX);
    unsigned short gcur[4] = {0, 0, 0, 0}, gnxt[4] = {0, 0, 0, 0};
    if (SAMPLE || PASS == 2) {
#pragma unroll
        for (int r = 0; r < 4; ++r) gcur[r] = proj[((size_t)row0 + 4 * fq + r) * DIN + 512 + ch];
    }
#pragma unroll 2
    for (int s = 0; s < NTOK / 16; ++s) {
        if ((SAMPLE || PASS == 2) && s + 1 < NTOK / 16) {
#pragma unroll
            for (int r = 0; r < 4; ++r) gnxt[r] = proj[((size_t)row0 + 16 * (s + 1) + 4 * fq + r) * DIN + 512 + ch];
        }
        bf16x8 aF[2];
#pragma unroll
        for (int kh = 0; kh < 2; ++kh) aF[kh] = *(const LAS bf16x8*)(XC + (16 * s + fr) * RS + (nb * 64 + kh * 32 + 8 * fq) * 2);
        f32x4 accA = {0.f, 0.f, 0.f, 0.f}, accX = {0.f, 0.f, 0.f, 0.f};
        accA = MFMA16(aF[0], bA[0], accA); accA = MFMA16(aF[1], bA[1], accA);
        accX = MFMA16(aF[0], bX[0], accX); accX = MFMA16(aF[1], bX[1], accX);
        const int base = SAMPLE ? (4 * s + fq) * 7 : 16 * s + 4 * fq;
        float x7[7];
#pragma unroll
        for (int q = 0; q < 7; ++q) x7[q] = bf2f(*(const LAS unsigned short*)(XR + (base + q) * RS + chl * 2));
        float av[4], bv[4];
#pragma unroll
        for (int r = 0; r < 4; ++r) {
            const float xc = bcv + wc0 * x7[r] + wc1 * x7[r + 1] + wc2 * x7[r + 2] + wc3 * x7[r + 3];
            const float rg = sigmoidf_(accA[r] + ba_), ig = sigmoidf_(accX[r] + bx_);
            const float a_ = fexp2(k8 * rg);
            av[r] = a_; bv[r] = __builtin_sqrtf(fmaxf(1.0f - a_ * a_, 0.f)) * (ig * xc);
        }
        float hv[4];
        if (SAMPLE) {
            const int bs = chunk * 16 + 4 * s + fq;
            float h = a->in[I_SLH][(size_t)bs * 512 + ch];
#pragma unroll
            for (int r = 0; r < 4; ++r) { h = av[r] * h + bv[r]; hv[r] = h; }
            a->out[O_SLH + (size_t)bs * 512 + ch] = h;
        } else {
            float Ai = av[0] * av[1] * av[2] * av[3], Hi = 0.f;
#pragma unroll
            for (int r = 0; r < 4; ++r) Hi = av[r] * Hi + bv[r];
            float tA = __shfl_up(Ai, 16), tH = __shfl_up(Hi, 16);
            if (fq >= 1) { Hi = Ai * tH + Hi; Ai = Ai * tA; }
            tA = __shfl_up(Ai, 32); tH = __shfl_up(Hi, 32);
            if (fq >= 2) { Hi = Ai * tH + Hi; Ai = Ai * tA; }
            float Ae = __shfl_up(Ai, 16), He = __shfl_up(Hi, 16);
            if (fq == 0) { Ae = 1.f; He = 0.f; }
            const float At = __shfl(Ai, 48 + fr), Ht = __shfl(Hi, 48 + fr);
            if (PASS == 1) { Htot = At * Htot + Ht; Atot *= At; }
            else {
                float h = Ae * hc + He;
#pragma unroll
                for (int r = 0; r < 4; ++r) { h = av[r] * h + bv[r]; hv[r] = h; }
                hc = At * hc + Ht;
            }
        }
        if (SAMPLE || PASS == 2) {
#pragma unroll
            for (int r = 0; r < 4; ++r) {
                const size_t row = (size_t)row0 + 16 * s + 4 * fq + r;
                mix[row * 1024 + ch] = (bf16_t)f2bf(hv[r] * gelu_tanh(bf2f(gcur[r])));
            }
#pragma unroll
            for (int r = 0; r < 4; ++r) gcur[r] = gnxt[r];
        }
    }
    if (!SAMPLE && PASS == 1 && fq == 0) { summ[((size_t)(b * 32 + chunk) * 512 + ch) * 2] = Atot; summ[((size_t)(b * 32 + chunk) * 512 + ch) * 2 + 1] = Htot; }
    if (!SAMPLE && PASS == 2 && chunk == 31 && fq == 0) a->out[O_PLH + (size_t)b * 512 + ch] = hc;
}

__device__ __forceinline__ void swa_prompt_unit(KA a, ldsp lds, int unit, int tid, int lane, int w) {
    constexpr int KRS = 144, VRS = 400;
    const ldsp Ks = lds, VT = lds + 192 * KRS;
    const bf16_t* proj = (const bf16_t*)(a->ws + WS_PROJ);
    const int b = unit >> 8, hk = (unit >> 7) & 1, qb = unit & 127, t0 = qb * 64;
    __syncthreads();
#pragma unroll
    for (int it = tid; it < 192 * 8; it += NTHREADS) {
        const int kl = it >> 3, cq = it & 7, t = t0 - 128 + kl;
        u32x4 kv = {0u, 0u, 0u, 0u}, vv = {0u, 0u, 0u, 0u};
        if (t >= 0) { const bf16_t* p = proj + (size_t)(b * SEQ + t) * DIN; kv = *(const u32x4*)(p + 1536 + hk * 64 + cq * 8); vv = *(const u32x4*)(p + 1664 + hk * 64 + cq * 8); }
        *(LAS u32x4*)(Ks + kl * KRS + cq * 16) = kv;
#pragma unroll
        for (int e = 0; e < 8; ++e) *(LAS unsigned short*)(VT + (cq * 8 + e) * VRS + kl * 2) = (unsigned short)(vv[e >> 1] >> (16 * (e & 1)));
    }
    __syncthreads();
    const int g = w >> 1, hf = w & 1, hq = hk * 4 + g, j = lane & 31, hi = lane >> 5;
    const size_t qrow = (size_t)b * SEQ + t0 + 32 * hf + j;
    bf16x8 qf[4];
#pragma unroll
    for (int ks = 0; ks < 4; ++ks) qf[ks] = *(const bf16x8*)(proj + qrow * DIN + 1024 + hq * 64 + 16 * ks + 8 * hi);
    const float slope2 = fexp2(-(float)(hq + 1)) * LOG2E, sink2 = a->in[I_SINK][hq] * LOG2E;
    float mx = sink2;
    f32x16 st[5];
#pragma unroll
    for (int kt = 0; kt < 5; ++kt) {
        f32x16 acc = {};
#pragma unroll
        for (int ks = 0; ks < 4; ++ks) { const bf16x8 kf = *(const LAS bf16x8*)(Ks + (32 * hf + 32 * kt + j) * KRS + (16 * ks + 8 * hi) * 2); acc = MFMA32(kf, qf[ks], acc); }
        int dbase = 128 + j - 32 * kt - 4 * hi;
        int kpb = t0 - 128 + 32 * hf + 32 * kt + 4 * hi;
        asm volatile("" : "+v"(dbase), "+v"(kpb));
#pragma unroll
        for (int r = 0; r < 16; ++r) {
            const int cr = (r & 3) + 8 * (r >> 2), dist = dbase - cr;
            const bool valid = (unsigned)dist < 128u && (kpb + cr) >= 0;
            float s = acc[r] * LOG2E - slope2 * (float)dist; s = valid ? s : -1e30f; acc[r] = s; mx = fmaxf(mx, s);
        }
        st[kt] = acc;
        __builtin_amdgcn_sched_barrier(0);
    }
    mx = fmaxf(mx, __shfl_xor(mx, 32));
    float l = 0.f;
#pragma unroll
    for (int kt = 0; kt < 5; ++kt)
#pragma unroll
        for (int r = 0; r < 16; ++r) { const float p = fexp2(st[kt][r] - mx); st[kt][r] = p; l += p; }
    l += __shfl_xor(l, 32); l += fexp2(sink2 - mx);
    const float inv = frcp(l);
    f32x16 o[2] = {};
#pragma unroll
    for (int kt = 0; kt < 5; ++kt)
#pragma unroll
        for (int s = 0; s < 2; ++s) {
            const bf16x8 pf = pack8(st[kt], s);
#pragma unroll
            for (int dt = 0; dt < 2; ++dt) {
                const int d = 32 * dt + j, kb = 32 * hf + 32 * kt + 16 * s + 4 * hi;
                const s16x4 lo = *(const LAS s16x4*)(VT + d * VRS + kb * 2), hi4 = *(const LAS s16x4*)(VT + d * VRS + (kb + 8) * 2);
                const bf16x8 vf = __builtin_shufflevector(lo, hi4, 0, 1, 2, 3, 4, 5, 6, 7);
                o[dt] = MFMA32(vf, pf, o[dt]);
            }
            __builtin_amdgcn_sched_barrier(0);
        }
    bf16_t* mix = (bf16_t*)(a->ws + WS_MIX);
#pragma unroll
    for (int dt = 0; dt < 2; ++dt)
#pragma unroll
        for (int rg = 0; rg < 4; ++rg) {
            u32x2 wv; wv.x = pkbf(o[dt][4 * rg] * inv, o[dt][4 * rg + 1] * inv); wv.y = pkbf(o[dt][4 * rg + 2] * inv, o[dt][4 * rg + 3] * inv);
            *(u32x2*)(mix + qrow * 1024 + 512 + hq * 64 + 32 * dt + 8 * rg + 4 * hi) = wv;
        }
}

__device__ __forceinline__ void swa_sample_unit(KA a, ldsp lds, int bs, int tid) {
    LAS float* Kc = (LAS float*)lds;
    LAS float* Vc = (LAS float*)(lds + 69696);
    LAS float* Qs = (LAS float*)(lds + 137280);
    LAS float* P = Kc;
    const bf16_t* proj = (const bf16_t*)(a->ws + WS_PROJ);
    __syncthreads();
    {
        f32x4 kvv[8], vvv[8]; unsigned short qv[4], nk, nv;
#pragma unroll
        for (int q = 0; q < 8; ++q) { const int it = tid + q * NTHREADS, r = it >> 5, c4 = (it & 31) * 4;
            kvv[q] = *(const f32x4*)(a->in[I_CSK] + (size_t)(bs * 128 + r) * 128 + c4); vvv[q] = *(const f32x4*)(a->in[I_CSV] + (size_t)(bs * 128 + r) * 128 + c4); }
#pragma unroll
        for (int q = 0; q < 4; ++q) { const int e = tid + q * NTHREADS, rq = e >> 6, d = e & 63, hq = rq >> 2, i = rq & 3; qv[q] = proj[(size_t)(MP + bs * 4 + i) * DIN + 1024 + hq * 64 + d]; }
        { const int i = tid >> 7, c = tid & 127; const bf16_t* p = proj + (size_t)(MP + bs * 4 + i) * DIN; nk = p[1536 + c]; nv = p[1664 + c]; }
#pragma unroll
        for (int q = 0; q < 8; ++q) { const int it = tid + q * NTHREADS, r = it >> 5, c4 = (it & 31) * 4;
            *(LAS f32x4*)(Kc + r * 132 + c4) = kvv[q]; *(LAS f32x4*)(Vc + r * 128 + c4) = vvv[q];
            if (r >= 4) { *(f32x4*)(a->out + O_SSK + (size_t)(bs * 128 + r - 4) * 128 + c4) = kvv[q]; *(f32x4*)(a->out + O_SSV + (size_t)(bs * 128 + r - 4) * 128 + c4) = vvv[q]; } }
#pragma unroll
        for (int q = 0; q < 4; ++q) { const int e = tid + q * NTHREADS; Qs[e] = bf2f(qv[q]); }
        { const int i = tid >> 7, c = tid & 127; Kc[(128 + i) * 132 + c] = bf2f(nk); Vc[(128 + i) * 128 + c] = bf2f(nv); }
    }
    __syncthreads();
    float sc[16];
    const int rg = tid / 33, kg = tid - rg * 33, hkS = rg >> 2;
#pragma unroll
    for (int q = 0; q < 16; ++q) sc[q] = 0.f;
    if (tid < 264) {
#pragma unroll 2
        for (int c = 0; c < 16; ++c) {
            f32x4 kk[4], qq[4];
#pragma unroll
            for (int i = 0; i < 4; ++i) { kk[i] = *(const LAS f32x4*)(Kc + (kg + 33 * i) * 132 + hkS * 64 + 4 * c); qq[i] = *(const LAS f32x4*)(Qs + (rg * 4 + i) * 64 + 4 * c); }
#pragma unroll
            for (int ri = 0; ri < 4; ++ri)
#pragma unroll
                for (int ki = 0; ki < 4; ++ki) sc[ri * 4 + ki] += (qq[ri][0] * kk[ki][0] + qq[ri][1] * kk[ki][1]) + (qq[ri][2] * kk[ki][2] + qq[ri][3] * kk[ki][3]);
        }
    }
    __syncthreads();
    if (tid < 264) {
#pragma unroll
        for (int ri = 0; ri < 4; ++ri)
#pragma unroll
            for (int ki = 0; ki < 4; ++ki) { const int row = rg * 4 + ri, hq = row >> 2, i = row & 3, key = kg + 33 * ki, dist = i + 128 - key; const bool valid = dist >= 0 && dist < 128;
                const float s = sc[ri * 4 + ki] * LOG2E - fexp2(-(float)(hq + 1)) * LOG2E * (float)dist; P[row * 132 + key] = valid ? s : -1e30f; }
    }
    __syncthreads();
    {
        const int row = tid >> 4, sub = tid & 15, hq = row >> 2; const float sink2 = a->in[I_SINK][hq] * LOG2E;
        float v[9], m = sink2;
#pragma unroll
        for (int jj = 0; jj < 9; ++jj) { const int k2 = sub + 16 * jj; v[jj] = k2 < 132 ? P[row * 132 + k2] : -1e30f; m = fmaxf(m, v[jj]); }
#pragma unroll
        for (int o = 8; o >= 1; o >>= 1) m = fmaxf(m, __shfl_xor(m, o));
        float l = 0.f;
#pragma unroll
        for (int jj = 0; jj < 9; ++jj) { v[jj] = fexp2(v[jj] - m); l += v[jj]; }
#pragma unroll
        for (int o = 8; o >= 1; o >>= 1) l += __shfl_xor(l, o);
        l += fexp2(sink2 - m);
        const float inv = 1.0f / l;
#pragma unroll
        for (int jj = 0; jj < 9; ++jj) { const int k2 = sub + 16 * jj; if (k2 < 132) P[row * 132 + k2] = v[jj] * inv; }
    }
    __syncthreads();
    {
        LAS float* PART2 = Kc + 5120;
        const int lane = tid & 63, d4 = (lane & 15) * 4, kq = lane >> 4, rowgrp = tid >> 6, hk2 = rowgrp >> 2;
        f32x4 acc[4];
#pragma unroll
        for (int ri = 0; ri < 4; ++ri) acc[ri] = (f32x4){0.f, 0.f, 0.f, 0.f};
#pragma unroll 3
        for (int k2 = kq * 33; k2 < kq * 33 + 33; ++k2) { const f32x4 v4 = *(const LAS f32x4*)(Vc + k2 * 128 + hk2 * 64 + d4);
#pragma unroll
            for (int ri = 0; ri < 4; ++ri) acc[ri] += P[(rowgrp * 4 + ri) * 132 + k2] * v4; }
#pragma unroll
        for (int ri = 0; ri < 4; ++ri) *(LAS f32x4*)(PART2 + (kq * 32 + rowgrp * 4 + ri) * 64 + d4) = acc[ri];
    }
    __syncthreads();
    {
        const LAS float* PART2 = Kc + 5120;
        const int row = tid >> 4, d4 = (tid & 15) * 4, hq = row >> 2, i = row & 3;
        f32x4 acc = *(const LAS f32x4*)(PART2 + row * 64 + d4);
#pragma unroll
        for (int p = 1; p < 4; ++p) acc += *(const LAS f32x4*)(PART2 + (p * 32 + row) * 64 + d4);
        u32x2 wv; wv.x = pkbf(acc[0], acc[1]); wv.y = pkbf(acc[2], acc[3]);
        *(u32x2*)((bf16_t*)(a->ws + WS_MIX) + (size_t)(MP + bs * 4 + i) * 1024 + 512 + hq * 64 + d4) = wv;
    }
}

__device__ __forceinline__ void xattn_prompt_unit(KA a, ldsp lds, int unit, int tid, int lane, int w) {
    constexpr int KRS = 272, VRS = 528;
    const ldsp Km = lds, VmT = lds + 256 * KRS;
    const bf16_t* memkv = (const bf16_t*)(a->ws + WS_MEMKV);
    const bf16_t* qcb = (const bf16_t*)(a->ws + WS_QC);
    const int b = unit >> 7, h = (unit >> 5) & 3, qc = unit & 31;
    __syncthreads();
#pragma unroll
    for (int it = tid; it < 256 * 16; it += NTHREADS) {
        const int key = it >> 4, cq = it & 15; const bf16_t* p = memkv + (size_t)(b * 256 + key) * 1024 + h * 128 + cq * 8;
        const u32x4 kv = *(const u32x4*)p, vv = *(const u32x4*)(p + 512);
        *(LAS u32x4*)(Km + key * KRS + cq * 16) = kv;
#pragma unroll
        for (int e = 0; e < 8; ++e) *(LAS unsigned short*)(VmT + (cq * 8 + e) * VRS + key * 2) = (unsigned short)(vv[e >> 1] >> (16 * (e & 1)));
    }
    __syncthreads();
    const int j = lane & 31, hi = lane >> 5;
    const size_t qrow = (size_t)b * SEQ + qc * 256 + 32 * w + j;
    bf16x8 qf[8];
#pragma unroll
    for (int ks = 0; ks < 8; ++ks) qf[ks] = *(const bf16x8*)(qcb + qrow * 512 + h * 128 + 16 * ks + 8 * hi);
    float m = -1e30f, l = 0.f;
    f32x16 o[4] = {};
#pragma unroll
    for (int kh = 0; kh < 2; ++kh) {
        f32x16 st[4];
        float mx = -1e30f;
#pragma unroll
        for (int kt = 0; kt < 4; ++kt) {
            f32x16 acc = {};
#pragma unroll
            for (int ks = 0; ks < 8; ++ks) { const bf16x8 kf = *(const LAS bf16x8*)(Km + (128 * kh + 32 * kt + j) * KRS + (16 * ks + 8 * hi) * 2); acc = MFMA32(kf, qf[ks], acc); }
#pragma unroll
            for (int r = 0; r < 16; ++r) { acc[r] *= LOG2E; mx = fmaxf(mx, acc[r]); }
            st[kt] = acc;
        }
        mx = fmaxf(mx, __shfl_xor(mx, 32));
        const float mn = fmaxf(m, mx), scl = fexp2(m - mn);
        m = mn; l *= scl;
#pragma unroll
        for (int dt = 0; dt < 4; ++dt) o[dt] *= scl;
#pragma unroll
        for (int kt = 0; kt < 4; ++kt)
#pragma unroll
            for (int r = 0; r < 16; ++r) { const float p = fexp2(st[kt][r] - m); st[kt][r] = p; l += p; }
#pragma unroll
        for (int kt = 0; kt < 4; ++kt)
#pragma unroll
            for (int s = 0; s < 2; ++s) {
                const bf16x8 pf = pack8(st[kt], s);
#pragma unroll
                for (int dt = 0; dt < 4; ++dt) {
                    const int d = 32 * dt + j, kb = 128 * kh + 32 * kt + 16 * s + 4 * hi;
                    const s16x4 lo = *(const LAS s16x4*)(VmT + d * VRS + kb * 2), hi4 = *(const LAS s16x4*)(VmT + d * VRS + (kb + 8) * 2);
                    const bf16x8 vf = __builtin_shufflevector(lo, hi4, 0, 1, 2, 3, 4, 5, 6, 7);
                    o[dt] = MFMA32(vf, pf, o[dt]);
                }
            }
    }
    l += __shfl_xor(l, 32);
    const float inv = frcp(l);
    bf16_t* oc = (bf16_t*)(a->ws + WS_OC);
#pragma unroll
    for (int dt = 0; dt < 4; ++dt)
#pragma unroll
        for (int rg = 0; rg < 4; ++rg) {
            u32x2 wv; wv.x = pkbf(o[dt][4 * rg] * inv, o[dt][4 * rg + 1] * inv); wv.y = pkbf(o[dt][4 * rg + 2] * inv, o[dt][4 * rg + 3] * inv);
            *(u32x2*)(oc + qrow * 512 + h * 128 + 32 * dt + 8 * rg + 4 * hi) = wv;
        }
}
__device__ __forceinline__ void xattn_sample_unit(KA a, ldsp lds, int unit, int tid, int lane, int w) {
    LAS float* Qs = (LAS float*)lds;
    LAS float* S = (LAS float*)(lds + 2048);
    LAS float* RED = (LAS float*)(lds + 8192);
    const bf16_t* qcb = (const bf16_t*)(a->ws + WS_QC);
    const int bs = unit >> 2, h = unit & 3;
    __syncthreads();
    { const int i = tid >> 7, d = tid & 127; Qs[i * 128 + d] = bf2f(qcb[(size_t)(MP + bs * 4 + i) * 512 + h * 128 + d]); }
    __syncthreads();
    {
        const int key = tid >> 1, hf = tid & 1; const float* kp = a->in[I_CMK] + ((size_t)(bs * 256 + key) * 4 + h) * 128 + hf * 64;
        float s0 = 0.f, s1 = 0.f, s2 = 0.f, s3 = 0.f;
#pragma unroll
        for (int c = 0; c < 16; ++c) {
            const f32x4 k4 = *(const f32x4*)(kp + 4 * c);
            const f32x4 q0 = *(const LAS f32x4*)(Qs + hf * 64 + 4 * c), q1 = *(const LAS f32x4*)(Qs + 128 + hf * 64 + 4 * c), q2 = *(const LAS f32x4*)(Qs + 256 + hf * 64 + 4 * c), q3 = *(const LAS f32x4*)(Qs + 384 + hf * 64 + 4 * c);
            s0 += (k4[0] * q0[0] + k4[1] * q0[1]) + (k4[2] * q0[2] + k4[3] * q0[3]); s1 += (k4[0] * q1[0] + k4[1] * q1[1]) + (k4[2] * q1[2] + k4[3] * q1[3]);
            s2 += (k4[0] * q2[0] + k4[1] * q2[1]) + (k4[2] * q2[2] + k4[3] * q2[3]); s3 += (k4[0] * q3[0] + k4[1] * q3[1]) + (k4[2] * q3[2] + k4[3] * q3[3]);
        }
        s0 += __shfl_xor(s0, 1); s1 += __shfl_xor(s1, 1); s2 += __shfl_xor(s2, 1); s3 += __shfl_xor(s3, 1);
        if (hf == 0) { S[key] = s0 * LOG2E; S[256 + key] = s1 * LOG2E; S[512 + key] = s2 * LOG2E; S[768 + key] = s3 * LOG2E; }
    }
    __syncthreads();
    if (w < 4) {
        f32x4 v = *(const LAS f32x4*)(S + w * 256 + lane * 4);
        float m = fmaxf(fmaxf(v[0], v[1]), fmaxf(v[2], v[3]));
#pragma unroll
        for (int o = 32; o >= 1; o >>= 1) m = fmaxf(m, __shfl_xor(m, o));
        v[0] = fexp2(v[0] - m); v[1] = fexp2(v[1] - m); v[2] = fexp2(v[2] - m); v[3] = fexp2(v[3] - m);
        const float l = wave_sum((v[0] + v[1]) + (v[2] + v[3]));
        v *= (1.0f / l);
        *(LAS f32x4*)(S + w * 256 + lane * 4) = v;
    }
    __syncthreads();
    {
        const int dq = tid & 31, kg = tid >> 5; const float* vp = a->in[I_CMV] + ((size_t)(bs * 256 + kg * 16) * 4 + h) * 128 + dq * 4;
        f32x4 a0 = {0.f, 0.f, 0.f, 0.f}, a1 = a0, a2 = a0, a3 = a0;
#pragma unroll
        for (int kk = 0; kk < 16; ++kk) { const f32x4 v4 = *(const f32x4*)(vp + (size_t)kk * 512); const int k2 = kg * 16 + kk;
            a0 += S[k2] * v4; a1 += S[256 + k2] * v4; a2 += S[512 + k2] * v4; a3 += S[768 + k2] * v4; }
        *(LAS f32x4*)(RED + (kg * 4 + 0) * 128 + dq * 4) = a0; *(LAS f32x4*)(RED + (kg * 4 + 1) * 128 + dq * 4) = a1;
        *(LAS f32x4*)(RED + (kg * 4 + 2) * 128 + dq * 4) = a2; *(LAS f32x4*)(RED + (kg * 4 + 3) * 128 + dq * 4) = a3;
    }
    __syncthreads();
    { const int i = tid >> 7, d = tid & 127; float s = 0.f;
#pragma unroll
        for (int kg = 0; kg < 16; ++kg) s += RED[(kg * 4 + i) * 128 + d];
        ((bf16_t*)(a->ws + WS_OC))[(size_t)(MP + bs * 4 + i) * 512 + h * 128 + d] = (bf16_t)f2bf(s); }
}


template <class Post> __device__ __forceinline__ void sk_tile(ldsp lds, const bf16_t* A, int lda, const bf16_t* B0, const bf16_t* B1, int K, const Post& post, int tid, int lane, int w) {
    const int fr = lane & 15, fq = lane >> 4, kper = K >> 3;
    const bf16_t* ap = A + (size_t)fr * lda + w * kper + 16 * fq;
    const bf16_t* bp0 = B0 + (size_t)fr * K + w * kper + 16 * fq;
    const bf16_t* bp1 = B1 + (size_t)fr * K + w * kper + 16 * fq;
    f32x4 acc[2][8];
#pragma unroll
    for (int i = 0; i < 2; ++i)
#pragma unroll
        for (int j = 0; j < 8; ++j) acc[i][j] = (f32x4){0.f, 0.f, 0.f, 0.f};
    for (int k0 = 0; k0 < kper; k0 += 128) {
        bf16x8 af[2][2][2], bf[2][8][2];
#pragma unroll
        for (int c = 0; c < 2; ++c) {
            const int kk = k0 + 64 * c;
            if (kk < kper) {
#pragma unroll
                for (int i = 0; i < 2; ++i) { af[c][i][0] = *(const bf16x8*)(ap + (size_t)(16 * i) * lda + kk); af[c][i][1] = *(const bf16x8*)(ap + (size_t)(16 * i) * lda + kk + 8); }
#pragma unroll
                for (int j = 0; j < 4; ++j) { bf[c][j][0] = *(const bf16x8*)(bp0 + (size_t)(16 * j) * K + kk); bf[c][j][1] = *(const bf16x8*)(bp0 + (size_t)(16 * j) * K + kk + 8);
                    bf[c][4 + j][0] = *(const bf16x8*)(bp1 + (size_t)(16 * j) * K + kk); bf[c][4 + j][1] = *(const bf16x8*)(bp1 + (size_t)(16 * j) * K + kk + 8); }
            }
        }
#pragma unroll
        for (int c = 0; c < 2; ++c) {
            if (k0 + 64 * c < kper) {
#pragma unroll
                for (int hl = 0; hl < 2; ++hl)
#pragma unroll
                    for (int i = 0; i < 2; ++i)
#pragma unroll
                        for (int j = 0; j < 8; ++j) acc[i][j] = MFMA16(af[c][i][hl], bf[c][j][hl], acc[i][j]);
            }
        }
    }
    LAS float* PART = (LAS float*)lds;
    __syncthreads();
#pragma unroll
    for (int i = 0; i < 2; ++i)
#pragma unroll
        for (int j = 0; j < 8; ++j)
#pragma unroll
            for (int r = 0; r < 4; ++r) PART[(w * 32 + 16 * i + 4 * fq + r) * 132 + 16 * j + fr] = acc[i][j][r];
    __syncthreads();
    const int row = tid >> 4, cc = tid & 15;
    f32x4 v0 = *(const LAS f32x4*)(PART + row * 132 + 4 * cc), v1 = *(const LAS f32x4*)(PART + row * 132 + 64 + 4 * cc);
#pragma unroll
    for (int p = 1; p < 8; ++p) { v0 += *(const LAS f32x4*)(PART + (p * 32 + row) * 132 + 4 * cc); v1 += *(const LAS f32x4*)(PART + (p * 32 + row) * 132 + 64 + 4 * cc); }
    post(row, cc, v0, v1);
}
__device__ __forceinline__ void st4bf(bf16_t* p, f32x4 v) { u32x2 w_; w_.x = pkbf(v[0], v[1]); w_.y = pkbf(v[2], v[3]); *(u32x2*)p = w_; }
struct SkProj {
    bf16_t* proj; const float* ssq; float* out; int mt, n0;
    __device__ __forceinline__ void operator()(int row, int cc, f32x4 va, f32x4 vb) const {
        const int grow = MP + 32 * mt + row, r2 = grow - MP, b = r2 >> 2, t = r2 & 3;
        const float rs0 = __builtin_amdgcn_rsqf(ssq[grow] * (1.0f / 1024.0f) + EPS);
#pragma unroll
        for (int hh = 0; hh < 2; ++hh) {
            const int col = n0 + hh * 64 + 4 * cc; const float rs = rs0 * ((col >= 1024 && col < 1536) ? 0.125f : 1.0f);
            const f32x4 v = (hh ? vb : va) * rs;
            st4bf(proj + (size_t)grow * DIN + col, v);
            float* dst = nullptr;
            if (col >= 1536) dst = out + (col < 1664 ? O_SSK + (size_t)(b * 128 + 124 + t) * 128 + (col - 1536) : O_SSV + (size_t)(b * 128 + 124 + t) * 128 + (col - 1664));
            else if (col < 512 && t >= 1) dst = out + O_SLC + (size_t)(b * 3 + t - 1) * 512 + col;
            if (dst) *(f32x4*)dst = v;
        }
    }
};
template <int MODE> struct SkRes {
    const float* res; float* xout; bf16_t* xb; float* ssq; int mt, n0;
    __device__ __forceinline__ void operator()(int row, int cc, f32x4 va, f32x4 vb) const {
        const int grow = MP + 32 * mt + row; float sq = 0.f;
#pragma unroll
        for (int hh = 0; hh < 2; ++hh) {
            const int col = n0 + hh * 64 + 4 * cc;
            f32x4 v = hh ? vb : va;
            if (MODE == 0) v += *(const f32x4*)(res + (size_t)grow * 1024 + col);
            else { const u32x2 rr = *(const u32x2*)(xb + (size_t)grow * 1024 + col); v += (f32x4){bflo(rr.x), bfhi(rr.x), bflo(rr.y), bfhi(rr.y)}; }
            if (MODE == 2) *(f32x4*)(xout + (size_t)grow * 1024 + col) = v; else st4bf(xb + (size_t)grow * 1024 + col, v);
            sq += (v[0] * v[0] + v[1] * v[1]) + (v[2] * v[2] + v[3] * v[3]);
        }
        if (MODE != 2) {
            sq += __shfl_xor(sq, 1); sq += __shfl_xor(sq, 2); sq += __shfl_xor(sq, 4); sq += __shfl_xor(sq, 8);
            if (cc == 0) __hip_atomic_fetch_add(ssq + grow, sq, __ATOMIC_RELAXED, __HIP_MEMORY_SCOPE_AGENT);
        }
    }
};
struct SkQ {
    bf16_t* qc; const float* ssq; int mt, n0;
    __device__ __forceinline__ void operator()(int row, int cc, f32x4 va, f32x4 vb) const {
        const int grow = MP + 32 * mt + row; const float rs = __builtin_amdgcn_rsqf(ssq[grow] * (1.0f / 1024.0f) + EPS) * 0.08838834764831845f;
        st4bf(qc + (size_t)grow * 512 + n0 + 4 * cc, va * rs); st4bf(qc + (size_t)grow * 512 + n0 + 64 + 4 * cc, vb * rs);
    }
};
struct SkGU {
    bf16_t* h; const float* ssq; const float* wconv; const float* bconv; const float* state; float* out; int mt, ch0;
    __device__ __forceinline__ void operator()(int row, int cc, f32x4 va, f32x4 vb) const {
        const int grow = MP + 32 * mt + row, r2 = grow - MP, bs = r2 >> 2, t = r2 & 3, c = ch0 + 4 * cc;
        const float rs = __builtin_amdgcn_rsqf(ssq[grow] * (1.0f / 1024.0f) + EPS);
        const f32x4 g = va * rs, up = vb * rs;
        f32x4 p1, p2;
#pragma unroll
        for (int j = 0; j < 4; ++j) { p1[j] = __shfl_up(g[j], 16); p2[j] = __shfl_up(g[j], 32); }
        f32x4 s1 = {0.f, 0.f, 0.f, 0.f}, s0 = {0.f, 0.f, 0.f, 0.f};
        if (t < 2) s1 = *(const f32x4*)(state + ((size_t)bs * 2 + 1) * DFF + c);
        if (t == 0) s0 = *(const f32x4*)(state + ((size_t)bs * 2 + 0) * DFF + c);
        const f32x4 g1 = t >= 1 ? p1 : s1, g2 = t >= 2 ? p2 : (t == 1 ? s1 : s0);
        if (t >= 2) *(f32x4*)(out + O_SFC + ((size_t)bs * 2 + (t - 2)) * DFF + c) = g;
        const f32x4 w0 = *(const f32x4*)(wconv + c), w1 = *(const f32x4*)(wconv + DFF + c), w2 = *(const f32x4*)(wconv + 2 * DFF + c), bc = *(const f32x4*)(bconv + c);
        const f32x4 gc = bc + w0 * g2 + w1 * g1 + w2 * g;
        u32x2 wv; wv.x = pkbf(gelu_tanh(gc[0]) * up[0], gelu_tanh(gc[1]) * up[1]); wv.y = pkbf(gelu_tanh(gc[2]) * up[2], gelu_tanh(gc[3]) * up[3]);
        *(u32x2*)(h + (size_t)grow * DFF + c) = wv;
    }
};

__device__ __forceinline__ void ffn_fixup_tile(KA a, int pm, int tid) {
    const float* edge = (const float*)(a->ws + WS_EDGE); bf16_t* hb = (bf16_t*)(a->ws + WS_H);
    const float* wconv = a->in[I_WFC]; const float* bconv = a->in[I_BFC];
#pragma unroll 4
    for (int it = tid; it < 4 * 2 * 768; it += NTHREADS) {
        const int q = it / 1536, rem = it % 1536, rr = rem / 768, c4 = (rem % 768) * 4;
        const int blk = pm * 4 + q; const bool hasprev = (blk & 127) != 0;
        const f32x4 z = {0.f, 0.f, 0.f, 0.f};
        const f32x4 G0 = *(const f32x4*)(edge + ((size_t)blk * 6 + 0) * DFF + c4), G1 = *(const f32x4*)(edge + ((size_t)blk * 6 + 1) * DFF + c4);
        const f32x4 Gm2 = hasprev ? *(const f32x4*)(edge + ((size_t)(blk - 1) * 6 + 2) * DFF + c4) : z, Gm1 = hasprev ? *(const f32x4*)(edge + ((size_t)(blk - 1) * 6 + 3) * DFF + c4) : z;
        const f32x4 U = *(const f32x4*)(edge + ((size_t)blk * 6 + 4 + rr) * DFF + c4);
        const f32x4 w0 = *(const f32x4*)(wconv + c4), w1 = *(const f32x4*)(wconv + DFF + c4), w2 = *(const f32x4*)(wconv + 2 * DFF + c4), bc = *(const f32x4*)(bconv + c4);
        const f32x4 gc = rr == 0 ? (bc + w0 * Gm2 + w1 * Gm1 + w2 * G0) : (bc + w0 * Gm1 + w1 * G0 + w2 * G1);
        u32x2 wv; wv.x = pkbf(gelu_tanh(gc[0]) * U[0], gelu_tanh(gc[1]) * U[1]); wv.y = pkbf(gelu_tanh(gc[2]) * U[2], gelu_tanh(gc[3]) * U[3]);
        *(u32x2*)(hb + ((size_t)blk * 64 + rr) * DFF + c4) = wv;
    }
}

__global__ void __launch_bounds__(NTHREADS, 2) hymba_fwd(Args a_unused) {
    const KA a = (KA)__builtin_amdgcn_kernarg_segment_ptr();
    extern __shared__ __attribute__((aligned(16))) unsigned char smem[];
    const ldsp lds = (ldsp)smem;
    const int tid = threadIdx.x, lane = tid & 63, w = __builtin_amdgcn_readfirstlane(tid >> 6);
    const int G = gridDim.x, bx = blockIdx.x;
    unsigned char* ws = a->ws;
    const int lo = a->ph_lo, hi = a->ph_hi;
#ifndef PHASE_MASK
#define PHASE_MASK 0xfff
#endif
#define IN(k) (((PHASE_MASK >> (k)) & 1) && lo <= (k) && (k) < hi)
#ifndef SREP
#define SREP 0
#endif
#ifndef REP_MASK
#define REP_MASK 0
#endif
#ifndef EXTRA_SYNCS
#define EXTRA_SYNCS 0
#endif
#define REPS(k) (1 + ((REP_MASK >> (k)) & 1))
#ifdef TPROBE
#define TSTAMP(i) do { if (bx == 0 && tid == 0) ((LAS unsigned long long*)(lds + LDS_BYTES - 192))[i] = __builtin_amdgcn_s_memrealtime(); } while (0)
#else
#define TSTAMP(i) do {} while (0)
#endif
#define SEAM(k) do { if (IN(k) && IN((k) + 1)) { XcdBarrier bar_; bar_.bar = (unsigned*)(a->ws + WS_BAR); bar_.x = xb_xcc_id(); bar_.st = (volatile LAS unsigned*)(lds + MISC_OFF); xcd_barrier(bar_); } TSTAMP((k) + 1); } while (0)
    bf16_t* XB = (bf16_t*)(ws + WS_XB);
    if (tid < 16) ((LAS unsigned*)(lds + MISC_OFF))[tid] = 0u;
    __syncthreads();
    (void)xcd_barrier_post((unsigned*)(ws + WS_BAR), (volatile LAS unsigned*)(lds + MISC_OFF));
    if (hi > 1000) cg::this_grid().sync();
    TSTAMP(0);
    if (IN(0)) { for (int rep = 0; rep < REPS(0); ++rep) p0_prologue(a, lds, tid, lane, w); }
    for (int es = 0; es < EXTRA_SYNCS; ++es) { XcdBarrier bar_; bar_.bar = (unsigned*)(a->ws + WS_BAR); bar_.x = xb_xcc_id(); bar_.st = (volatile LAS unsigned*)(lds + MISC_OFF); xcd_barrier(bar_); }
    SEAM(0);
    struct ListOrder { int c, n, base;
        __device__ __forceinline__ bool next(int i, pg8::Unit& u) const { if (i > 0 || c >= n) return false; u.pm = c & 63; u.pn = base + (c >> 6); return true; }
        __device__ __forceinline__ void a_ready(const pg8::Unit&) const {}
        __device__ __forceinline__ void done(const pg8::Unit&) const {} };
    if (IN(1)) for (int rep = 0; rep < REPS(1); ++rep) {
        { for (int srep = 0; srep < 1 + SREP; ++srep) for (int t = G - 1 - bx; t < 16 * 14; t += G) { const int mt = t / 14, nt = t % 14; const bf16_t* Bt = (const bf16_t*)(ws + WS_WIN) + (size_t)(nt * 128) * 1024;
              SkProj P{(bf16_t*)(ws + WS_PROJ), (const float*)(ws + WS_SSQ0), a->out, mt, nt * 128}; sk_tile(lds, XB + (size_t)(MP + 32 * mt) * 1024, 1024, Bt, Bt + 64 * 1024, 1024, P, tid, lane, w); }
          __syncthreads();
          pg8::Gemm g{XB, (const bf16_t*)(ws + WS_WIN), MP, DIN, 1024};
          pg8::EpiProj E{(bf16_t*)(ws + WS_PROJ), (const float*)(ws + WS_SSQ0), a->out};
          ListOrder S{bx, 256, 0}; pg8::gemm_phase<pg8::EpiProj, ListOrder, true, true>(lds, g, S, E); }
    }
    SEAM(1);
#ifdef CPROBE
    const unsigned long long cp_t0 = __builtin_amdgcn_s_memrealtime();
#endif
    if (IN(2)) for (int rep = 0; rep < REPS(2); ++rep) {
        {
            if (bx < 192) { pg8::Gemm g{XB, (const bf16_t*)(ws + WS_WIN), MP, DIN, 1024}; pg8::EpiProj E{(bf16_t*)(ws + WS_PROJ), (const float*)(ws + WS_SSQ0), a->out};
                ListOrder S{bx, 192, 4}; pg8::gemm_phase<pg8::EpiProj, ListOrder, true, true>(lds, g, S, E); }
            else if (bx < 200) { pg8::Gemm g{(const bf16_t*)(ws + WS_MEMA), (const bf16_t*)(ws + WS_WKV), 512, 1024, 1024}; pg8::StaticOrder S; S.init(512, 1024, G, bx - 192);
                pg8::EpiMemKV E{(bf16_t*)(ws + WS_MEMKV), (const float*)(ws + WS_SSQM), a->out};
                pg8::gemm_phase<pg8::EpiMemKV, pg8::StaticOrder, true, true>(lds, g, S, E); }
            lru_unit<false, 1>(a, lds, bx, tid, lane, w);
            if (bx >= 200) for (int u = bx - 200; u < 160; u += 56) {
#ifdef CPROBE
                const unsigned long long cu0 = __builtin_amdgcn_s_memrealtime();
#endif
                if (u < 32) lru_unit<true, 2>(a, lds, u, tid, lane, w); else swa_sample_unit(a, lds, u - 32, tid);
#ifdef CPROBE
                __syncthreads();
                if (tid == 0) atomicMax((unsigned*)(ws + WS_BAR) + 3610 + (u < 32 ? 0 : 2), (unsigned)(__builtin_amdgcn_s_memrealtime() - cu0));
#endif
            }
        }
    }
#ifdef CPROBE
    if (tid == 0) { const unsigned el = (unsigned)(__builtin_amdgcn_s_memrealtime() - cp_t0); atomicMax((unsigned*)(ws + WS_BAR) + 3600 + (bx < 192 ? 0 : (bx < 200 ? 1 : 2)), el); }
#endif
    SEAM(2);
    if (IN(3)) for (int rep = 0; rep < REPS(3); ++rep) {
        for (int u = bx; u < 768; u += G) {
            if (u < 256) lru_unit<false, 2>(a, lds, u, tid, lane, w);
            else swa_prompt_unit(a, lds, u - 256, tid, lane, w);
        }
    }
    SEAM(3);
    if (IN(4)) {
        for (int t = G - 1 - bx; t < 128; t += G) { const int mt = t >> 3, nt = t & 7; const bf16_t* Bt = (const bf16_t*)(ws + WS_WOUT) + (size_t)(nt * 128) * 1024;
            SkRes<0> P{a->in[I_XS] - (size_t)MP * 1024, a->out, XB, (float*)(ws + WS_SSQ1), mt, nt * 128}; sk_tile(lds, (const bf16_t*)(ws + WS_MIX) + (size_t)(MP + 32 * mt) * 1024, 1024, Bt, Bt + 64 * 1024, 1024, P, tid, lane, w); }
        __syncthreads();
        pg8::Gemm g{(const bf16_t*)(ws + WS_MIX), (const bf16_t*)(ws + WS_WOUT), MP, 1024, 1024}; pg8::StaticOrder S; S.init(MP, 1024, G, bx);
        pg8::EpiRes<0> E{a->in[I_XP], a->out, XB, (float*)(ws + WS_SSQ1)};
        pg8::gemm_phase<pg8::EpiRes<0>, pg8::StaticOrder, true, true>(lds, g, S, E);
        if (REPS(4) > 1) { pg8::EpiRes<0, true> E2{a->in[I_XP], a->out, XB, (float*)(ws + WS_SSQ1)}; pg8::gemm_phase<pg8::EpiRes<0, true>, pg8::StaticOrder, true, true>(lds, g, S, E2); }
    }
    SEAM(4);
    if (IN(5)) for (int rep = 0; rep < REPS(5); ++rep) {
        for (int srep = 0; srep < 1 + SREP; ++srep) for (int t = G - 1 - bx; t < 64; t += G) { const int mt = t >> 2, nt = t & 3; const bf16_t* Bt = (const bf16_t*)(ws + WS_WQ) + (size_t)(nt * 128) * 1024;
            SkQ P{(bf16_t*)(ws + WS_QC), (const float*)(ws + WS_SSQ1), mt, nt * 128}; sk_tile(lds, XB + (size_t)(MP + 32 * mt) * 1024, 1024, Bt, Bt + 64 * 1024, 1024, P, tid, lane, w); }
        __syncthreads();
        pg8::Gemm g{XB, (const bf16_t*)(ws + WS_WQ), MP, 512, 1024}; pg8::StaticOrder S; S.init(MP, 512, G, bx);
        pg8::EpiQ E{(bf16_t*)(ws + WS_QC), (const float*)(ws + WS_SSQ1)};
        pg8::gemm_phase<pg8::EpiQ, pg8::StaticOrder, true, true>(lds, g, S, E);
    }
    SEAM(5);
    if (IN(6)) for (int rep = 0; rep < REPS(6); ++rep) {
        if (bx & 1) { for (int u = bx + G; u < 768; u += G) xattn_sample_unit(a, lds, u - 256, tid, lane, w); xattn_prompt_unit(a, lds, bx, tid, lane, w); }
        else { xattn_prompt_unit(a, lds, bx, tid, lane, w); for (int u = bx + G; u < 768; u += G) xattn_sample_unit(a, lds, u - 256, tid, lane, w); }
    }
    SEAM(6);
    if (IN(7)) {
        for (int t = G - 1 - bx; t < 128; t += G) { const int mt = t >> 3, nt = t & 7; const bf16_t* Bt = (const bf16_t*)(ws + WS_WMO) + (size_t)(nt * 128) * 512;
            SkRes<1> P{a->out, a->out, XB, (float*)(ws + WS_SSQ2), mt, nt * 128}; sk_tile(lds, (const bf16_t*)(ws + WS_OC) + (size_t)(MP + 32 * mt) * 512, 512, Bt, Bt + 64 * 512, 512, P, tid, lane, w); }
        __syncthreads();
        pg8::Gemm g{(const bf16_t*)(ws + WS_OC), (const bf16_t*)(ws + WS_WMO), MP, 1024, 512}; pg8::StaticOrder S; S.init(MP, 1024, G, bx);
        pg8::EpiRes<1> E{nullptr, a->out, XB, (float*)(ws + WS_SSQ2)};
        pg8::gemm_phase<pg8::EpiRes<1>, pg8::StaticOrder, true, true>(lds, g, S, E);
        if (REPS(7) > 1) { pg8::EpiRes<1, true> E2{nullptr, a->out, XB, (float*)(ws + WS_SSQ2)}; pg8::gemm_phase<pg8::EpiRes<1, true>, pg8::StaticOrder, true, true>(lds, g, S, E2); }
    }
    SEAM(7);
    if (IN(8)) for (int rep = 0; rep < REPS(8); ++rep) {
        for (int srep = 0; srep < 1 + SREP; ++srep) for (int t = G - 1 - bx; t < 16 * 48; t += G) { const int mt = t / 48, cb = t % 48; const bf16_t* Bg = (const bf16_t*)(ws + WS_WGU) + (size_t)((cb >> 1) * 256 + (cb & 1) * 64) * 1024;
            SkGU P{(bf16_t*)(ws + WS_H), (const float*)(ws + WS_SSQ2), a->in[I_WFC], a->in[I_BFC], a->in[I_SFC], a->out, mt, cb * 64}; sk_tile(lds, XB + (size_t)(MP + 32 * mt) * 1024, 1024, Bg, Bg + 128 * 1024, 1024, P, tid, lane, w); }
        __syncthreads();
        pg8::Gemm g{XB, (const bf16_t*)(ws + WS_WGU), MP, 2 * DFF, 1024}; pg8::StaticOrder S; S.init(MP, 2 * DFF, G, bx);
        pg8::EpiGU E{(bf16_t*)(ws + WS_H), (const float*)(ws + WS_SSQ2), (float*)(ws + WS_EDGE), a->in[I_WFC], a->in[I_BFC], a->in[I_SFC], a->out};
        pg8::gemm_phase<pg8::EpiGU, pg8::StaticOrder, true, true>(lds, g, S, E);
    }
    SEAM(8);
    if (IN(9)) {
        for (int t = G - 1 - bx; t < 128; t += G) { const int mt = t >> 3, nt = t & 7; const bf16_t* Bt = (const bf16_t*)(ws + WS_WD) + (size_t)(nt * 128) * DFF;
            SkRes<2> P{a->out, a->out, XB, (float*)(ws + WS_SSQ3), mt, nt * 128}; sk_tile(lds, (const bf16_t*)(ws + WS_H) + (size_t)(MP + 32 * mt) * DFF, DFF, Bt, Bt + 64 * DFF, DFF, P, tid, lane, w); }
        __syncthreads();
        pg8::Gemm g{(const bf16_t*)(ws + WS_H), (const bf16_t*)(ws + WS_WD), MP, 1024, DFF}; pg8::StaticOrder S; S.init(MP, 1024, G, bx);
        pg8::Unit u;
        for (int i = 0; S.next(i, u); ++i) if (u.pm < MP / 256) ffn_fixup_tile(a, u.pm, tid);
        asm volatile("s_waitcnt vmcnt(0)" ::: "memory");
        __syncthreads();
        pg8::EpiRes<2> E{nullptr, a->out, XB, (float*)(ws + WS_SSQ3)};
        pg8::gemm_phase<pg8::EpiRes<2>, pg8::StaticOrder, true, true>(lds, g, S, E);
        if (REPS(9) > 1) { pg8::EpiRes<2, true> E2{nullptr, a->out, XB, (float*)(ws + WS_SSQ3)}; pg8::gemm_phase<pg8::EpiRes<2, true>, pg8::StaticOrder, true, true>(lds, g, S, E2); }
    }
    SEAM(9);
    if (IN(10)) {
        const float* ssq3 = (const float*)(ws + WS_SSQ3); const float* gf = a->in[I_GFIN];
        f32x4 gv[4];
#pragma unroll
        for (int j = 0; j < 4; ++j) gv[j] = *((const f32x4*)gf + lane + 64 * j);
        for (int m0 = bx * NWAVES + w; m0 < MT; m0 += 2 * G * NWAVES) {
            const int m1 = m0 + G * NWAVES; const bool ok1 = m1 < MT;
            f32x4* xr0 = (f32x4*)(a->out + (size_t)m0 * 1024) + lane; f32x4* xr1 = (f32x4*)(a->out + (size_t)(ok1 ? m1 : m0) * 1024) + lane;
            f32x4 v0[4], v1[4]; float s0 = 0.f, s1 = 0.f;
#pragma unroll
            for (int j = 0; j < 4; ++j) { v0[j] = xr0[64 * j]; v1[j] = xr1[64 * j]; }
#pragma unroll
            for (int j = 0; j < 4; ++j) { s0 += (v0[j].x * v0[j].x + v0[j].y * v0[j].y) + (v0[j].z * v0[j].z + v0[j].w * v0[j].w); s1 += (v1[j].x * v1[j].x + v1[j].y * v1[j].y) + (v1[j].z * v1[j].z + v1[j].w * v1[j].w); }
            const float rs0 = __builtin_amdgcn_rsqf(wave_sum(s0) * (1.0f / 1024.0f) + EPS), rs1 = __builtin_amdgcn_rsqf(wave_sum(s1) * (1.0f / 1024.0f) + EPS);
#pragma unroll
            for (int j = 0; j < 4; ++j) xr0[64 * j] = v0[j] * rs0 * gv[j];
            if (ok1) {
#pragma unroll
                for (int j = 0; j < 4; ++j) xr1[64 * j] = v1[j] * rs1 * gv[j];
            }
        }
    }
#ifdef CPROBE
    if (bx == 0) {
        const unsigned* cw = (const unsigned*)(ws + WS_BAR) + CBASE;
        const float eps = (float)__hip_atomic_load(cw + CA, __ATOMIC_RELAXED, __HIP_MEMORY_SCOPE_AGENT) * 1e-5f, dd = (float)__hip_atomic_load(cw + CB, __ATOMIC_RELAXED, __HIP_MEMORY_SCOPE_AGENT) * 1e-4f;
        __syncthreads();
        for (int i = tid; i < 1024; i += NTHREADS) a->out[O_PLH + i] *= (1.0f + eps);
        if (tid == 0) a->out[O_PLC] += dd;
    }
#endif
#ifdef TPROBE
    TSTAMP(11);
    if (bx == 0) {
        __syncthreads();
        const LAS unsigned long long* ts = (const LAS unsigned long long*)(lds + LDS_BYTES - 192);
        const float eps = (float)(ts[TA_HI] - ts[TA_LO]) * 1e-5f, dd = (float)(ts[TB_HI] - ts[TB_LO]) * 1e-4f;
        for (int i = tid; i < 1024; i += NTHREADS) a->out[O_PLH + i] *= (1.0f + eps);
        if (tid == 0) a->out[O_PLC] += dd;
    }
#endif
#undef IN
#undef SEAM
}
constexpr int N_PHASES = 11;

extern "C" void kernel_launch(void* const* d_in, const int* in_sizes, int n_in, void* d_out, int out_size, void* d_ws, size_t ws_size, hipStream_t stream) {
    static int grid = 0;
    if (grid == 0) {
        if (n_in != 34 || ws_size < WS_END) { fprintf(stderr, "kernel_launch: unexpected n_in %d / ws %zu\n", n_in, ws_size); grid = -1; return; }
        int dev = 0, cus = 0, per_cu = 0;
        if (hipGetDevice(&dev) != hipSuccess || hipDeviceGetAttribute(&cus, hipDeviceAttributeMultiprocessorCount, dev) != hipSuccess) { grid = -1; return; }
        if (hipFuncSetAttribute((const void*)hymba_fwd, hipFuncAttributeMaxDynamicSharedMemorySize, LDS_BYTES) != hipSuccess) { fprintf(stderr, "kernel_launch: hipFuncSetAttribute failed\n"); grid = -1; return; }
        if (hipOccupancyMaxActiveBlocksPerMultiprocessor(&per_cu, (const void*)hymba_fwd, NTHREADS, LDS_BYTES) != hipSuccess || per_cu < 1) { fprintf(stderr, "kernel_launch: occupancy query says %d\n", per_cu); per_cu = 1; }
        (void)hipGetLastError();
        grid = cus;
        if (cus != 256) { fprintf(stderr, "kernel_launch: built for a 256-CU device, found %d CUs; nothing launched\n", cus); grid = -1; return; }
    }
    if (grid < 0) return;
    Args a{};
    for (int i = 0; i < 34; ++i) a.in[i] = (const float*)d_in[i];
    a.out = (float*)d_out; a.ws = (unsigned char*)d_ws;
    if (hipMemsetAsync((char*)d_ws + WS_BAR, 0, BAR_ZERO_BYTES, stream) != hipSuccess) { fprintf(stderr, "kernel_launch: memset failed\n"); return; }
#if MK_N_LAUNCHES == 1
    a.ph_lo = 0; a.ph_hi = N_PHASES;
    void* args[] = {&a};
    hipError_t e = hipLaunchCooperativeKernel((const void*)hymba_fwd, dim3(grid), dim3(NTHREADS), args, LDS_BYTES, stream);
    if (e != hipSuccess) fprintf(stderr, "kernel_launch: cooperative launch failed: %s (grid %d)\n", hipGetErrorString(e), grid);
#else
    for (int p = 0; p < N_PHASES; ++p) { a.ph_lo = p; a.ph_hi = p + 1; hipLaunchKernelGGL(hymba_fwd, dim3(grid), dim3(NTHREADS), LDS_BYTES, stream, a); }
#endif
}
```

```cpp
#include <hip/hip_runtime.h>
#include <hip/hip_cooperative_groups.h>
#include <cstdio>
#include <cstdint>
namespace cg = cooperative_groups;

#ifndef MK_N_LAUNCHES
#define MK_N_LAUNCHES 1
#endif

constexpr int MP = 16384, MS = 512, MT = MP + MS;
constexpr int DM = 1024, SEQ = 8192, DIN = 1792, DFF = 3072, DLRU = 512;
constexpr float EPS = 1e-6f;
constexpr float LOG2E = 1.4426950408889634f;
constexpr size_t O_YP = 0, O_YS = 16777216, O_PSK = 17301504, O_PSV = 17334272, O_PMK = 17367040, O_PMV = 17629184, O_PLC = 17891328,
                 O_PLH = 17894400, O_PFC = 17895424, O_SSK = 17907712, O_SSV = 20004864, O_SLC = 22102016, O_SLH = 22298624, O_SFC = 22364160;
constexpr size_t MiB = 1u << 20;
constexpr size_t WS_SSQ0 = 0, WS_SSQ1 = 128 * 1024, WS_SSQ2 = 256 * 1024, WS_SSQ3 = 384 * 1024, WS_SSQM = 512 * 1024, WS_SUMM = 640 * 1024;
constexpr size_t WS_WIN = 1 * MiB, WS_WOUT = 5 * MiB, WS_WQ = 7 * MiB, WS_WKV = 8 * MiB, WS_WMO = 10 * MiB, WS_WGU = 11 * MiB, WS_WD = 23 * MiB;
constexpr size_t WS_MEMA = 29 * MiB, WS_MEMKV = 30 * MiB, WS_EDGE = 31 * MiB, WS_XB = 50 * MiB, WS_PROJ = 83 * MiB, WS_MIX = 141 * MiB, WS_QC = 174 * MiB, WS_OC = 191 * MiB;
constexpr size_t WS_H = 83 * MiB;
constexpr size_t WS_END = 208 * MiB;
static_assert(WS_EDGE + (size_t)264 * 6 * 3072 * 4 <= WS_XB && WS_XB + (size_t)MT * 1024 * 2 <= WS_PROJ && WS_PROJ + (size_t)MT * DIN * 2 <= WS_MIX &&
              WS_MIX + (size_t)MT * 1024 * 2 <= WS_QC && WS_QC + (size_t)MT * 512 * 2 <= WS_OC && WS_OC + (size_t)MT * 512 * 2 <= WS_END && WS_H + (size_t)MT * DFF * 2 <= WS_OC, "ws map");

__device__ __forceinline__ unsigned pkbf(float lo, float hi) {
    typedef float f2_t __attribute__((ext_vector_type(2))); typedef __bf16 b2_t __attribute__((ext_vector_type(2)));
    f2_t v = {lo, hi}; b2_t b = __builtin_convertvector(v, b2_t); return __builtin_bit_cast(unsigned, b);
}
__device__ __forceinline__ float bf2f(unsigned short x) { return __uint_as_float((unsigned)x << 16); }
__device__ __forceinline__ float bflo(unsigned x) { return __uint_as_float(x << 16); }
__device__ __forceinline__ float bfhi(unsigned x) { return __uint_as_float(x & 0xffff0000u); }
__device__ __forceinline__ float fexp2(float x) { return __builtin_amdgcn_exp2f(x); }
__device__ __forceinline__ float frcp(float x) { return __builtin_amdgcn_rcpf(x); }
__device__ __forceinline__ float sigmoidf_(float x) { return frcp(1.0f + fexp2(-LOG2E * x)); }
__device__ __forceinline__ float gelu_tanh(float x) {
    const float t = x * (1.0f + 0.044715f * x * x);
    return x * frcp(1.0f + fexp2(-2.302208198f * t));
}
namespace pg8 {
#define PG8_LAS __attribute__((address_space(3)))
typedef unsigned short bf16_t;
typedef short bf16x8 __attribute__((ext_vector_type(8)));
typedef float f32x4 __attribute__((ext_vector_type(4)));
typedef unsigned u32x4 __attribute__((ext_vector_type(4)));
constexpr int BM = 256, BK = 64, HALF = 128, HTB = HALF * BK * 2  , STAGE_BYTES = 8 * HTB, NXCD = 8, WGM = 8;

__host__ __device__ __forceinline__ int lds_byte(int r, int c) { const int st = (r >> 4) * 2 + (c >> 5), rr = r & 15, cc = c & 31, ob = rr * 64 + cc * 2; return st * 1024 + (ob ^ (((ob >> 9) & 1) << 5)); }
__host__ __device__ __forceinline__ void stage_rc(int b, int& R, int& C) { const int st = b / 1024, sb = b % 1024, swz = sb ^ (((sb >> 9) & 1) << 5); R = (st >> 1) * 16 + swz / 64; C = (st & 1) * 32 + (swz % 64) / 2; }
__host__ __device__ __forceinline__ int perm32(int rho) { const int n = rho >> 4, i = rho & 15; return 8 * (i >> 2) + 4 * n + (i & 3); }

struct Unit { int pm, pn; };
struct Gemm { const bf16_t* A; const bf16_t* Bt; int M, N, K; };

struct StaticOrder {
    int nM, nN, nwg, G, c;
    __host__ __device__ __forceinline__ void init(int M, int N, int G_, int c_) { nM = M / BM; nN = N / BM; nwg = nM * nN; G = G_; c = c_; }
    __host__ __device__ __forceinline__ bool next(int i, Unit& u) const {
        const long L = (long)i * G + c; if (L >= nwg) return false;
        int wgid = (int)L; { const int q = nwg / NXCD, r = nwg % NXCD, xcd = wgid % NXCD, off = wgid / NXCD; wgid = (xcd < r ? xcd * (q + 1) : r * (q + 1) + (xcd - r) * q) + off; }
        const int nig = WGM * nN, gid = wgid / nig, fm = gid * WGM, gsz = (nM - fm) < WGM ? (nM - fm) : WGM;
        u.pm = fm + ((wgid % nig) % gsz); u.pn = (wgid % nig) / gsz; return true;
    }
    __device__ __forceinline__ void a_ready(const Unit&) const {}
    __device__ __forceinline__ void done(const Unit&) const {}
};

#define EPI_ROW(u, ai, m) ((u).pm * BM + (ai) * HALF + wr * 64 + (m) * 16 + fr)
__device__ __forceinline__ void st_bf16x8(bf16_t* p, f32x4 v0, f32x4 v1) { u32x4 w; w.x = pkbf(v0[0], v0[1]); w.y = pkbf(v0[2], v0[3]); w.z = pkbf(v1[0], v1[1]); w.w = pkbf(v1[2], v1[3]); *(u32x4*)p = w; }

struct EpiProj {
    static constexpr bool PERM = true, AFTER_DRAIN = false;
    bf16_t* proj; const float* ssq; float* out;
    __device__ __forceinline__ void operator()(const f32x4 (&acc)[2][2][4][2], const Unit& u, int wr, int wc, int fr, int fq) const {
        float rsv[2][4];
#pragma unroll
        for (int ai = 0; ai < 2; ++ai)
#pragma unroll
            for (int m = 0; m < 4; ++m) rsv[ai][m] = ssq[EPI_ROW(u, ai, m)];
        const int colb = u.pn * BM + wc * 32 + 8 * fq;
        const float qs = (u.pn == 4 || u.pn == 5) ? 0.125f : 1.0f;
#pragma unroll
        for (int ai = 0; ai < 2; ++ai)
#pragma unroll
            for (int m = 0; m < 4; ++m) {
                const int row = EPI_ROW(u, ai, m);
                const float rs = __builtin_amdgcn_rsqf(rsv[ai][m] * (1.0f / 1024.0f) + EPS) * qs;
#pragma unroll
                for (int bj = 0; bj < 2; ++bj) {
                    const int col = colb + bj * HALF;
                    const f32x4 v0 = acc[ai][bj][m][0] * rs, v1 = acc[ai][bj][m][1] * rs;
                    st_bf16x8(proj + (size_t)row * DIN + col, v0, v1);
                    float* dst = nullptr;
                    if (u.pn == 6) {
                        const int kc = wc * 32 + 8 * fq;
                        if (row < MP) { const int t = row & 8191, b = row >> 13; if (t >= 8064) dst = out + (bj ? O_PSV : O_PSK) + (size_t)(b * 128 + t - 8064) * 128 + kc; }
                        else { const int r2 = row - MP, b = r2 >> 2, t = r2 & 3; dst = out + (bj ? O_SSV : O_SSK) + (size_t)(b * 128 + 124 + t) * 128 + kc; }
                    } else if (u.pn < 2) {
                        if (row < MP) { const int t = row & 8191, b = row >> 13; if (t >= 8189) dst = out + O_PLC + (size_t)(b * 3 + t - 8189) * 512 + col; }
                        else { const int r2 = row - MP, b = r2 >> 2, t = r2 & 3; if (t >= 1) dst = out + O_SLC + (size_t)(b * 3 + t - 1) * 512 + col; }
                    }
                    if (dst) { *(f32x4*)dst = v0; *(f32x4*)(dst + 4) = v1; }
                }
            }
    }
};
struct EpiMemKV {
    static constexpr bool PERM = true, AFTER_DRAIN = false;
    bf16_t* memkv; const float* ssq; float* out;
    __device__ __forceinline__ void operator()(const f32x4 (&acc)[2][2][4][2], const Unit& u, int wr, int wc, int fr, int fq) const {
        float rsv[2][4];
#pragma unroll
        for (int ai = 0; ai < 2; ++ai)
#pragma unroll
            for (int m = 0; m < 4; ++m) rsv[ai][m] = ssq[EPI_ROW(u, ai, m)];
        const int colb = u.pn * BM + wc * 32 + 8 * fq;
#pragma unroll
        for (int ai = 0; ai < 2; ++ai)
#pragma unroll
            for (int m = 0; m < 4; ++m) {
                const int row = EPI_ROW(u, ai, m);
                const float rs = __builtin_amdgcn_rsqf(rsv[ai][m] * (1.0f / 1024.0f) + EPS);
#pragma unroll
                for (int bj = 0; bj < 2; ++bj) {
                    const int col = colb + bj * HALF;
                    const f32x4 v0 = acc[ai][bj][m][0] * rs, v1 = acc[ai][bj][m][1] * rs;
                    st_bf16x8(memkv + (size_t)row * 1024 + col, v0, v1);
                    float* dst = out + (col < 512 ? O_PMK + (size_t)row * 512 + col : O_PMV + (size_t)row * 512 + (col - 512));
                    *(f32x4*)dst = v0; *(f32x4*)(dst + 4) = v1;
                }
            }
    }
};
template <int MODE, bool DRY = false> struct EpiRes {
    static constexpr bool PERM = true, AFTER_DRAIN = false;
    const float* resp; float* xout; bf16_t* xb; float* ssq;
    __device__ __forceinline__ void operator()(const f32x4 (&acc)[2][2][4][2], const Unit& u, int wr, int wc, int fr, int fq) const {
        const int colb = u.pn * BM + wc * 32 + 8 * fq;
#pragma unroll
        for (int ai = 0; ai < 2; ++ai) {
            f32x4 rf[4][2][2]; u32x4 rb[4][2];
#pragma unroll
            for (int m = 0; m < 4; ++m)
#pragma unroll
                for (int bj = 0; bj < 2; ++bj) {
                    const int row = EPI_ROW(u, ai, m), col = colb + bj * HALF;
                    if (MODE == 0) { const float* rp = resp + (size_t)row * 1024 + col; rf[m][bj][0] = *(const f32x4*)rp; rf[m][bj][1] = *(const f32x4*)(rp + 4); }
                    else rb[m][bj] = *(const u32x4*)(xb + (size_t)row * 1024 + col);
                }
#pragma unroll
            for (int m = 0; m < 4; ++m) {
                const int row = EPI_ROW(u, ai, m);
                float sq = 0.f;
#pragma unroll
                for (int bj = 0; bj < 2; ++bj) {
                    const int col = colb + bj * HALF;
                    f32x4 v0, v1;
                    if (MODE == 0) { v0 = acc[ai][bj][m][0] + rf[m][bj][0]; v1 = acc[ai][bj][m][1] + rf[m][bj][1]; }
                    else { const u32x4 r = rb[m][bj];
                        v0 = acc[ai][bj][m][0] + (f32x4){bflo(r.x), bfhi(r.x), bflo(r.y), bfhi(r.y)}; v1 = acc[ai][bj][m][1] + (f32x4){bflo(r.z), bfhi(r.z), bflo(r.w), bfhi(r.w)}; }
                    if (!DRY) {
                        if (MODE == 2) { float* op = xout + (size_t)row * 1024 + col; *(f32x4*)op = v0; *(f32x4*)(op + 4) = v1; }
                        else st_bf16x8(xb + (size_t)row * 1024 + col, v0, v1);
                    }
                    sq += (v0[0] * v0[0] + v0[1] * v0[1]) + (v0[2] * v0[2] + v0[3] * v0[3]) + (v1[0] * v1[0] + v1[1] * v1[1]) + (v1[2] * v1[2] + v1[3] * v1[3]);
                }
                if (MODE != 2 || DRY) {
                    sq += __shfl_xor(sq, 16); sq += __shfl_xor(sq, 32);
                    if (!DRY) { if (fq == 0) __hip_atomic_fetch_add(ssq + row, sq, __ATOMIC_RELAXED, __HIP_MEMORY_SCOPE_AGENT); }
                    else if (sq == 12345.678f) ssq[row] = sq;
                }
            }
        }
    }
};
struct EpiQ {
    static constexpr bool PERM = true, AFTER_DRAIN = false;
    bf16_t* qc; const float* ssq;
    __device__ __forceinline__ void operator()(const f32x4 (&acc)[2][2][4][2], const Unit& u, int wr, int wc, int fr, int fq) const {
        float rsv[2][4];
#pragma unroll
        for (int ai = 0; ai < 2; ++ai)
#pragma unroll
            for (int m = 0; m < 4; ++m) rsv[ai][m] = ssq[EPI_ROW(u, ai, m)];
        const int colb = u.pn * BM + wc * 32 + 8 * fq;
#pragma unroll
        for (int ai = 0; ai < 2; ++ai)
#pragma unroll
            for (int m = 0; m < 4; ++m) {
                const int row = EPI_ROW(u, ai, m);
                const float rs = __builtin_amdgcn_rsqf(rsv[ai][m] * (1.0f / 1024.0f) + EPS) * 0.08838834764831845f;
#pragma unroll
                for (int bj = 0; bj < 2; ++bj) st_bf16x8(qc + (size_t)row * 512 + colb + bj * HALF, acc[ai][bj][m][0] * rs, acc[ai][bj][m][1] * rs);
            }
    }
};
__device__ __forceinline__ float dpp_ror1(float v) { return __builtin_bit_cast(float, __builtin_amdgcn_update_dpp(0, __builtin_bit_cast(int, v), 0x121, 0xf, 0xf, false)); }
__device__ __forceinline__ float dpp_ror2(float v) { return __builtin_bit_cast(float, __builtin_amdgcn_update_dpp(0, __builtin_bit_cast(int, v), 0x122, 0xf, 0xf, false)); }
struct EpiGU {
    static constexpr bool PERM = true, AFTER_DRAIN = false;
    bf16_t* h; const float* ssq; float* edge; const float* wconv; const float* bconv; const float* state; float* out;
    __device__ __forceinline__ void operator()(const f32x4 (&acc)[2][2][4][2], const Unit& u, int wr, int wc, int fr, int fq) const {
        float rsv[2][4];
#pragma unroll
        for (int ai = 0; ai < 2; ++ai)
#pragma unroll
            for (int m = 0; m < 4; ++m) rsv[ai][m] = ssq[EPI_ROW(u, ai, m)];
        const int chb = u.pn * HALF + wc * 32 + 8 * fq;
        const bool sample = u.pm >= MP / BM;
#pragma unroll
        for (int n = 0; n < 2; ++n) {
            const int ch = chb + 4 * n;
            const f32x4 w0 = *(const f32x4*)(wconv + ch), w1 = *(const f32x4*)(wconv + DFF + ch), w2 = *(const f32x4*)(wconv + 2 * DFF + ch), bc = *(const f32x4*)(bconv + ch);
#pragma unroll
            for (int ai = 0; ai < 2; ++ai) {
                f32x4 p1p = {0.f, 0.f, 0.f, 0.f}, p2p = {0.f, 0.f, 0.f, 0.f};
#pragma unroll
                for (int m = 0; m < 4; ++m) {
                    const int row = EPI_ROW(u, ai, m);
                    const float rs = __builtin_amdgcn_rsqf(ssq[row] * (1.0f / 1024.0f) + EPS);
                    const f32x4 g = acc[ai][0][m][n] * rs, up = acc[ai][1][m][n] * rs;
                    f32x4 p1, p2, g1, g2;
#pragma unroll
                    for (int j = 0; j < 4; ++j) { p1[j] = dpp_ror1(g[j]); p2[j] = dpp_ror2(g[j]); }
                    if (!sample) {
                        g1 = fr >= 1 ? p1 : p1p; g2 = fr >= 2 ? p2 : p2p; p1p = p1; p2p = p2;
                        const int blk = row >> 6;
                        if (m == 0 && fr < 2) { *(f32x4*)(edge + ((size_t)blk * 6 + fr) * DFF + ch) = g; *(f32x4*)(edge + ((size_t)blk * 6 + 4 + fr) * DFF + ch) = up; }
                        if (m == 3 && fr >= 14) {
                            *(f32x4*)(edge + ((size_t)blk * 6 + 2 + (fr - 14)) * DFF + ch) = g;
                            if ((blk & 127) == 127) *(f32x4*)(out + O_PFC + (size_t)((blk >> 7) * 2 + (fr - 14)) * DFF + ch) = g;
                        }
                    } else {
                        const int r2 = row - MP, bs = r2 >> 2, t = r2 & 3;
                        f32x4 s1 = {0.f, 0.f, 0.f, 0.f}, s0 = {0.f, 0.f, 0.f, 0.f};
                        if (t < 2) s1 = *(const f32x4*)(state + ((size_t)bs * 2 + 1) * DFF + ch);
                        if (t == 0) s0 = *(const f32x4*)(state + ((size_t)bs * 2 + 0) * DFF + ch);
                        g1 = t >= 1 ? p1 : s1; g2 = t >= 2 ? p2 : (t == 1 ? s1 : s0);
                        if (t >= 2) *(f32x4*)(out + O_SFC + ((size_t)bs * 2 + (t - 2)) * DFF + ch) = g;
                    }
                    const f32x4 gc = bc + w0 * g2 + w1 * g1 + w2 * g;
                    f32x4 hv;
#pragma unroll
                    for (int j = 0; j < 4; ++j) hv[j] = gelu_tanh(gc[j]) * up[j];
                    typedef unsigned u32x2_t __attribute__((ext_vector_type(2)));
                    u32x2_t w; w.x = pkbf(hv[0], hv[1]); w.y = pkbf(hv[2], hv[3]);
                    *(u32x2_t*)(h + (size_t)row * DFF + ch) = w;
                }
            }
        }
    }
};
template <class Epi, class Sched, bool ALIGN_EPI = false, bool SP2 = false>
__device__ __forceinline__ void gemm_phase(PG8_LAS unsigned char* lds, const Gemm g, const Sched& S, const Epi& E) {
    const int tid = threadIdx.x, wid = __builtin_amdgcn_readfirstlane(tid >> 6), lane = tid & 63, wr = wid >> 2, wc = wid & 3, fr = lane & 15, fq = lane >> 4;
    const int K = g.K, nt = K / BK;
    unsigned voffA[2], voffB[2];
#pragma unroll
    for (int i = 0; i < 2; ++i) { int R, C; stage_rc(tid * 16 + i * 8192, R, C); const int Rb = Epi::PERM ? ((R & ~31) + perm32(R & 31)) : R;
        voffA[i] = (unsigned)(R * K + C) * 2u; voffB[i] = (unsigned)(Rb * K + C) * 2u; }
    const size_t kstep = (size_t)(BK * 2);
    const size_t hstep = (size_t)HALF * K * 2;
    const size_t tstep = 2 * hstep;
    const unsigned ldsw = (unsigned)wid * 1024u;
    const int aoff = lds_byte(wr * 64 + fr, fq * 8), boff = lds_byte(wc * 32 + fr, fq * 8);
#define PG8_SA(b, h) (((b) * 2 + (h)) * HTB)
#define PG8_SB(b, h) ((4 + (b) * 2 + (h)) * HTB)
#define PG8_STAGE(bufoff, gbase, voff) do { _Pragma("unroll") for (int _i = 0; _i < 2; ++_i) \
        __builtin_amdgcn_global_load_lds((const unsigned*)((const char*)(gbase) + (voff)[_i]), (PG8_LAS unsigned*)(lds + (bufoff) + ldsw + _i * 8192), 16, 0, 0); } while (0)
#define PG8_LDA(dst, b, h) do { _Pragma("unroll") for (int m = 0; m < 4; ++m) _Pragma("unroll") for (int k = 0; k < 2; ++k) dst[m][k] = *(const PG8_LAS bf16x8*)(lds + PG8_SA(b, h) + aoff + m * 2048 + k * 1024); } while (0)
#define PG8_LDB(dst, b, h) do { _Pragma("unroll") for (int n = 0; n < 2; ++n) _Pragma("unroll") for (int k = 0; k < 2; ++k) dst[n][k] = *(const PG8_LAS bf16x8*)(lds + PG8_SB(b, h) + boff + n * 2048 + k * 1024); } while (0)
#define PG8_MMA(ai, bj, At, Bt) do { __builtin_amdgcn_s_setprio(1); _Pragma("unroll") for (int m = 0; m < 4; ++m) _Pragma("unroll") for (int n = 0; n < 2; ++n) _Pragma("unroll") for (int k = 0; k < 2; ++k) \
        acc[ai][bj][m][n] = __builtin_amdgcn_mfma_f32_16x16x32_bf16(Bt[n][k], At[m][k], acc[ai][bj][m][n], 0, 0, 0); __builtin_amdgcn_s_setprio(0); } while (0)
#define PG8_WAIT_V(n) asm volatile("s_waitcnt vmcnt(" #n ")" ::: "memory")
#define PG8_WAIT_L(n) asm volatile("s_waitcnt lgkmcnt(" #n ")" ::: "memory")
#define PG8_BAR __builtin_amdgcn_s_barrier()
#define PG8_SCHED __builtin_amdgcn_sched_barrier(0)
    Unit cur, nxt; int ui = 0;
    if (!S.next(0, cur)) return;
    f32x4 acc[2][2][4][2];
#pragma unroll
    for (int a = 0; a < 2; ++a)
#pragma unroll
        for (int b = 0; b < 2; ++b)
#pragma unroll
            for (int m = 0; m < 4; ++m)
#pragma unroll
                for (int n = 0; n < 2; ++n) acc[a][b][m][n] = (f32x4){0.f, 0.f, 0.f, 0.f};
    bf16x8 At[4][2], B0[2][2], B1[2][2];
    const char* cA = (const char*)g.A + (size_t)cur.pm * tstep; const char* cB = (const char*)g.Bt + (size_t)cur.pn * tstep;
    S.a_ready(cur);
    if constexpr (SP2) {
        PG8_STAGE(PG8_SB(0, 0), cB, voffB); PG8_STAGE(PG8_SB(0, 1), cB + hstep, voffB); PG8_STAGE(PG8_SA(0, 0), cA, voffA); PG8_STAGE(PG8_SA(0, 1), cA + hstep, voffA);
        if (wr == 1) PG8_BAR;
        PG8_WAIT_V(2); PG8_BAR;
        PG8_STAGE(PG8_SB(1, 0), cB + kstep, voffB); PG8_STAGE(PG8_SA(1, 0), cA + kstep, voffA); PG8_STAGE(PG8_SB(1, 1), cB + hstep + kstep, voffB);
        PG8_WAIT_V(6); PG8_BAR;
    } else {
        PG8_STAGE(PG8_SB(0, 0), cB, voffB); PG8_STAGE(PG8_SA(0, 0), cA, voffA); PG8_STAGE(PG8_SB(0, 1), cB + hstep, voffB); PG8_STAGE(PG8_SA(0, 1), cA + hstep, voffA);
        if (wr == 1) PG8_BAR;
        PG8_WAIT_V(4); PG8_BAR;
        PG8_STAGE(PG8_SB(1, 0), cB + kstep, voffB); PG8_STAGE(PG8_SA(1, 0), cA + kstep, voffA); PG8_STAGE(PG8_SB(1, 1), cB + hstep + kstep, voffB);
        PG8_WAIT_V(6); PG8_BAR;
    }
    for (;;) {
        const bool has_next = S.next(ui + 1, nxt);
        const char* nA = has_next ? (const char*)g.A + (size_t)nxt.pm * tstep : cA; const char* nB = has_next ? (const char*)g.Bt + (size_t)nxt.pn * tstep : cB;
        for (int t = 0; t < nt; t += 2) {
            const bool last = (t == nt - 2);
            const char* a1 = cA + (size_t)(t + 1) * kstep;
            const char* a2 = last ? nA : cA + (size_t)(t + 2) * kstep; const char* b2 = last ? nB : cB + (size_t)(t + 2) * kstep;
            const char* a3 = a2 + kstep; const char* b3 = b2 + kstep;
            if (last && has_next) S.a_ready(nxt);
            if constexpr (SP2) {
            PG8_LDB(B0, 0, 0); PG8_LDB(B1, 0, 1); PG8_SCHED; PG8_LDA(At, 0, 0); PG8_STAGE(PG8_SA(1, 1), a1 + hstep, voffA);
            PG8_WAIT_V(8); PG8_WAIT_L(0); PG8_BAR; PG8_MMA(0, 0, At, B0); PG8_MMA(0, 1, At, B1); PG8_BAR; PG8_SCHED;
            PG8_LDA(At, 0, 1); PG8_STAGE(PG8_SB(0, 0), b2, voffB); PG8_STAGE(PG8_SB(0, 1), b2 + hstep, voffB); PG8_STAGE(PG8_SA(0, 0), a2, voffA);
            PG8_WAIT_V(8); PG8_WAIT_L(0); PG8_BAR; PG8_MMA(1, 0, At, B0); PG8_MMA(1, 1, At, B1); PG8_BAR; PG8_SCHED;
            PG8_LDB(B0, 1, 0); PG8_LDB(B1, 1, 1); PG8_SCHED; PG8_LDA(At, 1, 0); PG8_STAGE(PG8_SA(0, 1), a2 + hstep, voffA);
            PG8_WAIT_V(8); PG8_WAIT_L(0); PG8_BAR; PG8_MMA(0, 0, At, B0); PG8_MMA(0, 1, At, B1); PG8_BAR; PG8_SCHED;
            PG8_LDA(At, 1, 1); PG8_STAGE(PG8_SB(1, 0), b3, voffB); PG8_STAGE(PG8_SB(1, 1), b3 + hstep, voffB); PG8_STAGE(PG8_SA(1, 0), a3, voffA);
            PG8_WAIT_V(8); PG8_WAIT_L(0); PG8_BAR; PG8_MMA(1, 0, At, B0); PG8_MMA(1, 1, At, B1); PG8_BAR; PG8_SCHED;
            } else {
            PG8_LDB(B0, 0, 0); PG8_SCHED; PG8_LDA(At, 0, 0); PG8_STAGE(PG8_SA(1, 1), a1 + hstep, voffA);
            PG8_WAIT_L(8); PG8_BAR; PG8_WAIT_L(0); PG8_MMA(0, 0, At, B0); PG8_BAR; PG8_SCHED;
            PG8_LDB(B1, 0, 1); PG8_STAGE(PG8_SB(0, 0), b2, voffB);
            PG8_BAR; PG8_WAIT_L(0); PG8_MMA(0, 1, At, B1); PG8_BAR;
            PG8_LDA(At, 0, 1); PG8_STAGE(PG8_SA(0, 0), a2, voffA);
            PG8_BAR; PG8_WAIT_L(0); PG8_MMA(1, 0, At, B0); PG8_BAR; PG8_SCHED;
            PG8_STAGE(PG8_SB(0, 1), b2 + hstep, voffB);
            PG8_WAIT_V(6); PG8_BAR; PG8_MMA(1, 1, At, B1); PG8_BAR;
            PG8_LDB(B0, 1, 0); PG8_SCHED; PG8_LDA(At, 1, 0); PG8_STAGE(PG8_SA(0, 1), a2 + hstep, voffA);
            PG8_WAIT_L(8); PG8_BAR; PG8_WAIT_L(0); PG8_MMA(0, 0, At, B0); PG8_BAR; PG8_SCHED;
            PG8_LDB(B1, 1, 1); PG8_STAGE(PG8_SB(1, 0), b3, voffB);
            PG8_BAR; PG8_WAIT_L(0); PG8_MMA(0, 1, At, B1); PG8_BAR;
            PG8_LDA(At, 1, 1); PG8_STAGE(PG8_SA(1, 0), a3, voffA);
            PG8_BAR; PG8_WAIT_L(0); PG8_MMA(1, 0, At, B0); PG8_BAR; PG8_SCHED;
            PG8_STAGE(PG8_SB(1, 1), b3 + hstep, voffB);
            PG8_WAIT_V(6); PG8_BAR; PG8_MMA(1, 1, At, B1); PG8_BAR;
            }
        }
        if constexpr (ALIGN_EPI) { if (wr == 0) PG8_BAR; }
        if constexpr (!Epi::AFTER_DRAIN) { E(acc, cur, wr, wc, fr, fq); S.done(cur); }
        if (!has_next) break;
#pragma unroll
        for (int a = 0; a < 2; ++a)
#pragma unroll
            for (int b = 0; b < 2; ++b)
#pragma unroll
                for (int m = 0; m < 4; ++m)
#pragma unroll
                    for (int n = 0; n < 2; ++n) acc[a][b][m][n] = (f32x4){0.f, 0.f, 0.f, 0.f};
        cur = nxt; cA = nA; cB = nB; ++ui;
        if constexpr (ALIGN_EPI) { if (wr == 1) PG8_BAR; }
    }
    PG8_WAIT_V(0);
    if constexpr (!ALIGN_EPI) { if (wr == 0) PG8_BAR; }
    PG8_BAR;
    if constexpr (Epi::AFTER_DRAIN) { E.fused(acc, cur, wr, wc, fr, fq, lds, wid, lane); S.done(cur); }
#undef PG8_SA
#undef PG8_SB
#undef PG8_STAGE
#undef PG8_LDA
#undef PG8_LDB
#undef PG8_MMA
#undef PG8_WAIT_V
#undef PG8_WAIT_L
#undef PG8_BAR
#undef PG8_SCHED
}
}

#define LAS __attribute__((address_space(3)))
typedef unsigned short bf16_t;
typedef short bf16x8 __attribute__((ext_vector_type(8)));
typedef short s16x4 __attribute__((ext_vector_type(4)));
typedef float f32x4 __attribute__((ext_vector_type(4)));
typedef float f32x16 __attribute__((ext_vector_type(16)));
typedef unsigned u32x4 __attribute__((ext_vector_type(4)));
typedef unsigned u32x2 __attribute__((ext_vector_type(2)));
typedef LAS unsigned char* ldsp;
constexpr int NWAVES = 8, NTHREADS = 512, LDS_BYTES = 147456;
#define MFMA32(a, b, c) __builtin_amdgcn_mfma_f32_32x32x16_bf16((a), (b), (c), 0, 0, 0)
#define MFMA16(a, b, c) __builtin_amdgcn_mfma_f32_16x16x32_bf16((a), (b), (c), 0, 0, 0)
__device__ __forceinline__ int crow(int r, int hi) { return (r & 3) + 8 * (r >> 2) + 4 * hi; }
__device__ __forceinline__ unsigned f2bf(float f) { return pkbf(f, 0.f) & 0xffffu; }
__device__ __forceinline__ float wave_sum(float v) {
#pragma unroll
    for (int o = 1; o < 64; o <<= 1) v += __shfl_xor(v, o);
    return v;
}
__device__ __forceinline__ bf16x8 pack8(const f32x16& x, int s) {
    u32x4 p; p.x = pkbf(x[8 * s], x[8 * s + 1]); p.y = pkbf(x[8 * s + 2], x[8 * s + 3]); p.z = pkbf(x[8 * s + 4], x[8 * s + 5]); p.w = pkbf(x[8 * s + 6], x[8 * s + 7]);
    return __builtin_bit_cast(bf16x8, p);
}

struct Args {
    const float* in[34]; float* out; unsigned char* ws; int ph_lo, ph_hi;
};
typedef const __attribute__((address_space(4))) Args* KA;
enum { I_XP = 0, I_XS, I_CSK, I_CSV, I_CMK, I_CMV, I_SLC, I_SLH, I_SFC, I_MEMP, I_GMIX, I_WIN, I_WLC, I_BLC, I_WLA, I_BLA, I_WLX, I_BLX, I_LAM, I_SINK, I_WOUT, I_GCROSS, I_GMEM,
       I_WMQ, I_WMK, I_WMV, I_WMO, I_GFFN, I_WFG, I_WFU, I_WFC, I_BFC, I_WFD, I_GFIN };

#define RLX_AGENT __ATOMIC_RELAXED, __HIP_MEMORY_SCOPE_AGENT
constexpr size_t WS_BAR = 896 * 1024, BAR_ZERO_BYTES = 16384;
__device__ unsigned g_bar[4096];
constexpr int MISC_OFF = LDS_BYTES - 64;
#define XB_TMO      128
#define XB_XCNT(j)  (256  + 64 * (j))
#define XB_XSUB(j)  (1280 + 64 * (j))
#define XB_XGEN(j)  (2304 + 64 * (j))
#define XB_TOP      3328
#define XB_TOPGEN   3392
#define XCD_BAR_WORDS 3456
#define XB_SPIN_CAP (1u << 18)

__device__ __forceinline__ unsigned xb_ld(unsigned* p)              { return __hip_atomic_load(p, __ATOMIC_RELAXED, __HIP_MEMORY_SCOPE_AGENT); }
__device__ __forceinline__ unsigned xb_add(unsigned* p, unsigned v) { return __hip_atomic_fetch_add(p, v, __ATOMIC_RELAXED, __HIP_MEMORY_SCOPE_AGENT); }
__device__ __forceinline__ unsigned xb_xcc_id() { return (unsigned)__builtin_amdgcn_s_getreg((3 << 11) | 20) & 0xFu; }
#define XB_SPIN(cond, bar) do { unsigned _sp = 0; while (cond) { __builtin_amdgcn_s_sleep(1); \
    if ((++_sp & 255u) == 0u) { if (xb_ld(&(bar)[XB_TMO])) break; if (_sp > XB_SPIN_CAP) { atomicAdd(&(bar)[XB_TMO], 1u); break; } } } } while (0)

struct XcdBarrier {
    unsigned* bar; unsigned x;
    volatile LAS unsigned* st;
};

__device__ __forceinline__ XcdBarrier xcd_barrier_post(unsigned* bar, volatile LAS unsigned* st) {
    XcdBarrier b; b.bar = bar; b.x = xb_xcc_id(); b.st = st;
    if (threadIdx.x == 0) (void)xb_add(&bar[XB_XCNT(b.x)], 1u);
    return b;
}
__device__ __forceinline__ void xcd_barrier_complete(unsigned* bar, unsigned x, unsigned& nloc, unsigned& nx) {
    const unsigned G = gridDim.x * gridDim.y * gridDim.z;
    unsigned sum, cnt, mine, sp = 0u;
    for (;;) {
        sum = 0u; cnt = 0u; mine = 0u;
#pragma unroll
        for (unsigned j = 0; j < 16; ++j) { const unsigned c = xb_ld(&bar[XB_XCNT(j)]); sum += c; cnt += (c > 0u) ? 1u : 0u; mine = (j == x) ? c : mine; }
        if (sum == G) break;
        __builtin_amdgcn_s_sleep(1);
        if ((++sp & 255u) == 0u) { if (xb_ld(&bar[XB_TMO])) break; if (sp > XB_SPIN_CAP) { atomicAdd(&bar[XB_TMO], 1u); break; } }
    }
    nloc = mine > 0u ? mine : 1u; nx = cnt > 0u ? cnt : 1u;
}

__device__ __forceinline__ void xcd_barrier(const XcdBarrier& b) {
    asm volatile("s_waitcnt vmcnt(0)" ::: "memory");
    __syncthreads();
    if (threadIdx.x == 0) {
        unsigned* bar = b.bar;
        __builtin_amdgcn_s_waitcnt(0);
        unsigned nloc = b.st[0], nx = b.st[1];
        if (nloc == 0u) { xcd_barrier_complete(bar, b.x, nloc, nx); b.st[0] = nloc; b.st[1] = nx; }
        const unsigned old = xb_add(&bar[XB_XSUB(b.x)], 1u);
        const unsigned gen = old / nloc;
        if (old + 1u == (gen + 1u) * nloc) {
            __builtin_amdgcn_fence(__ATOMIC_RELEASE, "agent");
            asm volatile("s_waitcnt vmcnt(0)" ::: "memory");
            const unsigned og = xb_add(&bar[XB_TOP], 1u);
            const unsigned tg = og / nx;
            if (og + 1u == (tg + 1u) * nx) xb_add(&bar[XB_TOPGEN], 1u);
            else XB_SPIN(xb_ld(&bar[XB_TOPGEN]) == tg, bar);
            __builtin_amdgcn_fence(__ATOMIC_ACQUIRE, "agent");
            xb_add(&bar[XB_XGEN(b.x)], 1u);
            asm volatile("s_waitcnt vmcnt(0)" ::: "memory");
        } else {
            XB_SPIN(xb_ld(&bar[XB_XGEN(b.x)]) == gen, bar);
            __builtin_amdgcn_fence(__ATOMIC_ACQUIRE, "agent");
            asm volatile("s_waitcnt vmcnt(0)" ::: "memory");
        }
    }
    __syncthreads();
}

__device__ __forceinline__ void p0_transpose_item(const float* W, const float* g, int K, int N, bf16_t* WT, int row_off, int ilv, LAS float* scr, int item, int lane) {
    const int nblk = N / 32, kb = item / nblk, nb = item % nblk, k0 = 64 * kb, n0 = 32 * nb;
#pragma unroll
    for (int i = 0; i < 32; ++i) { const int kk = 2 * i + (lane >> 5); const float s = g ? g[k0 + kk] : 1.0f; scr[kk * 33 + (lane & 31)] = W[(size_t)(k0 + kk) * N + n0 + (lane & 31)] * s; }
    asm volatile("s_waitcnt lgkmcnt(0)" ::: "memory");
    const int c = lane & 7;
    const int rbase = ilv ? (((n0 >> 7) << 8) + (n0 & 127) + (ilv == 2 ? 128 : 0)) : (row_off + n0);
#pragma unroll
    for (int j = 0; j < 4; ++j) { const int n = (lane >> 3) + 8 * j; const LAS float* s = scr + (8 * c) * 33 + n;
        u32x4 o; o.x = pkbf(s[0 * 33], s[1 * 33]); o.y = pkbf(s[2 * 33], s[3 * 33]); o.z = pkbf(s[4 * 33], s[5 * 33]); o.w = pkbf(s[6 * 33], s[7 * 33]);
        *(u32x4*)(WT + (size_t)(rbase + n) * K + k0 + 8 * c) = o; }
    asm volatile("s_waitcnt lgkmcnt(0)" ::: "memory");
}
__device__ __forceinline__ void row_to_bf16(const float* xrow, bf16_t* orow, float* ssq, int lane) {
    const f32x4* xr = (const f32x4*)xrow + lane;
    f32x4 v[4]; float s = 0.f;
#pragma unroll
    for (int j = 0; j < 4; ++j) { v[j] = xr[64 * j]; s += (v[j].x * v[j].x + v[j].y * v[j].y) + (v[j].z * v[j].z + v[j].w * v[j].w); }
    s = wave_sum(s);
    u32x2* o8 = (u32x2*)orow + lane;
#pragma unroll
    for (int j = 0; j < 4; ++j) { u32x2 w; w.x = pkbf(v[j].x, v[j].y); w.y = pkbf(v[j].z, v[j].w); o8[64 * j] = w; }
    if (lane == 0) *ssq = s;
}
__device__ __forceinline__ void p0_prologue(KA a, ldsp lds, int tid, int lane, int wave) {
    unsigned char* ws = a->ws;
    LAS float* scr = (LAS float*)(lds + wave * 16384);
    const int gw = blockIdx.x * NWAVES + wave, NGW = gridDim.x * NWAVES;
    constexpr int I_IN = 16 * 56, I_OUT = 16 * 32, I_Q = 16 * 16, I_MO = 8 * 32, I_G = 16 * 96, I_D = 48 * 32;
    constexpr int NITEMS = I_IN + I_OUT + 3 * I_Q + I_MO + 2 * I_G + I_D;
#ifndef P0REP
#define P0REP 0
#endif
    for (int prep = 0; prep < ((P0REP & 1) ? 2 : 1); ++prep)
    for (int it = gw; it < NITEMS; it += NGW) {
        int r = it;
        if (r < I_IN) { p0_transpose_item(a->in[I_WIN], a->in[I_GMIX], 1024, DIN, (bf16_t*)(ws + WS_WIN), 0, 0, scr, r, lane); continue; } r -= I_IN;
        if (r < I_OUT) { p0_transpose_item(a->in[I_WOUT], nullptr, 1024, 1024, (bf16_t*)(ws + WS_WOUT), 0, 0, scr, r, lane); continue; } r -= I_OUT;
        if (r < I_Q) { p0_transpose_item(a->in[I_WMQ], a->in[I_GCROSS], 1024, 512, (bf16_t*)(ws + WS_WQ), 0, 0, scr, r, lane); continue; } r -= I_Q;
        if (r < I_Q) { p0_transpose_item(a->in[I_WMK], a->in[I_GMEM], 1024, 512, (bf16_t*)(ws + WS_WKV), 0, 0, scr, r, lane); continue; } r -= I_Q;
        if (r < I_Q) { p0_transpose_item(a->in[I_WMV], a->in[I_GMEM], 1024, 512, (bf16_t*)(ws + WS_WKV), 512, 0, scr, r, lane); continue; } r -= I_Q;
        if (r < I_MO) { p0_transpose_item(a->in[I_WMO], nullptr, 512, 1024, (bf16_t*)(ws + WS_WMO), 0, 0, scr, r, lane); continue; } r -= I_MO;
        if (r < I_G) { p0_transpose_item(a->in[I_WFG], a->in[I_GFFN], 1024, DFF, (bf16_t*)(ws + WS_WGU), 0, 1, scr, r, lane); continue; } r -= I_G;
        if (r < I_G) { p0_transpose_item(a->in[I_WFU], a->in[I_GFFN], 1024, DFF, (bf16_t*)(ws + WS_WGU), 0, 2, scr, r, lane); continue; } r -= I_G;
        p0_transpose_item(a->in[I_WFD], nullptr, DFF, 1024, (bf16_t*)(ws + WS_WD), 0, 0, scr, r, lane);
    }
    bf16_t* xb = (bf16_t*)(ws + WS_XB); float* ssq0 = (float*)(ws + WS_SSQ0);
    for (int prep2 = 0; prep2 < ((P0REP & 2) ? 2 : 1); ++prep2)
    for (int m0 = gw; m0 < MT + 512; m0 += 2 * NGW) {
        const float* src[2]; bf16_t* dst[2]; float* sq[2]; bool ok[2];
#pragma unroll
        for (int q = 0; q < 2; ++q) { const int m = m0 + q * NGW; ok[q] = m < MT + 512;
            if (m < MP) { src[q] = a->in[I_XP] + (size_t)m * 1024; dst[q] = xb + (size_t)m * 1024; sq[q] = ssq0 + m; }
            else if (m < MT) { src[q] = a->in[I_XS] + (size_t)(m - MP) * 1024; dst[q] = xb + (size_t)m * 1024; sq[q] = ssq0 + m; }
            else { const int rr = ok[q] ? m - MT : 0; src[q] = a->in[I_MEMP] + (size_t)rr * 1024; dst[q] = (bf16_t*)(ws + WS_MEMA) + (size_t)rr * 1024; sq[q] = (float*)(ws + WS_SSQM) + rr; } }
        f32x4 v[2][4]; float s[2] = {0.f, 0.f};
#pragma unroll
        for (int q = 0; q < 2; ++q)
#pragma unroll
            for (int j = 0; j < 4; ++j) v[q][j] = ((const f32x4*)src[q] + lane)[64 * j];
#pragma unroll
        for (int q = 0; q < 2; ++q) {
#pragma unroll
            for (int j = 0; j < 4; ++j) s[q] += (v[q][j].x * v[q][j].x + v[q][j].y * v[q][j].y) + (v[q][j].z * v[q][j].z + v[q][j].w * v[q][j].w);
            s[q] = wave_sum(s[q]);
            if (ok[q]) {
#pragma unroll
                for (int j = 0; j < 4; ++j) { u32x2 wv; wv.x = pkbf(v[q][j].x, v[q][j].y); wv.y = pkbf(v[q][j].z, v[q][j].w); ((u32x2*)dst[q] + lane)[64 * j] = wv; }
                if (lane == 0) *sq[q] = s[q];
            }
        }
    }
    for (int i = blockIdx.x * NTHREADS + tid; i < MT; i += gridDim.x * NTHREADS) { ((float*)(ws + WS_SSQ1))[i] = 0.f; ((float*)(ws + WS_SSQ2))[i] = 0.f; ((float*)(ws + WS_SSQ3))[i] = 0.f; }
}

template <bool SAMPLE, int PASS>
__device__ __forceinline__ void lru_unit(KA a, ldsp lds, int unit, int tid, int lane, int w) {
    constexpr int NTOK = SAMPLE ? 64 : 256, NROW = SAMPLE ? (NTOK / 4) * 7 : NTOK + 3, RS = 272;
    const ldsp XR = lds, XC = lds + 259 * RS;
    unsigned char* ws = a->ws;
    const bf16_t* proj = (const bf16_t*)(ws + WS_PROJ);
    int b = 0, chunk, bp;
    if (!SAMPLE) { b = unit >> 7; chunk = (unit >> 2) & 31; bp = unit & 3; } else { chunk = unit >> 2; bp = unit & 3; }
    const int c0 = bp * 128;
    const int row0 = SAMPLE ? MP + chunk * 64 : b * SEQ + chunk * 256;
    const int nb = w >> 2, jt = w & 3, n = bp * 2 + nb, fr = lane & 15, fq = lane >> 4;
    const int ch = n * 64 + jt * 16 + fr, chl = nb * 64 + jt * 16 + fr;
    float wA[2][8], wX[2][8];
#pragma unroll
    for (int kh = 0; kh < 2; ++kh)
#pragma unroll
        for (int j = 0; j < 8; ++j) { const int c = kh * 32 + 8 * fq + j; const size_t o = (size_t)(n * 64 + c) * 64 + jt * 16 + fr; wA[kh][j] = a->in[I_WLA][o]; wX[kh][j] = a->in[I_WLX][o]; }
    const float ba_ = a->in[I_BLA][ch], bx_ = a->in[I_BLX][ch];
    const float lam = a->in[I_LAM][ch];
    const float wc0 = a->in[I_WLC][ch], wc1 = a->in[I_WLC][512 + ch], wc2 = a->in[I_WLC][1024 + ch], wc3 = a->in[I_WLC][1536 + ch], bcv = a->in[I_BLC][ch];
    float hc = 0.f, Atot = 1.f, Htot = 0.f;
    float* summ = (float*)(ws + WS_SUMM);
    typedef float f32x2_ __attribute__((ext_vector_type(2)));
    f32x2_ ah[32];
    if (!SAMPLE && PASS == 2) {
#pragma unroll
        for (int j = 0; j < 32; ++j) ah[j] = *(const f32x2_*)(summ + ((size_t)(b * 32 + j) * 512 + ch) * 2);
    }
    __syncthreads();
#pragma unroll
    for (int it = tid; it < NROW * 16; it += NTHREADS) {
        const int r = it >> 4, cq = it & 15;
        u32x4 v = {0u, 0u, 0u, 0u};
        if (!SAMPLE) { const int t = chunk * 256 - 3 + r; if (t >= 0) v = *(const u32x4*)(proj + (size_t)(b * SEQ + t) * DIN + c0 + cq * 8); }
        else { const int bl = r / 7, rr = r % 7, bs = chunk * 16 + bl;
            if (rr >= 3) v = *(const u32x4*)(proj + (size_t)(MP + bs * 4 + rr - 3) * DIN + c0 + cq * 8);
            else { const float* s = a->in[I_SLC] + (size_t)(bs * 3 + rr) * 512 + c0 + cq * 8; const f32x4 s0 = *(const f32x4*)s, s1 = *(const f32x4*)(s + 4);
                v.x = pkbf(s0[0], s0[1]); v.y = pkbf(s0[2], s0[3]); v.z = pkbf(s1[0], s1[1]); v.w = pkbf(s1[2], s1[3]); } }
        *(LAS u32x4*)(XR + r * RS + cq * 16) = v;
    }
    __syncthreads();
    {
        const int cq = tid & 15, tg = tid >> 4;
        float wk[4][8], bb[8];
#pragma unroll
        for (int j = 0; j < 8; ++j) { bb[j] = a->in[I_BLC][c0 + cq * 8 + j];
#pragma unroll
            for (int k = 0; k < 4; ++k) wk[k][j] = a->in[I_WLC][k * 512 + c0 + cq * 8 + j]; }
#pragma unroll
        for (int q = 0; q < NTOK / 32; ++q) {
            const int tok = tg * (NTOK / 32) + q; const int base = SAMPLE ? (tok >> 2) * 7 + (tok & 3) : tok;
            float x[8];
#pragma unroll
            for (int j = 0; j < 8; ++j) x[j] = bb[j];
#pragma unroll
            for (int k = 0; k < 4; ++k) { const u32x4 v = *(const LAS u32x4*)(XR + (base + k) * RS + cq * 16);
                x[0] += wk[k][0] * bflo(v.x); x[1] += wk[k][1] * bfhi(v.x); x[2] += wk[k][2] * bflo(v.y); x[3] += wk[k][3] * bfhi(v.y);
                x[4] += wk[k][4] * bflo(v.z); x[5] += wk[k][5] * bfhi(v.z); x[6] += wk[k][6] * bflo(v.w); x[7] += wk[k][7] * bfhi(v.w); }
            u32x4 o; o.x = pkbf(x[0], x[1]); o.y = pkbf(x[2], x[3]); o.z = pkbf(x[4], x[5]); o.w = pkbf(x[6], x[7]);
            *(LAS u32x4*)(XC + tok * RS + cq * 16) = o;
        }
    }
    __syncthreads();
    const float sp = (lam > 15.f) ? __expf(-lam) : log1pf(__expf(-lam));
    const float k8 = -8.0f * sp * LOG2E;
    bf16x8 bA[2], bX[2];
#pragma unroll
    for (int kh = 0; kh < 2; ++kh)
#pragma unroll
        for (int j = 0; j < 8; ++j) { bA[kh][j] = (short)f2bf(wA[kh][j]); bX[kh][j] = (short)f2bf(wX[kh][j]); }
    if (!SAMPLE && PASS == 2) {
#pragma unroll
        for (int j = 0; j < 32; ++j) if (j < chunk) hc = ah[j].x * hc + ah[j].y;
    }
    bf16_t* mix = (bf16_t*)(ws + WS_MIX);
    unsigned short gcur[4] = {0, 0, 0, 0}, gnxt[4] = {0, 0, 0, 0};
    if (SAMPLE || PASS == 2) {
#pragma unroll
        for (int r = 0; r < 4; ++r) gcur[r] = proj[((size_t)row0 + 4 * fq + r) * DIN + 512 + ch];
    }
#pragma unroll 2
    for (int s = 0; s < NTOK / 16; ++s) {
        if ((SAMPLE || PASS == 2) && s + 1 < NTOK / 16) {
#pragma unroll
            for (int r = 0; r < 4; ++r) gnxt[r] = proj[((size_t)row0 + 16 * (s + 1) + 4 * fq + r) * DIN + 512 + ch];
        }
        bf16x8 aF[2];
#pragma unroll
        for (int kh = 0; kh < 2; ++kh) aF[kh] = *(const LAS bf16x8*)(XC + (16 * s + fr) * RS + (nb * 64 + kh * 32 + 8 * fq) * 2);
        f32x4 accA = {0.f, 0.f, 0.f, 0.f}, accX = {0.f, 0.f, 0.f, 0.f};
        accA = MFMA16(aF[0], bA[0], accA); accA = MFMA16(aF[1], bA[1], accA);
        accX = MFMA16(aF[0], bX[0], accX); accX = MFMA16(aF[1], bX[1], accX);
        const int base = SAMPLE ? (4 * s + fq) * 7 : 16 * s + 4 * fq;
        float x7[7];
#pragma unroll
        for (int q = 0; q < 7; ++q) x7[q] = bf2f(*(const LAS unsigned short*)(XR + (base + q) * RS + chl * 2));
        float av[4], bv[4];
#pragma unroll
        for (int r = 0; r < 4; ++r) {
            const float xc = bcv + wc0 * x7[r] + wc1 * x7[r + 1] + wc2 * x7[r + 2] + wc3 * x7[r + 3];
            const float rg = sigmoidf_(accA[r] + ba_), ig = sigmoidf_(accX[r] + bx_);
            const float a_ = fexp2(k8 * rg);
            av[r] = a_; bv[r] = __builtin_sqrtf(fmaxf(1.0f - a_ * a_, 0.f)) * (ig * xc);
        }
        float hv[4];
        if (SAMPLE) {
            const int bs = chunk * 16 + 4 * s + fq;
            float h = a->in[I_SLH][(size_t)bs * 512 + ch];
#pragma unroll
            for (int r = 0; r < 4; ++r) { h = av[r] * h + bv[r]; hv[r] = h; }
            a->out[O_SLH + (size_t)bs * 512 + ch] = h;
        } else {
            float Ai = av[0] * av[1] * av[2] * av[3], Hi = 0.f;
#pragma unroll
            for (int r = 0; r < 4; ++r) Hi = av[r] * Hi + bv[r];
            float tA = __shfl_up(Ai, 16), tH = __shfl_up(Hi, 16);
            if (fq >= 1) { Hi = Ai * tH + Hi; Ai = Ai * tA; }
            tA = __shfl_up(Ai, 32); tH = __shfl_up(Hi, 32);
            if (fq >= 2) { Hi = Ai * tH + Hi; Ai = Ai * tA; }
            float Ae = __shfl_up(Ai, 16), He = __shfl_up(Hi, 16);
            if (fq == 0) { Ae = 1.f; He = 0.f; }
            const float At = __shfl(Ai, 48 + fr), Ht = __shfl(Hi, 48 + fr);
            if (PASS == 1) { Htot = At * Htot + Ht; Atot *= At; }
            else {
                float h = Ae * hc + He;
#pragma unroll
                for (int r = 0; r < 4; ++r) { h = av[r] * h + bv[r]; hv[r] = h; }
                hc = At * hc + Ht;
            }
        }
        if (SAMPLE || PASS == 2) {
#pragma unroll
            for (int r = 0; r < 4; ++r) {
                const size_t row = (size_t)row0 + 16 * s + 4 * fq + r;
                mix[row * 1024 + ch] = (bf16_t)f2bf(hv[r] * gelu_tanh(bf2f(gcur[r])));
            }
#pragma unroll
            for (int r = 0; r < 4; ++r) gcur[r] = gnxt[r];
        }
    }
    if (!SAMPLE && PASS == 1 && fq == 0) { summ[((size_t)(b * 32 + chunk) * 512 + ch) * 2] = Atot; summ[((size_t)(b * 32 + chunk) * 512 + ch) * 2 + 1] = Htot; }
    if (!SAMPLE && PASS == 2 && chunk == 31 && fq == 0) a->out[O_PLH + (size_t)b * 512 + ch] = hc;
}

__device__ __forceinline__ void swa_prompt_unit(KA a, ldsp lds, int unit, int tid, int lane, int w) {
    constexpr int KRS = 144, VRS = 400;
    const ldsp Ks = lds, VT = lds + 192 * KRS;
    const bf16_t* proj = (const bf16_t*)(a->ws + WS_PROJ);
    const int b = unit >> 8, hk = (unit >> 7) & 1, qb = unit & 127, t0 = qb * 64;
    __syncthreads();
#pragma unroll
    for (int it = tid; it < 192 * 8; it += NTHREADS) {
        const int kl = it >> 3, cq = it & 7, t = t0 - 128 + kl;
        u32x4 kv = {0u, 0u, 0u, 0u}, vv = {0u, 0u, 0u, 0u};
        if (t >= 0) { const bf16_t* p = proj + (size_t)(b * SEQ + t) * DIN; kv = *(const u32x4*)(p + 1536 + hk * 64 + cq * 8); vv = *(const u32x4*)(p + 1664 + hk * 64 + cq * 8); }
        *(LAS u32x4*)(Ks + kl * KRS + cq * 16) = kv;
#pragma unroll
        for (int e = 0; e < 8; ++e) *(LAS unsigned short*)(VT + (cq * 8 + e) * VRS + kl * 2) = (unsigned short)(vv[e >> 1] >> (16 * (e & 1)));
    }
    __syncthreads();
    const int g = w >> 1, hf = w & 1, hq = hk * 4 + g, j = lane & 31, hi = lane >> 5;
    const size_t qrow = (size_t)b * SEQ + t0 + 32 * hf + j;
    bf16x8 qf[4];
#pragma unroll
    for (int ks = 0; ks < 4; ++ks) qf[ks] = *(const bf16x8*)(proj + qrow * DIN + 1024 + hq * 64 + 16 * ks + 8 * hi);
    const float slope2 = fexp2(-(float)(hq + 1)) * LOG2E, sink2 = a->in[I_SINK][hq] * LOG2E;
    float mx = sink2;
    f32x16 st[5];
#pragma unroll
    for (int kt = 0; kt < 5; ++kt) {
        f32x16 acc = {};
#pragma unroll
        for (int ks = 0; ks < 4; ++ks) { const bf16x8 kf = *(const LAS bf16x8*)(Ks + (32 * hf + 32 * kt + j) * KRS + (16 * ks + 8 * hi) * 2); acc = MFMA32(kf, qf[ks], acc); }
        int dbase = 128 + j - 32 * kt - 4 * hi;
        int kpb = t0 - 128 + 32 * hf + 32 * kt + 4 * hi;
        asm volatile("" : "+v"(dbase), "+v"(kpb));
#pragma unroll
        for (int r = 0; r < 16; ++r) {
            const int cr = (r & 3) + 8 * (r >> 2), dist = dbase - cr;
            const bool valid = (unsigned)dist < 128u && (kpb + cr) >= 0;
            float s = acc[r] * LOG2E - slope2 * (float)dist; s = valid ? s : -1e30f; acc[r] = s; mx = fmaxf(mx, s);
        }
        st[kt] = acc;
        __builtin_amdgcn_sched_barrier(0);
    }
    mx = fmaxf(mx, __shfl_xor(mx, 32));
    float l = 0.f;
#pragma unroll
    for (int kt = 0; kt < 5; ++kt)
#pragma unroll
        for (int r = 0; r < 16; ++r) { const float p = fexp2(st[kt][r] - mx); st[kt][r] = p; l += p; }
    l += __shfl_xor(l, 32); l += fexp2(sink2 - mx);
    const float inv = frcp(l);
    f32x16 o[2] = {};
#pragma unroll
    for (int kt = 0; kt < 5; ++kt)
#pragma unroll
        for (int s = 0; s < 2; ++s) {
            const bf16x8 pf = pack8(st[kt], s);
#pragma unroll
            for (int dt = 0; dt < 2; ++dt) {
                const int d = 32 * dt + j, kb = 32 * hf + 32 * kt + 16 * s + 4 * hi;
                const s16x4 lo = *(const LAS s16x4*)(VT + d * VRS + kb * 2), hi4 = *(const LAS s16x4*)(VT + d * VRS + (kb + 8) * 2);
                const bf16x8 vf = __builtin_shufflevector(lo, hi4, 0, 1, 2, 3, 4, 5, 6, 7);
                o[dt] = MFMA32(vf, pf, o[dt]);
            }
            __builtin_amdgcn_sched_barrier(0);
        }
    bf16_t* mix = (bf16_t*)(a->ws + WS_MIX);
#pragma unroll
    for (int dt = 0; dt < 2; ++dt)
#pragma unroll
        for (int rg = 0; rg < 4; ++rg) {
            u32x2 wv; wv.x = pkbf(o[dt][4 * rg] * inv, o[dt][4 * rg + 1] * inv); wv.y = pkbf(o[dt][4 * rg + 2] * inv, o[dt][4 * rg + 3] * inv);
            *(u32x2*)(mix + qrow * 1024 + 512 + hq * 64 + 32 * dt + 8 * rg + 4 * hi) = wv;
        }
}

__device__ __forceinline__ void swa_sample_unit(KA a, ldsp lds, int bs, int tid) {
    LAS float* Kc = (LAS float*)lds;
    LAS float* Vc = (LAS float*)(lds + 69696);
    LAS float* Qs = (LAS float*)(lds + 137280);
    LAS float* P = Kc;
    const bf16_t* proj = (const bf16_t*)(a->ws + WS_PROJ);
    __syncthreads();
    {
        f32x4 kvv[8], vvv[8]; unsigned short qv[4], nk, nv;
#pragma unroll
        for (int q = 0; q < 8; ++q) { const int it = tid + q * NTHREADS, r = it >> 5, c4 = (it & 31) * 4;
            kvv[q] = *(const f32x4*)(a->in[I_CSK] + (size_t)(bs * 128 + r) * 128 + c4); vvv[q] = *(const f32x4*)(a->in[I_CSV] + (size_t)(bs * 128 + r) * 128 + c4); }
#pragma unroll
        for (int q = 0; q < 4; ++q) { const int e = tid + q * NTHREADS, rq = e >> 6, d = e & 63, hq = rq >> 2, i = rq & 3; qv[q] = proj[(size_t)(MP + bs * 4 + i) * DIN + 1024 + hq * 64 + d]; }
        { const int i = tid >> 7, c = tid & 127; const bf16_t* p = proj + (size_t)(MP + bs * 4 + i) * DIN; nk = p[1536 + c]; nv = p[1664 + c]; }
#pragma unroll
        for (int q = 0; q < 8; ++q) { const int it = tid + q * NTHREADS, r = it >> 5, c4 = (it & 31) * 4;
            *(LAS f32x4*)(Kc + r * 132 + c4) = kvv[q]; *(LAS f32x4*)(Vc + r * 128 + c4) = vvv[q];
            if (r >= 4) { *(f32x4*)(a->out + O_SSK + (size_t)(bs * 128 + r - 4) * 128 + c4) = kvv[q]; *(f32x4*)(a->out + O_SSV + (size_t)(bs * 128 + r - 4) * 128 + c4) = vvv[q]; } }
#pragma unroll
        for (int q = 0; q < 4; ++q) { const int e = tid + q * NTHREADS; Qs[e] = bf2f(qv[q]); }
        { const int i = tid >> 7, c = tid & 127; Kc[(128 + i) * 132 + c] = bf2f(nk); Vc[(128 + i) * 128 + c] = bf2f(nv); }
    }
    __syncthreads();
    float sc[16];
    const int rg = tid / 33, kg = tid - rg * 33, hkS = rg >> 2;
#pragma unroll
    for (int q = 0; q < 16; ++q) sc[q] = 0.f;
    if (tid < 264) {
#pragma unroll 2
        for (int c = 0; c < 16; ++c) {
            f32x4 kk[4], qq[4];
#pragma unroll
            for (int i = 0; i < 4; ++i) { kk[i] = *(const LAS f32x4*)(Kc + (kg + 33 * i) * 132 + hkS * 64 + 4 * c); qq[i] = *(const LAS f32x4*)(Qs + (rg * 4 + i) * 64 + 4 * c); }
#pragma unroll
            for (int ri = 0; ri < 4; ++ri)
#pragma unroll
                for (int ki = 0; ki < 4; ++ki) sc[ri * 4 + ki] += (qq[ri][0] * kk[ki][0] + qq[ri][1] * kk[ki][1]) + (qq[ri][2] * kk[ki][2] + qq[ri][3] * kk[ki][3]);
        }
    }
    __syncthreads();
    if (tid < 264) {
#pragma unroll
        for (int ri = 0; ri < 4; ++ri)
#pragma unroll
            for (int ki = 0; ki < 4; ++ki) { const int row = rg * 4 + ri, hq = row >> 2, i = row & 3, key = kg + 33 * ki, dist = i + 128 - key; const bool valid = dist >= 0 && dist < 128;
                const float s = sc[ri * 4 + ki] * LOG2E - fexp2(-(float)(hq + 1)) * LOG2E * (float)dist; P[row * 132 + key] = valid ? s : -1e30f; }
    }
    __syncthreads();
    {
        const int row = tid >> 4, sub = tid & 15, hq = row >> 2; const float sink2 = a->in[I_SINK][hq] * LOG2E;
        float v[9], m = sink2;
#pragma unroll
        for (int jj = 0; jj < 9; ++jj) { const int k2 = sub + 16 * jj; v[jj] = k2 < 132 ? P[row * 132 + k2] : -1e30f; m = fmaxf(m, v[jj]); }
#pragma unroll
        for (int o = 8; o >= 1; o >>= 1) m = fmaxf(m, __shfl_xor(m, o));
        float l = 0.f;
#pragma unroll
        for (int jj = 0; jj < 9; ++jj) { v[jj] = fexp2(v[jj] - m); l += v[jj]; }
#pragma unroll
        for (int o = 8; o >= 1; o >>= 1) l += __shfl_xor(l, o);
        l += fexp2(sink2 - m);
        const float inv = 1.0f / l;
#pragma unroll
        for (int jj = 0; jj < 9; ++jj) { const int k2 = sub + 16 * jj; if (k2 < 132) P[row * 132 + k2] = v[jj] * inv; }
    }
    __syncthreads();
    {
        LAS float* PART2 = Kc + 5120;
        const int lane = tid & 63, d4 = (lane & 15) * 4, kq = lane >> 4, rowgrp = tid >> 6, hk2 = rowgrp >> 2;
        f32x4 acc[4];
#pragma unroll
        for (int ri = 0; ri < 4; ++ri) acc[ri] = (f32x4){0.f, 0.f, 0.f, 0.f};
#pragma unroll 3
        for (int k2 = kq * 33; k2 < kq * 33 + 33; ++k2) { const f32x4 v4 = *(const LAS f32x4*)(Vc + k2 * 128 + hk2 * 64 + d4);
#pragma unroll
            for (int ri = 0; ri < 4; ++ri) acc[ri] += P[(rowgrp * 4 + ri) * 132 + k2] * v4; }
#pragma unroll
        for (int ri = 0; ri < 4; ++ri) *(LAS f32x4*)(PART2 + (kq * 32 + rowgrp * 4 + ri) * 64 + d4) = acc[ri];
    }
    __syncthreads();
    {
        const LAS float* PART2 = Kc + 5120;
        const int row = tid >> 4, d4 = (tid & 15) * 4, hq = row >> 2, i = row & 3;
        f32x4 acc = *(const LAS f32x4*)(PART2 + row * 64 + d4);
#pragma unroll
        for (int p = 1; p < 4; ++p) acc += *(const LAS f32x4*)(PART2 + (p * 32 + row) * 64 + d4);
        u32x2 wv; wv.x = pkbf(acc[0], acc[1]); wv.y = pkbf(acc[2], acc[3]);
        *(u32x2*)((bf16_t*)(a->ws + WS_MIX) + (size_t)(MP + bs * 4 + i) * 1024 + 512 + hq * 64 + d4) = wv;
    }
}

__device__ __forceinline__ void xattn_prompt_unit(KA a, ldsp lds, int unit, int tid, int lane, int w) {
    constexpr int KRS = 272, VRS = 528;
    const ldsp Km = lds, VmT = lds + 256 * KRS;
    const bf16_t* memkv = (const bf16_t*)(a->ws + WS_MEMKV);
    const bf16_t* qcb = (const bf16_t*)(a->ws + WS_QC);
    const int b = unit >> 7, h = (unit >> 5) & 3, qc = unit & 31;
    __syncthreads();
#pragma unroll
    for (int it = tid; it < 256 * 16; it += NTHREADS) {
        const int key = it >> 4, cq = it & 15; const bf16_t* p = memkv + (size_t)(b * 256 + key) * 1024 + h * 128 + cq * 8;
        const u32x4 kv = *(const u32x4*)p, vv = *(const u32x4*)(p + 512);
        *(LAS u32x4*)(Km + key * KRS + cq * 16) = kv;
#pragma unroll
        for (int e = 0; e < 8; ++e) *(LAS unsigned short*)(VmT + (cq * 8 + e) * VRS + key * 2) = (unsigned short)(vv[e >> 1] >> (16 * (e & 1)));
    }
    __syncthreads();
    const int j = lane & 31, hi = lane >> 5;
    const size_t qrow = (size_t)b * SEQ + qc * 256 + 32 * w + j;
    bf16x8 qf[8];
#pragma unroll
    for (int ks = 0; ks < 8; ++ks) qf[ks] = *(const bf16x8*)(qcb + qrow * 512 + h * 128 + 16 * ks + 8 * hi);
    float m = -1e30f, l = 0.f;
    f32x16 o[4] = {};
#pragma unroll
    for (int kh = 0; kh < 2; ++kh) {
        f32x16 st[4];
        float mx = -1e30f;
#pragma unroll
        for (int kt = 0; kt < 4; ++kt) {
            f32x16 acc = {};
#pragma unroll
            for (int ks = 0; ks < 8; ++ks) { const bf16x8 kf = *(const LAS bf16x8*)(Km + (128 * kh + 32 * kt + j) * KRS + (16 * ks + 8 * hi) * 2); acc = MFMA32(kf, qf[ks], acc); }
#pragma unroll
            for (int r = 0; r < 16; ++r) { acc[r] *= LOG2E; mx = fmaxf(mx, acc[r]); }
            st[kt] = acc;
        }
        mx = fmaxf(mx, __shfl_xor(mx, 32));
        const float mn = fmaxf(m, mx), scl = fexp2(m - mn);
        m = mn; l *= scl;
#pragma unroll
        for (int dt = 0; dt < 4; ++dt) o[dt] *= scl;
#pragma unroll
        for (int kt = 0; kt < 4; ++kt)
#pragma unroll
            for (int r = 0; r < 16; ++r) { const float p = fexp2(st[kt][r] - m); st[kt][r] = p; l += p; }
#pragma unroll
        for (int kt = 0; kt < 4; ++kt)
#pragma unroll
            for (int s = 0; s < 2; ++s) {
                const bf16x8 pf = pack8(st[kt], s);
#pragma unroll
                for (int dt = 0; dt < 4; ++dt) {
                    const int d = 32 * dt + j, kb = 128 * kh + 32 * kt + 16 * s + 4 * hi;
                    const s16x4 lo = *(const LAS s16x4*)(VmT + d * VRS + kb * 2), hi4 = *(const LAS s16x4*)(VmT + d * VRS + (kb + 8) * 2);
                    const bf16x8 vf = __builtin_shufflevector(lo, hi4, 0, 1, 2, 3, 4, 5, 6, 7);
                    o[dt] = MFMA32(vf, pf, o[dt]);
                }
            }
    }
    l += __shfl_xor(l, 32);
    const float inv = frcp(l);
    bf16_t* oc = (bf16_t*)(a->ws + WS_OC);
#pragma unroll
    for (int dt = 0; dt < 4; ++dt)
#pragma unroll
        for (int rg = 0; rg < 4; ++rg) {
            u32x2 wv; wv.x = pkbf(o[dt][4 * rg] * inv, o[dt][4 * rg + 1] * inv); wv.y = pkbf(o[dt][4 * rg + 2] * inv, o[dt][4 * rg + 3] * inv);
            *(u32x2*)(oc + qrow * 512 + h * 128 + 32 * dt + 8 * rg + 4 * hi) = wv;
        }
}
__device__ __forceinline__ void xattn_sample_unit(KA a, ldsp lds, int unit, int tid, int lane, int w) {
    LAS float* Qs = (LAS float*)lds;
    LAS float* S = (LAS float*)(lds + 2048);
    LAS float* RED = (LAS float*)(lds + 8192);
    const bf16_t* qcb = (const bf16_t*)(a->ws + WS_QC);
    const int bs = unit >> 2, h = unit & 3;
    __syncthreads();
    { const int i = tid >> 7, d = tid & 127; Qs[i * 128 + d] = bf2f(qcb[(size_t)(MP + bs * 4 + i) * 512 + h * 128 + d]); }
    __syncthreads();
    {
        const int key = tid >> 1, hf = tid & 1; const float* kp = a->in[I_CMK] + ((size_t)(bs * 256 + key) * 4 + h) * 128 + hf * 64;
        float s0 = 0.f, s1 = 0.f, s2 = 0.f, s3 = 0.f;
#pragma unroll
        for (int c = 0; c < 16; ++c) {
            const f32x4 k4 = *(const f32x4*)(kp + 4 * c);
            const f32x4 q0 = *(const LAS f32x4*)(Qs + hf * 64 + 4 * c), q1 = *(const LAS f32x4*)(Qs + 128 + hf * 64 + 4 * c), q2 = *(const LAS f32x4*)(Qs + 256 + hf * 64 + 4 * c), q3 = *(const LAS f32x4*)(Qs + 384 + hf * 64 + 4 * c);
            s0 += (k4[0] * q0[0] + k4[1] * q0[1]) + (k4[2] * q0[2] + k4[3] * q0[3]); s1 += (k4[0] * q1[0] + k4[1] * q1[1]) + (k4[2] * q1[2] + k4[3] * q1[3]);
            s2 += (k4[0] * q2[0] + k4[1] * q2[1]) + (k4[2] * q2[2] + k4[3] * q2[3]); s3 += (k4[0] * q3[0] + k4[1] * q3[1]) + (k4[2] * q3[2] + k4[3] * q3[3]);
        }
        s0 += __shfl_xor(s0, 1); s1 += __shfl_xor(s1, 1); s2 += __shfl_xor(s2, 1); s3 += __shfl_xor(s3, 1);
        if (hf == 0) { S[key] = s0 * LOG2E; S[256 + key] = s1 * LOG2E; S[512 + key] = s2 * LOG2E; S[768 + key] = s3 * LOG2E; }
    }
    __syncthreads();
    if (w < 4) {
        f32x4 v = *(const LAS f32x4*)(S + w * 256 + lane * 4);
        float m = fmaxf(fmaxf(v[0], v[1]), fmaxf(v[2], v[3]));
#pragma unroll
        for (int o = 32; o >= 1; o >>= 1) m = fmaxf(m, __shfl_xor(m, o));
        v[0] = fexp2(v[0] - m); v[1] = fexp2(v[1] - m); v[2] = fexp2(v[2] - m); v[3] = fexp2(v[3] - m);
        const float l = wave_sum((v[0] + v[1]) + (v[2] + v[3]));
        v *= (1.0f / l);
        *(LAS f32x4*)(S + w * 256 + lane * 4) = v;
    }
    __syncthreads();
    {
        const int dq = tid & 31, kg = tid >> 5; const float* vp = a->in[I_CMV] + ((size_t)(bs * 256 + kg * 16) * 4 + h) * 128 + dq * 4;
        f32x4 a0 = {0.f, 0.f, 0.f, 0.f}, a1 = a0, a2 = a0, a3 = a0;
#pragma unroll
        for (int kk = 0; kk < 16; ++kk) { const f32x4 v4 = *(const f32x4*)(vp + (size_t)kk * 512); const int k2 = kg * 16 + kk;
            a0 += S[k2] * v4; a1 += S[256 + k2] * v4; a2 += S[512 + k2] * v4; a3 += S[768 + k2] * v4; }
        *(LAS f32x4*)(RED + (kg * 4 + 0) * 128 + dq * 4) = a0; *(LAS f32x4*)(RED + (kg * 4 + 1) * 128 + dq * 4) = a1;
        *(LAS f32x4*)(RED + (kg * 4 + 2) * 128 + dq * 4) = a2; *(LAS f32x4*)(RED + (kg * 4 + 3) * 128 + dq * 4) = a3;
    }
    __syncthreads();
    { const int i = tid >> 7, d = tid & 127; float s = 0.f;
#pragma unroll
        for (int kg = 0; kg < 16; ++kg) s += RED[(kg * 4 + i) * 128 + d];
        ((bf16_t*)(a->ws + WS_OC))[(size_t)(MP + bs * 4 + i) * 512 + h * 128 + d] = (bf16_t)f2bf(s); }
}


template <class Post> __device__ __forceinline__ void sk_tile(ldsp lds, const bf16_t* A, int lda, const bf16_t* B0, const bf16_t* B1, int K, const Post& post, int tid, int lane, int w) {
    const int fr = lane & 15, fq = lane >> 4, kper = K >> 3;
    const bf16_t* ap = A + (size_t)fr * lda + w * kper + 16 * fq;
    const bf16_t* bp0 = B0 + (size_t)fr * K + w * kper + 16 * fq;
    const bf16_t* bp1 = B1 + (size_t)fr * K + w * kper + 16 * fq;
    f32x4 acc[2][8];
#pragma unroll
    for (int i = 0; i < 2; ++i)
#pragma unroll
        for (int j = 0; j < 8; ++j) acc[i][j] = (f32x4){0.f, 0.f, 0.f, 0.f};
    for (int k0 = 0; k0 < kper; k0 += 128) {
        bf16x8 af[2][2][2], bf[2][8][2];
#pragma unroll
        for (int c = 0; c < 2; ++c) {
            const int kk = k0 + 64 * c;
            if (kk < kper) {
#pragma unroll
                for (int i = 0; i < 2; ++i) { af[c][i][0] = *(const bf16x8*)(ap + (size_t)(16 * i) * lda + kk); af[c][i][1] = *(const bf16x8*)(ap + (size_t)(16 * i) * lda + kk + 8); }
#pragma unroll
                for (int j = 0; j < 4; ++j) { bf[c][j][0] = *(const bf16x8*)(bp0 + (size_t)(16 * j) * K + kk); bf[c][j][1] = *(const bf16x8*)(bp0 + (size_t)(16 * j) * K + kk + 8);
                    bf[c][4 + j][0] = *(const bf16x8*)(bp1 + (size_t)(16 * j) * K + kk); bf[c][4 + j][1] = *(const bf16x8*)(bp1 + (size_t)(16 * j) * K + kk + 8); }
            }
        }
#pragma unroll
        for (int c = 0; c < 2; ++c) {
            if (k0 + 64 * c < kper) {
#pragma unroll
                for (int hl = 0; hl < 2; ++hl)
#pragma unroll
                    for (int i = 0; i < 2; ++i)
#pragma unroll
                        for (int j = 0; j < 8; ++j) acc[i][j] = MFMA16(af[c][i][hl], bf[c][j][hl], acc[i][j]);
            }
        }
    }
    LAS float* PART = (LAS float*)lds;
    __syncthreads();
#pragma unroll
    for (int i = 0; i < 2; ++i)
#pragma unroll
        for (int j = 0; j < 8; ++j)
#pragma unroll
            for (int r = 0; r < 4; ++r) PART[(w * 32 + 16 * i + 4 * fq + r) * 132 + 16 * j + fr] = acc[i][j][r];
    __syncthreads();
    const int row = tid >> 4, cc = tid & 15;
    f32x4 v0 = *(const LAS f32x4*)(PART + row * 132 + 4 * cc), v1 = *(const LAS f32x4*)(PART + row * 132 + 64 + 4 * cc);
#pragma unroll
    for (int p = 1; p < 8; ++p) { v0 += *(const LAS f32x4*)(PART + (p * 32 + row) * 132 + 4 * cc); v1 += *(const LAS f32x4*)(PART + (p * 32 + row) * 132 + 64 + 4 * cc); }
    post(row, cc, v0, v1);
}
__device__ __forceinline__ void st4bf(bf16_t* p, f32x4 v) { u32x2 w_; w_.x = pkbf(v[0], v[1]); w_.y = pkbf(v[2], v[3]); *(u32x2*)p = w_; }
struct SkProj {
    bf16_t* proj; const float* ssq; float* out; int mt, n0;
    __device__ __forceinline__ void operator()(int row, int cc, f32x4 va, f32x4 vb) const {
        const int grow = MP + 32 * mt + row, r2 = grow - MP, b = r2 >> 2, t = r2 & 3;
        const float rs0 = __builtin_amdgcn_rsqf(ssq[grow] * (1.0f / 1024.0f) + EPS);
#pragma unroll
        for (int hh = 0; hh < 2; ++hh) {
            const int col = n0 + hh * 64 + 4 * cc; const float rs = rs0 * ((col >= 1024 && col < 1536) ? 0.125f : 1.0f);
            const f32x4 v = (hh ? vb : va) * rs;
            st4bf(proj + (size_t)grow * DIN + col, v);
            float* dst = nullptr;
            if (col >= 1536) dst = out + (col < 1664 ? O_SSK + (size_t)(b * 128 + 124 + t) * 128 + (col - 1536) : O_SSV + (size_t)(b * 128 + 124 + t) * 128 + (col - 1664));
            else if (col < 512 && t >= 1) dst = out + O_SLC + (size_t)(b * 3 + t - 1) * 512 + col;
            if (dst) *(f32x4*)dst = v;
        }
    }
};
template <int MODE> struct SkRes {
    const float* res; float* xout; bf16_t* xb; float* ssq; int mt, n0;
    __device__ __forceinline__ void operator()(int row, int cc, f32x4 va, f32x4 vb) const {
        const int grow = MP + 32 * mt + row; float sq = 0.f;
#pragma unroll
        for (int hh = 0; hh < 2; ++hh) {
            const int col = n0 + hh * 64 + 4 * cc;
            f32x4 v = hh ? vb : va;
            if (MODE == 0) v += *(const f32x4*)(res + (size_t)grow * 1024 + col);
            else { const u32x2 rr = *(const u32x2*)(xb + (size_t)grow * 1024 + col); v += (f32x4){bflo(rr.x), bfhi(rr.x), bflo(rr.y), bfhi(rr.y)}; }
            if (MODE == 2) *(f32x4*)(xout + (size_t)grow * 1024 + col) = v; else st4bf(xb + (size_t)grow * 1024 + col, v);
            sq += (v[0] * v[0] + v[1] * v[1]) + (v[2] * v[2] + v[3] * v[3]);
        }
        if (MODE != 2) {
            sq += __shfl_xor(sq, 1); sq += __shfl_xor(sq, 2); sq += __shfl_xor(sq, 4); sq += __shfl_xor(sq, 8);
            if (cc == 0) __hip_atomic_fetch_add(ssq + grow, sq, __ATOMIC_RELAXED, __HIP_MEMORY_SCOPE_AGENT);
        }
    }
};
struct SkQ {
    bf16_t* qc; const float* ssq; int mt, n0;
    __device__ __forceinline__ void operator()(int row, int cc, f32x4 va, f32x4 vb) const {
        const int grow = MP + 32 * mt + row; const float rs = __builtin_amdgcn_rsqf(ssq[grow] * (1.0f / 1024.0f) + EPS) * 0.08838834764831845f;
        st4bf(qc + (size_t)grow * 512 + n0 + 4 * cc, va * rs); st4bf(qc + (size_t)grow * 512 + n0 + 64 + 4 * cc, vb * rs);
    }
};
struct SkGU {
    bf16_t* h; const float* ssq; const float* wconv; const float* bconv; const float* state; float* out; int mt, ch0;
    __device__ __forceinline__ void operator()(int row, int cc, f32x4 va, f32x4 vb) const {
        const int grow = MP + 32 * mt + row, r2 = grow - MP, bs = r2 >> 2, t = r2 & 3, c = ch0 + 4 * cc;
        const float rs = __builtin_amdgcn_rsqf(ssq[grow] * (1.0f / 1024.0f) + EPS);
        const f32x4 g = va * rs, up = vb * rs;
        f32x4 p1, p2;
#pragma unroll
        for (int j = 0; j < 4; ++j) { p1[j] = __shfl_up(g[j], 16); p2[j] = __shfl_up(g[j], 32); }
        f32x4 s1 = {0.f, 0.f, 0.f, 0.f}, s0 = {0.f, 0.f, 0.f, 0.f};
        if (t < 2) s1 = *(const f32x4*)(state + ((size_t)bs * 2 + 1) * DFF + c);
        if (t == 0) s0 = *(const f32x4*)(state + ((size_t)bs * 2 + 0) * DFF + c);
        const f32x4 g1 = t >= 1 ? p1 : s1, g2 = t >= 2 ? p2 : (t == 1 ? s1 : s0);
        if (t >= 2) *(f32x4*)(out + O_SFC + ((size_t)bs * 2 + (t - 2)) * DFF + c) = g;
        const f32x4 w0 = *(const f32x4*)(wconv + c), w1 = *(const f32x4*)(wconv + DFF + c), w2 = *(const f32x4*)(wconv + 2 * DFF + c), bc = *(const f32x4*)(bconv + c);
        const f32x4 gc = bc + w0 * g2 + w1 * g1 + w2 * g;
        u32x2 wv; wv.x = pkbf(gelu_tanh(gc[0]) * up[0], gelu_tanh(gc[1]) * up[1]); wv.y = pkbf(gelu_tanh(gc[2]) * up[2], gelu_tanh(gc[3]) * up[3]);
        *(u32x2*)(h + (size_t)grow * DFF + c) = wv;
    }
};

__device__ __forceinline__ void ffn_fixup_tile(KA a, int pm, int tid) {
    const float* edge = (const float*)(a->ws + WS_EDGE); bf16_t* hb = (bf16_t*)(a->ws + WS_H);
    const float* wconv = a->in[I_WFC]; const float* bconv = a->in[I_BFC];
#pragma unroll 4
    for (int it = tid; it < 4 * 2 * 768; it += NTHREADS) {
        const int q = it / 1536, rem = it % 1536, rr = rem / 768, c4 = (rem % 768) * 4;
        const int blk = pm * 4 + q; const bool hasprev = (blk & 127) != 0;
        const f32x4 z = {0.f, 0.f, 0.f, 0.f};
        const f32x4 G0 = *(const f32x4*)(edge + ((size_t)blk * 6 + 0) * DFF + c4), G1 = *(const f32x4*)(edge + ((size_t)blk * 6 + 1) * DFF + c4);
        const f32x4 Gm2 = hasprev ? *(const f32x4*)(edge + ((size_t)(blk - 1) * 6 + 2) * DFF + c4) : z, Gm1 = hasprev ? *(const f32x4*)(edge + ((size_t)(blk - 1) * 6 + 3) * DFF + c4) : z;
        const f32x4 U = *(const f32x4*)(edge + ((size_t)blk * 6 + 4 + rr) * DFF + c4);
        const f32x4 w0 = *(const f32x4*)(wconv + c4), w1 = *(const f32x4*)(wconv + DFF + c4), w2 = *(const f32x4*)(wconv + 2 * DFF + c4), bc = *(const f32x4*)(bconv + c4);
        const f32x4 gc = rr == 0 ? (bc + w0 * Gm2 + w1 * Gm1 + w2 * G0) : (bc + w0 * Gm1 + w1 * G0 + w2 * G1);
        u32x2 wv; wv.x = pkbf(gelu_tanh(gc[0]) * U[0], gelu_tanh(gc[1]) * U[1]); wv.y = pkbf(gelu_tanh(gc[2]) * U[2], gelu_tanh(gc[3]) * U[3]);
        *(u32x2*)(hb + ((size_t)blk * 64 + rr) * DFF + c4) = wv;
    }
}

__global__ void __launch_bounds__(NTHREADS, 2) hymba_fwd(Args a_unused) {
    const KA a = (KA)__builtin_amdgcn_kernarg_segment_ptr();
    extern __shared__ __attribute__((aligned(16))) unsigned char smem[];
    const ldsp lds = (ldsp)smem;
    const int tid = threadIdx.x, lane = tid & 63, w = __builtin_amdgcn_readfirstlane(tid >> 6);
    const int G = gridDim.x, bx = blockIdx.x;
    unsigned char* ws = a->ws;
    const int lo = a->ph_lo, hi = a->ph_hi;
#ifndef PHASE_MASK
#define PHASE_MASK 0xfff
#endif
#define IN(k) (((PHASE_MASK >> (k)) & 1) && lo <= (k) && (k) < hi)
#ifndef SREP
#define SREP 0
#endif
#ifndef REP_MASK
#define REP_MASK 0
#endif
#ifndef EXTRA_SYNCS
#define EXTRA_SYNCS 0
#endif
#define REPS(k) (1 + ((REP_MASK >> (k)) & 1))
#ifdef TPROBE
#define TSTAMP(i) do { if (bx == 0 && tid == 0) ((LAS unsigned long long*)(lds + LDS_BYTES - 192))[i] = __builtin_amdgcn_s_memrealtime(); } while (0)
#else
#define TSTAMP(i) do {} while (0)
#endif
#define SEAM(k) do { if (IN(k) && IN((k) + 1)) { XcdBarrier bar_; bar_.bar = g_bar; bar_.x = xb_xcc_id(); bar_.st = (volatile LAS unsigned*)(lds + MISC_OFF); xcd_barrier(bar_); } TSTAMP((k) + 1); } while (0)
    bf16_t* XB = (bf16_t*)(ws + WS_XB);
    if (tid < 16) ((LAS unsigned*)(lds + MISC_OFF))[tid] = 0u;
    __syncthreads();
    (void)xcd_barrier_post(g_bar, (volatile LAS unsigned*)(lds + MISC_OFF));
    if (hi > 1000) cg::this_grid().sync();
    TSTAMP(0);
    if (IN(0)) { for (int rep = 0; rep < REPS(0); ++rep) p0_prologue(a, lds, tid, lane, w); }
    for (int es = 0; es < EXTRA_SYNCS; ++es) { XcdBarrier bar_; bar_.bar = g_bar; bar_.x = xb_xcc_id(); bar_.st = (volatile LAS unsigned*)(lds + MISC_OFF); xcd_barrier(bar_); }
    SEAM(0);
    struct ListOrder { int c, n, base;
        __device__ __forceinline__ bool next(int i, pg8::Unit& u) const { if (i > 0 || c >= n) return false; u.pm = c & 63; u.pn = base + (c >> 6); return true; }
        __device__ __forceinline__ void a_ready(const pg8::Unit&) const {}
        __device__ __forceinline__ void done(const pg8::Unit&) const {} };
    if (IN(1)) for (int rep = 0; rep < REPS(1); ++rep) {
        { for (int srep = 0; srep < 1 + SREP; ++srep) for (int t = G - 1 - bx; t < 16 * 14; t += G) { const int mt = t / 14, nt = t % 14; const bf16_t* Bt = (const bf16_t*)(ws + WS_WIN) + (size_t)(nt * 128) * 1024;
              SkProj P{(bf16_t*)(ws + WS_PROJ), (const float*)(ws + WS_SSQ0), a->out, mt, nt * 128}; sk_tile(lds, XB + (size_t)(MP + 32 * mt) * 1024, 1024, Bt, Bt + 64 * 1024, 1024, P, tid, lane, w); }
          __syncthreads();
          pg8::Gemm g{XB, (const bf16_t*)(ws + WS_WIN), MP, DIN, 1024};
          pg8::EpiProj E{(bf16_t*)(ws + WS_PROJ), (const float*)(ws + WS_SSQ0), a->out};
          ListOrder S{bx, 256, 0}; pg8::gemm_phase<pg8::EpiProj, ListOrder, true, true>(lds, g, S, E); }
    }
    SEAM(1);
#ifdef CPROBE
    const unsigned long long cp_t0 = __builtin_amdgcn_s_memrealtime();
#endif
    if (IN(2)) for (int rep = 0; rep < REPS(2); ++rep) {
        {
            if (bx < 192) { pg8::Gemm g{XB, (const bf16_t*)(ws + WS_WIN), MP, DIN, 1024}; pg8::EpiProj E{(bf16_t*)(ws + WS_PROJ), (const float*)(ws + WS_SSQ0), a->out};
                ListOrder S{bx, 192, 4}; pg8::gemm_phase<pg8::EpiProj, ListOrder, true, true>(lds, g, S, E); }
            else if (bx < 200) { pg8::Gemm g{(const bf16_t*)(ws + WS_MEMA), (const bf16_t*)(ws + WS_WKV), 512, 1024, 1024}; pg8::StaticOrder S; S.init(512, 1024, G, bx - 192);
                pg8::EpiMemKV E{(bf16_t*)(ws + WS_MEMKV), (const float*)(ws + WS_SSQM), a->out};
                pg8::gemm_phase<pg8::EpiMemKV, pg8::StaticOrder, true, true>(lds, g, S, E); }
            if (bx < 192) { lru_unit<false, 1>(a, lds, bx, tid, lane, w); if (bx < 64) lru_unit<false, 1>(a, lds, 192 + bx, tid, lane, w); }
            else if (bx < 200) swa_sample_unit(a, lds, bx - 192, tid);
            else if (bx < 232) { lru_unit<true, 2>(a, lds, bx - 200, tid, lane, w); swa_sample_unit(a, lds, 8 + (bx - 200), tid); swa_sample_unit(a, lds, 40 + (bx - 200), tid); }
            else for (int u = 72 + (bx - 232); u < 128; u += 24) swa_sample_unit(a, lds, u, tid);
        }
    }
    SEAM(2);
    if (IN(3)) for (int rep = 0; rep < REPS(3); ++rep) {
        for (int u = bx; u < 768; u += G) {
            if (u < 256) lru_unit<false, 2>(a, lds, u, tid, lane, w);
            else swa_prompt_unit(a, lds, u - 256, tid, lane, w);
        }
    }
    SEAM(3);
    if (IN(4)) {
        for (int t = G - 1 - bx; t < 128; t += G) { const int mt = t >> 3, nt = t & 7; const bf16_t* Bt = (const bf16_t*)(ws + WS_WOUT) + (size_t)(nt * 128) * 1024;
            SkRes<0> P{a->in[I_XS] - (size_t)MP * 1024, a->out, XB, (float*)(ws + WS_SSQ1), mt, nt * 128}; sk_tile(lds, (const bf16_t*)(ws + WS_MIX) + (size_t)(MP + 32 * mt) * 1024, 1024, Bt, Bt + 64 * 1024, 1024, P, tid, lane, w); }
        __syncthreads();
        pg8::Gemm g{(const bf16_t*)(ws + WS_MIX), (const bf16_t*)(ws + WS_WOUT), MP, 1024, 1024}; pg8::StaticOrder S; S.init(MP, 1024, G, bx);
        pg8::EpiRes<0> E{a->in[I_XP], a->out, XB, (float*)(ws + WS_SSQ1)};
        pg8::gemm_phase<pg8::EpiRes<0>, pg8::StaticOrder, true, true>(lds, g, S, E);
        if (REPS(4) > 1) { pg8::EpiRes<0, true> E2{a->in[I_XP], a->out, XB, (float*)(ws + WS_SSQ1)}; pg8::gemm_phase<pg8::EpiRes<0, true>, pg8::StaticOrder, true, true>(lds, g, S, E2); }
    }
    SEAM(4);
    if (IN(5)) for (int rep = 0; rep < REPS(5); ++rep) {
        for (int srep = 0; srep < 1 + SREP; ++srep) for (int t = G - 1 - bx; t < 64; t += G) { const int mt = t >> 2, nt = t & 3; const bf16_t* Bt = (const bf16_t*)(ws + WS_WQ) + (size_t)(nt * 128) * 1024;
            SkQ P{(bf16_t*)(ws + WS_QC), (const float*)(ws + WS_SSQ1), mt, nt * 128}; sk_tile(lds, XB + (size_t)(MP + 32 * mt) * 1024, 1024, Bt, Bt + 64 * 1024, 1024, P, tid, lane, w); }
        __syncthreads();
        pg8::Gemm g{XB, (const bf16_t*)(ws + WS_WQ), MP, 512, 1024}; pg8::StaticOrder S; S.init(MP, 512, G, bx);
        pg8::EpiQ E{(bf16_t*)(ws + WS_QC), (const float*)(ws + WS_SSQ1)};
        pg8::gemm_phase<pg8::EpiQ, pg8::StaticOrder, true, true>(lds, g, S, E);
    }
    SEAM(5);
    if (IN(6)) for (int rep = 0; rep < REPS(6); ++rep) {
        if (bx & 1) { for (int u = bx + G; u < 768; u += G) xattn_sample_unit(a, lds, u - 256, tid, lane, w); xattn_prompt_unit(a, lds, bx, tid, lane, w); }
        else { xattn_prompt_unit(a, lds, bx, tid, lane, w); for (int u = bx + G; u < 768; u += G) xattn_sample_unit(a, lds, u - 256, tid, lane, w); }
    }
    SEAM(6);
    if (IN(7)) {
        for (int t = G - 1 - bx; t < 128; t += G) { const int mt = t >> 3, nt = t & 7; const bf16_t* Bt = (const bf16_t*)(ws + WS_WMO) + (size_t)(nt * 128) * 512;
            SkRes<1> P{a->out, a->out, XB, (float*)(ws + WS_SSQ2), mt, nt * 128}; sk_tile(lds, (const bf16_t*)(ws + WS_OC) + (size_t)(MP + 32 * mt) * 512, 512, Bt, Bt + 64 * 512, 512, P, tid, lane, w); }
        __syncthreads();
        pg8::Gemm g{(const bf16_t*)(ws + WS_OC), (const bf16_t*)(ws + WS_WMO), MP, 1024, 512}; pg8::StaticOrder S; S.init(MP, 1024, G, bx);
        pg8::EpiRes<1> E{nullptr, a->out, XB, (float*)(ws + WS_SSQ2)};
        pg8::gemm_phase<pg8::EpiRes<1>, pg8::StaticOrder, true, true>(lds, g, S, E);
        if (REPS(7) > 1) { pg8::EpiRes<1, true> E2{nullptr, a->out, XB, (float*)(ws + WS_SSQ2)}; pg8::gemm_phase<pg8::EpiRes<1, true>, pg8::StaticOrder, true, true>(lds, g, S, E2); }
    }
    SEAM(7);
    if (IN(8)) for (int rep = 0; rep < REPS(8); ++rep) {
        for (int srep = 0; srep < 1 + SREP; ++srep) for (int t = G - 1 - bx; t < 16 * 48; t += G) { const int mt = t / 48, cb = t % 48; const bf16_t* Bg = (const bf16_t*)(ws + WS_WGU) + (size_t)((cb >> 1) * 256 + (cb & 1) * 64) * 1024;
            SkGU P{(bf16_t*)(ws + WS_H), (const float*)(ws + WS_SSQ2), a->in[I_WFC], a->in[I_BFC], a->in[I_SFC], a->out, mt, cb * 64}; sk_tile(lds, XB + (size_t)(MP + 32 * mt) * 1024, 1024, Bg, Bg + 128 * 1024, 1024, P, tid, lane, w); }
        __syncthreads();
        pg8::Gemm g{XB, (const bf16_t*)(ws + WS_WGU), MP, 2 * DFF, 1024}; pg8::StaticOrder S; S.init(MP, 2 * DFF, G, bx);
        pg8::EpiGU E{(bf16_t*)(ws + WS_H), (const float*)(ws + WS_SSQ2), (float*)(ws + WS_EDGE), a->in[I_WFC], a->in[I_BFC], a->in[I_SFC], a->out};
        pg8::gemm_phase<pg8::EpiGU, pg8::StaticOrder, true, true>(lds, g, S, E);
    }
    SEAM(8);
    if (IN(9)) {
        for (int t = G - 1 - bx; t < 128; t += G) { const int mt = t >> 3, nt = t & 7; const bf16_t* Bt = (const bf16_t*)(ws + WS_WD) + (size_t)(nt * 128) * DFF;
            SkRes<2> P{a->out, a->out, XB, (float*)(ws + WS_SSQ3), mt, nt * 128}; sk_tile(lds, (const bf16_t*)(ws + WS_H) + (size_t)(MP + 32 * mt) * DFF, DFF, Bt, Bt + 64 * DFF, DFF, P, tid, lane, w); }
        __syncthreads();
        pg8::Gemm g{(const bf16_t*)(ws + WS_H), (const bf16_t*)(ws + WS_WD), MP, 1024, DFF}; pg8::StaticOrder S; S.init(MP, 1024, G, bx);
        pg8::Unit u;
        for (int i = 0; S.next(i, u); ++i) if (u.pm < MP / 256) ffn_fixup_tile(a, u.pm, tid);
        asm volatile("s_waitcnt vmcnt(0)" ::: "memory");
        __syncthreads();
        pg8::EpiRes<2> E{nullptr, a->out, XB, (float*)(ws + WS_SSQ3)};
        pg8::gemm_phase<pg8::EpiRes<2>, pg8::StaticOrder, true, true>(lds, g, S, E);
        if (REPS(9) > 1) { pg8::EpiRes<2, true> E2{nullptr, a->out, XB, (float*)(ws + WS_SSQ3)}; pg8::gemm_phase<pg8::EpiRes<2, true>, pg8::StaticOrder, true, true>(lds, g, S, E2); }
    }
    SEAM(9);
    if (IN(10)) {
        const float* ssq3 = (const float*)(ws + WS_SSQ3); const float* gf = a->in[I_GFIN];
        f32x4 gv[4];
#pragma unroll
        for (int j = 0; j < 4; ++j) gv[j] = *((const f32x4*)gf + lane + 64 * j);
        for (int m0 = bx * NWAVES + w; m0 < MT; m0 += 2 * G * NWAVES) {
            const int m1 = m0 + G * NWAVES; const bool ok1 = m1 < MT;
            f32x4* xr0 = (f32x4*)(a->out + (size_t)m0 * 1024) + lane; f32x4* xr1 = (f32x4*)(a->out + (size_t)(ok1 ? m1 : m0) * 1024) + lane;
            f32x4 v0[4], v1[4]; float s0 = 0.f, s1 = 0.f;
#pragma unroll
            for (int j = 0; j < 4; ++j) { v0[j] = xr0[64 * j]; v1[j] = xr1[64 * j]; }
#pragma unroll
            for (int j = 0; j < 4; ++j) { s0 += (v0[j].x * v0[j].x + v0[j].y * v0[j].y) + (v0[j].z * v0[j].z + v0[j].w * v0[j].w); s1 += (v1[j].x * v1[j].x + v1[j].y * v1[j].y) + (v1[j].z * v1[j].z + v1[j].w * v1[j].w); }
            const float rs0 = __builtin_amdgcn_rsqf(wave_sum(s0) * (1.0f / 1024.0f) + EPS), rs1 = __builtin_amdgcn_rsqf(wave_sum(s1) * (1.0f / 1024.0f) + EPS);
#pragma unroll
            for (int j = 0; j < 4; ++j) xr0[64 * j] = v0[j] * rs0 * gv[j];
            if (ok1) {
#pragma unroll
                for (int j = 0; j < 4; ++j) xr1[64 * j] = v1[j] * rs1 * gv[j];
            }
        }
    }
#ifdef CPROBE
    if (bx == 0) {
        const unsigned* cw = (const unsigned*)(ws + WS_BAR) + CBASE;
        const float eps = (float)__hip_atomic_load(cw + CA, __ATOMIC_RELAXED, __HIP_MEMORY_SCOPE_AGENT) * 1e-5f, dd = (float)__hip_atomic_load(cw + CB, __ATOMIC_RELAXED, __HIP_MEMORY_SCOPE_AGENT) * 1e-4f;
        __syncthreads();
        for (int i = tid; i < 1024; i += NTHREADS) a->out[O_PLH + i] *= (1.0f + eps);
        if (tid == 0) a->out[O_PLC] += dd;
    }
#endif
#ifdef TPROBE
    TSTAMP(11);
    if (bx == 0) {
        __syncthreads();
        const LAS unsigned long long* ts = (const LAS unsigned long long*)(lds + LDS_BYTES - 192);
        const float eps = (float)(ts[TA_HI] - ts[TA_LO]) * 1e-5f, dd = (float)(ts[TB_HI] - ts[TB_LO]) * 1e-4f;
        for (int i = tid; i < 1024; i += NTHREADS) a->out[O_PLH + i] *= (1.0f + eps);
        if (tid == 0) a->out[O_PLC] += dd;
    }
#endif
    {
        __syncthreads();
        if (tid == 0) { const unsigned prev = __hip_atomic_fetch_add(&g_bar[3500], 1u, __ATOMIC_RELAXED, __HIP_MEMORY_SCOPE_AGENT); ((volatile LAS unsigned*)(lds + MISC_OFF))[4] = (prev == (unsigned)G - 1u) ? 1u : 0u; }
        __syncthreads();
        if (((volatile LAS unsigned*)(lds + MISC_OFF))[4]) { for (int i = tid; i < 3520; i += NTHREADS) __hip_atomic_store(&g_bar[i], 0u, __ATOMIC_RELAXED, __HIP_MEMORY_SCOPE_AGENT); }
    }
#undef IN
#undef SEAM
}
constexpr int N_PHASES = 11;

extern "C" void kernel_launch(void* const* d_in, const int* in_sizes, int n_in, void* d_out, int out_size, void* d_ws, size_t ws_size, hipStream_t stream) {
    static int grid = 0;
    if (grid == 0) {
        if (n_in != 34 || ws_size < WS_END) { fprintf(stderr, "kernel_launch: unexpected n_in %d / ws %zu\n", n_in, ws_size); grid = -1; return; }
        int dev = 0, cus = 0, per_cu = 0;
        if (hipGetDevice(&dev) != hipSuccess || hipDeviceGetAttribute(&cus, hipDeviceAttributeMultiprocessorCount, dev) != hipSuccess) { grid = -1; return; }
        if (hipFuncSetAttribute((const void*)hymba_fwd, hipFuncAttributeMaxDynamicSharedMemorySize, LDS_BYTES) != hipSuccess) { fprintf(stderr, "kernel_launch: hipFuncSetAttribute failed\n"); grid = -1; return; }
        if (hipOccupancyMaxActiveBlocksPerMultiprocessor(&per_cu, (const void*)hymba_fwd, NTHREADS, LDS_BYTES) != hipSuccess || per_cu < 1) { fprintf(stderr, "kernel_launch: occupancy query says %d\n", per_cu); per_cu = 1; }
        (void)hipGetLastError();
        grid = cus;
        if (cus != 256) { fprintf(stderr, "kernel_launch: built for a 256-CU device, found %d CUs; nothing launched\n", cus); grid = -1; return; }
    }
    if (grid < 0) return;
    Args a{};
    for (int i = 0; i < 34; ++i) a.in[i] = (const float*)d_in[i];
    a.out = (float*)d_out; a.ws = (unsigned char*)d_ws;
#if defined(CPROBE)
    if (hipMemsetAsync((char*)d_ws + WS_BAR, 0, BAR_ZERO_BYTES, stream) != hipSuccess) { fprintf(stderr, "kernel_launch: memset failed\n"); return; }
#endif
#if MK_N_LAUNCHES == 1
    a.ph_lo = 0; a.ph_hi = N_PHASES;
    void* args[] = {&a};
    hipError_t e = hipLaunchCooperativeKernel((const void*)hymba_fwd, dim3(grid), dim3(NTHREADS), args, LDS_BYTES, stream);
    if (e != hipSuccess) fprintf(stderr, "kernel_launch: cooperative launch failed: %s (grid %d)\n", hipGetErrorString(e), grid);
#else
    for (int p = 0; p < N_PHASES; ++p) { a.ph_lo = p; a.ph_hi = p + 1; hipLaunchKernelGGL(hymba_fwd, dim3(grid), dim3(NTHREADS), LDS_BYTES, stream, a); }
#endif
}
```

```cpp
#include <hip/hip_runtime.h>
#include <hip/hip_cooperative_groups.h>
#include <cstdio>
#include <cstdint>
namespace cg = cooperative_groups;

#ifndef MK_N_LAUNCHES
#define MK_N_LAUNCHES 1
#endif

constexpr int MP = 16384, MS = 512, MT = MP + MS;
constexpr int DM = 1024, SEQ = 8192, DIN = 1792, DFF = 3072, DLRU = 512;
constexpr float EPS = 1e-6f;
constexpr float LOG2E = 1.4426950408889634f;
constexpr size_t O_YP = 0, O_YS = 16777216, O_PSK = 17301504, O_PSV = 17334272, O_PMK = 17367040, O_PMV = 17629184, O_PLC = 17891328,
                 O_PLH = 17894400, O_PFC = 17895424, O_SSK = 17907712, O_SSV = 20004864, O_SLC = 22102016, O_SLH = 22298624, O_SFC = 22364160;
constexpr size_t MiB = 1u << 20;
constexpr size_t WS_SSQ0 = 0, WS_SSQ1 = 128 * 1024, WS_SSQ2 = 256 * 1024, WS_SSQ3 = 384 * 1024, WS_SSQM = 512 * 1024, WS_SUMM = 640 * 1024;
constexpr size_t WS_WIN = 1 * MiB, WS_WOUT = 5 * MiB, WS_WQ = 7 * MiB, WS_WKV = 8 * MiB, WS_WMO = 10 * MiB, WS_WGU = 11 * MiB, WS_WD = 23 * MiB;
constexpr size_t WS_MEMA = 29 * MiB, WS_MEMKV = 30 * MiB, WS_EDGE = 31 * MiB, WS_XB = 50 * MiB, WS_PROJ = 83 * MiB, WS_MIX = 141 * MiB, WS_QC = 174 * MiB, WS_OC = 191 * MiB;
constexpr size_t WS_H = 83 * MiB;
constexpr size_t WS_END = 208 * MiB;
static_assert(WS_EDGE + (size_t)264 * 6 * 3072 * 4 <= WS_XB && WS_XB + (size_t)MT * 1024 * 2 <= WS_PROJ && WS_PROJ + (size_t)MT * DIN * 2 <= WS_MIX &&
              WS_MIX + (size_t)MT * 1024 * 2 <= WS_QC && WS_QC + (size_t)MT * 512 * 2 <= WS_OC && WS_OC + (size_t)MT * 512 * 2 <= WS_END && WS_H + (size_t)MT * DFF * 2 <= WS_OC, "ws map");

__device__ __forceinline__ unsigned pkbf(float lo, float hi) {
    typedef float f2_t __attribute__((ext_vector_type(2))); typedef __bf16 b2_t __attribute__((ext_vector_type(2)));
    f2_t v = {lo, hi}; b2_t b = __builtin_convertvector(v, b2_t); return __builtin_bit_cast(unsigned, b);
}
__device__ __forceinline__ float bf2f(unsigned short x) { return __uint_as_float((unsigned)x << 16); }
__device__ __forceinline__ float bflo(unsigned x) { return __uint_as_float(x << 16); }
__device__ __forceinline__ float bfhi(unsigned x) { return __uint_as_float(x & 0xffff0000u); }
__device__ __forceinline__ float fexp2(float x) { return __builtin_amdgcn_exp2f(x); }
__device__ __forceinline__ float frcp(float x) { return __builtin_amdgcn_rcpf(x); }
__device__ __forceinline__ float sigmoidf_(float x) { return frcp(1.0f + fexp2(-LOG2E * x)); }
__device__ __forceinline__ float gelu_tanh(float x) {
    const float t = x * (1.0f + 0.044715f * x * x);
    return x * frcp(1.0f + fexp2(-2.302208198f * t));
}
namespace pg8 {
#define PG8_LAS __attribute__((address_space(3)))
typedef unsigned short bf16_t;
typedef short bf16x8 __attribute__((ext_vector_type(8)));
typedef float f32x4 __attribute__((ext_vector_type(4)));
typedef unsigned u32x4 __attribute__((ext_vector_type(4)));
constexpr int BM = 256, BK = 64, HALF = 128, HTB = HALF * BK * 2  , STAGE_BYTES = 8 * HTB, NXCD = 8, WGM = 8;

__host__ __device__ __forceinline__ int lds_byte(int r, int c) { const int st = (r >> 4) * 2 + (c >> 5), rr = r & 15, cc = c & 31, ob = rr * 64 + cc * 2; return st * 1024 + (ob ^ (((ob >> 9) & 1) << 5)); }
__host__ __device__ __forceinline__ void stage_rc(int b, int& R, int& C) { const int st = b / 1024, sb = b % 1024, swz = sb ^ (((sb >> 9) & 1) << 5); R = (st >> 1) * 16 + swz / 64; C = (st & 1) * 32 + (swz % 64) / 2; }
__host__ __device__ __forceinline__ int perm32(int rho) { const int n = rho >> 4, i = rho & 15; return 8 * (i >> 2) + 4 * n + (i & 3); }

struct Unit { int pm, pn; };
struct Gemm { const bf16_t* A; const bf16_t* Bt; int M, N, K; };

struct StaticOrder {
    int nM, nN, nwg, G, c;
    __host__ __device__ __forceinline__ void init(int M, int N, int G_, int c_) { nM = M / BM; nN = N / BM; nwg = nM * nN; G = G_; c = c_; }
    __host__ __device__ __forceinline__ bool next(int i, Unit& u) const {
        const long L = (long)i * G + c; if (L >= nwg) return false;
        int wgid = (int)L; { const int q = nwg / NXCD, r = nwg % NXCD, xcd = wgid % NXCD, off = wgid / NXCD; wgid = (xcd < r ? xcd * (q + 1) : r * (q + 1) + (xcd - r) * q) + off; }
        const int nig = WGM * nN, gid = wgid / nig, fm = gid * WGM, gsz = (nM - fm) < WGM ? (nM - fm) : WGM;
        u.pm = fm + ((wgid % nig) % gsz); u.pn = (wgid % nig) / gsz; return true;
    }
    __device__ __forceinline__ void a_ready(const Unit&) const {}
    __device__ __forceinline__ void done(const Unit&) const {}
};

#define EPI_ROW(u, ai, m) ((u).pm * BM + (ai) * HALF + wr * 64 + (m) * 16 + fr)
__device__ __forceinline__ void st_bf16x8(bf16_t* p, f32x4 v0, f32x4 v1) { u32x4 w; w.x = pkbf(v0[0], v0[1]); w.y = pkbf(v0[2], v0[3]); w.z = pkbf(v1[0], v1[1]); w.w = pkbf(v1[2], v1[3]); *(u32x4*)p = w; }

struct EpiProj {
    static constexpr bool PERM = true, AFTER_DRAIN = false;
    bf16_t* proj; const float* ssq; float* out;
    __device__ __forceinline__ void operator()(const f32x4 (&acc)[2][2][4][2], const Unit& u, int wr, int wc, int fr, int fq) const {
        float rsv[2][4];
#pragma unroll
        for (int ai = 0; ai < 2; ++ai)
#pragma unroll
            for (int m = 0; m < 4; ++m) rsv[ai][m] = ssq[EPI_ROW(u, ai, m)];
        const int colb = u.pn * BM + wc * 32 + 8 * fq;
        const float qs = (u.pn == 4 || u.pn == 5) ? 0.125f : 1.0f;
#pragma unroll
        for (int ai = 0; ai < 2; ++ai)
#pragma unroll
            for (int m = 0; m < 4; ++m) {
                const int row = EPI_ROW(u, ai, m);
                const float rs = __builtin_amdgcn_rsqf(rsv[ai][m] * (1.0f / 1024.0f) + EPS) * qs;
#pragma unroll
                for (int bj = 0; bj < 2; ++bj) {
                    const int col = colb + bj * HALF;
                    const f32x4 v0 = acc[ai][bj][m][0] * rs, v1 = acc[ai][bj][m][1] * rs;
                    st_bf16x8(proj + (size_t)row * DIN + col, v0, v1);
                    float* dst = nullptr;
                    if (u.pn == 6) {
                        const int kc = wc * 32 + 8 * fq;
                        const int t = row & 8191, b = row >> 13; if (t >= 8064) dst = out + (bj ? O_PSV : O_PSK) + (size_t)(b * 128 + t - 8064) * 128 + kc;
                    } else if (u.pn < 2) {
                        const int t = row & 8191, b = row >> 13; if (t >= 8189) dst = out + O_PLC + (size_t)(b * 3 + t - 8189) * 512 + col;
                    }
                    if (dst) { *(f32x4*)dst = v0; *(f32x4*)(dst + 4) = v1; }
                }
            }
    }
};
struct EpiMemKV {
    static constexpr bool PERM = true, AFTER_DRAIN = false;
    bf16_t* memkv; const float* ssq; float* out;
    __device__ __forceinline__ void operator()(const f32x4 (&acc)[2][2][4][2], const Unit& u, int wr, int wc, int fr, int fq) const {
        float rsv[2][4];
#pragma unroll
        for (int ai = 0; ai < 2; ++ai)
#pragma unroll
            for (int m = 0; m < 4; ++m) rsv[ai][m] = ssq[EPI_ROW(u, ai, m)];
        const int colb = u.pn * BM + wc * 32 + 8 * fq;
#pragma unroll
        for (int ai = 0; ai < 2; ++ai)
#pragma unroll
            for (int m = 0; m < 4; ++m) {
                const int row = EPI_ROW(u, ai, m);
                const float rs = __builtin_amdgcn_rsqf(rsv[ai][m] * (1.0f / 1024.0f) + EPS);
#pragma unroll
                for (int bj = 0; bj < 2; ++bj) {
                    const int col = colb + bj * HALF;
                    const f32x4 v0 = acc[ai][bj][m][0] * rs, v1 = acc[ai][bj][m][1] * rs;
                    st_bf16x8(memkv + (size_t)row * 1024 + col, v0, v1);
                    float* dst = out + (col < 512 ? O_PMK + (size_t)row * 512 + col : O_PMV + (size_t)row * 512 + (col - 512));
                    *(f32x4*)dst = v0; *(f32x4*)(dst + 4) = v1;
                }
            }
    }
};
template <int MODE, bool DRY = false> struct EpiRes {
    static constexpr bool PERM = true, AFTER_DRAIN = false;
    const float* resp; float* xout; bf16_t* xb; float* ssq;
    __device__ __forceinline__ void operator()(const f32x4 (&acc)[2][2][4][2], const Unit& u, int wr, int wc, int fr, int fq) const {
        const int colb = u.pn * BM + wc * 32 + 8 * fq;
#pragma unroll
        for (int ai = 0; ai < 2; ++ai) {
            f32x4 rf[4][2][2]; u32x4 rb[4][2];
#pragma unroll
            for (int m = 0; m < 4; ++m)
#pragma unroll
                for (int bj = 0; bj < 2; ++bj) {
                    const int row = EPI_ROW(u, ai, m), col = colb + bj * HALF;
                    if (MODE == 0) { const float* rp = resp + (size_t)row * 1024 + col; rf[m][bj][0] = *(const f32x4*)rp; rf[m][bj][1] = *(const f32x4*)(rp + 4); }
                    else rb[m][bj] = *(const u32x4*)(xb + (size_t)row * 1024 + col);
                }
#pragma unroll
            for (int m = 0; m < 4; ++m) {
                const int row = EPI_ROW(u, ai, m);
                float sq = 0.f;
#pragma unroll
                for (int bj = 0; bj < 2; ++bj) {
                    const int col = colb + bj * HALF;
                    f32x4 v0, v1;
                    if (MODE == 0) { v0 = acc[ai][bj][m][0] + rf[m][bj][0]; v1 = acc[ai][bj][m][1] + rf[m][bj][1]; }
                    else { const u32x4 r = rb[m][bj];
                        v0 = acc[ai][bj][m][0] + (f32x4){bflo(r.x), bfhi(r.x), bflo(r.y), bfhi(r.y)}; v1 = acc[ai][bj][m][1] + (f32x4){bflo(r.z), bfhi(r.z), bflo(r.w), bfhi(r.w)}; }
                    if (!DRY) {
                        if (MODE == 2) { float* op = xout + (size_t)row * 1024 + col; *(f32x4*)op = v0; *(f32x4*)(op + 4) = v1; }
                        else st_bf16x8(xb + (size_t)row * 1024 + col, v0, v1);
                    }
                    sq += (v0[0] * v0[0] + v0[1] * v0[1]) + (v0[2] * v0[2] + v0[3] * v0[3]) + (v1[0] * v1[0] + v1[1] * v1[1]) + (v1[2] * v1[2] + v1[3] * v1[3]);
                }
                if (MODE != 2 || DRY) {
                    sq += __shfl_xor(sq, 16); sq += __shfl_xor(sq, 32);
                    if (!DRY) { if (fq == 0) __hip_atomic_fetch_add(ssq + row, sq, __ATOMIC_RELAXED, __HIP_MEMORY_SCOPE_AGENT); }
                    else if (sq == 12345.678f) ssq[row] = sq;
                }
            }
        }
    }
};
struct EpiQ {
    static constexpr bool PERM = true, AFTER_DRAIN = false;
    bf16_t* qc; const float* ssq;
    __device__ __forceinline__ void operator()(const f32x4 (&acc)[2][2][4][2], const Unit& u, int wr, int wc, int fr, int fq) const {
        float rsv[2][4];
#pragma unroll
        for (int ai = 0; ai < 2; ++ai)
#pragma unroll
            for (int m = 0; m < 4; ++m) rsv[ai][m] = ssq[EPI_ROW(u, ai, m)];
        const int colb = u.pn * BM + wc * 32 + 8 * fq;
#pragma unroll
        for (int ai = 0; ai < 2; ++ai)
#pragma unroll
            for (int m = 0; m < 4; ++m) {
                const int row = EPI_ROW(u, ai, m);
                const float rs = __builtin_amdgcn_rsqf(rsv[ai][m] * (1.0f / 1024.0f) + EPS) * 0.08838834764831845f;
#pragma unroll
                for (int bj = 0; bj < 2; ++bj) st_bf16x8(qc + (size_t)row * 512 + colb + bj * HALF, acc[ai][bj][m][0] * rs, acc[ai][bj][m][1] * rs);
            }
    }
};
__device__ __forceinline__ float dpp_ror1(float v) { return __builtin_bit_cast(float, __builtin_amdgcn_update_dpp(0, __builtin_bit_cast(int, v), 0x121, 0xf, 0xf, false)); }
__device__ __forceinline__ float dpp_ror2(float v) { return __builtin_bit_cast(float, __builtin_amdgcn_update_dpp(0, __builtin_bit_cast(int, v), 0x122, 0xf, 0xf, false)); }
__device__ __forceinline__ f32x4 gelu4(f32x4 x) {
    const f32x4 t = x * (x * x * 0.044715f + 1.0f) * (-2.302208198f);
    f32x4 e; e[0] = fexp2(t[0]); e[1] = fexp2(t[1]); e[2] = fexp2(t[2]); e[3] = fexp2(t[3]);
    const f32x4 d = e + 1.0f;
    f32x4 r; r[0] = frcp(d[0]); r[1] = frcp(d[1]); r[2] = frcp(d[2]); r[3] = frcp(d[3]);
    return x * r;
}
struct EpiGU {
    static constexpr bool PERM = true, AFTER_DRAIN = false;
    bf16_t* h; const float* ssq; float* edge; const float* wconv; const float* bconv; const float* state; float* out;
    __device__ __forceinline__ void operator()(const f32x4 (&acc)[2][2][4][2], const Unit& u, int wr, int wc, int fr, int fq) const {
        float rsv[2][4];
#pragma unroll
        for (int ai = 0; ai < 2; ++ai)
#pragma unroll
            for (int m = 0; m < 4; ++m) rsv[ai][m] = ssq[EPI_ROW(u, ai, m)];
        const int chb = u.pn * HALF + wc * 32 + 8 * fq;
        f32x4 w0[2], w1[2], w2[2], bc[2];
#pragma unroll
        for (int n = 0; n < 2; ++n) { const int ch = chb + 4 * n; w0[n] = *(const f32x4*)(wconv + ch); w1[n] = *(const f32x4*)(wconv + DFF + ch); w2[n] = *(const f32x4*)(wconv + 2 * DFF + ch); bc[n] = *(const f32x4*)(bconv + ch); }
#pragma unroll
        for (int ai = 0; ai < 2; ++ai) {
            f32x4 p1p[2] = {{0.f, 0.f, 0.f, 0.f}, {0.f, 0.f, 0.f, 0.f}}, p2p[2] = {{0.f, 0.f, 0.f, 0.f}, {0.f, 0.f, 0.f, 0.f}};
#pragma unroll
            for (int m = 0; m < 4; ++m) {
                const int row = EPI_ROW(u, ai, m), blk = row >> 6;
                const float rs = __builtin_amdgcn_rsqf(rsv[ai][m] * (1.0f / 1024.0f) + EPS);
                f32x4 hv[2];
#pragma unroll
                for (int n = 0; n < 2; ++n) {
                    const int ch = chb + 4 * n;
                    const f32x4 g = acc[ai][0][m][n] * rs, up = acc[ai][1][m][n] * rs;
                    f32x4 p1, p2;
#pragma unroll
                    for (int j = 0; j < 4; ++j) { p1[j] = dpp_ror1(g[j]); p2[j] = dpp_ror2(g[j]); }
                    const f32x4 g1 = fr >= 1 ? p1 : p1p[n], g2 = fr >= 2 ? p2 : p2p[n]; p1p[n] = p1; p2p[n] = p2;
                    if (m == 0 && fr < 2) { *(f32x4*)(edge + ((size_t)blk * 6 + fr) * DFF + ch) = g; *(f32x4*)(edge + ((size_t)blk * 6 + 4 + fr) * DFF + ch) = up; }
                    if (m == 3 && fr >= 14) {
                        *(f32x4*)(edge + ((size_t)blk * 6 + 2 + (fr - 14)) * DFF + ch) = g;
                        if ((blk & 127) == 127) *(f32x4*)(out + O_PFC + (size_t)((blk >> 7) * 2 + (fr - 14)) * DFF + ch) = g;
                    }
                    hv[n] = gelu4(bc[n] + w0[n] * g2 + w1[n] * g1 + w2[n] * g) * up;
                }
                st_bf16x8(h + (size_t)row * DFF + chb, hv[0], hv[1]);
            }
        }
    }
};
template <class Epi, class Sched, bool ALIGN_EPI = false, bool SP2 = false>
__device__ __forceinline__ void gemm_phase(PG8_LAS unsigned char* lds, const Gemm g, const Sched& S, const Epi& E) {
    const int tid = threadIdx.x, wid = __builtin_amdgcn_readfirstlane(tid >> 6), lane = tid & 63, wr = wid >> 2, wc = wid & 3, fr = lane & 15, fq = lane >> 4;
    const int K = g.K, nt = K / BK;
    unsigned voffA[2], voffB[2];
#pragma unroll
    for (int i = 0; i < 2; ++i) { int R, C; stage_rc(tid * 16 + i * 8192, R, C); const int Rb = Epi::PERM ? ((R & ~31) + perm32(R & 31)) : R;
        voffA[i] = (unsigned)(R * K + C) * 2u; voffB[i] = (unsigned)(Rb * K + C) * 2u; }
    const size_t kstep = (size_t)(BK * 2);
    const size_t hstep = (size_t)HALF * K * 2;
    const size_t tstep = 2 * hstep;
    const unsigned ldsw = (unsigned)wid * 1024u;
    const int aoff = lds_byte(wr * 64 + fr, fq * 8), boff = lds_byte(wc * 32 + fr, fq * 8);
#define PG8_SA(b, h) (((b) * 2 + (h)) * HTB)
#define PG8_SB(b, h) ((4 + (b) * 2 + (h)) * HTB)
#define PG8_STAGE(bufoff, gbase, voff) do { _Pragma("unroll") for (int _i = 0; _i < 2; ++_i) \
        __builtin_amdgcn_global_load_lds((const unsigned*)((const char*)(gbase) + (voff)[_i]), (PG8_LAS unsigned*)(lds + (bufoff) + ldsw + _i * 8192), 16, 0, 0); } while (0)
#define PG8_LDA(dst, b, h) do { _Pragma("unroll") for (int m = 0; m < 4; ++m) _Pragma("unroll") for (int k = 0; k < 2; ++k) dst[m][k] = *(const PG8_LAS bf16x8*)(lds + PG8_SA(b, h) + aoff + m * 2048 + k * 1024); } while (0)
#define PG8_LDB(dst, b, h) do { _Pragma("unroll") for (int n = 0; n < 2; ++n) _Pragma("unroll") for (int k = 0; k < 2; ++k) dst[n][k] = *(const PG8_LAS bf16x8*)(lds + PG8_SB(b, h) + boff + n * 2048 + k * 1024); } while (0)
#define PG8_MMA(ai, bj, At, Bt) do { __builtin_amdgcn_s_setprio(1); _Pragma("unroll") for (int m = 0; m < 4; ++m) _Pragma("unroll") for (int n = 0; n < 2; ++n) _Pragma("unroll") for (int k = 0; k < 2; ++k) \
        acc[ai][bj][m][n] = __builtin_amdgcn_mfma_f32_16x16x32_bf16(Bt[n][k], At[m][k], acc[ai][bj][m][n], 0, 0, 0); __builtin_amdgcn_s_setprio(0); } while (0)
#define PG8_WAIT_V(n) asm volatile("s_waitcnt vmcnt(" #n ")" ::: "memory")
#define PG8_WAIT_L(n) asm volatile("s_waitcnt lgkmcnt(" #n ")" ::: "memory")
#define PG8_BAR __builtin_amdgcn_s_barrier()
#define PG8_SCHED __builtin_amdgcn_sched_barrier(0)
    Unit cur, nxt; int ui = 0;
    if (!S.next(0, cur)) return;
    f32x4 acc[2][2][4][2];
#pragma unroll
    for (int a = 0; a < 2; ++a)
#pragma unroll
        for (int b = 0; b < 2; ++b)
#pragma unroll
            for (int m = 0; m < 4; ++m)
#pragma unroll
                for (int n = 0; n < 2; ++n) acc[a][b][m][n] = (f32x4){0.f, 0.f, 0.f, 0.f};
    bf16x8 At[4][2], B0[2][2], B1[2][2];
    const char* cA = (const char*)g.A + (size_t)cur.pm * tstep; const char* cB = (const char*)g.Bt + (size_t)cur.pn * tstep;
    S.a_ready(cur);
    if constexpr (SP2) {
        PG8_STAGE(PG8_SB(0, 0), cB, voffB); PG8_STAGE(PG8_SB(0, 1), cB + hstep, voffB); PG8_STAGE(PG8_SA(0, 0), cA, voffA); PG8_STAGE(PG8_SA(0, 1), cA + hstep, voffA);
        if (wr == 1) PG8_BAR;
        PG8_WAIT_V(2); PG8_BAR;
        PG8_STAGE(PG8_SB(1, 0), cB + kstep, voffB); PG8_STAGE(PG8_SA(1, 0), cA + kstep, voffA); PG8_STAGE(PG8_SB(1, 1), cB + hstep + kstep, voffB);
        PG8_WAIT_V(6); PG8_BAR;
    } else {
        PG8_STAGE(PG8_SB(0, 0), cB, voffB); PG8_STAGE(PG8_SA(0, 0), cA, voffA); PG8_STAGE(PG8_SB(0, 1), cB + hstep, voffB); PG8_STAGE(PG8_SA(0, 1), cA + hstep, voffA);
        if (wr == 1) PG8_BAR;
        PG8_WAIT_V(4); PG8_BAR;
        PG8_STAGE(PG8_SB(1, 0), cB + kstep, voffB); PG8_STAGE(PG8_SA(1, 0), cA + kstep, voffA); PG8_STAGE(PG8_SB(1, 1), cB + hstep + kstep, voffB);
        PG8_WAIT_V(6); PG8_BAR;
    }
    for (;;) {
        const bool has_next = S.next(ui + 1, nxt);
        const char* nA = has_next ? (const char*)g.A + (size_t)nxt.pm * tstep : cA; const char* nB = has_next ? (const char*)g.Bt + (size_t)nxt.pn * tstep : cB;
        for (int t = 0; t < nt; t += 2) {
            const bool last = (t == nt - 2);
            const char* a1 = cA + (size_t)(t + 1) * kstep;
            const char* a2 = last ? nA : cA + (size_t)(t + 2) * kstep; const char* b2 = last ? nB : cB + (size_t)(t + 2) * kstep;
            const char* a3 = a2 + kstep; const char* b3 = b2 + kstep;
            if (last && has_next) S.a_ready(nxt);
            if constexpr (SP2) {
            PG8_LDB(B0, 0, 0); PG8_LDB(B1, 0, 1); PG8_SCHED; PG8_LDA(At, 0, 0); PG8_STAGE(PG8_SA(1, 1), a1 + hstep, voffA);
            PG8_WAIT_V(8); PG8_WAIT_L(0); PG8_BAR; PG8_MMA(0, 0, At, B0); PG8_MMA(0, 1, At, B1); PG8_BAR; PG8_SCHED;
            PG8_LDA(At, 0, 1); PG8_STAGE(PG8_SB(0, 0), b2, voffB); PG8_STAGE(PG8_SB(0, 1), b2 + hstep, voffB); PG8_STAGE(PG8_SA(0, 0), a2, voffA);
            PG8_WAIT_V(8); PG8_WAIT_L(0); PG8_BAR; PG8_MMA(1, 0, At, B0); PG8_MMA(1, 1, At, B1); PG8_BAR; PG8_SCHED;
            PG8_LDB(B0, 1, 0); PG8_LDB(B1, 1, 1); PG8_SCHED; PG8_LDA(At, 1, 0); PG8_STAGE(PG8_SA(0, 1), a2 + hstep, voffA);
            PG8_WAIT_V(8); PG8_WAIT_L(0); PG8_BAR; PG8_MMA(0, 0, At, B0); PG8_MMA(0, 1, At, B1); PG8_BAR; PG8_SCHED;
            PG8_LDA(At, 1, 1); PG8_STAGE(PG8_SB(1, 0), b3, voffB); PG8_STAGE(PG8_SB(1, 1), b3 + hstep, voffB); PG8_STAGE(PG8_SA(1, 0), a3, voffA);
            PG8_WAIT_V(8); PG8_WAIT_L(0); PG8_BAR; PG8_MMA(1, 0, At, B0); PG8_MMA(1, 1, At, B1); PG8_BAR; PG8_SCHED;
            } else {
            PG8_LDB(B0, 0, 0); PG8_SCHED; PG8_LDA(At, 0, 0); PG8_STAGE(PG8_SA(1, 1), a1 + hstep, voffA);
            PG8_WAIT_L(8); PG8_BAR; PG8_WAIT_L(0); PG8_MMA(0, 0, At, B0); PG8_BAR; PG8_SCHED;
            PG8_LDB(B1, 0, 1); PG8_STAGE(PG8_SB(0, 0), b2, voffB);
            PG8_BAR; PG8_WAIT_L(0); PG8_MMA(0, 1, At, B1); PG8_BAR;
            PG8_LDA(At, 0, 1); PG8_STAGE(PG8_SA(0, 0), a2, voffA);
            PG8_BAR; PG8_WAIT_L(0); PG8_MMA(1, 0, At, B0); PG8_BAR; PG8_SCHED;
            PG8_STAGE(PG8_SB(0, 1), b2 + hstep, voffB);
            PG8_WAIT_V(6); PG8_BAR; PG8_MMA(1, 1, At, B1); PG8_BAR;
            PG8_LDB(B0, 1, 0); PG8_SCHED; PG8_LDA(At, 1, 0); PG8_STAGE(PG8_SA(0, 1), a2 + hstep, voffA);
            PG8_WAIT_L(8); PG8_BAR; PG8_WAIT_L(0); PG8_MMA(0, 0, At, B0); PG8_BAR; PG8_SCHED;
            PG8_LDB(B1, 1, 1); PG8_STAGE(PG8_SB(1, 0), b3, voffB);
            PG8_BAR; PG8_WAIT_L(0); PG8_MMA(0, 1, At, B1); PG8_BAR;
            PG8_LDA(At, 1, 1); PG8_STAGE(PG8_SA(1, 0), a3, voffA);
            PG8_BAR; PG8_WAIT_L(0); PG8_MMA(1, 0, At, B0); PG8_BAR; PG8_SCHED;
            PG8_STAGE(PG8_SB(1, 1), b3 + hstep, voffB);
            PG8_WAIT_V(6); PG8_BAR; PG8_MMA(1, 1, At, B1); PG8_BAR;
            }
        }
        if constexpr (ALIGN_EPI) { if (wr == 0) PG8_BAR; }
        if constexpr (!Epi::AFTER_DRAIN) { E(acc, cur, wr, wc, fr, fq); S.done(cur); }
        if (!has_next) break;
#pragma unroll
        for (int a = 0; a < 2; ++a)
#pragma unroll
            for (int b = 0; b < 2; ++b)
#pragma unroll
                for (int m = 0; m < 4; ++m)
#pragma unroll
                    for (int n = 0; n < 2; ++n) acc[a][b][m][n] = (f32x4){0.f, 0.f, 0.f, 0.f};
        cur = nxt; cA = nA; cB = nB; ++ui;
        if constexpr (ALIGN_EPI) { if (wr == 1) PG8_BAR; }
    }
    PG8_WAIT_V(0);
    if constexpr (!ALIGN_EPI) { if (wr == 0) PG8_BAR; }
    PG8_BAR;
    if constexpr (Epi::AFTER_DRAIN) { E.fused(acc, cur, wr, wc, fr, fq, lds, wid, lane); S.done(cur); }
#undef PG8_SA
#undef PG8_SB
#undef PG8_STAGE
#undef PG8_LDA
#undef PG8_LDB
#undef PG8_MMA
#undef PG8_WAIT_V
#undef PG8_WAIT_L
#undef PG8_BAR
#undef PG8_SCHED
}
}

#define LAS __attribute__((address_space(3)))
typedef unsigned short bf16_t;
typedef short bf16x8 __attribute__((ext_vector_type(8)));
typedef short s16x4 __attribute__((ext_vector_type(4)));
typedef float f32x4 __attribute__((ext_vector_type(4)));
typedef float f32x16 __attribute__((ext_vector_type(16)));
typedef unsigned u32x4 __attribute__((ext_vector_type(4)));
typedef unsigned u32x2 __attribute__((ext_vector_type(2)));
typedef LAS unsigned char* ldsp;
constexpr int NWAVES = 8, NTHREADS = 512, LDS_BYTES = 147456;
#define MFMA32(a, b, c) __builtin_amdgcn_mfma_f32_32x32x16_bf16((a), (b), (c), 0, 0, 0)
#define MFMA16(a, b, c) __builtin_amdgcn_mfma_f32_16x16x32_bf16((a), (b), (c), 0, 0, 0)
__device__ __forceinline__ int crow(int r, int hi) { return (r & 3) + 8 * (r >> 2) + 4 * hi; }
__device__ __forceinline__ unsigned f2bf(float f) { return pkbf(f, 0.f) & 0xffffu; }
__device__ __forceinline__ float wave_sum(float v) {
#pragma unroll
    for (int o = 1; o < 64; o <<= 1) v += __shfl_xor(v, o);
    return v;
}
__device__ __forceinline__ bf16x8 pack8(const f32x16& x, int s) {
    u32x4 p; p.x = pkbf(x[8 * s], x[8 * s + 1]); p.y = pkbf(x[8 * s + 2], x[8 * s + 3]); p.z = pkbf(x[8 * s + 4], x[8 * s + 5]); p.w = pkbf(x[8 * s + 6], x[8 * s + 7]);
    return __builtin_bit_cast(bf16x8, p);
}

struct Args {
    const float* in[34]; float* out; unsigned char* ws; int ph_lo, ph_hi;
};
typedef const __attribute__((address_space(4))) Args* KA;
enum { I_XP = 0, I_XS, I_CSK, I_CSV, I_CMK, I_CMV, I_SLC, I_SLH, I_SFC, I_MEMP, I_GMIX, I_WIN, I_WLC, I_BLC, I_WLA, I_BLA, I_WLX, I_BLX, I_LAM, I_SINK, I_WOUT, I_GCROSS, I_GMEM,
       I_WMQ, I_WMK, I_WMV, I_WMO, I_GFFN, I_WFG, I_WFU, I_WFC, I_BFC, I_WFD, I_GFIN };

#define RLX_AGENT __ATOMIC_RELAXED, __HIP_MEMORY_SCOPE_AGENT
constexpr size_t WS_BAR = 896 * 1024, BAR_ZERO_BYTES = 16384;
__device__ unsigned g_bar[4096];
constexpr int MISC_OFF = LDS_BYTES - 64;
#define XB_TMO      128
#define XB_XCNT(j)  (256  + 64 * (j))
#define XB_XSUB(j)  (1280 + 64 * (j))
#define XB_XGEN(j)  (2304 + 64 * (j))
#define XB_TOP      3328
#define XB_TOPGEN   3392
#define XCD_BAR_WORDS 3456
#define XB_SPIN_CAP (1u << 18)

__device__ __forceinline__ unsigned xb_ld(unsigned* p)              { return __hip_atomic_load(p, __ATOMIC_RELAXED, __HIP_MEMORY_SCOPE_AGENT); }
__device__ __forceinline__ unsigned xb_add(unsigned* p, unsigned v) { return __hip_atomic_fetch_add(p, v, __ATOMIC_RELAXED, __HIP_MEMORY_SCOPE_AGENT); }
__device__ __forceinline__ unsigned xb_xcc_id() { return (unsigned)__builtin_amdgcn_s_getreg((3 << 11) | 20) & 0xFu; }
#define XB_SPIN(cond, bar) do { unsigned _sp = 0; while (cond) { __builtin_amdgcn_s_sleep(1); \
    if ((++_sp & 255u) == 0u) { if (xb_ld(&(bar)[XB_TMO])) break; if (_sp > XB_SPIN_CAP) { atomicAdd(&(bar)[XB_TMO], 1u); break; } } } } while (0)

struct XcdBarrier {
    unsigned* bar; unsigned x;
    volatile LAS unsigned* st;
};

__device__ __forceinline__ XcdBarrier xcd_barrier_post(unsigned* bar, volatile LAS unsigned* st) {
    XcdBarrier b; b.bar = bar; b.x = xb_xcc_id(); b.st = st;
    if (threadIdx.x == 0) (void)xb_add(&bar[XB_XCNT(b.x)], 1u);
    return b;
}
__device__ __forceinline__ void xcd_barrier_complete(unsigned* bar, unsigned x, unsigned& nloc, unsigned& nx) {
    const unsigned G = gridDim.x * gridDim.y * gridDim.z;
    unsigned sum, cnt, mine, sp = 0u;
    for (;;) {
        sum = 0u; cnt = 0u; mine = 0u;
#pragma unroll
        for (unsigned j = 0; j < 16; ++j) { const unsigned c = xb_ld(&bar[XB_XCNT(j)]); sum += c; cnt += (c > 0u) ? 1u : 0u; mine = (j == x) ? c : mine; }
        if (sum == G) break;
        __builtin_amdgcn_s_sleep(1);
        if ((++sp & 255u) == 0u) { if (xb_ld(&bar[XB_TMO])) break; if (sp > XB_SPIN_CAP) { atomicAdd(&bar[XB_TMO], 1u); break; } }
    }
    nloc = mine > 0u ? mine : 1u; nx = cnt > 0u ? cnt : 1u;
}

__device__ __forceinline__ void xcd_barrier(const XcdBarrier& b) {
    asm volatile("s_waitcnt vmcnt(0)" ::: "memory");
    __syncthreads();
    if (threadIdx.x == 0) {
        unsigned* bar = b.bar;
        __builtin_amdgcn_s_waitcnt(0);
        unsigned nloc = b.st[0], nx = b.st[1];
        if (nloc == 0u) { xcd_barrier_complete(bar, b.x, nloc, nx); b.st[0] = nloc; b.st[1] = nx; }
        const unsigned old = xb_add(&bar[XB_XSUB(b.x)], 1u);
        const unsigned gen = old / nloc;
        if (old + 1u == (gen + 1u) * nloc) {
            __builtin_amdgcn_fence(__ATOMIC_RELEASE, "agent");
            asm volatile("s_waitcnt vmcnt(0)" ::: "memory");
            const unsigned og = xb_add(&bar[XB_TOP], 1u);
            const unsigned tg = og / nx;
            if (og + 1u == (tg + 1u) * nx) xb_add(&bar[XB_TOPGEN], 1u);
            else XB_SPIN(xb_ld(&bar[XB_TOPGEN]) == tg, bar);
            __builtin_amdgcn_fence(__ATOMIC_ACQUIRE, "agent");
            xb_add(&bar[XB_XGEN(b.x)], 1u);
            asm volatile("s_waitcnt vmcnt(0)" ::: "memory");
        } else {
            XB_SPIN(xb_ld(&bar[XB_XGEN(b.x)]) == gen, bar);
            __builtin_amdgcn_fence(__ATOMIC_ACQUIRE, "agent");
            asm volatile("s_waitcnt vmcnt(0)" ::: "memory");
        }
    }
    __syncthreads();
}

struct TItem { const float* W; const float* g; bf16_t* WT; int K, N, row_off, ilv, item; };
__device__ __forceinline__ void p0_transpose_load(const TItem& t, float (&v)[32], int lane) {
    const int nblk = t.N / 32, kb = t.item / nblk, nb = t.item % nblk, k0 = 64 * kb, n0 = 32 * nb;
#pragma unroll
    for (int i = 0; i < 32; ++i) { const int kk = 2 * i + (lane >> 5); v[i] = t.W[(size_t)(k0 + kk) * t.N + n0 + (lane & 31)] * (t.g ? t.g[k0 + kk] : 1.0f); }
}
__device__ __forceinline__ void p0_transpose_store(const TItem& t, const float (&v)[32], LAS float* scr, int lane) {
    const int nblk = t.N / 32, kb = t.item / nblk, nb = t.item % nblk, k0 = 64 * kb, n0 = 32 * nb;
#pragma unroll
    for (int i = 0; i < 32; ++i) { const int kk = 2 * i + (lane >> 5); scr[kk * 33 + (lane & 31)] = v[i]; }
    asm volatile("s_waitcnt lgkmcnt(0)" ::: "memory");
    const int c = lane & 7;
    const int rbase = t.ilv ? (((n0 >> 7) << 8) + (n0 & 127) + (t.ilv == 2 ? 128 : 0)) : (t.row_off + n0);
#pragma unroll
    for (int j = 0; j < 4; ++j) { const int n = (lane >> 3) + 8 * j; const LAS float* s = scr + (8 * c) * 33 + n;
        u32x4 o; o.x = pkbf(s[0 * 33], s[1 * 33]); o.y = pkbf(s[2 * 33], s[3 * 33]); o.z = pkbf(s[4 * 33], s[5 * 33]); o.w = pkbf(s[6 * 33], s[7 * 33]);
        *(u32x4*)(t.WT + (size_t)(rbase + n) * t.K + k0 + 8 * c) = o; }
    asm volatile("s_waitcnt lgkmcnt(0)" ::: "memory");
}
__device__ __forceinline__ void row_to_bf16(const float* xrow, bf16_t* orow, float* ssq, int lane) {
    const f32x4* xr = (const f32x4*)xrow + lane;
    f32x4 v[4]; float s = 0.f;
#pragma unroll
    for (int j = 0; j < 4; ++j) { v[j] = xr[64 * j]; s += (v[j].x * v[j].x + v[j].y * v[j].y) + (v[j].z * v[j].z + v[j].w * v[j].w); }
    s = wave_sum(s);
    u32x2* o8 = (u32x2*)orow + lane;
#pragma unroll
    for (int j = 0; j < 4; ++j) { u32x2 w; w.x = pkbf(v[j].x, v[j].y); w.y = pkbf(v[j].z, v[j].w); o8[64 * j] = w; }
    if (lane == 0) *ssq = s;
}
__device__ __forceinline__ void p0_prologue(KA a, ldsp lds, int tid, int lane, int wave) {
    unsigned char* ws = a->ws;
    LAS float* scr = (LAS float*)(lds + wave * 16384);
    const int gw = blockIdx.x * NWAVES + wave, NGW = gridDim.x * NWAVES;
    constexpr int I_IN = 16 * 56, I_OUT = 16 * 32, I_Q = 16 * 16, I_MO = 8 * 32, I_G = 16 * 96, I_D = 48 * 32;
    constexpr int NITEMS = I_IN + I_OUT + 3 * I_Q + I_MO + 2 * I_G + I_D;
    auto item_of = [&](int it) -> TItem {
        int r = it;
        if (r < I_IN) return TItem{a->in[I_WIN], a->in[I_GMIX], (bf16_t*)(ws + WS_WIN), 1024, DIN, 0, 0, r}; r -= I_IN;
        if (r < I_OUT) return TItem{a->in[I_WOUT], nullptr, (bf16_t*)(ws + WS_WOUT), 1024, 1024, 0, 0, r}; r -= I_OUT;
        if (r < I_Q) return TItem{a->in[I_WMQ], a->in[I_GCROSS], (bf16_t*)(ws + WS_WQ), 1024, 512, 0, 0, r}; r -= I_Q;
        if (r < I_Q) return TItem{a->in[I_WMK], a->in[I_GMEM], (bf16_t*)(ws + WS_WKV), 1024, 512, 0, 0, r}; r -= I_Q;
        if (r < I_Q) return TItem{a->in[I_WMV], a->in[I_GMEM], (bf16_t*)(ws + WS_WKV), 1024, 512, 512, 0, r}; r -= I_Q;
        if (r < I_MO) return TItem{a->in[I_WMO], nullptr, (bf16_t*)(ws + WS_WMO), 512, 1024, 0, 0, r}; r -= I_MO;
        if (r < I_G) return TItem{a->in[I_WFG], a->in[I_GFFN], (bf16_t*)(ws + WS_WGU), 1024, DFF, 0, 1, r}; r -= I_G;
        if (r < I_G) return TItem{a->in[I_WFU], a->in[I_GFFN], (bf16_t*)(ws + WS_WGU), 1024, DFF, 0, 2, r}; r -= I_G;
        return TItem{a->in[I_WFD], nullptr, (bf16_t*)(ws + WS_WD), DFF, 1024, 0, 0, r};
    };
    for (int it = gw; it < NITEMS; it += 2 * NGW) {
        const TItem t0 = item_of(it); const bool two = it + NGW < NITEMS; const TItem t1 = item_of(two ? it + NGW : it);
        float v0[32], v1[32];
        p0_transpose_load(t0, v0, lane); p0_transpose_load(t1, v1, lane);
        p0_transpose_store(t0, v0, scr, lane);
        if (two) p0_transpose_store(t1, v1, scr, lane);
    }
    bf16_t* xb = (bf16_t*)(ws + WS_XB); float* ssq0 = (float*)(ws + WS_SSQ0);
    for (int m0 = gw; m0 < MT + 512; m0 += 2 * NGW) {
        const float* src[2]; bf16_t* dst[2]; float* sq[2]; bool ok[2];
#pragma unroll
        for (int q = 0; q < 2; ++q) { const int m = m0 + q * NGW; ok[q] = m < MT + 512;
            if (m < MP) { src[q] = a->in[I_XP] + (size_t)m * 1024; dst[q] = xb + (size_t)m * 1024; sq[q] = ssq0 + m; }
            else if (m < MT) { src[q] = a->in[I_XS] + (size_t)(m - MP) * 1024; dst[q] = xb + (size_t)m * 1024; sq[q] = ssq0 + m; }
            else { const int rr = ok[q] ? m - MT : 0; src[q] = a->in[I_MEMP] + (size_t)rr * 1024; dst[q] = (bf16_t*)(ws + WS_MEMA) + (size_t)rr * 1024; sq[q] = (float*)(ws + WS_SSQM) + rr; } }
        f32x4 v[2][4]; float s[2] = {0.f, 0.f};
#pragma unroll
        for (int q = 0; q < 2; ++q)
#pragma unroll
            for (int j = 0; j < 4; ++j) v[q][j] = ((const f32x4*)src[q] + lane)[64 * j];
#pragma unroll
        for (int q = 0; q < 2; ++q) {
#pragma unroll
            for (int j = 0; j < 4; ++j) s[q] += (v[q][j].x * v[q][j].x + v[q][j].y * v[q][j].y) + (v[q][j].z * v[q][j].z + v[q][j].w * v[q][j].w);
            s[q] = wave_sum(s[q]);
            if (ok[q]) {
#pragma unroll
                for (int j = 0; j < 4; ++j) { u32x2 wv; wv.x = pkbf(v[q][j].x, v[q][j].y); wv.y = pkbf(v[q][j].z, v[q][j].w); ((u32x2*)dst[q] + lane)[64 * j] = wv; }
                if (lane == 0) *sq[q] = s[q];
            }
        }
    }
    for (int i = blockIdx.x * NTHREADS + tid; i < MT; i += gridDim.x * NTHREADS) { ((float*)(ws + WS_SSQ1))[i] = 0.f; ((float*)(ws + WS_SSQ2))[i] = 0.f; ((float*)(ws + WS_SSQ3))[i] = 0.f; }
}

template <bool SAMPLE, int PASS>
__device__ __forceinline__ void lru_unit(KA a, ldsp lds, int unit, int tid, int lane, int w) {
    constexpr int NTOK = SAMPLE ? 64 : 256, NROW = SAMPLE ? (NTOK / 4) * 7 : NTOK + 3, RS = 272;
    const ldsp XR = lds, XC = lds + 259 * RS;
    unsigned char* ws = a->ws;
    const bf16_t* proj = (const bf16_t*)(ws + WS_PROJ);
    int b = 0, chunk, bp;
    if (!SAMPLE) { b = unit >> 7; chunk = (unit >> 2) & 31; bp = unit & 3; } else { chunk = unit >> 2; bp = unit & 3; }
    const int c0 = bp * 128;
    const int row0 = SAMPLE ? MP + chunk * 64 : b * SEQ + chunk * 256;
    const int nb = w >> 2, jt = w & 3, n = bp * 2 + nb, fr = lane & 15, fq = lane >> 4;
    const int ch = n * 64 + jt * 16 + fr, chl = nb * 64 + jt * 16 + fr;
    float wA[2][8], wX[2][8];
#pragma unroll
    for (int kh = 0; kh < 2; ++kh)
#pragma unroll
        for (int j = 0; j < 8; ++j) { const int c = kh * 32 + 8 * fq + j; const size_t o = (size_t)(n * 64 + c) * 64 + jt * 16 + fr; wA[kh][j] = a->in[I_WLA][o]; wX[kh][j] = a->in[I_WLX][o]; }
    const float ba_ = a->in[I_BLA][ch], bx_ = a->in[I_BLX][ch];
    const float lam = a->in[I_LAM][ch];
    const float wc0 = a->in[I_WLC][ch], wc1 = a->in[I_WLC][512 + ch], wc2 = a->in[I_WLC][1024 + ch], wc3 = a->in[I_WLC][1536 + ch], bcv = a->in[I_BLC][ch];
    float hc = 0.f, Atot = 1.f, Htot = 0.f;
    float* summ = (float*)(ws + WS_SUMM);
    typedef float f32x2_ __attribute__((ext_vector_type(2)));
    f32x2_ ah[32];
    if (!SAMPLE && PASS == 2) {
#pragma unroll
        for (int j = 0; j < 32; ++j) ah[j] = *(const f32x2_*)(summ + ((size_t)(b * 32 + j) * 512 + ch) * 2);
    }
    __syncthreads();
#pragma unroll
    for (int it = tid; it < NROW * 16; it += NTHREADS) {
        const int r = it >> 4, cq = it & 15;
        u32x4 v = {0u, 0u, 0u, 0u};
        if (!SAMPLE) { const int t = chunk * 256 - 3 + r; if (t >= 0) v = *(const u32x4*)(proj + (size_t)(b * SEQ + t) * DIN + c0 + cq * 8); }
        else { const int bl = r / 7, rr = r % 7, bs = chunk * 16 + bl;
            if (rr >= 3) v = *(const u32x4*)(proj + (size_t)(MP + bs * 4 + rr - 3) * DIN + c0 + cq * 8);
            else { const float* s = a->in[I_SLC] + (size_t)(bs * 3 + rr) * 512 + c0 + cq * 8; const f32x4 s0 = *(const f32x4*)s, s1 = *(const f32x4*)(s + 4);
                v.x = pkbf(s0[0], s0[1]); v.y = pkbf(s0[2], s0[3]); v.z = pkbf(s1[0], s1[1]); v.w = pkbf(s1[2], s1[3]); } }
        *(LAS u32x4*)(XR + r * RS + cq * 16) = v;
    }
    __syncthreads();
    {
        const int cq = tid & 15, tg = tid >> 4;
        float wk[4][8], bb[8];
#pragma unroll
        for (int j = 0; j < 8; ++j) { bb[j] = a->in[I_BLC][c0 + cq * 8 + j];
#pragma unroll
            for (int k = 0; k < 4; ++k) wk[k][j] = a->in[I_WLC][k * 512 + c0 + cq * 8 + j]; }
#pragma unroll
        for (int q = 0; q < NTOK / 32; ++q) {
            const int tok = tg * (NTOK / 32) + q; const int base = SAMPLE ? (tok >> 2) * 7 + (tok & 3) : tok;
            float x[8];
#pragma unroll
            for (int j = 0; j < 8; ++j) x[j] = bb[j];
#pragma unroll
            for (int k = 0; k < 4; ++k) { const u32x4 v = *(const LAS u32x4*)(XR + (base + k) * RS + cq * 16);
                x[0] += wk[k][0] * bflo(v.x); x[1] += wk[k][1] * bfhi(v.x); x[2] += wk[k][2] * bflo(v.y); x[3] += wk[k][3] * bfhi(v.y);
                x[4] += wk[k][4] * bflo(v.z); x[5] += wk[k][5] * bfhi(v.z); x[6] += wk[k][6] * bflo(v.w); x[7] += wk[k][7] * bfhi(v.w); }
            u32x4 o; o.x = pkbf(x[0], x[1]); o.y = pkbf(x[2], x[3]); o.z = pkbf(x[4], x[5]); o.w = pkbf(x[6], x[7]);
            *(LAS u32x4*)(XC + tok * RS + cq * 16) = o;
        }
    }
    __syncthreads();
    const float sp = (lam > 15.f) ? __expf(-lam) : log1pf(__expf(-lam));
    const float k8 = -8.0f * sp * LOG2E;
    bf16x8 bA[2], bX[2];
#pragma unroll
    for (int kh = 0; kh < 2; ++kh)
#pragma unroll
        for (int j = 0; j < 8; ++j) { bA[kh][j] = (short)f2bf(wA[kh][j]); bX[kh][j] = (short)f2bf(wX[kh][j]); }
    if (!SAMPLE && PASS == 2) {
#pragma unroll
        for (int j = 0; j < 32; ++j) if (j < chunk) hc = ah[j].x * hc + ah[j].y;
    }
    bf16_t* mix = (bf16_t*)(ws + WS_MIX);
    unsigned short gcur[4] = {0, 0, 0, 0}, gnxt[4] = {0, 0, 0, 0};
    if (SAMPLE || PASS == 2) {
#pragma unroll
        for (int r = 0; r < 4; ++r) gcur[r] = proj[((size_t)row0 + 4 * fq + r) * DIN + 512 + ch];
    }
#pragma unroll 2
    for (int s = 0; s < NTOK / 16; ++s) {
        if ((SAMPLE || PASS == 2) && s + 1 < NTOK / 16) {
#pragma unroll
            for (int r = 0; r < 4; ++r) gnxt[r] = proj[((size_t)row0 + 16 * (s + 1) + 4 * fq + r) * DIN + 512 + ch];
        }
        bf16x8 aF[2];
#pragma unroll
        for (int kh = 0; kh < 2; ++kh) aF[kh] = *(const LAS bf16x8*)(XC + (16 * s + fr) * RS + (nb * 64 + kh * 32 + 8 * fq) * 2);
        f32x4 accA = {0.f, 0.f, 0.f, 0.f}, accX = {0.f, 0.f, 0.f, 0.f};
        accA = MFMA16(aF[0], bA[0], accA); accA = MFMA16(aF[1], bA[1], accA);
        accX = MFMA16(aF[0], bX[0], accX); accX = MFMA16(aF[1], bX[1], accX);
        const int base = SAMPLE ? (4 * s + fq) * 7 : 16 * s + 4 * fq;
        float x7[7];
#pragma unroll
        for (int q = 0; q < 7; ++q) x7[q] = bf2f(*(const LAS unsigned short*)(XR + (base + q) * RS + chl * 2));
        float av[4], bv[4];
#pragma unroll
        for (int r = 0; r < 4; ++r) {
            const float xc = bcv + wc0 * x7[r] + wc1 * x7[r + 1] + wc2 * x7[r + 2] + wc3 * x7[r + 3];
            const float rg = sigmoidf_(accA[r] + ba_), ig = sigmoidf_(accX[r] + bx_);
            const float a_ = fexp2(k8 * rg);
            av[r] = a_; bv[r] = __builtin_sqrtf(fmaxf(1.0f - a_ * a_, 0.f)) * (ig * xc);
        }
        float hv[4];
        if (SAMPLE) {
            const int bs = chunk * 16 + 4 * s + fq;
            float h = a->in[I_SLH][(size_t)bs * 512 + ch];
#pragma unroll
            for (int r = 0; r < 4; ++r) { h = av[r] * h + bv[r]; hv[r] = h; }
            a->out[O_SLH + (size_t)bs * 512 + ch] = h;
        } else {
            float Ai = av[0] * av[1] * av[2] * av[3], Hi = 0.f;
#pragma unroll
            for (int r = 0; r < 4; ++r) Hi = av[r] * Hi + bv[r];
            float tA = __shfl_up(Ai, 16), tH = __shfl_up(Hi, 16);
            if (fq >= 1) { Hi = Ai * tH + Hi; Ai = Ai * tA; }
            tA = __shfl_up(Ai, 32); tH = __shfl_up(Hi, 32);
            if (fq >= 2) { Hi = Ai * tH + Hi; Ai = Ai * tA; }
            float Ae = __shfl_up(Ai, 16), He = __shfl_up(Hi, 16);
            if (fq == 0) { Ae = 1.f; He = 0.f; }
            const float At = __shfl(Ai, 48 + fr), Ht = __shfl(Hi, 48 + fr);
            if (PASS == 1) { Htot = At * Htot + Ht; Atot *= At; }
            else {
                float h = Ae * hc + He;
#pragma unroll
                for (int r = 0; r < 4; ++r) { h = av[r] * h + bv[r]; hv[r] = h; }
                hc = At * hc + Ht;
            }
        }
        if (SAMPLE || PASS == 2) {
#pragma unroll
            for (int r = 0; r < 4; ++r) {
                const size_t row = (size_t)row0 + 16 * s + 4 * fq + r;
                mix[row * 1024 + ch] = (bf16_t)f2bf(hv[r] * gelu_tanh(bf2f(gcur[r])));
            }
#pragma unroll
            for (int r = 0; r < 4; ++r) gcur[r] = gnxt[r];
        }
    }
    if (!SAMPLE && PASS == 1 && fq == 0) { summ[((size_t)(b * 32 + chunk) * 512 + ch) * 2] = Atot; summ[((size_t)(b * 32 + chunk) * 512 + ch) * 2 + 1] = Htot; }
    if (!SAMPLE && PASS == 2 && chunk == 31 && fq == 0) a->out[O_PLH + (size_t)b * 512 + ch] = hc;
}

__device__ __forceinline__ void swa_prompt_unit(KA a, ldsp lds, int unit, int tid, int lane, int w) {
    constexpr int KRS = 144, VRS = 400;
    const ldsp Ks = lds, VT = lds + 192 * KRS;
    const bf16_t* proj = (const bf16_t*)(a->ws + WS_PROJ);
    const int b = unit >> 8, hk = (unit >> 7) & 1, qb = unit & 127, t0 = qb * 64;
    __syncthreads();
#pragma unroll
    for (int it = tid; it < 192 * 8; it += NTHREADS) {
        const int kl = it >> 3, cq = it & 7, t = t0 - 128 + kl;
        u32x4 kv = {0u, 0u, 0u, 0u}, vv = {0u, 0u, 0u, 0u};
        if (t >= 0) { const bf16_t* p = proj + (size_t)(b * SEQ + t) * DIN; kv = *(const u32x4*)(p + 1536 + hk * 64 + cq * 8); vv = *(const u32x4*)(p + 1664 + hk * 64 + cq * 8); }
        *(LAS u32x4*)(Ks + kl * KRS + cq * 16) = kv;
#pragma unroll
        for (int e = 0; e < 8; ++e) *(LAS unsigned short*)(VT + (cq * 8 + e) * VRS + kl * 2) = (unsigned short)(vv[e >> 1] >> (16 * (e & 1)));
    }
    __syncthreads();
    const int g = w >> 1, hf = w & 1, hq = hk * 4 + g, j = lane & 31, hi = lane >> 5;
    const size_t qrow = (size_t)b * SEQ + t0 + 32 * hf + j;
    bf16x8 qf[4];
#pragma unroll
    for (int ks = 0; ks < 4; ++ks) qf[ks] = *(const bf16x8*)(proj + qrow * DIN + 1024 + hq * 64 + 16 * ks + 8 * hi);
    const float slope2 = fexp2(-(float)(hq + 1)) * LOG2E, sink2 = a->in[I_SINK][hq] * LOG2E;
    float mx = sink2;
    f32x16 st[5];
#pragma unroll
    for (int kt = 0; kt < 5; ++kt) {
        f32x16 acc = {};
#pragma unroll
        for (int ks = 0; ks < 4; ++ks) { const bf16x8 kf = *(const LAS bf16x8*)(Ks + (32 * hf + 32 * kt + j) * KRS + (16 * ks + 8 * hi) * 2); acc = MFMA32(kf, qf[ks], acc); }
        int dbase = 128 + j - 32 * kt - 4 * hi;
        int kpb = t0 - 128 + 32 * hf + 32 * kt + 4 * hi;
        asm volatile("" : "+v"(dbase), "+v"(kpb));
#pragma unroll
        for (int r = 0; r < 16; ++r) {
            const int cr = (r & 3) + 8 * (r >> 2), dist = dbase - cr;
            const bool valid = (unsigned)dist < 128u && (kpb + cr) >= 0;
            float s = acc[r] * LOG2E - slope2 * (float)dist; s = valid ? s : -1e30f; acc[r] = s; mx = fmaxf(mx, s);
        }
        st[kt] = acc;
        __builtin_amdgcn_sched_barrier(0);
    }
    mx = fmaxf(mx, __shfl_xor(mx, 32));
    float l = 0.f;
#pragma unroll
    for (int kt = 0; kt < 5; ++kt)
#pragma unroll
        for (int r = 0; r < 16; ++r) { const float p = fexp2(st[kt][r] - mx); st[kt][r] = p; l += p; }
    l += __shfl_xor(l, 32); l += fexp2(sink2 - mx);
    const float inv = frcp(l);
    f32x16 o[2] = {};
#pragma unroll
    for (int kt = 0; kt < 5; ++kt)
#pragma unroll
        for (int s = 0; s < 2; ++s) {
            const bf16x8 pf = pack8(st[kt], s);
#pragma unroll
            for (int dt = 0; dt < 2; ++dt) {
                const int d = 32 * dt + j, kb = 32 * hf + 32 * kt + 16 * s + 4 * hi;
                const s16x4 lo = *(const LAS s16x4*)(VT + d * VRS + kb * 2), hi4 = *(const LAS s16x4*)(VT + d * VRS + (kb + 8) * 2);
                const bf16x8 vf = __builtin_shufflevector(lo, hi4, 0, 1, 2, 3, 4, 5, 6, 7);
                o[dt] = MFMA32(vf, pf, o[dt]);
            }
            __builtin_amdgcn_sched_barrier(0);
        }
    bf16_t* mix = (bf16_t*)(a->ws + WS_MIX);
#pragma unroll
    for (int dt = 0; dt < 2; ++dt)
#pragma unroll
        for (int rg = 0; rg < 4; ++rg) {
            u32x2 wv; wv.x = pkbf(o[dt][4 * rg] * inv, o[dt][4 * rg + 1] * inv); wv.y = pkbf(o[dt][4 * rg + 2] * inv, o[dt][4 * rg + 3] * inv);
            *(u32x2*)(mix + qrow * 1024 + 512 + hq * 64 + 32 * dt + 8 * rg + 4 * hi) = wv;
        }
}

__device__ __forceinline__ void swa_sample_unit(KA a, ldsp lds, int bs, int tid) {
    LAS float* Kc = (LAS float*)lds;
    LAS float* Vc = (LAS float*)(lds + 69696);
    LAS float* Qs = (LAS float*)(lds + 137280);
    LAS float* P = Kc;
    const bf16_t* proj = (const bf16_t*)(a->ws + WS_PROJ);
    __syncthreads();
    {
        f32x4 kvv[8], vvv[8]; unsigned short qv[4], nk, nv;
#pragma unroll
        for (int q = 0; q < 8; ++q) { const int it = tid + q * NTHREADS, r = it >> 5, c4 = (it & 31) * 4;
            kvv[q] = *(const f32x4*)(a->in[I_CSK] + (size_t)(bs * 128 + r) * 128 + c4); vvv[q] = *(const f32x4*)(a->in[I_CSV] + (size_t)(bs * 128 + r) * 128 + c4); }
#pragma unroll
        for (int q = 0; q < 4; ++q) { const int e = tid + q * NTHREADS, rq = e >> 6, d = e & 63, hq = rq >> 2, i = rq & 3; qv[q] = proj[(size_t)(MP + bs * 4 + i) * DIN + 1024 + hq * 64 + d]; }
        { const int i = tid >> 7, c = tid & 127; const bf16_t* p = proj + (size_t)(MP + bs * 4 + i) * DIN; nk = p[1536 + c]; nv = p[1664 + c]; }
#pragma unroll
        for (int q = 0; q < 8; ++q) { const int it = tid + q * NTHREADS, r = it >> 5, c4 = (it & 31) * 4;
            *(LAS f32x4*)(Kc + r * 132 + c4) = kvv[q]; *(LAS f32x4*)(Vc + r * 128 + c4) = vvv[q];
            if (r >= 4) { *(f32x4*)(a->out + O_SSK + (size_t)(bs * 128 + r - 4) * 128 + c4) = kvv[q]; *(f32x4*)(a->out + O_SSV + (size_t)(bs * 128 + r - 4) * 128 + c4) = vvv[q]; } }
#pragma unroll
        for (int q = 0; q < 4; ++q) { const int e = tid + q * NTHREADS; Qs[e] = bf2f(qv[q]); }
        { const int i = tid >> 7, c = tid & 127; Kc[(128 + i) * 132 + c] = bf2f(nk); Vc[(128 + i) * 128 + c] = bf2f(nv); }
    }
    __syncthreads();
    float sc[16];
    const int rg = tid / 33, kg = tid - rg * 33, hkS = rg >> 2;
#pragma unroll
    for (int q = 0; q < 16; ++q) sc[q] = 0.f;
    if (tid < 264) {
#pragma unroll 2
        for (int c = 0; c < 16; ++c) {
            f32x4 kk[4], qq[4];
#pragma unroll
            for (int i = 0; i < 4; ++i) { kk[i] = *(const LAS f32x4*)(Kc + (kg + 33 * i) * 132 + hkS * 64 + 4 * c); qq[i] = *(const LAS f32x4*)(Qs + (rg * 4 + i) * 64 + 4 * c); }
#pragma unroll
            for (int ri = 0; ri < 4; ++ri)
#pragma unroll
                for (int ki = 0; ki < 4; ++ki) sc[ri * 4 + ki] += (qq[ri][0] * kk[ki][0] + qq[ri][1] * kk[ki][1]) + (qq[ri][2] * kk[ki][2] + qq[ri][3] * kk[ki][3]);
        }
    }
    __syncthreads();
    if (tid < 264) {
#pragma unroll
        for (int ri = 0; ri < 4; ++ri)
#pragma unroll
            for (int ki = 0; ki < 4; ++ki) { const int row = rg * 4 + ri, hq = row >> 2, i = row & 3, key = kg + 33 * ki, dist = i + 128 - key; const bool valid = dist >= 0 && dist < 128;
                const float s = sc[ri * 4 + ki] * LOG2E - fexp2(-(float)(hq + 1)) * LOG2E * (float)dist; P[row * 132 + key] = valid ? s : -1e30f; }
    }
    __syncthreads();
    {
        const int row = tid >> 4, sub = tid & 15, hq = row >> 2; const float sink2 = a->in[I_SINK][hq] * LOG2E;
        float v[9], m = sink2;
#pragma unroll
        for (int jj = 0; jj < 9; ++jj) { const int k2 = sub + 16 * jj; v[jj] = k2 < 132 ? P[row * 132 + k2] : -1e30f; m = fmaxf(m, v[jj]); }
#pragma unroll
        for (int o = 8; o >= 1; o >>= 1) m = fmaxf(m, __shfl_xor(m, o));
        float l = 0.f;
#pragma unroll
        for (int jj = 0; jj < 9; ++jj) { v[jj] = fexp2(v[jj] - m); l += v[jj]; }
#pragma unroll
        for (int o = 8; o >= 1; o >>= 1) l += __shfl_xor(l, o);
        l += fexp2(sink2 - m);
        const float inv = 1.0f / l;
#pragma unroll
        for (int jj = 0; jj < 9; ++jj) { const int k2 = sub + 16 * jj; if (k2 < 132) P[row * 132 + k2] = v[jj] * inv; }
    }
    __syncthreads();
    {
        LAS float* PART2 = Kc + 5120;
        const int lane = tid & 63, d4 = (lane & 15) * 4, kq = lane >> 4, rowgrp = tid >> 6, hk2 = rowgrp >> 2;
        f32x4 acc[4];
#pragma unroll
        for (int ri = 0; ri < 4; ++ri) acc[ri] = (f32x4){0.f, 0.f, 0.f, 0.f};
#pragma unroll 3
        for (int k2 = kq * 33; k2 < kq * 33 + 33; ++k2) { const f32x4 v4 = *(const LAS f32x4*)(Vc + k2 * 128 + hk2 * 64 + d4);
#pragma unroll
            for (int ri = 0; ri < 4; ++ri) acc[ri] += P[(rowgrp * 4 + ri) * 132 + k2] * v4; }
#pragma unroll
        for (int ri = 0; ri < 4; ++ri) *(LAS f32x4*)(PART2 + (kq * 32 + rowgrp * 4 + ri) * 64 + d4) = acc[ri];
    }
    __syncthreads();
    {
        const LAS float* PART2 = Kc + 5120;
        const int row = tid >> 4, d4 = (tid & 15) * 4, hq = row >> 2, i = row & 3;
        f32x4 acc = *(const LAS f32x4*)(PART2 + row * 64 + d4);
#pragma unroll
        for (int p = 1; p < 4; ++p) acc += *(const LAS f32x4*)(PART2 + (p * 32 + row) * 64 + d4);
        u32x2 wv; wv.x = pkbf(acc[0], acc[1]); wv.y = pkbf(acc[2], acc[3]);
        *(u32x2*)((bf16_t*)(a->ws + WS_MIX) + (size_t)(MP + bs * 4 + i) * 1024 + 512 + hq * 64 + d4) = wv;
    }
}

__device__ __forceinline__ void xattn_prompt_unit(KA a, ldsp lds, int unit, int tid, int lane, int w) {
    constexpr int KRS = 272, VRS = 528;
    const ldsp Km = lds, VmT = lds + 256 * KRS;
    const bf16_t* memkv = (const bf16_t*)(a->ws + WS_MEMKV);
    const bf16_t* qcb = (const bf16_t*)(a->ws + WS_QC);
    const int b = unit >> 7, h = (unit >> 5) & 3, qc = unit & 31;
    __syncthreads();
#pragma unroll
    for (int it = tid; it < 256 * 16; it += NTHREADS) {
        const int key = it >> 4, cq = it & 15; const bf16_t* p = memkv + (size_t)(b * 256 + key) * 1024 + h * 128 + cq * 8;
        const u32x4 kv = *(const u32x4*)p, vv = *(const u32x4*)(p + 512);
        *(LAS u32x4*)(Km + key * KRS + cq * 16) = kv;
#pragma unroll
        for (int e = 0; e < 8; ++e) *(LAS unsigned short*)(VmT + (cq * 8 + e) * VRS + key * 2) = (unsigned short)(vv[e >> 1] >> (16 * (e & 1)));
    }
    __syncthreads();
    const int j = lane & 31, hi = lane >> 5;
    const size_t qrow = (size_t)b * SEQ + qc * 256 + 32 * w + j;
    bf16x8 qf[8];
#pragma unroll
    for (int ks = 0; ks < 8; ++ks) qf[ks] = *(const bf16x8*)(qcb + qrow * 512 + h * 128 + 16 * ks + 8 * hi);
    float m = -1e30f, l = 0.f;
    f32x16 o[4] = {};
#pragma unroll
    for (int kh = 0; kh < 2; ++kh) {
        f32x16 st[4];
        float mx = -1e30f;
#pragma unroll
        for (int kt = 0; kt < 4; ++kt) {
            f32x16 acc = {};
#pragma unroll
            for (int ks = 0; ks < 8; ++ks) { const bf16x8 kf = *(const LAS bf16x8*)(Km + (128 * kh + 32 * kt + j) * KRS + (16 * ks + 8 * hi) * 2); acc = MFMA32(kf, qf[ks], acc); }
#pragma unroll
            for (int r = 0; r < 16; ++r) { acc[r] *= LOG2E; mx = fmaxf(mx, acc[r]); }
            st[kt] = acc;
        }
        mx = fmaxf(mx, __shfl_xor(mx, 32));
        const float mn = fmaxf(m, mx), scl = fexp2(m - mn);
        m = mn; l *= scl;
#pragma unroll
        for (int dt = 0; dt < 4; ++dt) o[dt] *= scl;
#pragma unroll
        for (int kt = 0; kt < 4; ++kt)
#pragma unroll
            for (int r = 0; r < 16; ++r) { const float p = fexp2(st[kt][r] - m); st[kt][r] = p; l += p; }
#pragma unroll
        for (int kt = 0; kt < 4; ++kt)
#pragma unroll
            for (int s = 0; s < 2; ++s) {
                const bf16x8 pf = pack8(st[kt], s);
#pragma unroll
                for (int dt = 0; dt < 4; ++dt) {
                    const int d = 32 * dt + j, kb = 128 * kh + 32 * kt + 16 * s + 4 * hi;
                    const s16x4 lo = *(const LAS s16x4*)(VmT + d * VRS + kb * 2), hi4 = *(const LAS s16x4*)(VmT + d * VRS + (kb + 8) * 2);
                    const bf16x8 vf = __builtin_shufflevector(lo, hi4, 0, 1, 2, 3, 4, 5, 6, 7);
                    o[dt] = MFMA32(vf, pf, o[dt]);
                }
            }
    }
    l += __shfl_xor(l, 32);
    const float inv = frcp(l);
    bf16_t* oc = (bf16_t*)(a->ws + WS_OC);
#pragma unroll
    for (int dt = 0; dt < 4; ++dt)
#pragma unroll
        for (int rg = 0; rg < 4; ++rg) {
            u32x2 wv; wv.x = pkbf(o[dt][4 * rg] * inv, o[dt][4 * rg + 1] * inv); wv.y = pkbf(o[dt][4 * rg + 2] * inv, o[dt][4 * rg + 3] * inv);
            *(u32x2*)(oc + qrow * 512 + h * 128 + 32 * dt + 8 * rg + 4 * hi) = wv;
        }
}
__device__ __forceinline__ void xattn_sample_unit(KA a, ldsp lds, int unit, int tid, int lane, int w) {
    LAS float* Qs = (LAS float*)lds;
    LAS float* S = (LAS float*)(lds + 2048);
    LAS float* RED = (LAS float*)(lds + 8192);
    const bf16_t* qcb = (const bf16_t*)(a->ws + WS_QC);
    const int bs = unit >> 2, h = unit & 3;
    __syncthreads();
    { const int i = tid >> 7, d = tid & 127; Qs[i * 128 + d] = bf2f(qcb[(size_t)(MP + bs * 4 + i) * 512 + h * 128 + d]); }
    __syncthreads();
    {
        const int key = tid >> 1, hf = tid & 1; const float* kp = a->in[I_CMK] + ((size_t)(bs * 256 + key) * 4 + h) * 128 + hf * 64;
        float s0 = 0.f, s1 = 0.f, s2 = 0.f, s3 = 0.f;
#pragma unroll
        for (int c = 0; c < 16; ++c) {
            const f32x4 k4 = *(const f32x4*)(kp + 4 * c);
            const f32x4 q0 = *(const LAS f32x4*)(Qs + hf * 64 + 4 * c), q1 = *(const LAS f32x4*)(Qs + 128 + hf * 64 + 4 * c), q2 = *(const LAS f32x4*)(Qs + 256 + hf * 64 + 4 * c), q3 = *(const LAS f32x4*)(Qs + 384 + hf * 64 + 4 * c);
            s0 += (k4[0] * q0[0] + k4[1] * q0[1]) + (k4[2] * q0[2] + k4[3] * q0[3]); s1 += (k4[0] * q1[0] + k4[1] * q1[1]) + (k4[2] * q1[2] + k4[3] * q1[3]);
            s2 += (k4[0] * q2[0] + k4[1] * q2[1]) + (k4[2] * q2[2] + k4[3] * q2[3]); s3 += (k4[0] * q3[0] + k4[1] * q3[1]) + (k4[2] * q3[2] + k4[3] * q3[3]);
        }
        s0 += __shfl_xor(s0, 1); s1 += __shfl_xor(s1, 1); s2 += __shfl_xor(s2, 1); s3 += __shfl_xor(s3, 1);
        if (hf == 0) { S[key] = s0 * LOG2E; S[256 + key] = s1 * LOG2E; S[512 + key] = s2 * LOG2E; S[768 + key] = s3 * LOG2E; }
    }
    __syncthreads();
    if (w < 4) {
        f32x4 v = *(const LAS f32x4*)(S + w * 256 + lane * 4);
        float m = fmaxf(fmaxf(v[0], v[1]), fmaxf(v[2], v[3]));
#pragma unroll
        for (int o = 32; o >= 1; o >>= 1) m = fmaxf(m, __shfl_xor(m, o));
        v[0] = fexp2(v[0] - m); v[1] = fexp2(v[1] - m); v[2] = fexp2(v[2] - m); v[3] = fexp2(v[3] - m);
        const float l = wave_sum((v[0] + v[1]) + (v[2] + v[3]));
        v *= (1.0f / l);
        *(LAS f32x4*)(S + w * 256 + lane * 4) = v;
    }
    __syncthreads();
    {
        const int dq = tid & 31, kg = tid >> 5; const float* vp = a->in[I_CMV] + ((size_t)(bs * 256 + kg * 16) * 4 + h) * 128 + dq * 4;
        f32x4 a0 = {0.f, 0.f, 0.f, 0.f}, a1 = a0, a2 = a0, a3 = a0;
#pragma unroll
        for (int kk = 0; kk < 16; ++kk) { const f32x4 v4 = *(const f32x4*)(vp + (size_t)kk * 512); const int k2 = kg * 16 + kk;
            a0 += S[k2] * v4; a1 += S[256 + k2] * v4; a2 += S[512 + k2] * v4; a3 += S[768 + k2] * v4; }
        *(LAS f32x4*)(RED + (kg * 4 + 0) * 128 + dq * 4) = a0; *(LAS f32x4*)(RED + (kg * 4 + 1) * 128 + dq * 4) = a1;
        *(LAS f32x4*)(RED + (kg * 4 + 2) * 128 + dq * 4) = a2; *(LAS f32x4*)(RED + (kg * 4 + 3) * 128 + dq * 4) = a3;
    }
    __syncthreads();
    { const int i = tid >> 7, d = tid & 127; float s = 0.f;
#pragma unroll
        for (int kg = 0; kg < 16; ++kg) s += RED[(kg * 4 + i) * 128 + d];
        ((bf16_t*)(a->ws + WS_OC))[(size_t)(MP + bs * 4 + i) * 512 + h * 128 + d] = (bf16_t)f2bf(s); }
}


template <class Post> __device__ __forceinline__ void sk_tile(ldsp lds, const bf16_t* A, int lda, const bf16_t* B0, const bf16_t* B1, int K, const Post& post, int tid, int lane, int w) {
    const int fr = lane & 15, fq = lane >> 4, kper = K >> 3;
    const bf16_t* ap = A + (size_t)fr * lda + w * kper + 16 * fq;
    const bf16_t* bp0 = B0 + (size_t)fr * K + w * kper + 16 * fq;
    const bf16_t* bp1 = B1 + (size_t)fr * K + w * kper + 16 * fq;
    f32x4 acc[2][8];
#pragma unroll
    for (int i = 0; i < 2; ++i)
#pragma unroll
        for (int j = 0; j < 8; ++j) acc[i][j] = (f32x4){0.f, 0.f, 0.f, 0.f};
    for (int k0 = 0; k0 < kper; k0 += 128) {
        bf16x8 af[2][2][2], bf[2][8][2];
#pragma unroll
        for (int c = 0; c < 2; ++c) {
            const int kk = k0 + 64 * c;
            if (kk < kper) {
#pragma unroll
                for (int i = 0; i < 2; ++i) { af[c][i][0] = *(const bf16x8*)(ap + (size_t)(16 * i) * lda + kk); af[c][i][1] = *(const bf16x8*)(ap + (size_t)(16 * i) * lda + kk + 8); }
#pragma unroll
                for (int j = 0; j < 4; ++j) { bf[c][j][0] = *(const bf16x8*)(bp0 + (size_t)(16 * j) * K + kk); bf[c][j][1] = *(const bf16x8*)(bp0 + (size_t)(16 * j) * K + kk + 8);
                    bf[c][4 + j][0] = *(const bf16x8*)(bp1 + (size_t)(16 * j) * K + kk); bf[c][4 + j][1] = *(const bf16x8*)(bp1 + (size_t)(16 * j) * K + kk + 8); }
            }
        }
#pragma unroll
        for (int c = 0; c < 2; ++c) {
            if (k0 + 64 * c < kper) {
#pragma unroll
                for (int hl = 0; hl < 2; ++hl)
#pragma unroll
                    for (int i = 0; i < 2; ++i)
#pragma unroll
                        for (int j = 0; j < 8; ++j) acc[i][j] = MFMA16(af[c][i][hl], bf[c][j][hl], acc[i][j]);
            }
        }
    }
    LAS float* PART = (LAS float*)lds;
    __syncthreads();
#pragma unroll
    for (int i = 0; i < 2; ++i)
#pragma unroll
        for (int j = 0; j < 8; ++j)
#pragma unroll
            for (int r = 0; r < 4; ++r) PART[(w * 32 + 16 * i + 4 * fq + r) * 132 + 16 * j + fr] = acc[i][j][r];
    __syncthreads();
    const int row = tid >> 4, cc = tid & 15;
    f32x4 v0 = *(const LAS f32x4*)(PART + row * 132 + 4 * cc), v1 = *(const LAS f32x4*)(PART + row * 132 + 64 + 4 * cc);
#pragma unroll
    for (int p = 1; p < 8; ++p) { v0 += *(const LAS f32x4*)(PART + (p * 32 + row) * 132 + 4 * cc); v1 += *(const LAS f32x4*)(PART + (p * 32 + row) * 132 + 64 + 4 * cc); }
    post(row, cc, v0, v1);
}
__device__ __forceinline__ void st4bf(bf16_t* p, f32x4 v) { u32x2 w_; w_.x = pkbf(v[0], v[1]); w_.y = pkbf(v[2], v[3]); *(u32x2*)p = w_; }
struct SkProj {
    bf16_t* proj; const float* ssq; float* out; int mt, n0;
    __device__ __forceinline__ void operator()(int row, int cc, f32x4 va, f32x4 vb) const {
        const int grow = MP + 32 * mt + row, r2 = grow - MP, b = r2 >> 2, t = r2 & 3;
        const float rs0 = __builtin_amdgcn_rsqf(ssq[grow] * (1.0f / 1024.0f) + EPS);
#pragma unroll
        for (int hh = 0; hh < 2; ++hh) {
            const int col = n0 + hh * 64 + 4 * cc; const float rs = rs0 * ((col >= 1024 && col < 1536) ? 0.125f : 1.0f);
            const f32x4 v = (hh ? vb : va) * rs;
            st4bf(proj + (size_t)grow * DIN + col, v);
            float* dst = nullptr;
            if (col >= 1536) dst = out + (col < 1664 ? O_SSK + (size_t)(b * 128 + 124 + t) * 128 + (col - 1536) : O_SSV + (size_t)(b * 128 + 124 + t) * 128 + (col - 1664));
            else if (col < 512 && t >= 1) dst = out + O_SLC + (size_t)(b * 3 + t - 1) * 512 + col;
            if (dst) *(f32x4*)dst = v;
        }
    }
};
template <int MODE> struct SkRes {
    const float* res; float* xout; bf16_t* xb; float* ssq; int mt, n0;
    __device__ __forceinline__ void operator()(int row, int cc, f32x4 va, f32x4 vb) const {
        const int grow = MP + 32 * mt + row; float sq = 0.f;
#pragma unroll
        for (int hh = 0; hh < 2; ++hh) {
            const int col = n0 + hh * 64 + 4 * cc;
            f32x4 v = hh ? vb : va;
            if (MODE == 0) v += *(const f32x4*)(res + (size_t)grow * 1024 + col);
            else { const u32x2 rr = *(const u32x2*)(xb + (size_t)grow * 1024 + col); v += (f32x4){bflo(rr.x), bfhi(rr.x), bflo(rr.y), bfhi(rr.y)}; }
            if (MODE == 2) *(f32x4*)(xout + (size_t)grow * 1024 + col) = v; else st4bf(xb + (size_t)grow * 1024 + col, v);
            sq += (v[0] * v[0] + v[1] * v[1]) + (v[2] * v[2] + v[3] * v[3]);
        }
        if (MODE != 2) {
            sq += __shfl_xor(sq, 1); sq += __shfl_xor(sq, 2); sq += __shfl_xor(sq, 4); sq += __shfl_xor(sq, 8);
            if (cc == 0) __hip_atomic_fetch_add(ssq + grow, sq, __ATOMIC_RELAXED, __HIP_MEMORY_SCOPE_AGENT);
        }
    }
};
struct SkQ {
    bf16_t* qc; const float* ssq; int mt, n0;
    __device__ __forceinline__ void operator()(int row, int cc, f32x4 va, f32x4 vb) const {
        const int grow = MP + 32 * mt + row; const float rs = __builtin_amdgcn_rsqf(ssq[grow] * (1.0f / 1024.0f) + EPS) * 0.08838834764831845f;
        st4bf(qc + (size_t)grow * 512 + n0 + 4 * cc, va * rs); st4bf(qc + (size_t)grow * 512 + n0 + 64 + 4 * cc, vb * rs);
    }
};
struct SkGU {
    bf16_t* h; const float* ssq; const float* wconv; const float* bconv; const float* state; float* out; int mt, ch0;
    __device__ __forceinline__ void operator()(int row, int cc, f32x4 va, f32x4 vb) const {
        const int grow = MP + 32 * mt + row, r2 = grow - MP, bs = r2 >> 2, t = r2 & 3, c = ch0 + 4 * cc;
        const float rs = __builtin_amdgcn_rsqf(ssq[grow] * (1.0f / 1024.0f) + EPS);
        const f32x4 g = va * rs, up = vb * rs;
        f32x4 p1, p2;
#pragma unroll
        for (int j = 0; j < 4; ++j) { p1[j] = __shfl_up(g[j], 16); p2[j] = __shfl_up(g[j], 32); }
        f32x4 s1 = {0.f, 0.f, 0.f, 0.f}, s0 = {0.f, 0.f, 0.f, 0.f};
        if (t < 2) s1 = *(const f32x4*)(state + ((size_t)bs * 2 + 1) * DFF + c);
        if (t == 0) s0 = *(const f32x4*)(state + ((size_t)bs * 2 + 0) * DFF + c);
        const f32x4 g1 = t >= 1 ? p1 : s1, g2 = t >= 2 ? p2 : (t == 1 ? s1 : s0);
        if (t >= 2) *(f32x4*)(out + O_SFC + ((size_t)bs * 2 + (t - 2)) * DFF + c) = g;
        const f32x4 w0 = *(const f32x4*)(wconv + c), w1 = *(const f32x4*)(wconv + DFF + c), w2 = *(const f32x4*)(wconv + 2 * DFF + c), bc = *(const f32x4*)(bconv + c);
        const f32x4 gc = bc + w0 * g2 + w1 * g1 + w2 * g;
        u32x2 wv; wv.x = pkbf(gelu_tanh(gc[0]) * up[0], gelu_tanh(gc[1]) * up[1]); wv.y = pkbf(gelu_tanh(gc[2]) * up[2], gelu_tanh(gc[3]) * up[3]);
        *(u32x2*)(h + (size_t)grow * DFF + c) = wv;
    }
};

__device__ __forceinline__ void ffn_fixup_tile(KA a, int pm, int tid) {
    const float* edge = (const float*)(a->ws + WS_EDGE); bf16_t* hb = (bf16_t*)(a->ws + WS_H);
    const float* wconv = a->in[I_WFC]; const float* bconv = a->in[I_BFC];
#pragma unroll 4
    for (int it = tid; it < 4 * 2 * 768; it += NTHREADS) {
        const int q = it / 1536, rem = it % 1536, rr = rem / 768, c4 = (rem % 768) * 4;
        const int blk = pm * 4 + q; const bool hasprev = (blk & 127) != 0;
        const f32x4 z = {0.f, 0.f, 0.f, 0.f};
        const f32x4 G0 = *(const f32x4*)(edge + ((size_t)blk * 6 + 0) * DFF + c4), G1 = *(const f32x4*)(edge + ((size_t)blk * 6 + 1) * DFF + c4);
        const f32x4 Gm2 = hasprev ? *(const f32x4*)(edge + ((size_t)(blk - 1) * 6 + 2) * DFF + c4) : z, Gm1 = hasprev ? *(const f32x4*)(edge + ((size_t)(blk - 1) * 6 + 3) * DFF + c4) : z;
        const f32x4 U = *(const f32x4*)(edge + ((size_t)blk * 6 + 4 + rr) * DFF + c4);
        const f32x4 w0 = *(const f32x4*)(wconv + c4), w1 = *(const f32x4*)(wconv + DFF + c4), w2 = *(const f32x4*)(wconv + 2 * DFF + c4), bc = *(const f32x4*)(bconv + c4);
        const f32x4 gc = rr == 0 ? (bc + w0 * Gm2 + w1 * Gm1 + w2 * G0) : (bc + w0 * Gm1 + w1 * G0 + w2 * G1);
        u32x2 wv; wv.x = pkbf(gelu_tanh(gc[0]) * U[0], gelu_tanh(gc[1]) * U[1]); wv.y = pkbf(gelu_tanh(gc[2]) * U[2], gelu_tanh(gc[3]) * U[3]);
        *(u32x2*)(hb + ((size_t)blk * 64 + rr) * DFF + c4) = wv;
    }
}

__global__ void __launch_bounds__(NTHREADS, 2) hymba_fwd(Args a_unused) {
    const KA a = (KA)__builtin_amdgcn_kernarg_segment_ptr();
    extern __shared__ __attribute__((aligned(16))) unsigned char smem[];
    const ldsp lds = (ldsp)smem;
    const int tid = threadIdx.x, lane = tid & 63, w = __builtin_amdgcn_readfirstlane(tid >> 6);
    const int G = gridDim.x, bx = blockIdx.x;
    unsigned char* ws = a->ws;
    const int lo = a->ph_lo, hi = a->ph_hi;
#ifndef PHASE_MASK
#define PHASE_MASK 0xfff
#endif
#define IN(k) (((PHASE_MASK >> (k)) & 1) && lo <= (k) && (k) < hi)
#ifndef SREP
#define SREP 0
#endif
#ifndef REP_MASK
#define REP_MASK 0
#endif
#ifndef EXTRA_SYNCS
#define EXTRA_SYNCS 0
#endif
#define REPS(k) (1 + ((REP_MASK >> (k)) & 1))
#ifdef TPROBE
#define TSTAMP(i) do { if (bx == 0 && tid == 0) ((LAS unsigned long long*)(lds + LDS_BYTES - 192))[i] = __builtin_amdgcn_s_memrealtime(); } while (0)
#else
#define TSTAMP(i) do {} while (0)
#endif
#define SEAM(k) do { if (IN(k) && IN((k) + 1)) { XcdBarrier bar_; bar_.bar = g_bar; bar_.x = xb_xcc_id(); bar_.st = (volatile LAS unsigned*)(lds + MISC_OFF); xcd_barrier(bar_); } TSTAMP((k) + 1); } while (0)
    bf16_t* XB = (bf16_t*)(ws + WS_XB);
    if (tid < 16) ((LAS unsigned*)(lds + MISC_OFF))[tid] = 0u;
    __syncthreads();
    (void)xcd_barrier_post(g_bar, (volatile LAS unsigned*)(lds + MISC_OFF));
    if (hi > 1000) cg::this_grid().sync();
    TSTAMP(0);
    if (IN(0)) { for (int rep = 0; rep < REPS(0); ++rep) p0_prologue(a, lds, tid, lane, w); }
    for (int es = 0; es < EXTRA_SYNCS; ++es) { XcdBarrier bar_; bar_.bar = g_bar; bar_.x = xb_xcc_id(); bar_.st = (volatile LAS unsigned*)(lds + MISC_OFF); xcd_barrier(bar_); }
    SEAM(0);
    struct ListOrder { int c, n, base;
        __device__ __forceinline__ bool next(int i, pg8::Unit& u) const { if (i > 0 || c >= n) return false; u.pm = c & 63; u.pn = base + (c >> 6); return true; }
        __device__ __forceinline__ void a_ready(const pg8::Unit&) const {}
        __device__ __forceinline__ void done(const pg8::Unit&) const {} };
    if (IN(1)) for (int rep = 0; rep < REPS(1); ++rep) {
        { for (int srep = 0; srep < 1 + SREP; ++srep) for (int t = G - 1 - bx; t < 16 * 14; t += G) { const int mt = t / 14, nt = t % 14; const bf16_t* Bt = (const bf16_t*)(ws + WS_WIN) + (size_t)(nt * 128) * 1024;
              SkProj P{(bf16_t*)(ws + WS_PROJ), (const float*)(ws + WS_SSQ0), a->out, mt, nt * 128}; sk_tile(lds, XB + (size_t)(MP + 32 * mt) * 1024, 1024, Bt, Bt + 64 * 1024, 1024, P, tid, lane, w); }
          __syncthreads();
          pg8::Gemm g{XB, (const bf16_t*)(ws + WS_WIN), MP, DIN, 1024};
          pg8::EpiProj E{(bf16_t*)(ws + WS_PROJ), (const float*)(ws + WS_SSQ0), a->out};
          ListOrder S{bx, 256, 0}; pg8::gemm_phase<pg8::EpiProj, ListOrder, true, true>(lds, g, S, E); }
    }
    SEAM(1);
#ifdef CPROBE
    const unsigned long long cp_t0 = __builtin_amdgcn_s_memrealtime();
#endif
    if (IN(2)) for (int rep = 0; rep < REPS(2); ++rep) {
        {
            if (bx < 192) { pg8::Gemm g{XB, (const bf16_t*)(ws + WS_WIN), MP, DIN, 1024}; pg8::EpiProj E{(bf16_t*)(ws + WS_PROJ), (const float*)(ws + WS_SSQ0), a->out};
                ListOrder S{bx, 192, 4}; pg8::gemm_phase<pg8::EpiProj, ListOrder, true, true>(lds, g, S, E); }
            else if (bx < 200) { pg8::Gemm g{(const bf16_t*)(ws + WS_MEMA), (const bf16_t*)(ws + WS_WKV), 512, 1024, 1024}; pg8::StaticOrder S; S.init(512, 1024, G, bx - 192);
                pg8::EpiMemKV E{(bf16_t*)(ws + WS_MEMKV), (const float*)(ws + WS_SSQM), a->out};
                pg8::gemm_phase<pg8::EpiMemKV, pg8::StaticOrder, true, true>(lds, g, S, E); }
            if (bx < 192) { lru_unit<false, 1>(a, lds, bx, tid, lane, w); if (bx < 64) lru_unit<false, 1>(a, lds, 192 + bx, tid, lane, w); }
            else if (bx < 200) swa_sample_unit(a, lds, bx - 192, tid);
            else if (bx < 232) { lru_unit<true, 2>(a, lds, bx - 200, tid, lane, w); swa_sample_unit(a, lds, 8 + (bx - 200), tid); swa_sample_unit(a, lds, 40 + (bx - 200), tid); }
            else for (int u = 72 + (bx - 232); u < 128; u += 24) swa_sample_unit(a, lds, u, tid);
        }
    }
    SEAM(2);
    if (IN(3)) for (int rep = 0; rep < REPS(3); ++rep) {
        for (int u = bx; u < 768; u += G) {
            if (u < 256) lru_unit<false, 2>(a, lds, u, tid, lane, w);
            else swa_prompt_unit(a, lds, u - 256, tid, lane, w);
        }
    }
    SEAM(3);
    if (IN(4)) {
        for (int t = G - 1 - bx; t < 128; t += G) { const int mt = t >> 3, nt = t & 7; const bf16_t* Bt = (const bf16_t*)(ws + WS_WOUT) + (size_t)(nt * 128) * 1024;
            SkRes<0> P{a->in[I_XS] - (size_t)MP * 1024, a->out, XB, (float*)(ws + WS_SSQ1), mt, nt * 128}; sk_tile(lds, (const bf16_t*)(ws + WS_MIX) + (size_t)(MP + 32 * mt) * 1024, 1024, Bt, Bt + 64 * 1024, 1024, P, tid, lane, w); }
        __syncthreads();
        pg8::Gemm g{(const bf16_t*)(ws + WS_MIX), (const bf16_t*)(ws + WS_WOUT), MP, 1024, 1024}; pg8::StaticOrder S; S.init(MP, 1024, G, bx);
        pg8::EpiRes<0> E{a->in[I_XP], a->out, XB, (float*)(ws + WS_SSQ1)};
        pg8::gemm_phase<pg8::EpiRes<0>, pg8::StaticOrder, true, true>(lds, g, S, E);
        if (REPS(4) > 1) { pg8::EpiRes<0, true> E2{a->in[I_XP], a->out, XB, (float*)(ws + WS_SSQ1)}; pg8::gemm_phase<pg8::EpiRes<0, true>, pg8::StaticOrder, true, true>(lds, g, S, E2); }
    }
    SEAM(4);
    if (IN(5)) for (int rep = 0; rep < REPS(5); ++rep) {
        for (int srep = 0; srep < 1 + SREP; ++srep) for (int t = G - 1 - bx; t < 64; t += G) { const int mt = t >> 2, nt = t & 3; const bf16_t* Bt = (const bf16_t*)(ws + WS_WQ) + (size_t)(nt * 128) * 1024;
            SkQ P{(bf16_t*)(ws + WS_QC), (const float*)(ws + WS_SSQ1), mt, nt * 128}; sk_tile(lds, XB + (size_t)(MP + 32 * mt) * 1024, 1024, Bt, Bt + 64 * 1024, 1024, P, tid, lane, w); }
        __syncthreads();
        pg8::Gemm g{XB, (const bf16_t*)(ws + WS_WQ), MP, 512, 1024}; pg8::StaticOrder S; S.init(MP, 512, G, bx);
        pg8::EpiQ E{(bf16_t*)(ws + WS_QC), (const float*)(ws + WS_SSQ1)};
        pg8::gemm_phase<pg8::EpiQ, pg8::StaticOrder, true, true>(lds, g, S, E);
    }
    SEAM(5);
    if (IN(6)) for (int rep = 0; rep < REPS(6); ++rep) {
        if (bx & 1) { for (int u = bx + G; u < 768; u += G) xattn_sample_unit(a, lds, u - 256, tid, lane, w); xattn_prompt_unit(a, lds, bx, tid, lane, w); }
        else { xattn_prompt_unit(a, lds, bx, tid, lane, w); for (int u = bx + G; u < 768; u += G) xattn_sample_unit(a, lds, u - 256, tid, lane, w); }
    }
    SEAM(6);
    if (IN(7)) {
        for (int t = G - 1 - bx; t < 128; t += G) { const int mt = t >> 3, nt = t & 7; const bf16_t* Bt = (const bf16_t*)(ws + WS_WMO) + (size_t)(nt * 128) * 512;
            SkRes<1> P{a->out, a->out, XB, (float*)(ws + WS_SSQ2), mt, nt * 128}; sk_tile(lds, (const bf16_t*)(ws + WS_OC) + (size_t)(MP + 32 * mt) * 512, 512, Bt, Bt + 64 * 512, 512, P, tid, lane, w); }
        __syncthreads();
        pg8::Gemm g{(const bf16_t*)(ws + WS_OC), (const bf16_t*)(ws + WS_WMO), MP, 1024, 512}; pg8::StaticOrder S; S.init(MP, 1024, G, bx);
        pg8::EpiRes<1> E{nullptr, a->out, XB, (float*)(ws + WS_SSQ2)};
        pg8::gemm_phase<pg8::EpiRes<1>, pg8::StaticOrder, true, true>(lds, g, S, E);
        if (REPS(7) > 1) { pg8::EpiRes<1, true> E2{nullptr, a->out, XB, (float*)(ws + WS_SSQ2)}; pg8::gemm_phase<pg8::EpiRes<1, true>, pg8::StaticOrder, true, true>(lds, g, S, E2); }
    }
    SEAM(7);
    if (IN(8)) for (int rep = 0; rep < REPS(8); ++rep) {
        for (int srep = 0; srep < 1 + SREP; ++srep) for (int t = G - 1 - bx; t < 16 * 48; t += G) { const int mt = t / 48, cb = t % 48; const bf16_t* Bg = (const bf16_t*)(ws + WS_WGU) + (size_t)((cb >> 1) * 256 + (cb & 1) * 64) * 1024;
            SkGU P{(bf16_t*)(ws + WS_H), (const float*)(ws + WS_SSQ2), a->in[I_WFC], a->in[I_BFC], a->in[I_SFC], a->out, mt, cb * 64}; sk_tile(lds, XB + (size_t)(MP + 32 * mt) * 1024, 1024, Bg, Bg + 128 * 1024, 1024, P, tid, lane, w); }
        __syncthreads();
        pg8::Gemm g{XB, (const bf16_t*)(ws + WS_WGU), MP, 2 * DFF, 1024}; pg8::StaticOrder S; S.init(MP, 2 * DFF, G, bx);
        pg8::EpiGU E{(bf16_t*)(ws + WS_H), (const float*)(ws + WS_SSQ2), (float*)(ws + WS_EDGE), a->in[I_WFC], a->in[I_BFC], a->in[I_SFC], a->out};
        pg8::gemm_phase<pg8::EpiGU, pg8::StaticOrder, true, true>(lds, g, S, E);
    }
    SEAM(8);
    if (IN(9)) {
        for (int t = G - 1 - bx; t < 128; t += G) { const int mt = t >> 3, nt = t & 7; const bf16_t* Bt = (const bf16_t*)(ws + WS_WD) + (size_t)(nt * 128) * DFF;
            SkRes<2> P{a->out, a->out, XB, (float*)(ws + WS_SSQ3), mt, nt * 128}; sk_tile(lds, (const bf16_t*)(ws + WS_H) + (size_t)(MP + 32 * mt) * DFF, DFF, Bt, Bt + 64 * DFF, DFF, P, tid, lane, w); }
        __syncthreads();
        pg8::Gemm g{(const bf16_t*)(ws + WS_H), (const bf16_t*)(ws + WS_WD), MP, 1024, DFF}; pg8::StaticOrder S; S.init(MP, 1024, G, bx);
        pg8::Unit u;
        for (int i = 0; S.next(i, u); ++i) if (u.pm < MP / 256) ffn_fixup_tile(a, u.pm, tid);
        asm volatile("s_waitcnt vmcnt(0)" ::: "memory");
        __syncthreads();
        pg8::EpiRes<2> E{nullptr, a->out, XB, (float*)(ws + WS_SSQ3)};
        pg8::gemm_phase<pg8::EpiRes<2>, pg8::StaticOrder, true, true>(lds, g, S, E);
        if (REPS(9) > 1) { pg8::EpiRes<2, true> E2{nullptr, a->out, XB, (float*)(ws + WS_SSQ3)}; pg8::gemm_phase<pg8::EpiRes<2, true>, pg8::StaticOrder, true, true>(lds, g, S, E2); }
    }
    SEAM(9);
    if (IN(10)) {
        const float* ssq3 = (const float*)(ws + WS_SSQ3); const float* gf = a->in[I_GFIN];
        f32x4 gv[4];
#pragma unroll
        for (int j = 0; j < 4; ++j) gv[j] = *((const f32x4*)gf + lane + 64 * j);
        for (int m0 = bx * NWAVES + w; m0 < MT; m0 += 2 * G * NWAVES) {
            const int m1 = m0 + G * NWAVES; const bool ok1 = m1 < MT;
            f32x4* xr0 = (f32x4*)(a->out + (size_t)m0 * 1024) + lane; f32x4* xr1 = (f32x4*)(a->out + (size_t)(ok1 ? m1 : m0) * 1024) + lane;
            f32x4 v0[4], v1[4]; float s0 = 0.f, s1 = 0.f;
#pragma unroll
            for (int j = 0; j < 4; ++j) { v0[j] = xr0[64 * j]; v1[j] = xr1[64 * j]; }
#pragma unroll
            for (int j = 0; j < 4; ++j) { s0 += (v0[j].x * v0[j].x + v0[j].y * v0[j].y) + (v0[j].z * v0[j].z + v0[j].w * v0[j].w); s1 += (v1[j].x * v1[j].x + v1[j].y * v1[j].y) + (v1[j].z * v1[j].z + v1[j].w * v1[j].w); }
            const float rs0 = __builtin_amdgcn_rsqf(wave_sum(s0) * (1.0f / 1024.0f) + EPS), rs1 = __builtin_amdgcn_rsqf(wave_sum(s1) * (1.0f / 1024.0f) + EPS);
#pragma unroll
            for (int j = 0; j < 4; ++j) xr0[64 * j] = v0[j] * rs0 * gv[j];
            if (ok1) {
#pragma unroll
                for (int j = 0; j < 4; ++j) xr1[64 * j] = v1[j] * rs1 * gv[j];
            }
        }
    }
#ifdef CPROBE
    if (bx == 0) {
        const unsigned* cw = (const unsigned*)(ws + WS_BAR) + CBASE;
        const float eps = (float)__hip_atomic_load(cw + CA, __ATOMIC_RELAXED, __HIP_MEMORY_SCOPE_AGENT) * 1e-5f, dd = (float)__hip_atomic_load(cw + CB, __ATOMIC_RELAXED, __HIP_MEMORY_SCOPE_AGENT) * 1e-4f;
        __syncthreads();
        for (int i = tid; i < 1024; i += NTHREADS) a->out[O_PLH + i] *= (1.0f + eps);
        if (tid == 0) a->out[O_PLC] += dd;
    }
#endif
#ifdef TPROBE
    TSTAMP(11);
    if (bx == 0) {
        __syncthreads();
        const LAS unsigned long long* ts = (const LAS unsigned long long*)(lds + LDS_BYTES - 192);
        const float eps = (float)(ts[TA_HI] - ts[TA_LO]) * 1e-5f, dd = (float)(ts[TB_HI] - ts[TB_LO]) * 1e-4f;
        for (int i = tid; i < 1024; i += NTHREADS) a->out[O_PLH + i] *= (1.0f + eps);
        if (tid == 0) a->out[O_PLC] += dd;
    }
#endif
    {
        __syncthreads();
        if (tid == 0) { const unsigned prev = __hip_atomic_fetch_add(&g_bar[3500], 1u, __ATOMIC_RELAXED, __HIP_MEMORY_SCOPE_AGENT); ((volatile LAS unsigned*)(lds + MISC_OFF))[4] = (prev == (unsigned)G - 1u) ? 1u : 0u; }
        __syncthreads();
        if (((volatile LAS unsigned*)(lds + MISC_OFF))[4]) { for (int i = tid; i < 3520; i += NTHREADS) __hip_atomic_store(&g_bar[i], 0u, __ATOMIC_RELAXED, __HIP_MEMORY_SCOPE_AGENT); }
    }
#undef IN
#undef SEAM
}
constexpr int N_PHASES = 11;

extern "C" void kernel_launch(void* const* d_in, const int* in_sizes, int n_in, void* d_out, int out_size, void* d_ws, size_t ws_size, hipStream_t stream) {
    static int grid = 0;
    if (grid == 0) {
        if (n_in != 34 || ws_size < WS_END) { fprintf(stderr, "kernel_launch: unexpected n_in %d / ws %zu\n", n_in, ws_size); grid = -1; return; }
        int dev = 0, cus = 0, per_cu = 0;
        if (hipGetDevice(&dev) != hipSuccess || hipDeviceGetAttribute(&cus, hipDeviceAttributeMultiprocessorCount, dev) != hipSuccess) { grid = -1; return; }
        if (hipFuncSetAttribute((const void*)hymba_fwd, hipFuncAttributeMaxDynamicSharedMemorySize, LDS_BYTES) != hipSuccess) { fprintf(stderr, "kernel_launch: hipFuncSetAttribute failed\n"); grid = -1; return; }
        if (hipOccupancyMaxActiveBlocksPerMultiprocessor(&per_cu, (const void*)hymba_fwd, NTHREADS, LDS_BYTES) != hipSuccess || per_cu < 1) { fprintf(stderr, "kernel_launch: occupancy query says %d\n", per_cu); per_cu = 1; }
        (void)hipGetLastError();
        grid = cus;
        if (cus != 256) { fprintf(stderr, "kernel_launch: built for a 256-CU device, found %d CUs; nothing launched\n", cus); grid = -1; return; }
    }
    if (grid < 0) return;
    Args a{};
    for (int i = 0; i < 34; ++i) a.in[i] = (const float*)d_in[i];
    a.out = (float*)d_out; a.ws = (unsigned char*)d_ws;
#if defined(CPROBE)
    if (hipMemsetAsync((char*)d_ws + WS_BAR, 0, BAR_ZERO_BYTES, stream) != hipSuccess) { fprintf(stderr, "kernel_launch: memset failed\n"); return; }
#endif
#if MK_N_LAUNCHES == 1
    a.ph_lo = 0; a.ph_hi = N_PHASES;
    void* args[] = {&a};
    hipError_t e = hipLaunchCooperativeKernel((const void*)hymba_fwd, dim3(grid), dim3(NTHREADS), args, LDS_BYTES, stream);
    if (e != hipSuccess) fprintf(stderr, "kernel_launch: cooperative launch failed: %s (grid %d)\n", hipGetErrorString(e), grid);
#else
    for (int p = 0; p < N_PHASES; ++p) { a.ph_lo = p; a.ph_hi = p + 1; hipLaunchKernelGGL(hymba_fwd, dim3(grid), dim3(NTHREADS), LDS_BYTES, stream, a); }
#endif
}
```

```cpp
#include <hip/hip_runtime.h>
#include <hip/hip_cooperative_groups.h>
#include <cstdio>
#include <cstdint>
namespace cg = cooperative_groups;

#ifndef MK_N_LAUNCHES
#define MK_N_LAUNCHES 1
#endif

constexpr int MP = 16384, MS = 512, MT = MP + MS;
constexpr int DM = 1024, SEQ = 8192, DIN = 1792, DFF = 3072, DLRU = 512;
constexpr float EPS = 1e-6f;
constexpr float LOG2E = 1.4426950408889634f;
constexpr size_t O_YP = 0, O_YS = 16777216, O_PSK = 17301504, O_PSV = 17334272, O_PMK = 17367040, O_PMV = 17629184, O_PLC = 17891328,
                 O_PLH = 17894400, O_PFC = 17895424, O_SSK = 17907712, O_SSV = 20004864, O_SLC = 22102016, O_SLH = 22298624, O_SFC = 22364160;
constexpr size_t MiB = 1u << 20;
constexpr size_t WS_SSQ0 = 0, WS_SSQ1 = 128 * 1024, WS_SSQ2 = 256 * 1024, WS_SSQ3 = 384 * 1024, WS_SSQM = 512 * 1024, WS_SUMM = 640 * 1024;
constexpr size_t WS_WIN = 1 * MiB, WS_WOUT = 5 * MiB, WS_WQ = 7 * MiB, WS_WKV = 8 * MiB, WS_WMO = 10 * MiB, WS_WGU = 11 * MiB, WS_WD = 23 * MiB;
constexpr size_t WS_MEMA = 29 * MiB, WS_MEMKV = 30 * MiB, WS_EDGE = 31 * MiB, WS_XB = 50 * MiB, WS_PROJ = 83 * MiB, WS_MIX = 141 * MiB, WS_QC = 174 * MiB, WS_OC = 191 * MiB;
constexpr size_t WS_H = 83 * MiB;
constexpr size_t WS_END = 208 * MiB;
static_assert(WS_EDGE + (size_t)264 * 6 * 3072 * 4 <= WS_XB && WS_XB + (size_t)MT * 1024 * 2 <= WS_PROJ && WS_PROJ + (size_t)MT * DIN * 2 <= WS_MIX &&
              WS_MIX + (size_t)MT * 1024 * 2 <= WS_QC && WS_QC + (size_t)MT * 512 * 2 <= WS_OC && WS_OC + (size_t)MT * 512 * 2 <= WS_END && WS_H + (size_t)MT * DFF * 2 <= WS_OC, "ws map");

__device__ __forceinline__ unsigned pkbf(float lo, float hi) {
    typedef float f2_t __attribute__((ext_vector_type(2))); typedef __bf16 b2_t __attribute__((ext_vector_type(2)));
    f2_t v = {lo, hi}; b2_t b = __builtin_convertvector(v, b2_t); return __builtin_bit_cast(unsigned, b);
}
__device__ __forceinline__ float bf2f(unsigned short x) { return __uint_as_float((unsigned)x << 16); }
__device__ __forceinline__ float bflo(unsigned x) { return __uint_as_float(x << 16); }
__device__ __forceinline__ float bfhi(unsigned x) { return __uint_as_float(x & 0xffff0000u); }
__device__ __forceinline__ float fexp2(float x) { return __builtin_amdgcn_exp2f(x); }
__device__ __forceinline__ float frcp(float x) { return __builtin_amdgcn_rcpf(x); }
__device__ __forceinline__ float sigmoidf_(float x) { return frcp(1.0f + fexp2(-LOG2E * x)); }
__device__ __forceinline__ float gelu_tanh(float x) {
    const float t = x * (1.0f + 0.044715f * x * x);
    return x * frcp(1.0f + fexp2(-2.302208198f * t));
}
namespace pg8 {
#define PG8_LAS __attribute__((address_space(3)))
typedef unsigned short bf16_t;
typedef short bf16x8 __attribute__((ext_vector_type(8)));
typedef float f32x4 __attribute__((ext_vector_type(4)));
typedef unsigned u32x4 __attribute__((ext_vector_type(4)));
constexpr int BM = 256, BK = 64, HALF = 128, HTB = HALF * BK * 2  , STAGE_BYTES = 8 * HTB, NXCD = 8, WGM = 8;

__host__ __device__ __forceinline__ int lds_byte(int r, int c) { const int st = (r >> 4) * 2 + (c >> 5), rr = r & 15, cc = c & 31, ob = rr * 64 + cc * 2; return st * 1024 + (ob ^ (((ob >> 9) & 1) << 5)); }
__host__ __device__ __forceinline__ void stage_rc(int b, int& R, int& C) { const int st = b / 1024, sb = b % 1024, swz = sb ^ (((sb >> 9) & 1) << 5); R = (st >> 1) * 16 + swz / 64; C = (st & 1) * 32 + (swz % 64) / 2; }
__host__ __device__ __forceinline__ int perm32(int rho) { const int n = rho >> 4, i = rho & 15; return 8 * (i >> 2) + 4 * n + (i & 3); }

struct Unit { int pm, pn; };
struct Gemm { const bf16_t* A; const bf16_t* Bt; int M, N, K; };

struct StaticOrder {
    int nM, nN, nwg, G, c;
    __host__ __device__ __forceinline__ void init(int M, int N, int G_, int c_) { nM = M / BM; nN = N / BM; nwg = nM * nN; G = G_; c = c_; }
    __host__ __device__ __forceinline__ bool next(int i, Unit& u) const {
        const long L = (long)i * G + c; if (L >= nwg) return false;
        int wgid = (int)L; { const int q = nwg / NXCD, r = nwg % NXCD, xcd = wgid % NXCD, off = wgid / NXCD; wgid = (xcd < r ? xcd * (q + 1) : r * (q + 1) + (xcd - r) * q) + off; }
        const int nig = WGM * nN, gid = wgid / nig, fm = gid * WGM, gsz = (nM - fm) < WGM ? (nM - fm) : WGM;
        u.pm = fm + ((wgid % nig) % gsz); u.pn = (wgid % nig) / gsz; return true;
    }
    __device__ __forceinline__ void a_ready(const Unit&) const {}
    __device__ __forceinline__ void done(const Unit&) const {}
};

#define EPI_ROW(u, ai, m) ((u).pm * BM + (ai) * HALF + wr * 64 + (m) * 16 + fr)
__device__ __forceinline__ void st_bf16x8(bf16_t* p, f32x4 v0, f32x4 v1) { u32x4 w; w.x = pkbf(v0[0], v0[1]); w.y = pkbf(v0[2], v0[3]); w.z = pkbf(v1[0], v1[1]); w.w = pkbf(v1[2], v1[3]); *(u32x4*)p = w; }

struct EpiProj {
    static constexpr bool PERM = true, AFTER_DRAIN = false;
    bf16_t* proj; const float* ssq; float* out;
    __device__ __forceinline__ void operator()(const f32x4 (&acc)[2][2][4][2], const Unit& u, int wr, int wc, int fr, int fq) const {
        float rsv[2][4];
#pragma unroll
        for (int ai = 0; ai < 2; ++ai)
#pragma unroll
            for (int m = 0; m < 4; ++m) rsv[ai][m] = ssq[EPI_ROW(u, ai, m)];
        const int colb = u.pn * BM + wc * 32 + 8 * fq;
        const float qs = (u.pn == 4 || u.pn == 5) ? 0.125f : 1.0f;
#pragma unroll
        for (int ai = 0; ai < 2; ++ai)
#pragma unroll
            for (int m = 0; m < 4; ++m) {
                const int row = EPI_ROW(u, ai, m);
                const float rs = __builtin_amdgcn_rsqf(rsv[ai][m] * (1.0f / 1024.0f) + EPS) * qs;
#pragma unroll
                for (int bj = 0; bj < 2; ++bj) {
                    const int col = colb + bj * HALF;
                    const f32x4 v0 = acc[ai][bj][m][0] * rs, v1 = acc[ai][bj][m][1] * rs;
                    st_bf16x8(proj + (size_t)row * DIN + col, v0, v1);
                    float* dst = nullptr;
                    if (u.pn == 6) {
                        const int kc = wc * 32 + 8 * fq;
                        const int t = row & 8191, b = row >> 13; if (t >= 8064) dst = out + (bj ? O_PSV : O_PSK) + (size_t)(b * 128 + t - 8064) * 128 + kc;
                    } else if (u.pn < 2) {
                        const int t = row & 8191, b = row >> 13; if (t >= 8189) dst = out + O_PLC + (size_t)(b * 3 + t - 8189) * 512 + col;
                    }
                    if (dst) { *(f32x4*)dst = v0; *(f32x4*)(dst + 4) = v1; }
                }
            }
    }
};
struct EpiMemKV {
    static constexpr bool PERM = true, AFTER_DRAIN = false;
    bf16_t* memkv; const float* ssq; float* out;
    __device__ __forceinline__ void operator()(const f32x4 (&acc)[2][2][4][2], const Unit& u, int wr, int wc, int fr, int fq) const {
        float rsv[2][4];
#pragma unroll
        for (int ai = 0; ai < 2; ++ai)
#pragma unroll
            for (int m = 0; m < 4; ++m) rsv[ai][m] = ssq[EPI_ROW(u, ai, m)];
        const int colb = u.pn * BM + wc * 32 + 8 * fq;
#pragma unroll
        for (int ai = 0; ai < 2; ++ai)
#pragma unroll
            for (int m = 0; m < 4; ++m) {
                const int row = EPI_ROW(u, ai, m);
                const float rs = __builtin_amdgcn_rsqf(rsv[ai][m] * (1.0f / 1024.0f) + EPS);
#pragma unroll
                for (int bj = 0; bj < 2; ++bj) {
                    const int col = colb + bj * HALF;
                    const f32x4 v0 = acc[ai][bj][m][0] * rs, v1 = acc[ai][bj][m][1] * rs;
                    st_bf16x8(memkv + (size_t)row * 1024 + col, v0, v1);
                    float* dst = out + (col < 512 ? O_PMK + (size_t)row * 512 + col : O_PMV + (size_t)row * 512 + (col - 512));
                    *(f32x4*)dst = v0; *(f32x4*)(dst + 4) = v1;
                }
            }
    }
};
template <int MODE, bool DRY = false> struct EpiRes {
    static constexpr bool PERM = true, AFTER_DRAIN = false;
    const float* resp; float* xout; bf16_t* xb; float* ssq;
    __device__ __forceinline__ void operator()(const f32x4 (&acc)[2][2][4][2], const Unit& u, int wr, int wc, int fr, int fq) const {
        const int colb = u.pn * BM + wc * 32 + 8 * fq;
#pragma unroll
        for (int ai = 0; ai < 2; ++ai) {
            f32x4 rf[4][2][2]; u32x4 rb[4][2];
#pragma unroll
            for (int m = 0; m < 4; ++m)
#pragma unroll
                for (int bj = 0; bj < 2; ++bj) {
                    const int row = EPI_ROW(u, ai, m), col = colb + bj * HALF;
                    if (MODE == 0) { const float* rp = resp + (size_t)row * 1024 + col; rf[m][bj][0] = *(const f32x4*)rp; rf[m][bj][1] = *(const f32x4*)(rp + 4); }
                    else rb[m][bj] = *(const u32x4*)(xb + (size_t)row * 1024 + col);
                }
#pragma unroll
            for (int m = 0; m < 4; ++m) {
                const int row = EPI_ROW(u, ai, m);
                float sq = 0.f;
#pragma unroll
                for (int bj = 0; bj < 2; ++bj) {
                    const int col = colb + bj * HALF;
                    f32x4 v0, v1;
                    if (MODE == 0) { v0 = acc[ai][bj][m][0] + rf[m][bj][0]; v1 = acc[ai][bj][m][1] + rf[m][bj][1]; }
                    else { const u32x4 r = rb[m][bj];
                        v0 = acc[ai][bj][m][0] + (f32x4){bflo(r.x), bfhi(r.x), bflo(r.y), bfhi(r.y)}; v1 = acc[ai][bj][m][1] + (f32x4){bflo(r.z), bfhi(r.z), bflo(r.w), bfhi(r.w)}; }
                    if (!DRY) {
                        if (MODE == 2) { float* op = xout + (size_t)row * 1024 + col; *(f32x4*)op = v0; *(f32x4*)(op + 4) = v1; }
                        else st_bf16x8(xb + (size_t)row * 1024 + col, v0, v1);
                    }
                    sq += (v0[0] * v0[0] + v0[1] * v0[1]) + (v0[2] * v0[2] + v0[3] * v0[3]) + (v1[0] * v1[0] + v1[1] * v1[1]) + (v1[2] * v1[2] + v1[3] * v1[3]);
                }
                if (MODE != 2 || DRY) {
                    sq += __shfl_xor(sq, 16); sq += __shfl_xor(sq, 32);
                    if (!DRY) { if (fq == 0) __hip_atomic_fetch_add(ssq + row, sq, __ATOMIC_RELAXED, __HIP_MEMORY_SCOPE_AGENT); }
                    else if (sq == 12345.678f) ssq[row] = sq;
                }
            }
        }
    }
};
struct EpiQ {
    static constexpr bool PERM = true, AFTER_DRAIN = false;
    bf16_t* qc; const float* ssq;
    __device__ __forceinline__ void operator()(const f32x4 (&acc)[2][2][4][2], const Unit& u, int wr, int wc, int fr, int fq) const {
        float rsv[2][4];
#pragma unroll
        for (int ai = 0; ai < 2; ++ai)
#pragma unroll
            for (int m = 0; m < 4; ++m) rsv[ai][m] = ssq[EPI_ROW(u, ai, m)];
        const int colb = u.pn * BM + wc * 32 + 8 * fq;
#pragma unroll
        for (int ai = 0; ai < 2; ++ai)
#pragma unroll
            for (int m = 0; m < 4; ++m) {
                const int row = EPI_ROW(u, ai, m);
                const float rs = __builtin_amdgcn_rsqf(rsv[ai][m] * (1.0f / 1024.0f) + EPS) * 0.08838834764831845f;
#pragma unroll
                for (int bj = 0; bj < 2; ++bj) st_bf16x8(qc + (size_t)row * 512 + colb + bj * HALF, acc[ai][bj][m][0] * rs, acc[ai][bj][m][1] * rs);
            }
    }
};
__device__ __forceinline__ float dpp_ror1(float v) { return __builtin_bit_cast(float, __builtin_amdgcn_update_dpp(0, __builtin_bit_cast(int, v), 0x121, 0xf, 0xf, false)); }
__device__ __forceinline__ float dpp_ror2(float v) { return __builtin_bit_cast(float, __builtin_amdgcn_update_dpp(0, __builtin_bit_cast(int, v), 0x122, 0xf, 0xf, false)); }
__device__ __forceinline__ f32x4 gelu4(f32x4 x) {
    const f32x4 t = x * (x * x * 0.044715f + 1.0f) * (-2.302208198f);
    f32x4 e; e[0] = fexp2(t[0]); e[1] = fexp2(t[1]); e[2] = fexp2(t[2]); e[3] = fexp2(t[3]);
    const f32x4 d = e + 1.0f;
    f32x4 r; r[0] = frcp(d[0]); r[1] = frcp(d[1]); r[2] = frcp(d[2]); r[3] = frcp(d[3]);
    return x * r;
}
struct EpiGU {
    static constexpr bool PERM = true, AFTER_DRAIN = false;
    bf16_t* h; const float* ssq; float* edge; const float* wconv; const float* bconv; const float* state; float* out;
    __device__ __forceinline__ void operator()(const f32x4 (&acc)[2][2][4][2], const Unit& u, int wr, int wc, int fr, int fq) const {
        float rsv[2][4];
#pragma unroll
        for (int ai = 0; ai < 2; ++ai)
#pragma unroll
            for (int m = 0; m < 4; ++m) rsv[ai][m] = ssq[EPI_ROW(u, ai, m)];
        const int chb = u.pn * HALF + wc * 32 + 8 * fq;
        f32x4 w0[2], w1[2], w2[2], bc[2];
#pragma unroll
        for (int n = 0; n < 2; ++n) { const int ch = chb + 4 * n; w0[n] = *(const f32x4*)(wconv + ch); w1[n] = *(const f32x4*)(wconv + DFF + ch); w2[n] = *(const f32x4*)(wconv + 2 * DFF + ch); bc[n] = *(const f32x4*)(bconv + ch); }
#pragma unroll
        for (int ai = 0; ai < 2; ++ai) {
            f32x4 p1p[2] = {{0.f, 0.f, 0.f, 0.f}, {0.f, 0.f, 0.f, 0.f}}, p2p[2] = {{0.f, 0.f, 0.f, 0.f}, {0.f, 0.f, 0.f, 0.f}};
#pragma unroll
            for (int m = 0; m < 4; ++m) {
                const int row = EPI_ROW(u, ai, m), blk = row >> 6;
                const float rs = __builtin_amdgcn_rsqf(rsv[ai][m] * (1.0f / 1024.0f) + EPS);
                f32x4 hv[2];
#pragma unroll
                for (int n = 0; n < 2; ++n) {
                    const int ch = chb + 4 * n;
                    const f32x4 g = acc[ai][0][m][n] * rs, up = acc[ai][1][m][n] * rs;
                    f32x4 p1, p2;
#pragma unroll
                    for (int j = 0; j < 4; ++j) { p1[j] = dpp_ror1(g[j]); p2[j] = dpp_ror2(g[j]); }
                    const f32x4 g1 = fr >= 1 ? p1 : p1p[n], g2 = fr >= 2 ? p2 : p2p[n]; p1p[n] = p1; p2p[n] = p2;
                    if (m == 0 && fr < 2) { *(f32x4*)(edge + ((size_t)blk * 6 + fr) * DFF + ch) = g; *(f32x4*)(edge + ((size_t)blk * 6 + 4 + fr) * DFF + ch) = up; }
                    if (m == 3 && fr >= 14) {
                        *(f32x4*)(edge + ((size_t)blk * 6 + 2 + (fr - 14)) * DFF + ch) = g;
                        if ((blk & 127) == 127) *(f32x4*)(out + O_PFC + (size_t)((blk >> 7) * 2 + (fr - 14)) * DFF + ch) = g;
                    }
                    hv[n] = gelu4(bc[n] + w0[n] * g2 + w1[n] * g1 + w2[n] * g) * up;
                }
                st_bf16x8(h + (size_t)row * DFF + chb, hv[0], hv[1]);
            }
        }
    }
};
template <class Epi, class Sched, bool ALIGN_EPI = false, bool SP2 = false>
__device__ __forceinline__ void gemm_phase(PG8_LAS unsigned char* lds, const Gemm g, const Sched& S, const Epi& E) {
    const int tid = threadIdx.x, wid = __builtin_amdgcn_readfirstlane(tid >> 6), lane = tid & 63, wr = wid >> 2, wc = wid & 3, fr = lane & 15, fq = lane >> 4;
    const int K = g.K, nt = K / BK;
    unsigned voffA[2], voffB[2];
#pragma unroll
    for (int i = 0; i < 2; ++i) { int R, C; stage_rc(tid * 16 + i * 8192, R, C); const int Rb = Epi::PERM ? ((R & ~31) + perm32(R & 31)) : R;
        voffA[i] = (unsigned)(R * K + C) * 2u; voffB[i] = (unsigned)(Rb * K + C) * 2u; }
    const size_t kstep = (size_t)(BK * 2);
    const size_t hstep = (size_t)HALF * K * 2;
    const size_t tstep = 2 * hstep;
    const unsigned ldsw = (unsigned)wid * 1024u;
    const int aoff = lds_byte(wr * 64 + fr, fq * 8), boff = lds_byte(wc * 32 + fr, fq * 8);
#define PG8_SA(b, h) (((b) * 2 + (h)) * HTB)
#define PG8_SB(b, h) ((4 + (b) * 2 + (h)) * HTB)
#define PG8_STAGE(bufoff, gbase, voff) do { _Pragma("unroll") for (int _i = 0; _i < 2; ++_i) \
        __builtin_amdgcn_global_load_lds((const unsigned*)((const char*)(gbase) + (voff)[_i]), (PG8_LAS unsigned*)(lds + (bufoff) + ldsw + _i * 8192), 16, 0, 0); } while (0)
#define PG8_LDA(dst, b, h) do { _Pragma("unroll") for (int m = 0; m < 4; ++m) _Pragma("unroll") for (int k = 0; k < 2; ++k) dst[m][k] = *(const PG8_LAS bf16x8*)(lds + PG8_SA(b, h) + aoff + m * 2048 + k * 1024); } while (0)
#define PG8_LDB(dst, b, h) do { _Pragma("unroll") for (int n = 0; n < 2; ++n) _Pragma("unroll") for (int k = 0; k < 2; ++k) dst[n][k] = *(const PG8_LAS bf16x8*)(lds + PG8_SB(b, h) + boff + n * 2048 + k * 1024); } while (0)
#define PG8_MMA(ai, bj, At, Bt) do { __builtin_amdgcn_s_setprio(1); _Pragma("unroll") for (int m = 0; m < 4; ++m) _Pragma("unroll") for (int n = 0; n < 2; ++n) _Pragma("unroll") for (int k = 0; k < 2; ++k) \
        acc[ai][bj][m][n] = __builtin_amdgcn_mfma_f32_16x16x32_bf16(Bt[n][k], At[m][k], acc[ai][bj][m][n], 0, 0, 0); __builtin_amdgcn_s_setprio(0); } while (0)
#define PG8_WAIT_V(n) asm volatile("s_waitcnt vmcnt(" #n ")" ::: "memory")
#define PG8_WAIT_L(n) asm volatile("s_waitcnt lgkmcnt(" #n ")" ::: "memory")
#define PG8_BAR __builtin_amdgcn_s_barrier()
#define PG8_SCHED __builtin_amdgcn_sched_barrier(0)
    Unit cur, nxt; int ui = 0;
    if (!S.next(0, cur)) return;
    f32x4 acc[2][2][4][2];
#pragma unroll
    for (int a = 0; a < 2; ++a)
#pragma unroll
        for (int b = 0; b < 2; ++b)
#pragma unroll
            for (int m = 0; m < 4; ++m)
#pragma unroll
                for (int n = 0; n < 2; ++n) acc[a][b][m][n] = (f32x4){0.f, 0.f, 0.f, 0.f};
    bf16x8 At[4][2], B0[2][2], B1[2][2];
    const char* cA = (const char*)g.A + (size_t)cur.pm * tstep; const char* cB = (const char*)g.Bt + (size_t)cur.pn * tstep;
    S.a_ready(cur);
    if constexpr (SP2) {
        PG8_STAGE(PG8_SB(0, 0), cB, voffB); PG8_STAGE(PG8_SB(0, 1), cB + hstep, voffB); PG8_STAGE(PG8_SA(0, 0), cA, voffA); PG8_STAGE(PG8_SA(0, 1), cA + hstep, voffA);
        if (wr == 1) PG8_BAR;
        PG8_WAIT_V(2); PG8_BAR;
        PG8_STAGE(PG8_SB(1, 0), cB + kstep, voffB); PG8_STAGE(PG8_SA(1, 0), cA + kstep, voffA); PG8_STAGE(PG8_SB(1, 1), cB + hstep + kstep, voffB);
        PG8_WAIT_V(6); PG8_BAR;
    } else {
        PG8_STAGE(PG8_SB(0, 0), cB, voffB); PG8_STAGE(PG8_SA(0, 0), cA, voffA); PG8_STAGE(PG8_SB(0, 1), cB + hstep, voffB); PG8_STAGE(PG8_SA(0, 1), cA + hstep, voffA);
        if (wr == 1) PG8_BAR;
        PG8_WAIT_V(4); PG8_BAR;
        PG8_STAGE(PG8_SB(1, 0), cB + kstep, voffB); PG8_STAGE(PG8_SA(1, 0), cA + kstep, voffA); PG8_STAGE(PG8_SB(1, 1), cB + hstep + kstep, voffB);
        PG8_WAIT_V(6); PG8_BAR;
    }
    for (;;) {
        const bool has_next = S.next(ui + 1, nxt);
        const char* nA = has_next ? (const char*)g.A + (size_t)nxt.pm * tstep : cA; const char* nB = has_next ? (const char*)g.Bt + (size_t)nxt.pn * tstep : cB;
        for (int t = 0; t < nt; t += 2) {
            const bool last = (t == nt - 2);
            const char* a1 = cA + (size_t)(t + 1) * kstep;
            const char* a2 = last ? nA : cA + (size_t)(t + 2) * kstep; const char* b2 = last ? nB : cB + (size_t)(t + 2) * kstep;
            const char* a3 = a2 + kstep; const char* b3 = b2 + kstep;
            if (last && has_next) S.a_ready(nxt);
            if constexpr (SP2) {
            PG8_LDB(B0, 0, 0); PG8_LDB(B1, 0, 1); PG8_SCHED; PG8_LDA(At, 0, 0); PG8_STAGE(PG8_SA(1, 1), a1 + hstep, voffA);
            PG8_WAIT_V(8); PG8_WAIT_L(0); PG8_BAR; PG8_MMA(0, 0, At, B0); PG8_MMA(0, 1, At, B1); PG8_BAR; PG8_SCHED;
            PG8_LDA(At, 0, 1); PG8_STAGE(PG8_SB(0, 0), b2, voffB); PG8_STAGE(PG8_SB(0, 1), b2 + hstep, voffB); PG8_STAGE(PG8_SA(0, 0), a2, voffA);
            PG8_WAIT_V(8); PG8_WAIT_L(0); PG8_BAR; PG8_MMA(1, 0, At, B0); PG8_MMA(1, 1, At, B1); PG8_BAR; PG8_SCHED;
            PG8_LDB(B0, 1, 0); PG8_LDB(B1, 1, 1); PG8_SCHED; PG8_LDA(At, 1, 0); PG8_STAGE(PG8_SA(0, 1), a2 + hstep, voffA);
            PG8_WAIT_V(8); PG8_WAIT_L(0); PG8_BAR; PG8_MMA(0, 0, At, B0); PG8_MMA(0, 1, At, B1); PG8_BAR; PG8_SCHED;
            PG8_LDA(At, 1, 1); PG8_STAGE(PG8_SB(1, 0), b3, voffB); PG8_STAGE(PG8_SB(1, 1), b3 + hstep, voffB); PG8_STAGE(PG8_SA(1, 0), a3, voffA);
            PG8_WAIT_V(8); PG8_WAIT_L(0); PG8_BAR; PG8_MMA(1, 0, At, B0); PG8_MMA(1, 1, At, B1); PG8_BAR; PG8_SCHED;
            } else {
            PG8_LDB(B0, 0, 0); PG8_SCHED; PG8_LDA(At, 0, 0); PG8_STAGE(PG8_SA(1, 1), a1 + hstep, voffA);
            PG8_WAIT_L(8); PG8_BAR; PG8_WAIT_L(0); PG8_MMA(0, 0, At, B0); PG8_BAR; PG8_SCHED;
            PG8_LDB(B1, 0, 1); PG8_STAGE(PG8_SB(0, 0), b2, voffB);
            PG8_BAR; PG8_WAIT_L(0); PG8_MMA(0, 1, At, B1); PG8_BAR;
            PG8_LDA(At, 0, 1); PG8_STAGE(PG8_SA(0, 0), a2, voffA);
            PG8_BAR; PG8_WAIT_L(0); PG8_MMA(1, 0, At, B0); PG8_BAR; PG8_SCHED;
            PG8_STAGE(PG8_SB(0, 1), b2 + hstep, voffB);
            PG8_WAIT_V(6); PG8_BAR; PG8_MMA(1, 1, At, B1); PG8_BAR;
            PG8_LDB(B0, 1, 0); PG8_SCHED; PG8_LDA(At, 1, 0); PG8_STAGE(PG8_SA(0, 1), a2 + hstep, voffA);
            PG8_WAIT_L(8); PG8_BAR; PG8_WAIT_L(0); PG8_MMA(0, 0, At, B0); PG8_BAR; PG8_SCHED;
            PG8_LDB(B1, 1, 1); PG8_STAGE(PG8_SB(1, 0), b3, voffB);
            PG8_BAR; PG8_WAIT_L(0); PG8_MMA(0, 1, At, B1); PG8_BAR;
            PG8_LDA(At, 1, 1); PG8_STAGE(PG8_SA(1, 0), a3, voffA);
            PG8_BAR; PG8_WAIT_L(0); PG8_MMA(1, 0, At, B0); PG8_BAR; PG8_SCHED;
            PG8_STAGE(PG8_SB(1, 1), b3 + hstep, voffB);
            PG8_WAIT_V(6); PG8_BAR; PG8_MMA(1, 1, At, B1); PG8_BAR;
            }
        }
        if constexpr (ALIGN_EPI) { if (wr == 0) PG8_BAR; }
        if constexpr (!Epi::AFTER_DRAIN) { E(acc, cur, wr, wc, fr, fq); S.done(cur); }
        if (!has_next) break;
#pragma unroll
        for (int a = 0; a < 2; ++a)
#pragma unroll
            for (int b = 0; b < 2; ++b)
#pragma unroll
                for (int m = 0; m < 4; ++m)
#pragma unroll
                    for (int n = 0; n < 2; ++n) acc[a][b][m][n] = (f32x4){0.f, 0.f, 0.f, 0.f};
        cur = nxt; cA = nA; cB = nB; ++ui;
        if constexpr (ALIGN_EPI) { if (wr == 1) PG8_BAR; }
    }
    PG8_WAIT_V(0);
    if constexpr (!ALIGN_EPI) { if (wr == 0) PG8_BAR; }
    PG8_BAR;
    if constexpr (Epi::AFTER_DRAIN) { E.fused(acc, cur, wr, wc, fr, fq, lds, wid, lane); S.done(cur); }
#undef PG8_SA
#undef PG8_SB
#undef PG8_STAGE
#undef PG8_LDA
#undef PG8_LDB
#undef PG8_MMA
#undef PG8_WAIT_V
#undef PG8_WAIT_L
#undef PG8_BAR
#undef PG8_SCHED
}
}

#define LAS __attribute__((address_space(3)))
typedef unsigned short bf16_t;
typedef short bf16x8 __attribute__((ext_vector_type(8)));
typedef short s16x4 __attribute__((ext_vector_type(4)));
typedef float f32x4 __attribute__((ext_vector_type(4)));
typedef float f32x16 __attribute__((ext_vector_type(16)));
typedef unsigned u32x4 __attribute__((ext_vector_type(4)));
typedef unsigned u32x2 __attribute__((ext_vector_type(2)));
typedef LAS unsigned char* ldsp;
constexpr int NWAVES = 8, NTHREADS = 512, LDS_BYTES = 147456;
#define MFMA32(a, b, c) __builtin_amdgcn_mfma_f32_32x32x16_bf16((a), (b), (c), 0, 0, 0)
#define MFMA16(a, b, c) __builtin_amdgcn_mfma_f32_16x16x32_bf16((a), (b), (c), 0, 0, 0)
__device__ __forceinline__ int crow(int r, int hi) { return (r & 3) + 8 * (r >> 2) + 4 * hi; }
__device__ __forceinline__ unsigned f2bf(float f) { return pkbf(f, 0.f) & 0xffffu; }
__device__ __forceinline__ float wave_sum(float v) {
#pragma unroll
    for (int o = 1; o < 64; o <<= 1) v += __shfl_xor(v, o);
    return v;
}
__device__ __forceinline__ bf16x8 pack8(const f32x16& x, int s) {
    u32x4 p; p.x = pkbf(x[8 * s], x[8 * s + 1]); p.y = pkbf(x[8 * s + 2], x[8 * s + 3]); p.z = pkbf(x[8 * s + 4], x[8 * s + 5]); p.w = pkbf(x[8 * s + 6], x[8 * s + 7]);
    return __builtin_bit_cast(bf16x8, p);
}

struct Args {
    const float* in[34]; float* out; unsigned char* ws; int ph_lo, ph_hi;
};
typedef const __attribute__((address_space(4))) Args* KA;
enum { I_XP = 0, I_XS, I_CSK, I_CSV, I_CMK, I_CMV, I_SLC, I_SLH, I_SFC, I_MEMP, I_GMIX, I_WIN, I_WLC, I_BLC, I_WLA, I_BLA, I_WLX, I_BLX, I_LAM, I_SINK, I_WOUT, I_GCROSS, I_GMEM,
       I_WMQ, I_WMK, I_WMV, I_WMO, I_GFFN, I_WFG, I_WFU, I_WFC, I_BFC, I_WFD, I_GFIN };

#define RLX_AGENT __ATOMIC_RELAXED, __HIP_MEMORY_SCOPE_AGENT
constexpr size_t WS_BAR = 896 * 1024, BAR_ZERO_BYTES = 16384;
__device__ unsigned g_bar[4096];
constexpr int MISC_OFF = LDS_BYTES - 64;
#define XB_TMO      128
#define XB_XCNT(j)  (256  + 64 * (j))
#define XB_XSUB(j)  (1280 + 64 * (j))
#define XB_XGEN(j)  (2304 + 64 * (j))
#define XB_TOP      3328
#define XB_TOPGEN   3392
#define XCD_BAR_WORDS 3456
#define XB_SPIN_CAP (1u << 18)

__device__ __forceinline__ unsigned xb_ld(unsigned* p)              { return __hip_atomic_load(p, __ATOMIC_RELAXED, __HIP_MEMORY_SCOPE_AGENT); }
__device__ __forceinline__ unsigned xb_add(unsigned* p, unsigned v) { return __hip_atomic_fetch_add(p, v, __ATOMIC_RELAXED, __HIP_MEMORY_SCOPE_AGENT); }
__device__ __forceinline__ unsigned xb_xcc_id() { return (unsigned)__builtin_amdgcn_s_getreg((3 << 11) | 20) & 0xFu; }
#define XB_SPIN(cond, bar) do { unsigned _sp = 0; while (cond) { __builtin_amdgcn_s_sleep(1); \
    if ((++_sp & 255u) == 0u) { if (xb_ld(&(bar)[XB_TMO])) break; if (_sp > XB_SPIN_CAP) { atomicAdd(&(bar)[XB_TMO], 1u); break; } } } } while (0)

struct XcdBarrier {
    unsigned* bar; unsigned x;
    volatile LAS unsigned* st;
};

__device__ __forceinline__ XcdBarrier xcd_barrier_post(unsigned* bar, volatile LAS unsigned* st) {
    XcdBarrier b; b.bar = bar; b.x = xb_xcc_id(); b.st = st;
    if (threadIdx.x == 0) (void)xb_add(&bar[XB_XCNT(b.x)], 1u);
    return b;
}
__device__ __forceinline__ void xcd_barrier_complete(unsigned* bar, unsigned x, unsigned& nloc, unsigned& nx) {
    const unsigned G = gridDim.x * gridDim.y * gridDim.z;
    unsigned sum, cnt, mine, sp = 0u;
    for (;;) {
        sum = 0u; cnt = 0u; mine = 0u;
#pragma unroll
        for (unsigned j = 0; j < 16; ++j) { const unsigned c = xb_ld(&bar[XB_XCNT(j)]); sum += c; cnt += (c > 0u) ? 1u : 0u; mine = (j == x) ? c : mine; }
        if (sum == G) break;
        __builtin_amdgcn_s_sleep(1);
        if ((++sp & 255u) == 0u) { if (xb_ld(&bar[XB_TMO])) break; if (sp > XB_SPIN_CAP) { atomicAdd(&bar[XB_TMO], 1u); break; } }
    }
    nloc = mine > 0u ? mine : 1u; nx = cnt > 0u ? cnt : 1u;
}

__device__ __forceinline__ void xcd_barrier(const XcdBarrier& b) {
    asm volatile("s_waitcnt vmcnt(0)" ::: "memory");
    __syncthreads();
    if (threadIdx.x == 0) {
        unsigned* bar = b.bar;
        __builtin_amdgcn_s_waitcnt(0);
        unsigned nloc = b.st[0], nx = b.st[1];
        if (nloc == 0u) { xcd_barrier_complete(bar, b.x, nloc, nx); b.st[0] = nloc; b.st[1] = nx; }
        const unsigned old = xb_add(&bar[XB_XSUB(b.x)], 1u);
        const unsigned gen = old / nloc;
        if (old + 1u == (gen + 1u) * nloc) {
            __builtin_amdgcn_fence(__ATOMIC_RELEASE, "agent");
            asm volatile("s_waitcnt vmcnt(0)" ::: "memory");
            const unsigned og = xb_add(&bar[XB_TOP], 1u);
            const unsigned tg = og / nx;
            if (og + 1u == (tg + 1u) * nx) xb_add(&bar[XB_TOPGEN], 1u);
            else XB_SPIN(xb_ld(&bar[XB_TOPGEN]) == tg, bar);
            __builtin_amdgcn_fence(__ATOMIC_ACQUIRE, "agent");
            xb_add(&bar[XB_XGEN(b.x)], 1u);
            asm volatile("s_waitcnt vmcnt(0)" ::: "memory");
        } else {
            XB_SPIN(xb_ld(&bar[XB_XGEN(b.x)]) == gen, bar);
            __builtin_amdgcn_fence(__ATOMIC_ACQUIRE, "agent");
            asm volatile("s_waitcnt vmcnt(0)" ::: "memory");
        }
    }
    __syncthreads();
}

struct TItem { const float* W; const float* g; bf16_t* WT; int K, N, row_off, ilv, item; };
__device__ __forceinline__ void p0_transpose_load(const TItem& t, float (&v)[32], int lane) {
    const int nblk = t.N / 32, kb = t.item / nblk, nb = t.item % nblk, k0 = 64 * kb, n0 = 32 * nb;
#pragma unroll
    for (int i = 0; i < 32; ++i) { const int kk = 2 * i + (lane >> 5); v[i] = t.W[(size_t)(k0 + kk) * t.N + n0 + (lane & 31)] * (t.g ? t.g[k0 + kk] : 1.0f); }
}
__device__ __forceinline__ void p0_transpose_store(const TItem& t, const float (&v)[32], LAS float* scr, int lane) {
    const int nblk = t.N / 32, kb = t.item / nblk, nb = t.item % nblk, k0 = 64 * kb, n0 = 32 * nb;
#pragma unroll
    for (int i = 0; i < 32; ++i) { const int kk = 2 * i + (lane >> 5); scr[kk * 33 + (lane & 31)] = v[i]; }
    asm volatile("s_waitcnt lgkmcnt(0)" ::: "memory");
    const int c = lane & 7;
    const int rbase = t.ilv ? (((n0 >> 7) << 8) + (n0 & 127) + (t.ilv == 2 ? 128 : 0)) : (t.row_off + n0);
#pragma unroll
    for (int j = 0; j < 4; ++j) { const int n = (lane >> 3) + 8 * j; const LAS float* s = scr + (8 * c) * 33 + n;
        u32x4 o; o.x = pkbf(s[0 * 33], s[1 * 33]); o.y = pkbf(s[2 * 33], s[3 * 33]); o.z = pkbf(s[4 * 33], s[5 * 33]); o.w = pkbf(s[6 * 33], s[7 * 33]);
        *(u32x4*)(t.WT + (size_t)(rbase + n) * t.K + k0 + 8 * c) = o; }
    asm volatile("s_waitcnt lgkmcnt(0)" ::: "memory");
}
__device__ __forceinline__ void row_to_bf16(const float* xrow, bf16_t* orow, float* ssq, int lane) {
    const f32x4* xr = (const f32x4*)xrow + lane;
    f32x4 v[4]; float s = 0.f;
#pragma unroll
    for (int j = 0; j < 4; ++j) { v[j] = xr[64 * j]; s += (v[j].x * v[j].x + v[j].y * v[j].y) + (v[j].z * v[j].z + v[j].w * v[j].w); }
    s = wave_sum(s);
    u32x2* o8 = (u32x2*)orow + lane;
#pragma unroll
    for (int j = 0; j < 4; ++j) { u32x2 w; w.x = pkbf(v[j].x, v[j].y); w.y = pkbf(v[j].z, v[j].w); o8[64 * j] = w; }
    if (lane == 0) *ssq = s;
}
__device__ __forceinline__ void p0_prologue(KA a, ldsp lds, int tid, int lane, int wave) {
    unsigned char* ws = a->ws;
    LAS float* scr = (LAS float*)(lds + wave * 16384);
    const int gw = blockIdx.x * NWAVES + wave, NGW = gridDim.x * NWAVES;
    constexpr int I_IN = 16 * 56, I_OUT = 16 * 32, I_Q = 16 * 16, I_MO = 8 * 32, I_G = 16 * 96, I_D = 48 * 32;
    constexpr int NITEMS = I_IN + I_OUT + 3 * I_Q + I_MO + 2 * I_G + I_D;
    auto item_of = [&](int it) -> TItem {
        int r = it;
        if (r < I_IN) return TItem{a->in[I_WIN], a->in[I_GMIX], (bf16_t*)(ws + WS_WIN), 1024, DIN, 0, 0, r}; r -= I_IN;
        if (r < I_OUT) return TItem{a->in[I_WOUT], nullptr, (bf16_t*)(ws + WS_WOUT), 1024, 1024, 0, 0, r}; r -= I_OUT;
        if (r < I_Q) return TItem{a->in[I_WMQ], a->in[I_GCROSS], (bf16_t*)(ws + WS_WQ), 1024, 512, 0, 0, r}; r -= I_Q;
        if (r < I_Q) return TItem{a->in[I_WMK], a->in[I_GMEM], (bf16_t*)(ws + WS_WKV), 1024, 512, 0, 0, r}; r -= I_Q;
        if (r < I_Q) return TItem{a->in[I_WMV], a->in[I_GMEM], (bf16_t*)(ws + WS_WKV), 1024, 512, 512, 0, r}; r -= I_Q;
        if (r < I_MO) return TItem{a->in[I_WMO], nullptr, (bf16_t*)(ws + WS_WMO), 512, 1024, 0, 0, r}; r -= I_MO;
        if (r < I_G) return TItem{a->in[I_WFG], a->in[I_GFFN], (bf16_t*)(ws + WS_WGU), 1024, DFF, 0, 1, r}; r -= I_G;
        if (r < I_G) return TItem{a->in[I_WFU], a->in[I_GFFN], (bf16_t*)(ws + WS_WGU), 1024, DFF, 0, 2, r}; r -= I_G;
        return TItem{a->in[I_WFD], nullptr, (bf16_t*)(ws + WS_WD), DFF, 1024, 0, 0, r};
    };
    for (int it = gw; it < NITEMS; it += 3 * NGW) {
        const bool ok1 = it + NGW < NITEMS, ok2 = it + 2 * NGW < NITEMS;
        const TItem t0 = item_of(it), t1 = item_of(ok1 ? it + NGW : it), t2 = item_of(ok2 ? it + 2 * NGW : it);
        float v0[32], v1[32], v2[32];
        p0_transpose_load(t0, v0, lane); p0_transpose_load(t1, v1, lane); p0_transpose_load(t2, v2, lane);
        p0_transpose_store(t0, v0, scr, lane);
        if (ok1) p0_transpose_store(t1, v1, scr, lane);
        if (ok2) p0_transpose_store(t2, v2, scr, lane);
    }
    bf16_t* xb = (bf16_t*)(ws + WS_XB); float* ssq0 = (float*)(ws + WS_SSQ0);
    for (int m0 = gw; m0 < MT + 512; m0 += 4 * NGW) {
        const float* src[4]; bf16_t* dst[4]; float* sq[4]; bool ok[4];
#pragma unroll
        for (int q = 0; q < 4; ++q) { const int m = m0 + q * NGW; ok[q] = m < MT + 512;
            if (m < MP) { src[q] = a->in[I_XP] + (size_t)m * 1024; dst[q] = xb + (size_t)m * 1024; sq[q] = ssq0 + m; }
            else if (m < MT) { src[q] = a->in[I_XS] + (size_t)(m - MP) * 1024; dst[q] = xb + (size_t)m * 1024; sq[q] = ssq0 + m; }
            else { const int rr = ok[q] ? m - MT : 0; src[q] = a->in[I_MEMP] + (size_t)rr * 1024; dst[q] = (bf16_t*)(ws + WS_MEMA) + (size_t)rr * 1024; sq[q] = (float*)(ws + WS_SSQM) + rr; } }
        f32x4 v[4][4]; float s[4] = {0.f, 0.f, 0.f, 0.f};
#pragma unroll
        for (int q = 0; q < 4; ++q)
#pragma unroll
            for (int j = 0; j < 4; ++j) v[q][j] = ((const f32x4*)src[q] + lane)[64 * j];
#pragma unroll
        for (int q = 0; q < 4; ++q) {
#pragma unroll
            for (int j = 0; j < 4; ++j) s[q] += (v[q][j].x * v[q][j].x + v[q][j].y * v[q][j].y) + (v[q][j].z * v[q][j].z + v[q][j].w * v[q][j].w);
            s[q] = wave_sum(s[q]);
            if (ok[q]) {
#pragma unroll
                for (int j = 0; j < 4; ++j) { u32x2 wv; wv.x = pkbf(v[q][j].x, v[q][j].y); wv.y = pkbf(v[q][j].z, v[q][j].w); ((u32x2*)dst[q] + lane)[64 * j] = wv; }
                if (lane == 0) *sq[q] = s[q];
            }
        }
    }
    for (int i = blockIdx.x * NTHREADS + tid; i < MT; i += gridDim.x * NTHREADS) { ((float*)(ws + WS_SSQ1))[i] = 0.f; ((float*)(ws + WS_SSQ2))[i] = 0.f; ((float*)(ws + WS_SSQ3))[i] = 0.f; }
}

template <bool SAMPLE, int PASS>
__device__ __forceinline__ void lru_unit(KA a, ldsp lds, int unit, int tid, int lane, int w) {
    constexpr int NTOK = SAMPLE ? 64 : 256, NROW = SAMPLE ? (NTOK / 4) * 7 : NTOK + 3, RS = 272;
    const ldsp XR = lds, XC = lds + 259 * RS;
    unsigned char* ws = a->ws;
    const bf16_t* proj = (const bf16_t*)(ws + WS_PROJ);
    int b = 0, chunk, bp;
    if (!SAMPLE) { b = unit >> 7; chunk = (unit >> 2) & 31; bp = unit & 3; } else { chunk = unit >> 2; bp = unit & 3; }
    const int c0 = bp * 128;
    const int row0 = SAMPLE ? MP + chunk * 64 : b * SEQ + chunk * 256;
    const int nb = w >> 2, jt = w & 3, n = bp * 2 + nb, fr = lane & 15, fq = lane >> 4;
    const int ch = n * 64 + jt * 16 + fr, chl = nb * 64 + jt * 16 + fr;
    float wA[2][8], wX[2][8];
#pragma unroll
    for (int kh = 0; kh < 2; ++kh)
#pragma unroll
        for (int j = 0; j < 8; ++j) { const int c = kh * 32 + 8 * fq + j; const size_t o = (size_t)(n * 64 + c) * 64 + jt * 16 + fr; wA[kh][j] = a->in[I_WLA][o]; wX[kh][j] = a->in[I_WLX][o]; }
    const float ba_ = a->in[I_BLA][ch], bx_ = a->in[I_BLX][ch];
    const float lam = a->in[I_LAM][ch];
    const float wc0 = a->in[I_WLC][ch], wc1 = a->in[I_WLC][512 + ch], wc2 = a->in[I_WLC][1024 + ch], wc3 = a->in[I_WLC][1536 + ch], bcv = a->in[I_BLC][ch];
    float hc = 0.f, Atot = 1.f, Htot = 0.f;
    float* summ = (float*)(ws + WS_SUMM);
    typedef float f32x2_ __attribute__((ext_vector_type(2)));
    f32x2_ ah[32];
    if (!SAMPLE && PASS == 2) {
#pragma unroll
        for (int j = 0; j < 32; ++j) ah[j] = *(const f32x2_*)(summ + ((size_t)(b * 32 + j) * 512 + ch) * 2);
    }
    __syncthreads();
#pragma unroll
    for (int it = tid; it < NROW * 16; it += NTHREADS) {
        const int r = it >> 4, cq = it & 15;
        u32x4 v = {0u, 0u, 0u, 0u};
        if (!SAMPLE) { const int t = chunk * 256 - 3 + r; if (t >= 0) v = *(const u32x4*)(proj + (size_t)(b * SEQ + t) * DIN + c0 + cq * 8); }
        else { const int bl = r / 7, rr = r % 7, bs = chunk * 16 + bl;
            if (rr >= 3) v = *(const u32x4*)(proj + (size_t)(MP + bs * 4 + rr - 3) * DIN + c0 + cq * 8);
            else { const float* s = a->in[I_SLC] + (size_t)(bs * 3 + rr) * 512 + c0 + cq * 8; const f32x4 s0 = *(const f32x4*)s, s1 = *(const f32x4*)(s + 4);
                v.x = pkbf(s0[0], s0[1]); v.y = pkbf(s0[2], s0[3]); v.z = pkbf(s1[0], s1[1]); v.w = pkbf(s1[2], s1[3]); } }
        *(LAS u32x4*)(XR + r * RS + cq * 16) = v;
    }
    __syncthreads();
    {
        const int cq = tid & 15, tg = tid >> 4;
        float wk[4][8], bb[8];
#pragma unroll
        for (int j = 0; j < 8; ++j) { bb[j] = a->in[I_BLC][c0 + cq * 8 + j];
#pragma unroll
            for (int k = 0; k < 4; ++k) wk[k][j] = a->in[I_WLC][k * 512 + c0 + cq * 8 + j]; }
#pragma unroll
        for (int q = 0; q < NTOK / 32; ++q) {
            const int tok = tg * (NTOK / 32) + q; const int base = SAMPLE ? (tok >> 2) * 7 + (tok & 3) : tok;
            float x[8];
#pragma unroll
            for (int j = 0; j < 8; ++j) x[j] = bb[j];
#pragma unroll
            for (int k = 0; k < 4; ++k) { const u32x4 v = *(const LAS u32x4*)(XR + (base + k) * RS + cq * 16);
                x[0] += wk[k][0] * bflo(v.x); x[1] += wk[k][1] * bfhi(v.x); x[2] += wk[k][2] * bflo(v.y); x[3] += wk[k][3] * bfhi(v.y);
                x[4] += wk[k][4] * bflo(v.z); x[5] += wk[k][5] * bfhi(v.z); x[6] += wk[k][6] * bflo(v.w); x[7] += wk[k][7] * bfhi(v.w); }
            u32x4 o; o.x = pkbf(x[0], x[1]); o.y = pkbf(x[2], x[3]); o.z = pkbf(x[4], x[5]); o.w = pkbf(x[6], x[7]);
            *(LAS u32x4*)(XC + tok * RS + cq * 16) = o;
        }
    }
    __syncthreads();
    const float sp = (lam > 15.f) ? __expf(-lam) : log1pf(__expf(-lam));
    const float k8 = -8.0f * sp * LOG2E;
    bf16x8 bA[2], bX[2];
#pragma unroll
    for (int kh = 0; kh < 2; ++kh)
#pragma unroll
        for (int j = 0; j < 8; ++j) { bA[kh][j] = (short)f2bf(wA[kh][j]); bX[kh][j] = (short)f2bf(wX[kh][j]); }
    if (!SAMPLE && PASS == 2) {
#pragma unroll
        for (int j = 0; j < 32; ++j) if (j < chunk) hc = ah[j].x * hc + ah[j].y;
    }
    bf16_t* mix = (bf16_t*)(ws + WS_MIX);
    unsigned short gcur[4] = {0, 0, 0, 0}, gnxt[4] = {0, 0, 0, 0};
    if (SAMPLE || PASS == 2) {
#pragma unroll
        for (int r = 0; r < 4; ++r) gcur[r] = proj[((size_t)row0 + 4 * fq + r) * DIN + 512 + ch];
    }
#pragma unroll 2
    for (int s = 0; s < NTOK / 16; ++s) {
        if ((SAMPLE || PASS == 2) && s + 1 < NTOK / 16) {
#pragma unroll
            for (int r = 0; r < 4; ++r) gnxt[r] = proj[((size_t)row0 + 16 * (s + 1) + 4 * fq + r) * DIN + 512 + ch];
        }
        bf16x8 aF[2];
#pragma unroll
        for (int kh = 0; kh < 2; ++kh) aF[kh] = *(const LAS bf16x8*)(XC + (16 * s + fr) * RS + (nb * 64 + kh * 32 + 8 * fq) * 2);
        f32x4 accA = {0.f, 0.f, 0.f, 0.f}, accX = {0.f, 0.f, 0.f, 0.f};
        accA = MFMA16(aF[0], bA[0], accA); accA = MFMA16(aF[1], bA[1], accA);
        accX = MFMA16(aF[0], bX[0], accX); accX = MFMA16(aF[1], bX[1], accX);
        const int base = SAMPLE ? (4 * s + fq) * 7 : 16 * s + 4 * fq;
        float x7[7];
#pragma unroll
        for (int q = 0; q < 7; ++q) x7[q] = bf2f(*(const LAS unsigned short*)(XR + (base + q) * RS + chl * 2));
        float av[4], bv[4];
#pragma unroll
        for (int r = 0; r < 4; ++r) {
            const float xc = bcv + wc0 * x7[r] + wc1 * x7[r + 1] + wc2 * x7[r + 2] + wc3 * x7[r + 3];
            const float rg = sigmoidf_(accA[r] + ba_), ig = sigmoidf_(accX[r] + bx_);
            const float a_ = fexp2(k8 * rg);
            av[r] = a_; bv[r] = __builtin_sqrtf(fmaxf(1.0f - a_ * a_, 0.f)) * (ig * xc);
        }
        float hv[4];
        if (SAMPLE) {
            const int bs = chunk * 16 + 4 * s + fq;
            float h = a->in[I_SLH][(size_t)bs * 512 + ch];
#pragma unroll
            for (int r = 0; r < 4; ++r) { h = av[r] * h + bv[r]; hv[r] = h; }
            a->out[O_SLH + (size_t)bs * 512 + ch] = h;
        } else {
            float Ai = av[0] * av[1] * av[2] * av[3], Hi = 0.f;
#pragma unroll
            for (int r = 0; r < 4; ++r) Hi = av[r] * Hi + bv[r];
            float tA = __shfl_up(Ai, 16), tH = __shfl_up(Hi, 16);
            if (fq >= 1) { Hi = Ai * tH + Hi; Ai = Ai * tA; }
            tA = __shfl_up(Ai, 32); tH = __shfl_up(Hi, 32);
            if (fq >= 2) { Hi = Ai * tH + Hi; Ai = Ai * tA; }
            float Ae = __shfl_up(Ai, 16), He = __shfl_up(Hi, 16);
            if (fq == 0) { Ae = 1.f; He = 0.f; }
            const float At = __shfl(Ai, 48 + fr), Ht = __shfl(Hi, 48 + fr);
            if (PASS == 1) { Htot = At * Htot + Ht; Atot *= At; }
            else {
                float h = Ae * hc + He;
#pragma unroll
                for (int r = 0; r < 4; ++r) { h = av[r] * h + bv[r]; hv[r] = h; }
                hc = At * hc + Ht;
            }
        }
        if (SAMPLE || PASS == 2) {
#pragma unroll
            for (int r = 0; r < 4; ++r) {
                const size_t row = (size_t)row0 + 16 * s + 4 * fq + r;
                mix[row * 1024 + ch] = (bf16_t)f2bf(hv[r] * gelu_tanh(bf2f(gcur[r])));
            }
#pragma unroll
            for (int r = 0; r < 4; ++r) gcur[r] = gnxt[r];
        }
    }
    if (!SAMPLE && PASS == 1 && fq == 0) { summ[((size_t)(b * 32 + chunk) * 512 + ch) * 2] = Atot; summ[((size_t)(b * 32 + chunk) * 512 + ch) * 2 + 1] = Htot; }
    if (!SAMPLE && PASS == 2 && chunk == 31 && fq == 0) a->out[O_PLH + (size_t)b * 512 + ch] = hc;
}

__device__ __forceinline__ void swa_prompt_unit(KA a, ldsp lds, int unit, int tid, int lane, int w) {
    constexpr int KRS = 144, VRS = 400;
    const ldsp Ks = lds, VT = lds + 192 * KRS;
    const bf16_t* proj = (const bf16_t*)(a->ws + WS_PROJ);
    const int b = unit >> 8, hk = (unit >> 7) & 1, qb = unit & 127, t0 = qb * 64;
    __syncthreads();
#pragma unroll
    for (int it = tid; it < 192 * 8; it += NTHREADS) {
        const int kl = it >> 3, cq = it & 7, t = t0 - 128 + kl;
        u32x4 kv = {0u, 0u, 0u, 0u}, vv = {0u, 0u, 0u, 0u};
        if (t >= 0) { const bf16_t* p = proj + (size_t)(b * SEQ + t) * DIN; kv = *(const u32x4*)(p + 1536 + hk * 64 + cq * 8); vv = *(const u32x4*)(p + 1664 + hk * 64 + cq * 8); }
        *(LAS u32x4*)(Ks + kl * KRS + cq * 16) = kv;
#pragma unroll
        for (int e = 0; e < 8; ++e) *(LAS unsigned short*)(VT + (cq * 8 + e) * VRS + kl * 2) = (unsigned short)(vv[e >> 1] >> (16 * (e & 1)));
    }
    __syncthreads();
    const int g = w >> 1, hf = w & 1, hq = hk * 4 + g, j = lane & 31, hi = lane >> 5;
    const size_t qrow = (size_t)b * SEQ + t0 + 32 * hf + j;
    bf16x8 qf[4];
#pragma unroll
    for (int ks = 0; ks < 4; ++ks) qf[ks] = *(const bf16x8*)(proj + qrow * DIN + 1024 + hq * 64 + 16 * ks + 8 * hi);
    const float slope2 = fexp2(-(float)(hq + 1)) * LOG2E, sink2 = a->in[I_SINK][hq] * LOG2E;
    float mx = sink2;
    f32x16 st[5];
#pragma unroll
    for (int kt = 0; kt < 5; ++kt) {
        f32x16 acc = {};
#pragma unroll
        for (int ks = 0; ks < 4; ++ks) { const bf16x8 kf = *(const LAS bf16x8*)(Ks + (32 * hf + 32 * kt + j) * KRS + (16 * ks + 8 * hi) * 2); acc = MFMA32(kf, qf[ks], acc); }
        int dbase = 128 + j - 32 * kt - 4 * hi;
        int kpb = t0 - 128 + 32 * hf + 32 * kt + 4 * hi;
        asm volatile("" : "+v"(dbase), "+v"(kpb));
#pragma unroll
        for (int r = 0; r < 16; ++r) {
            const int cr = (r & 3) + 8 * (r >> 2), dist = dbase - cr;
            const bool valid = (unsigned)dist < 128u && (kpb + cr) >= 0;
            float s = acc[r] * LOG2E - slope2 * (float)dist; s = valid ? s : -1e30f; acc[r] = s; mx = fmaxf(mx, s);
        }
        st[kt] = acc;
        __builtin_amdgcn_sched_barrier(0);
    }
    mx = fmaxf(mx, __shfl_xor(mx, 32));
    float l = 0.f;
#pragma unroll
    for (int kt = 0; kt < 5; ++kt)
#pragma unroll
        for (int r = 0; r < 16; ++r) { const float p = fexp2(st[kt][r] - mx); st[kt][r] = p; l += p; }
    l += __shfl_xor(l, 32); l += fexp2(sink2 - mx);
    const float inv = frcp(l);
    f32x16 o[2] = {};
#pragma unroll
    for (int kt = 0; kt < 5; ++kt)
#pragma unroll
        for (int s = 0; s < 2; ++s) {
            const bf16x8 pf = pack8(st[kt], s);
#pragma unroll
            for (int dt = 0; dt < 2; ++dt) {
                const int d = 32 * dt + j, kb = 32 * hf + 32 * kt + 16 * s + 4 * hi;
                const s16x4 lo = *(const LAS s16x4*)(VT + d * VRS + kb * 2), hi4 = *(const LAS s16x4*)(VT + d * VRS + (kb + 8) * 2);
                const bf16x8 vf = __builtin_shufflevector(lo, hi4, 0, 1, 2, 3, 4, 5, 6, 7);
                o[dt] = MFMA32(vf, pf, o[dt]);
            }
            __builtin_amdgcn_sched_barrier(0);
        }
    bf16_t* mix = (bf16_t*)(a->ws + WS_MIX);
#pragma unroll
    for (int dt = 0; dt < 2; ++dt)
#pragma unroll
        for (int rg = 0; rg < 4; ++rg) {
            u32x2 wv; wv.x = pkbf(o[dt][4 * rg] * inv, o[dt][4 * rg + 1] * inv); wv.y = pkbf(o[dt][4 * rg + 2] * inv, o[dt][4 * rg + 3] * inv);
            *(u32x2*)(mix + qrow * 1024 + 512 + hq * 64 + 32 * dt + 8 * rg + 4 * hi) = wv;
        }
}

__device__ __forceinline__ void swa_sample_unit(KA a, ldsp lds, int bs, int tid) {
    LAS float* Kc = (LAS float*)lds;
    LAS float* Vc = (LAS float*)(lds + 69696);
    LAS float* Qs = (LAS float*)(lds + 137280);
    LAS float* P = Kc;
    const bf16_t* proj = (const bf16_t*)(a->ws + WS_PROJ);
    __syncthreads();
    {
        f32x4 kvv[8], vvv[8]; unsigned short qv[4], nk, nv;
#pragma unroll
        for (int q = 0; q < 8; ++q) { const int it = tid + q * NTHREADS, r = it >> 5, c4 = (it & 31) * 4;
            kvv[q] = *(const f32x4*)(a->in[I_CSK] + (size_t)(bs * 128 + r) * 128 + c4); vvv[q] = *(const f32x4*)(a->in[I_CSV] + (size_t)(bs * 128 + r) * 128 + c4); }
#pragma unroll
        for (int q = 0; q < 4; ++q) { const int e = tid + q * NTHREADS, rq = e >> 6, d = e & 63, hq = rq >> 2, i = rq & 3; qv[q] = proj[(size_t)(MP + bs * 4 + i) * DIN + 1024 + hq * 64 + d]; }
        { const int i = tid >> 7, c = tid & 127; const bf16_t* p = proj + (size_t)(MP + bs * 4 + i) * DIN; nk = p[1536 + c]; nv = p[1664 + c]; }
#pragma unroll
        for (int q = 0; q < 8; ++q) { const int it = tid + q * NTHREADS, r = it >> 5, c4 = (it & 31) * 4;
            *(LAS f32x4*)(Kc + r * 132 + c4) = kvv[q]; *(LAS f32x4*)(Vc + r * 128 + c4) = vvv[q];
            if (r >= 4) { *(f32x4*)(a->out + O_SSK + (size_t)(bs * 128 + r - 4) * 128 + c4) = kvv[q]; *(f32x4*)(a->out + O_SSV + (size_t)(bs * 128 + r - 4) * 128 + c4) = vvv[q]; } }
#pragma unroll
        for (int q = 0; q < 4; ++q) { const int e = tid + q * NTHREADS; Qs[e] = bf2f(qv[q]); }
        { const int i = tid >> 7, c = tid & 127; Kc[(128 + i) * 132 + c] = bf2f(nk); Vc[(128 + i) * 128 + c] = bf2f(nv); }
    }
    __syncthreads();
    float sc[16];
    const int rg = tid / 33, kg = tid - rg * 33, hkS = rg >> 2;
#pragma unroll
    for (int q = 0; q < 16; ++q) sc[q] = 0.f;
    if (tid < 264) {
#pragma unroll 2
        for (int c = 0; c < 16; ++c) {
            f32x4 kk[4], qq[4];
#pragma unroll
            for (int i = 0; i < 4; ++i) { kk[i] = *(const LAS f32x4*)(Kc + (kg + 33 * i) * 132 + hkS * 64 + 4 * c); qq[i] = *(const LAS f32x4*)(Qs + (rg * 4 + i) * 64 + 4 * c); }
#pragma unroll
            for (int ri = 0; ri < 4; ++ri)
#pragma unroll
                for (int ki = 0; ki < 4; ++ki) sc[ri * 4 + ki] += (qq[ri][0] * kk[ki][0] + qq[ri][1] * kk[ki][1]) + (qq[ri][2] * kk[ki][2] + qq[ri][3] * kk[ki][3]);
        }
    }
    __syncthreads();
    if (tid < 264) {
#pragma unroll
        for (int ri = 0; ri < 4; ++ri)
#pragma unroll
            for (int ki = 0; ki < 4; ++ki) { const int row = rg * 4 + ri, hq = row >> 2, i = row & 3, key = kg + 33 * ki, dist = i + 128 - key; const bool valid = dist >= 0 && dist < 128;
                const float s = sc[ri * 4 + ki] * LOG2E - fexp2(-(float)(hq + 1)) * LOG2E * (float)dist; P[row * 132 + key] = valid ? s : -1e30f; }
    }
    __syncthreads();
    {
        const int row = tid >> 4, sub = tid & 15, hq = row >> 2; const float sink2 = a->in[I_SINK][hq] * LOG2E;
        float v[9], m = sink2;
#pragma unroll
        for (int jj = 0; jj < 9; ++jj) { const int k2 = sub + 16 * jj; v[jj] = k2 < 132 ? P[row * 132 + k2] : -1e30f; m = fmaxf(m, v[jj]); }
#pragma unroll
        for (int o = 8; o >= 1; o >>= 1) m = fmaxf(m, __shfl_xor(m, o));
        float l = 0.f;
#pragma unroll
        for (int jj = 0; jj < 9; ++jj) { v[jj] = fexp2(v[jj] - m); l += v[jj]; }
#pragma unroll
        for (int o = 8; o >= 1; o >>= 1) l += __shfl_xor(l, o);
        l += fexp2(sink2 - m);
        const float inv = 1.0f / l;
#pragma unroll
        for (int jj = 0; jj < 9; ++jj) { const int k2 = sub + 16 * jj; if (k2 < 132) P[row * 132 + k2] = v[jj] * inv; }
    }
    __syncthreads();
    {
        LAS float* PART2 = Kc + 5120;
        const int lane = tid & 63, d4 = (lane & 15) * 4, kq = lane >> 4, rowgrp = tid >> 6, hk2 = rowgrp >> 2;
        f32x4 acc[4];
#pragma unroll
        for (int ri = 0; ri < 4; ++ri) acc[ri] = (f32x4){0.f, 0.f, 0.f, 0.f};
#pragma unroll 3
        for (int k2 = kq * 33; k2 < kq * 33 + 33; ++k2) { const f32x4 v4 = *(const LAS f32x4*)(Vc + k2 * 128 + hk2 * 64 + d4);
#pragma unroll
            for (int ri = 0; ri < 4; ++ri) acc[ri] += P[(rowgrp * 4 + ri) * 132 + k2] * v4; }
#pragma unroll
        for (int ri = 0; ri < 4; ++ri) *(LAS f32x4*)(PART2 + (kq * 32 + rowgrp * 4 + ri) * 64 + d4) = acc[ri];
    }
    __syncthreads();
    {
        const LAS float* PART2 = Kc + 5120;
        const int row = tid >> 4, d4 = (tid & 15) * 4, hq = row >> 2, i = row & 3;
        f32x4 acc = *(const LAS f32x4*)(PART2 + row * 64 + d4);
#pragma unroll
        for (int p = 1; p < 4; ++p) acc += *(const LAS f32x4*)(PART2 + (p * 32 + row) * 64 + d4);
        u32x2 wv; wv.x = pkbf(acc[0], acc[1]); wv.y = pkbf(acc[2], acc[3]);
        *(u32x2*)((bf16_t*)(a->ws + WS_MIX) + (size_t)(MP + bs * 4 + i) * 1024 + 512 + hq * 64 + d4) = wv;
    }
}

__device__ __forceinline__ void xattn_prompt_unit(KA a, ldsp lds, int unit, int tid, int lane, int w) {
    constexpr int KRS = 272, VRS = 528;
    const ldsp Km = lds, VmT = lds + 256 * KRS;
    const bf16_t* memkv = (const bf16_t*)(a->ws + WS_MEMKV);
    const bf16_t* qcb = (const bf16_t*)(a->ws + WS_QC);
    const int b = unit >> 7, h = (unit >> 5) & 3, qc = unit & 31;
    __syncthreads();
#pragma unroll
    for (int it = tid; it < 256 * 16; it += NTHREADS) {
        const int key = it >> 4, cq = it & 15; const bf16_t* p = memkv + (size_t)(b * 256 + key) * 1024 + h * 128 + cq * 8;
        const u32x4 kv = *(const u32x4*)p, vv = *(const u32x4*)(p + 512);
        *(LAS u32x4*)(Km + key * KRS + cq * 16) = kv;
#pragma unroll
        for (int e = 0; e < 8; ++e) *(LAS unsigned short*)(VmT + (cq * 8 + e) * VRS + key * 2) = (unsigned short)(vv[e >> 1] >> (16 * (e & 1)));
    }
    __syncthreads();
    const int j = lane & 31, hi = lane >> 5;
    const size_t qrow = (size_t)b * SEQ + qc * 256 + 32 * w + j;
    bf16x8 qf[8];
#pragma unroll
    for (int ks = 0; ks < 8; ++ks) qf[ks] = *(const bf16x8*)(qcb + qrow * 512 + h * 128 + 16 * ks + 8 * hi);
    float m = -1e30f, l = 0.f;
    f32x16 o[4] = {};
#pragma unroll
    for (int kh = 0; kh < 2; ++kh) {
        f32x16 st[4];
        float mx = -1e30f;
#pragma unroll
        for (int kt = 0; kt < 4; ++kt) {
            f32x16 acc = {};
#pragma unroll
            for (int ks = 0; ks < 8; ++ks) { const bf16x8 kf = *(const LAS bf16x8*)(Km + (128 * kh + 32 * kt + j) * KRS + (16 * ks + 8 * hi) * 2); acc = MFMA32(kf, qf[ks], acc); }
#pragma unroll
            for (int r = 0; r < 16; ++r) { acc[r] *= LOG2E; mx = fmaxf(mx, acc[r]); }
            st[kt] = acc;
        }
        mx = fmaxf(mx, __shfl_xor(mx, 32));
        const float mn = fmaxf(m, mx), scl = fexp2(m - mn);
        m = mn; l *= scl;
#pragma unroll
        for (int dt = 0; dt < 4; ++dt) o[dt] *= scl;
#pragma unroll
        for (int kt = 0; kt < 4; ++kt)
#pragma unroll
            for (int r = 0; r < 16; ++r) { const float p = fexp2(st[kt][r] - m); st[kt][r] = p; l += p; }
#pragma unroll
        for (int kt = 0; kt < 4; ++kt)
#pragma unroll
            for (int s = 0; s < 2; ++s) {
                const bf16x8 pf = pack8(st[kt], s);
#pragma unroll
                for (int dt = 0; dt < 4; ++dt) {
                    const int d = 32 * dt + j, kb = 128 * kh + 32 * kt + 16 * s + 4 * hi;
                    const s16x4 lo = *(const LAS s16x4*)(VmT + d * VRS + kb * 2), hi4 = *(const LAS s16x4*)(VmT + d * VRS + (kb + 8) * 2);
                    const bf16x8 vf = __builtin_shufflevector(lo, hi4, 0, 1, 2, 3, 4, 5, 6, 7);
                    o[dt] = MFMA32(vf, pf, o[dt]);
                }
            }
    }
    l += __shfl_xor(l, 32);
    const float inv = frcp(l);
    bf16_t* oc = (bf16_t*)(a->ws + WS_OC);
#pragma unroll
    for (int dt = 0; dt < 4; ++dt)
#pragma unroll
        for (int rg = 0; rg < 4; ++rg) {
            u32x2 wv; wv.x = pkbf(o[dt][4 * rg] * inv, o[dt][4 * rg + 1] * inv); wv.y = pkbf(o[dt][4 * rg + 2] * inv, o[dt][4 * rg + 3] * inv);
            *(u32x2*)(oc + qrow * 512 + h * 128 + 32 * dt + 8 * rg + 4 * hi) = wv;
        }
}
__device__ __forceinline__ void xattn_sample_unit(KA a, ldsp lds, int unit, int tid, int lane, int w) {
    LAS float* Qs = (LAS float*)lds;
    LAS float* S = (LAS float*)(lds + 2048);
    LAS float* RED = (LAS float*)(lds + 8192);
    const bf16_t* qcb = (const bf16_t*)(a->ws + WS_QC);
    const int bs = unit >> 2, h = unit & 3;
    __syncthreads();
    { const int i = tid >> 7, d = tid & 127; Qs[i * 128 + d] = bf2f(qcb[(size_t)(MP + bs * 4 + i) * 512 + h * 128 + d]); }
    __syncthreads();
    f32x4 vpre[16];
    {
        const int dq = tid & 31, kg = tid >> 5; const float* vp = a->in[I_CMV] + ((size_t)(bs * 256 + kg * 16) * 4 + h) * 128 + dq * 4;
#pragma unroll
        for (int kk = 0; kk < 16; ++kk) vpre[kk] = *(const f32x4*)(vp + (size_t)kk * 512);
    }
    {
        const int key = tid >> 1, hf = tid & 1; const float* kp = a->in[I_CMK] + ((size_t)(bs * 256 + key) * 4 + h) * 128 + hf * 64;
        float s0 = 0.f, s1 = 0.f, s2 = 0.f, s3 = 0.f;
#pragma unroll
        for (int c = 0; c < 16; ++c) {
            const f32x4 k4 = *(const f32x4*)(kp + 4 * c);
            const f32x4 q0 = *(const LAS f32x4*)(Qs + hf * 64 + 4 * c), q1 = *(const LAS f32x4*)(Qs + 128 + hf * 64 + 4 * c), q2 = *(const LAS f32x4*)(Qs + 256 + hf * 64 + 4 * c), q3 = *(const LAS f32x4*)(Qs + 384 + hf * 64 + 4 * c);
            s0 += (k4[0] * q0[0] + k4[1] * q0[1]) + (k4[2] * q0[2] + k4[3] * q0[3]); s1 += (k4[0] * q1[0] + k4[1] * q1[1]) + (k4[2] * q1[2] + k4[3] * q1[3]);
            s2 += (k4[0] * q2[0] + k4[1] * q2[1]) + (k4[2] * q2[2] + k4[3] * q2[3]); s3 += (k4[0] * q3[0] + k4[1] * q3[1]) + (k4[2] * q3[2] + k4[3] * q3[3]);
        }
        s0 += __shfl_xor(s0, 1); s1 += __shfl_xor(s1, 1); s2 += __shfl_xor(s2, 1); s3 += __shfl_xor(s3, 1);
        if (hf == 0) { S[key] = s0 * LOG2E; S[256 + key] = s1 * LOG2E; S[512 + key] = s2 * LOG2E; S[768 + key] = s3 * LOG2E; }
    }
    __syncthreads();
    if (w < 4) {
        f32x4 v = *(const LAS f32x4*)(S + w * 256 + lane * 4);
        float m = fmaxf(fmaxf(v[0], v[1]), fmaxf(v[2], v[3]));
#pragma unroll
        for (int o = 32; o >= 1; o >>= 1) m = fmaxf(m, __shfl_xor(m, o));
        v[0] = fexp2(v[0] - m); v[1] = fexp2(v[1] - m); v[2] = fexp2(v[2] - m); v[3] = fexp2(v[3] - m);
        const float l = wave_sum((v[0] + v[1]) + (v[2] + v[3]));
        v *= (1.0f / l);
        *(LAS f32x4*)(S + w * 256 + lane * 4) = v;
    }
    __syncthreads();
    {
        const int dq = tid & 31, kg = tid >> 5;
        f32x4 a0 = {0.f, 0.f, 0.f, 0.f}, a1 = a0, a2 = a0, a3 = a0;
#pragma unroll
        for (int kk = 0; kk < 16; ++kk) { const f32x4 v4 = vpre[kk]; const int k2 = kg * 16 + kk;
            a0 += S[k2] * v4; a1 += S[256 + k2] * v4; a2 += S[512 + k2] * v4; a3 += S[768 + k2] * v4; }
        *(LAS f32x4*)(RED + (kg * 4 + 0) * 128 + dq * 4) = a0; *(LAS f32x4*)(RED + (kg * 4 + 1) * 128 + dq * 4) = a1;
        *(LAS f32x4*)(RED + (kg * 4 + 2) * 128 + dq * 4) = a2; *(LAS f32x4*)(RED + (kg * 4 + 3) * 128 + dq * 4) = a3;
    }
    __syncthreads();
    { const int i = tid >> 7, d = tid & 127; float s = 0.f;
#pragma unroll
        for (int kg = 0; kg < 16; ++kg) s += RED[(kg * 4 + i) * 128 + d];
        ((bf16_t*)(a->ws + WS_OC))[(size_t)(MP + bs * 4 + i) * 512 + h * 128 + d] = (bf16_t)f2bf(s); }
}


template <class Post> __device__ __forceinline__ void sk_tile(ldsp lds, const bf16_t* A, int lda, const bf16_t* B0, const bf16_t* B1, int K, const Post& post, int tid, int lane, int w) {
    const int fr = lane & 15, fq = lane >> 4, kper = K >> 3;
    const bf16_t* ap = A + (size_t)fr * lda + w * kper + 16 * fq;
    const bf16_t* bp0 = B0 + (size_t)fr * K + w * kper + 16 * fq;
    const bf16_t* bp1 = B1 + (size_t)fr * K + w * kper + 16 * fq;
    f32x4 acc[2][8];
#pragma unroll
    for (int i = 0; i < 2; ++i)
#pragma unroll
        for (int j = 0; j < 8; ++j) acc[i][j] = (f32x4){0.f, 0.f, 0.f, 0.f};
    for (int k0 = 0; k0 < kper; k0 += 128) {
        bf16x8 af[2][2][2], bf[2][8][2];
#pragma unroll
        for (int c = 0; c < 2; ++c) {
            const int kk = k0 + 64 * c;
            if (kk < kper) {
#pragma unroll
                for (int i = 0; i < 2; ++i) { af[c][i][0] = *(const bf16x8*)(ap + (size_t)(16 * i) * lda + kk); af[c][i][1] = *(const bf16x8*)(ap + (size_t)(16 * i) * lda + kk + 8); }
#pragma unroll
                for (int j = 0; j < 4; ++j) { bf[c][j][0] = *(const bf16x8*)(bp0 + (size_t)(16 * j) * K + kk); bf[c][j][1] = *(const bf16x8*)(bp0 + (size_t)(16 * j) * K + kk + 8);
                    bf[c][4 + j][0] = *(const bf16x8*)(bp1 + (size_t)(16 * j) * K + kk); bf[c][4 + j][1] = *(const bf16x8*)(bp1 + (size_t)(16 * j) * K + kk + 8); }
            }
        }
#pragma unroll
        for (int c = 0; c < 2; ++c) {
            if (k0 + 64 * c < kper) {
#pragma unroll
                for (int hl = 0; hl < 2; ++hl)
#pragma unroll
                    for (int i = 0; i < 2; ++i)
#pragma unroll
                        for (int j = 0; j < 8; ++j) acc[i][j] = MFMA16(af[c][i][hl], bf[c][j][hl], acc[i][j]);
            }
        }
    }
    LAS float* PART = (LAS float*)lds;
    __syncthreads();
#pragma unroll
    for (int i = 0; i < 2; ++i)
#pragma unroll
        for (int j = 0; j < 8; ++j)
#pragma unroll
            for (int r = 0; r < 4; ++r) PART[(w * 32 + 16 * i + 4 * fq + r) * 132 + 16 * j + fr] = acc[i][j][r];
    __syncthreads();
    const int row = tid >> 4, cc = tid & 15;
    f32x4 v0 = *(const LAS f32x4*)(PART + row * 132 + 4 * cc), v1 = *(const LAS f32x4*)(PART + row * 132 + 64 + 4 * cc);
#pragma unroll
    for (int p = 1; p < 8; ++p) { v0 += *(const LAS f32x4*)(PART + (p * 32 + row) * 132 + 4 * cc); v1 += *(const LAS f32x4*)(PART + (p * 32 + row) * 132 + 64 + 4 * cc); }
    post(row, cc, v0, v1);
}
__device__ __forceinline__ void st4bf(bf16_t* p, f32x4 v) { u32x2 w_; w_.x = pkbf(v[0], v[1]); w_.y = pkbf(v[2], v[3]); *(u32x2*)p = w_; }
struct SkProj {
    bf16_t* proj; const float* ssq; float* out; int mt, n0;
    __device__ __forceinline__ void operator()(int row, int cc, f32x4 va, f32x4 vb) const {
        const int grow = MP + 32 * mt + row, r2 = grow - MP, b = r2 >> 2, t = r2 & 3;
        const float rs0 = __builtin_amdgcn_rsqf(ssq[grow] * (1.0f / 1024.0f) + EPS);
#pragma unroll
        for (int hh = 0; hh < 2; ++hh) {
            const int col = n0 + hh * 64 + 4 * cc; const float rs = rs0 * ((col >= 1024 && col < 1536) ? 0.125f : 1.0f);
            const f32x4 v = (hh ? vb : va) * rs;
            st4bf(proj + (size_t)grow * DIN + col, v);
            float* dst = nullptr;
            if (col >= 1536) dst = out + (col < 1664 ? O_SSK + (size_t)(b * 128 + 124 + t) * 128 + (col - 1536) : O_SSV + (size_t)(b * 128 + 124 + t) * 128 + (col - 1664));
            else if (col < 512 && t >= 1) dst = out + O_SLC + (size_t)(b * 3 + t - 1) * 512 + col;
            if (dst) *(f32x4*)dst = v;
        }
    }
};
template <int MODE> struct SkRes {
    const float* res; float* xout; bf16_t* xb; float* ssq; int mt, n0;
    __device__ __forceinline__ void operator()(int row, int cc, f32x4 va, f32x4 vb) const {
        const int grow = MP + 32 * mt + row; float sq = 0.f;
#pragma unroll
        for (int hh = 0; hh < 2; ++hh) {
            const int col = n0 + hh * 64 + 4 * cc;
            f32x4 v = hh ? vb : va;
            if (MODE == 0) v += *(const f32x4*)(res + (size_t)grow * 1024 + col);
            else { const u32x2 rr = *(const u32x2*)(xb + (size_t)grow * 1024 + col); v += (f32x4){bflo(rr.x), bfhi(rr.x), bflo(rr.y), bfhi(rr.y)}; }
            if (MODE == 2) *(f32x4*)(xout + (size_t)grow * 1024 + col) = v; else st4bf(xb + (size_t)grow * 1024 + col, v);
            sq += (v[0] * v[0] + v[1] * v[1]) + (v[2] * v[2] + v[3] * v[3]);
        }
        if (MODE != 2) {
            sq += __shfl_xor(sq, 1); sq += __shfl_xor(sq, 2); sq += __shfl_xor(sq, 4); sq += __shfl_xor(sq, 8);
            if (cc == 0) __hip_atomic_fetch_add(ssq + grow, sq, __ATOMIC_RELAXED, __HIP_MEMORY_SCOPE_AGENT);
        }
    }
};
struct SkQ {
    bf16_t* qc; const float* ssq; int mt, n0;
    __device__ __forceinline__ void operator()(int row, int cc, f32x4 va, f32x4 vb) const {
        const int grow = MP + 32 * mt + row; const float rs = __builtin_amdgcn_rsqf(ssq[grow] * (1.0f / 1024.0f) + EPS) * 0.08838834764831845f;
        st4bf(qc + (size_t)grow * 512 + n0 + 4 * cc, va * rs); st4bf(qc + (size_t)grow * 512 + n0 + 64 + 4 * cc, vb * rs);
    }
};
struct SkGU {
    bf16_t* h; const float* ssq; const float* wconv; const float* bconv; const float* state; float* out; int mt, ch0;
    __device__ __forceinline__ void operator()(int row, int cc, f32x4 va, f32x4 vb) const {
        const int grow = MP + 32 * mt + row, r2 = grow - MP, bs = r2 >> 2, t = r2 & 3, c = ch0 + 4 * cc;
        const float rs = __builtin_amdgcn_rsqf(ssq[grow] * (1.0f / 1024.0f) + EPS);
        const f32x4 g = va * rs, up = vb * rs;
        f32x4 p1, p2;
#pragma unroll
        for (int j = 0; j < 4; ++j) { p1[j] = __shfl_up(g[j], 16); p2[j] = __shfl_up(g[j], 32); }
        f32x4 s1 = {0.f, 0.f, 0.f, 0.f}, s0 = {0.f, 0.f, 0.f, 0.f};
        if (t < 2) s1 = *(const f32x4*)(state + ((size_t)bs * 2 + 1) * DFF + c);
        if (t == 0) s0 = *(const f32x4*)(state + ((size_t)bs * 2 + 0) * DFF + c);
        const f32x4 g1 = t >= 1 ? p1 : s1, g2 = t >= 2 ? p2 : (t == 1 ? s1 : s0);
        if (t >= 2) *(f32x4*)(out + O_SFC + ((size_t)bs * 2 + (t - 2)) * DFF + c) = g;
        const f32x4 w0 = *(const f32x4*)(wconv + c), w1 = *(const f32x4*)(wconv + DFF + c), w2 = *(const f32x4*)(wconv + 2 * DFF + c), bc = *(const f32x4*)(bconv + c);
        const f32x4 gc = bc + w0 * g2 + w1 * g1 + w2 * g;
        u32x2 wv; wv.x = pkbf(gelu_tanh(gc[0]) * up[0], gelu_tanh(gc[1]) * up[1]); wv.y = pkbf(gelu_tanh(gc[2]) * up[2], gelu_tanh(gc[3]) * up[3]);
        *(u32x2*)(h + (size_t)grow * DFF + c) = wv;
    }
};

__device__ __forceinline__ void ffn_fixup_tile(KA a, int pm, int tid) {
    const float* edge = (const float*)(a->ws + WS_EDGE); bf16_t* hb = (bf16_t*)(a->ws + WS_H);
    const float* wconv = a->in[I_WFC]; const float* bconv = a->in[I_BFC];
#pragma unroll 6
    for (int it = tid; it < 4 * 2 * 768; it += NTHREADS) {
        const int q = it / 1536, rem = it % 1536, rr = rem / 768, c4 = (rem % 768) * 4;
        const int blk = pm * 4 + q; const bool hasprev = (blk & 127) != 0;
        const f32x4 z = {0.f, 0.f, 0.f, 0.f};
        const f32x4 G0 = *(const f32x4*)(edge + ((size_t)blk * 6 + 0) * DFF + c4), G1 = *(const f32x4*)(edge + ((size_t)blk * 6 + 1) * DFF + c4);
        const f32x4 Gm2 = hasprev ? *(const f32x4*)(edge + ((size_t)(blk - 1) * 6 + 2) * DFF + c4) : z, Gm1 = hasprev ? *(const f32x4*)(edge + ((size_t)(blk - 1) * 6 + 3) * DFF + c4) : z;
        const f32x4 U = *(const f32x4*)(edge + ((size_t)blk * 6 + 4 + rr) * DFF + c4);
        const f32x4 w0 = *(const f32x4*)(wconv + c4), w1 = *(const f32x4*)(wconv + DFF + c4), w2 = *(const f32x4*)(wconv + 2 * DFF + c4), bc = *(const f32x4*)(bconv + c4);
        const f32x4 gc = rr == 0 ? (bc + w0 * Gm2 + w1 * Gm1 + w2 * G0) : (bc + w0 * Gm1 + w1 * G0 + w2 * G1);
        u32x2 wv; wv.x = pkbf(gelu_tanh(gc[0]) * U[0], gelu_tanh(gc[1]) * U[1]); wv.y = pkbf(gelu_tanh(gc[2]) * U[2], gelu_tanh(gc[3]) * U[3]);
        *(u32x2*)(hb + ((size_t)blk * 64 + rr) * DFF + c4) = wv;
    }
}

__global__ void __launch_bounds__(NTHREADS, 2) hymba_fwd(Args a_unused) {
    const KA a = (KA)__builtin_amdgcn_kernarg_segment_ptr();
    extern __shared__ __attribute__((aligned(16))) unsigned char smem[];
    const ldsp lds = (ldsp)smem;
    const int tid = threadIdx.x, lane = tid & 63, w = __builtin_amdgcn_readfirstlane(tid >> 6);
    const int G = gridDim.x, bx = blockIdx.x;
    unsigned char* ws = a->ws;
    const int lo = a->ph_lo, hi = a->ph_hi;
#ifndef PHASE_MASK
#define PHASE_MASK 0xfff
#endif
#define IN(k) (((PHASE_MASK >> (k)) & 1) && lo <= (k) && (k) < hi)
#ifndef SREP
#define SREP 0
#endif
#ifndef REP_MASK
#define REP_MASK 0
#endif
#ifndef EXTRA_SYNCS
#define EXTRA_SYNCS 0
#endif
#define REPS(k) (1 + ((REP_MASK >> (k)) & 1))
#ifdef TPROBE
#define TSTAMP(i) do { if (bx == 0 && tid == 0) ((LAS unsigned long long*)(lds + LDS_BYTES - 192))[i] = __builtin_amdgcn_s_memrealtime(); } while (0)
#else
#define TSTAMP(i) do {} while (0)
#endif
#define SEAM(k) do { if (IN(k) && IN((k) + 1)) { XcdBarrier bar_; bar_.bar = g_bar; bar_.x = xb_xcc_id(); bar_.st = (volatile LAS unsigned*)(lds + MISC_OFF); xcd_barrier(bar_); } TSTAMP((k) + 1); } while (0)
    bf16_t* XB = (bf16_t*)(ws + WS_XB);
    if (tid < 16) ((LAS unsigned*)(lds + MISC_OFF))[tid] = 0u;
    __syncthreads();
    (void)xcd_barrier_post(g_bar, (volatile LAS unsigned*)(lds + MISC_OFF));
    if (hi > 1000) cg::this_grid().sync();
    TSTAMP(0);
    if (IN(0)) { for (int rep = 0; rep < REPS(0); ++rep) p0_prologue(a, lds, tid, lane, w); }
    for (int es = 0; es < EXTRA_SYNCS; ++es) { XcdBarrier bar_; bar_.bar = g_bar; bar_.x = xb_xcc_id(); bar_.st = (volatile LAS unsigned*)(lds + MISC_OFF); xcd_barrier(bar_); }
    SEAM(0);
    struct ListOrder { int c, n, base;
        __device__ __forceinline__ bool next(int i, pg8::Unit& u) const { if (i > 0 || c >= n) return false; u.pm = c & 63; u.pn = base + (c >> 6); return true; }
        __device__ __forceinline__ void a_ready(const pg8::Unit&) const {}
        __device__ __forceinline__ void done(const pg8::Unit&) const {} };
    if (IN(1)) for (int rep = 0; rep < REPS(1); ++rep) {
        { for (int srep = 0; srep < 1 + SREP; ++srep) for (int t = G - 1 - bx; t < 16 * 14; t += G) { const int mt = t / 14, nt = t % 14; const bf16_t* Bt = (const bf16_t*)(ws + WS_WIN) + (size_t)(nt * 128) * 1024;
              SkProj P{(bf16_t*)(ws + WS_PROJ), (const float*)(ws + WS_SSQ0), a->out, mt, nt * 128}; sk_tile(lds, XB + (size_t)(MP + 32 * mt) * 1024, 1024, Bt, Bt + 64 * 1024, 1024, P, tid, lane, w); }
          __syncthreads();
          pg8::Gemm g{XB, (const bf16_t*)(ws + WS_WIN), MP, DIN, 1024};
          pg8::EpiProj E{(bf16_t*)(ws + WS_PROJ), (const float*)(ws + WS_SSQ0), a->out};
          ListOrder S{bx, 256, 0}; pg8::gemm_phase<pg8::EpiProj, ListOrder, true, true>(lds, g, S, E); }
    }
    SEAM(1);
#ifdef CPROBE
    const unsigned long long cp_t0 = __builtin_amdgcn_s_memrealtime();
#endif
    if (IN(2)) for (int rep = 0; rep < REPS(2); ++rep) {
        {
            if (bx < 192) { pg8::Gemm g{XB, (const bf16_t*)(ws + WS_WIN), MP, DIN, 1024}; pg8::EpiProj E{(bf16_t*)(ws + WS_PROJ), (const float*)(ws + WS_SSQ0), a->out};
                ListOrder S{bx, 192, 4}; pg8::gemm_phase<pg8::EpiProj, ListOrder, true, true>(lds, g, S, E); }
            else if (bx < 200) { pg8::Gemm g{(const bf16_t*)(ws + WS_MEMA), (const bf16_t*)(ws + WS_WKV), 512, 1024, 1024}; pg8::StaticOrder S; S.init(512, 1024, G, bx - 192);
                pg8::EpiMemKV E{(bf16_t*)(ws + WS_MEMKV), (const float*)(ws + WS_SSQM), a->out};
                pg8::gemm_phase<pg8::EpiMemKV, pg8::StaticOrder, true, true>(lds, g, S, E); }
            if (bx < 192) { lru_unit<false, 1>(a, lds, bx, tid, lane, w); if (bx < 64) lru_unit<false, 1>(a, lds, 192 + bx, tid, lane, w); }
            else if (bx < 200) swa_sample_unit(a, lds, bx - 192, tid);
            else if (bx < 232) { lru_unit<true, 2>(a, lds, bx - 200, tid, lane, w); swa_sample_unit(a, lds, 8 + (bx - 200), tid); swa_sample_unit(a, lds, 40 + (bx - 200), tid); }
            else for (int u = 72 + (bx - 232); u < 128; u += 24) swa_sample_unit(a, lds, u, tid);
        }
    }
    SEAM(2);
    if (IN(3)) for (int rep = 0; rep < REPS(3); ++rep) {
        for (int u = bx; u < 768; u += G) {
            if (u < 256) lru_unit<false, 2>(a, lds, u, tid, lane, w);
            else swa_prompt_unit(a, lds, u - 256, tid, lane, w);
        }
    }
    SEAM(3);
    if (IN(4)) {
        for (int t = G - 1 - bx; t < 128; t += G) { const int mt = t >> 3, nt = t & 7; const bf16_t* Bt = (const bf16_t*)(ws + WS_WOUT) + (size_t)(nt * 128) * 1024;
            SkRes<1> P{nullptr, a->out, XB, (float*)(ws + WS_SSQ1), mt, nt * 128}; sk_tile(lds, (const bf16_t*)(ws + WS_MIX) + (size_t)(MP + 32 * mt) * 1024, 1024, Bt, Bt + 64 * 1024, 1024, P, tid, lane, w); }
        __syncthreads();
        pg8::Gemm g{(const bf16_t*)(ws + WS_MIX), (const bf16_t*)(ws + WS_WOUT), MP, 1024, 1024}; pg8::StaticOrder S; S.init(MP, 1024, G, bx);
        pg8::EpiRes<1> E{nullptr, a->out, XB, (float*)(ws + WS_SSQ1)};
        pg8::gemm_phase<pg8::EpiRes<1>, pg8::StaticOrder, true, true>(lds, g, S, E);

    }
    SEAM(4);
    if (IN(5)) for (int rep = 0; rep < REPS(5); ++rep) {
        for (int srep = 0; srep < 1 + SREP; ++srep) for (int t = G - 1 - bx; t < 64; t += G) { const int mt = t >> 2, nt = t & 3; const bf16_t* Bt = (const bf16_t*)(ws + WS_WQ) + (size_t)(nt * 128) * 1024;
            SkQ P{(bf16_t*)(ws + WS_QC), (const float*)(ws + WS_SSQ1), mt, nt * 128}; sk_tile(lds, XB + (size_t)(MP + 32 * mt) * 1024, 1024, Bt, Bt + 64 * 1024, 1024, P, tid, lane, w); }
        __syncthreads();
        pg8::Gemm g{XB, (const bf16_t*)(ws + WS_WQ), MP, 512, 1024}; pg8::StaticOrder S; S.init(MP, 512, G, bx);
        pg8::EpiQ E{(bf16_t*)(ws + WS_QC), (const float*)(ws + WS_SSQ1)};
        pg8::gemm_phase<pg8::EpiQ, pg8::StaticOrder, true, true>(lds, g, S, E);
    }
    SEAM(5);
    if (IN(6)) for (int rep = 0; rep < REPS(6); ++rep) {
        if (bx & 1) { for (int u = bx + G; u < 768; u += G) xattn_sample_unit(a, lds, u - 256, tid, lane, w); xattn_prompt_unit(a, lds, bx, tid, lane, w); }
        else { xattn_prompt_unit(a, lds, bx, tid, lane, w); for (int u = bx + G; u < 768; u += G) xattn_sample_unit(a, lds, u - 256, tid, lane, w); }
    }
    SEAM(6);
    if (IN(7)) {
        for (int t = G - 1 - bx; t < 128; t += G) { const int mt = t >> 3, nt = t & 7; const bf16_t* Bt = (const bf16_t*)(ws + WS_WMO) + (size_t)(nt * 128) * 512;
            SkRes<1> P{a->out, a->out, XB, (float*)(ws + WS_SSQ2), mt, nt * 128}; sk_tile(lds, (const bf16_t*)(ws + WS_OC) + (size_t)(MP + 32 * mt) * 512, 512, Bt, Bt + 64 * 512, 512, P, tid, lane, w); }
        __syncthreads();
        pg8::Gemm g{(const bf16_t*)(ws + WS_OC), (const bf16_t*)(ws + WS_WMO), MP, 1024, 512}; pg8::StaticOrder S; S.init(MP, 1024, G, bx);
        pg8::EpiRes<1> E{nullptr, a->out, XB, (float*)(ws + WS_SSQ2)};
        pg8::gemm_phase<pg8::EpiRes<1>, pg8::StaticOrder, true, true>(lds, g, S, E);
        if (REPS(7) > 1) { pg8::EpiRes<1, true> E2{nullptr, a->out, XB, (float*)(ws + WS_SSQ2)}; pg8::gemm_phase<pg8::EpiRes<1, true>, pg8::StaticOrder, true, true>(lds, g, S, E2); }
    }
    SEAM(7);
    if (IN(8)) for (int rep = 0; rep < REPS(8); ++rep) {
        for (int srep = 0; srep < 1 + SREP; ++srep) for (int t = G - 1 - bx; t < 16 * 48; t += G) { const int mt = t / 48, cb = t % 48; const bf16_t* Bg = (const bf16_t*)(ws + WS_WGU) + (size_t)((cb >> 1) * 256 + (cb & 1) * 64) * 1024;
            SkGU P{(bf16_t*)(ws + WS_H), (const float*)(ws + WS_SSQ2), a->in[I_WFC], a->in[I_BFC], a->in[I_SFC], a->out, mt, cb * 64}; sk_tile(lds, XB + (size_t)(MP + 32 * mt) * 1024, 1024, Bg, Bg + 128 * 1024, 1024, P, tid, lane, w); }
        __syncthreads();
        pg8::Gemm g{XB, (const bf16_t*)(ws + WS_WGU), MP, 2 * DFF, 1024}; pg8::StaticOrder S; S.init(MP, 2 * DFF, G, bx);
        pg8::EpiGU E{(bf16_t*)(ws + WS_H), (const float*)(ws + WS_SSQ2), (float*)(ws + WS_EDGE), a->in[I_WFC], a->in[I_BFC], a->in[I_SFC], a->out};
        pg8::gemm_phase<pg8::EpiGU, pg8::StaticOrder, true, true>(lds, g, S, E);
    }
    SEAM(8);
    if (IN(9)) {
        for (int t = G - 1 - bx; t < 128; t += G) { const int mt = t >> 3, nt = t & 7; const bf16_t* Bt = (const bf16_t*)(ws + WS_WD) + (size_t)(nt * 128) * DFF;
            SkRes<2> P{a->out, a->out, XB, (float*)(ws + WS_SSQ3), mt, nt * 128}; sk_tile(lds, (const bf16_t*)(ws + WS_H) + (size_t)(MP + 32 * mt) * DFF, DFF, Bt, Bt + 64 * DFF, DFF, P, tid, lane, w); }
        __syncthreads();
        pg8::Gemm g{(const bf16_t*)(ws + WS_H), (const bf16_t*)(ws + WS_WD), MP, 1024, DFF}; pg8::StaticOrder S; S.init(MP, 1024, G, bx);
        pg8::Unit u;
        for (int i = 0; S.next(i, u); ++i) if (u.pm < MP / 256) ffn_fixup_tile(a, u.pm, tid);
        asm volatile("s_waitcnt vmcnt(0)" ::: "memory");
        __syncthreads();
        pg8::EpiRes<2> E{nullptr, a->out, XB, (float*)(ws + WS_SSQ3)};
        pg8::gemm_phase<pg8::EpiRes<2>, pg8::StaticOrder, true, true>(lds, g, S, E);
        if (REPS(9) > 1) { pg8::EpiRes<2, true> E2{nullptr, a->out, XB, (float*)(ws + WS_SSQ3)}; pg8::gemm_phase<pg8::EpiRes<2, true>, pg8::StaticOrder, true, true>(lds, g, S, E2); }
    }
    SEAM(9);
    if (IN(10)) {
        const float* ssq3 = (const float*)(ws + WS_SSQ3); const float* gf = a->in[I_GFIN];
        f32x4 gv[4];
#pragma unroll
        for (int j = 0; j < 4; ++j) gv[j] = *((const f32x4*)gf + lane + 64 * j);
        for (int m0 = bx * NWAVES + w; m0 < MT; m0 += 2 * G * NWAVES) {
            const int m1 = m0 + G * NWAVES; const bool ok1 = m1 < MT;
            f32x4* xr0 = (f32x4*)(a->out + (size_t)m0 * 1024) + lane; f32x4* xr1 = (f32x4*)(a->out + (size_t)(ok1 ? m1 : m0) * 1024) + lane;
            f32x4 v0[4], v1[4]; float s0 = 0.f, s1 = 0.f;
#pragma unroll
            for (int j = 0; j < 4; ++j) { v0[j] = xr0[64 * j]; v1[j] = xr1[64 * j]; }
#pragma unroll
            for (int j = 0; j < 4; ++j) { s0 += (v0[j].x * v0[j].x + v0[j].y * v0[j].y) + (v0[j].z * v0[j].z + v0[j].w * v0[j].w); s1 += (v1[j].x * v1[j].x + v1[j].y * v1[j].y) + (v1[j].z * v1[j].z + v1[j].w * v1[j].w); }
            const float rs0 = __builtin_amdgcn_rsqf(wave_sum(s0) * (1.0f / 1024.0f) + EPS), rs1 = __builtin_amdgcn_rsqf(wave_sum(s1) * (1.0f / 1024.0f) + EPS);
#pragma unroll
            for (int j = 0; j < 4; ++j) xr0[64 * j] = v0[j] * rs0 * gv[j];
            if (ok1) {
#pragma unroll
                for (int j = 0; j < 4; ++j) xr1[64 * j] = v1[j] * rs1 * gv[j];
            }
        }
    }
#ifdef CPROBE
    if (bx == 0) {
        const unsigned* cw = (const unsigned*)(ws + WS_BAR) + CBASE;
        const float eps = (float)__hip_atomic_load(cw + CA, __ATOMIC_RELAXED, __HIP_MEMORY_SCOPE_AGENT) * 1e-5f, dd = (float)__hip_atomic_load(cw + CB, __ATOMIC_RELAXED, __HIP_MEMORY_SCOPE_AGENT) * 1e-4f;
        __syncthreads();
        for (int i = tid; i < 1024; i += NTHREADS) a->out[O_PLH + i] *= (1.0f + eps);
        if (tid == 0) a->out[O_PLC] += dd;
    }
#endif
#ifdef TPROBE
    TSTAMP(11);
    if (bx == 0) {
        __syncthreads();
        const LAS unsigned long long* ts = (const LAS unsigned long long*)(lds + LDS_BYTES - 192);
        const float eps = (float)(ts[TA_HI] - ts[TA_LO]) * 1e-5f, dd = (float)(ts[TB_HI] - ts[TB_LO]) * 1e-4f;
        for (int i = tid; i < 1024; i += NTHREADS) a->out[O_PLH + i] *= (1.0f + eps);
        if (tid == 0) a->out[O_PLC] += dd;
    }
#endif
    {
        __syncthreads();
        if (tid == 0) { const unsigned prev = __hip_atomic_fetch_add(&g_bar[3500], 1u, __ATOMIC_RELAXED, __HIP_MEMORY_SCOPE_AGENT); ((volatile LAS unsigned*)(lds + MISC_OFF))[4] = (prev == (unsigned)G - 1u) ? 1u : 0u; }
        __syncthreads();
        if (((volatile LAS unsigned*)(lds + MISC_OFF))[4]) { for (int i = tid; i < 3520; i += NTHREADS) __hip_atomic_store(&g_bar[i], 0u, __ATOMIC_RELAXED, __HIP_MEMORY_SCOPE_AGENT); }
    }
#undef IN
#undef SEAM
}
constexpr int N_PHASES = 11;

extern "C" void kernel_launch(void* const* d_in, const int* in_sizes, int n_in, void* d_out, int out_size, void* d_ws, size_t ws_size, hipStream_t stream) {
    static int grid = 0;
    if (grid == 0) {
        if (n_in != 34 || ws_size < WS_END) { fprintf(stderr, "kernel_launch: unexpected n_in %d / ws %zu\n", n_in, ws_size); grid = -1; return; }
        int dev = 0, cus = 0, per_cu = 0;
        if (hipGetDevice(&dev) != hipSuccess || hipDeviceGetAttribute(&cus, hipDeviceAttributeMultiprocessorCount, dev) != hipSuccess) { grid = -1; return; }
        if (hipFuncSetAttribute((const void*)hymba_fwd, hipFuncAttributeMaxDynamicSharedMemorySize, LDS_BYTES) != hipSuccess) { fprintf(stderr, "kernel_launch: hipFuncSetAttribute failed\n"); grid = -1; return; }
        if (hipOccupancyMaxActiveBlocksPerMultiprocessor(&per_cu, (const void*)hymba_fwd, NTHREADS, LDS_BYTES) != hipSuccess || per_cu < 1) { fprintf(stderr, "kernel_launch: occupancy query says %d\n", per_cu); per_cu = 1; }
        (void)hipGetLastError();
        grid = cus;
        if (cus != 256) { fprintf(stderr, "kernel_launch: built for a 256-CU device, found %d CUs; nothing launched\n", cus); grid = -1; return; }
    }
    if (grid < 0) return;
    Args a{};
    for (int i = 0; i < 34; ++i) a.in[i] = (const float*)d_in[i];
    a.out = (float*)d_out; a.ws = (unsigned char*)d_ws;
#if defined(CPROBE)
    if (hipMemsetAsync((char*)d_ws + WS_BAR, 0, BAR_ZERO_BYTES, stream) != hipSuccess) { fprintf(stderr, "kernel_launch: memset failed\n"); return; }
#endif
#if MK_N_LAUNCHES == 1
    a.ph_lo = 0; a.ph_hi = N_PHASES;
    void* args[] = {&a};
    hipError_t e = hipLaunchCooperativeKernel((const void*)hymba_fwd, dim3(grid), dim3(NTHREADS), args, LDS_BYTES, stream);
    if (e != hipSuccess) fprintf(stderr, "kernel_launch: cooperative launch failed: %s (grid %d)\n", hipGetErrorString(e), grid);
#else
    for (int p = 0; p < N_PHASES; ++p) { a.ph_lo = p; a.ph_hi = p + 1; hipLaunchKernelGGL(hymba_fwd, dim3(grid), dim3(NTHREADS), LDS_BYTES, stream, a); }
#endif
}
```
